# Optimizing an MI355X kernel written in HIP

```python
import jax
import jax.numpy as jnp
from jax import lax
import numpy as np

D_MODEL = 2048
BATCH = 16
SEQ = 2048
DEPTH = 2

HEAD_DIM = 64
NORM_EPS = 1e-6
FFN_HIDDEN = ((8 * D_MODEL + 3 * 256 - 1) // (3 * 256)) * 256

MOBA_HEADS = D_MODEL // (2 * HEAD_DIM)
MOBA_BLOCK = 256
MOBA_TOPK = 3
MOBA_Q_CHUNK = 16
RWKV_HEADS = D_MODEL // (2 * HEAD_DIM)
RWKV_DECAY_LORA = 64
RWKV_ICLR_LORA = 64
RWKV_GATE_LORA = 128
RWKV_GN_EPS = 6.4e-4
MOBA_W = MOBA_HEADS * HEAD_DIM
RWKV_W = RWKV_HEADS * HEAD_DIM
RWKV_SPLITS = (RWKV_W, RWKV_W, RWKV_W, RWKV_DECAY_LORA, RWKV_ICLR_LORA, RWKV_GATE_LORA)
RWKV_SHIFT_W = sum(RWKV_SPLITS)
EVEN_SPLITS = (MOBA_W, MOBA_W, MOBA_W, RWKV_SHIFT_W)
EVEN_IN = sum(EVEN_SPLITS)

RET_QK_DIM = HEAD_DIM
RET_V_DIM = 2 * HEAD_DIM
RET_HEADS = D_MODEL // (2 * RET_V_DIM)
RET_CHUNK = 128
RET_GN_EPS = 1e-6
ROPE_BASE = 10000.0
RET_W = RET_HEADS * RET_V_DIM
NSA_HEADS = D_MODEL // (2 * HEAD_DIM)
NSA_KV_GROUPS = 4
NSA_CMP_BLOCK = 32
NSA_CMP_STRIDE = 16
NSA_CMP_HIDDEN = 128
NSA_SLC_BLOCK = 64
NSA_SLC_TOPN = 16
NSA_WINDOW = 512
NSA_Q_CHUNK = 32
WIN_Q_BLOCK = 128
NSA_W = NSA_HEADS * HEAD_DIM
NSA_KV_W = NSA_KV_GROUPS * HEAD_DIM
ODD_SPLITS = (RET_HEADS * RET_QK_DIM, RET_HEADS * RET_QK_DIM, RET_W, RET_W, NSA_W) + (NSA_KV_W,) * 6 + (3 * NSA_HEADS,)
ODD_IN = sum(ODD_SPLITS)
N_EVEN = (DEPTH + 1) // 2
N_ODD = DEPTH // 2

kernel_name = 'moba_rwkv7_retnet_nsa_hybrid'


def split_cols(z, sizes):
    return jnp.split(z, [int(c) for c in np.cumsum(sizes)[:-1]], axis=-1)


def rms_norm(x, g):
    xf = x.astype(jnp.float32)
    y = xf * lax.rsqrt(jnp.mean(xf * xf, axis=-1, keepdims=True) + NORM_EPS)
    return (y * g.astype(jnp.float32)).astype(x.dtype)


def head_group_norm(y, eps):
    yf = y.astype(jnp.float32)
    mu = jnp.mean(yf, axis=-1, keepdims=True)
    var = jnp.mean(jnp.square(yf - mu), axis=-1, keepdims=True)
    return (yf - mu) * lax.rsqrt(var + eps)


def masked_softmax(s, mask):
    s = jnp.where(mask, s.astype(jnp.float32), -jnp.inf)
    m = jnp.max(s, axis=-1, keepdims=True)
    p = jnp.exp(s - jnp.where(jnp.isfinite(m), m, 0.0))
    den = jnp.sum(p, axis=-1, keepdims=True)
    return p / jnp.where(den > 0.0, den, 1.0)


def token_shift(z):
    return jnp.pad(z[:, :-1], ((0, 0), (1, 0), (0, 0)))


def swiglu(h, w1, w3, w2):
    return (jax.nn.silu(h @ w1) * (h @ w3)) @ w2


def rotary(z):
    S, d = z.shape[1], z.shape[-1]
    half = d // 2
    inv = ROPE_BASE ** (-jnp.arange(half, dtype=jnp.float32) / half)
    ang = jnp.arange(S, dtype=jnp.float32)[:, None] * inv
    cos, sin = jnp.cos(ang)[None, :, None, :], jnp.sin(ang)[None, :, None, :]
    z1, z2 = z[..., :half], z[..., half:]
    return jnp.concatenate([z1 * cos - z2 * sin, z1 * sin + z2 * cos], axis=-1)


def moba_attention(q, k, v):
    B, S, H, Dh = q.shape
    L, Qc = MOBA_BLOCK, MOBA_Q_CHUNK
    nb = -(-S // L)
    n_sel = min(MOBA_TOPK, nb - 1)
    nq = S // Qc
    pad = nb * L - S
    qh = q.transpose(0, 2, 1, 3) * (Dh ** -0.5)
    pad_blocks = lambda z: jnp.pad(z.transpose(0, 2, 1, 3), ((0, 0), (0, 0), (0, pad), (0, 0))).reshape(B, H, nb, L, Dh)
    kb, vb = pad_blocks(k), pad_blocks(v)
    to_chunks = lambda z: jnp.moveaxis(z.reshape(B, H, nq, Qc, *z.shape[3:]), 2, 0)
    xs = [jnp.arange(nq), to_chunks(qh)]
    if n_sel > 0:
        t = jnp.arange(S)
        gate = jnp.einsum('bhtd,bhnd->bhtn', qh, jnp.mean(kb, axis=3)).astype(jnp.float32)
        past = jnp.arange(nb)[None, :] < (t // L)[:, None]
        sel_score, sel_idx = lax.top_k(jnp.where(past, gate, -jnp.inf), n_sel)
        xs += [to_chunks(sel_idx), to_chunks(sel_score > -jnp.inf)]
    bi = jnp.arange(B)[:, None, None, None]
    hi = jnp.arange(H)[None, :, None, None]

    def chunk(args):
        c, q_c = args[0], args[1]
        t_c = c * Qc + jnp.arange(Qc)
        blk = (c * Qc) // L
        k_own = lax.dynamic_index_in_dim(kb, blk, axis=2, keepdims=False)
        v_own = lax.dynamic_index_in_dim(vb, blk, axis=2, keepdims=False)
        scores = [jnp.einsum('bhqd,bhld->bhql', q_c, k_own)]
        masks = [jnp.broadcast_to(blk * L + jnp.arange(L) <= t_c[:, None], (B, H, Qc, L))]
        if n_sel > 0:
            idx_c, ok_c = args[2], args[3]
            k_sel = kb[bi, hi, idx_c]
            v_sel = vb[bi, hi, idx_c]
            scores.append(jnp.einsum('bhqd,bhqnld->bhqnl', q_c, k_sel).reshape(B, H, Qc, n_sel * L))
            masks.append(jnp.repeat(ok_c, L, axis=-1))
        p = masked_softmax(jnp.concatenate(scores, axis=-1), jnp.concatenate(masks, axis=-1))
        out = jnp.einsum('bhql,bhld->bhqd', p[..., :L], v_own)
        if n_sel > 0:
            out = out + jnp.einsum('bhqnl,bhqnld->bhqd', p[..., L:].reshape(B, H, Qc, n_sel, L), v_sel)
        return out

    o = lax.map(chunk, tuple(xs))
    o = jnp.moveaxis(o, 0, 2).reshape(B, H, S, Dh)
    return o.transpose(0, 2, 1, 3).reshape(B, S, H * Dh)


def rwkv7_time_mix(r, k, v, w_lo, a_lo, g_lo, w0, w_up, a0, a_up, g_up, k_k, k_a, r_k, ln_g, ln_b):
    B, S, C = r.shape
    H, N = RWKV_HEADS, C // RWKV_HEADS
    f32 = jnp.float32
    w = -jax.nn.softplus(-(w0 + jnp.tanh(w_lo) @ w_up)) - 0.5
    decay = jnp.exp(-jnp.exp(w.astype(f32)))
    a = jax.nn.sigmoid(a0 + a_lo @ a_up)
    g = jax.nn.sigmoid(g_lo) @ g_up
    hd = lambda u: u.reshape(B, S, H, N).astype(f32)
    kk = hd(k * k_k)
    kk = kk / jnp.maximum(jnp.sqrt(jnp.sum(kk * kk, axis=-1, keepdims=True)), 1e-12)
    k = k * (1.0 + (a - 1.0) * k_a)
    rh, kh, vh, ah, wh = hd(r), hd(k), hd(v), hd(a), hd(decay)

    def step(state, inp):
        r_t, w_t, k_t, v_t, kk_t, a_t = inp
        sa = jnp.einsum('bhij,bhj->bhi', state, -kk_t)
        state = (state * w_t[:, :, None, :]
                 + sa[..., None] * (kk_t * a_t)[:, :, None, :]
                 + v_t[..., None] * k_t[:, :, None, :])
        return state, jnp.einsum('bhij,bhj->bhi', state, r_t)

    xs = tuple(jnp.moveaxis(u, 1, 0) for u in (rh, wh, kh, vh, kk, ah))
    _, y = lax.scan(step, jnp.zeros((B, H, N, N), f32), xs)
    y = jnp.moveaxis(y, 0, 1)
    y = head_group_norm(y, RWKV_GN_EPS) * ln_g.reshape(H, N) + ln_b.reshape(H, N)
    bonus = jnp.sum(rh * kh * r_k, axis=-1, keepdims=True) * vh
    return ((y + bonus).reshape(B, S, C) * g).astype(r.dtype)


def retention(q, k, v):
    B, S, H, dk = q.shape
    dv = v.shape[-1]
    C = RET_CHUNK
    nc = S // C
    f32 = jnp.float32
    q = rotary(q.astype(f32))
    k = rotary(k.astype(f32)) * (dk ** -0.5)
    v = v.astype(f32)
    log_g = jnp.asarray(np.log(1.0 - 2.0 ** (-5.0 - np.arange(H))), f32)
    n = jnp.arange(C, dtype=f32)
    diff = n[:, None] - n[None, :]
    decay_in = jnp.where(diff >= 0, jnp.exp(jnp.maximum(diff, 0.0) * log_g[:, None, None]), 0.0)
    decay_q = jnp.exp((n + 1.0) * log_g[:, None])[None, :, :, None]
    decay_k = jnp.exp((C - 1.0 - n) * log_g[:, None])[None, :, :, None]
    decay_c = jnp.exp(C * log_g)[None, :, None, None]
    chunks = lambda z: z.reshape(B, nc, C, H, z.shape[-1]).transpose(1, 0, 3, 2, 4)

    def step(state, inp):
        qi, ki, vi = inp
        inner = jnp.einsum('bhnd,bhmd->bhnm', qi, ki) * decay_in
        o = jnp.einsum('bhnm,bhme->bhne', inner, vi) + jnp.einsum('bhnd,bhde->bhne', qi, state) * decay_q
        state = jnp.einsum('bhmd,bhme->bhde', ki * decay_k, vi) + decay_c * state
        return state, o

    _, o = lax.scan(step, jnp.zeros((B, H, dk, dv), f32), (chunks(q), chunks(k), chunks(v)))
    o = o.transpose(1, 0, 3, 2, 4).reshape(B, S, H, dv)
    return head_group_norm(o, RET_GN_EPS)


def nsa_attention(q, k_cmp_in, v_cmp_in, k_slc, v_slc, k_win, v_win, gates, pe_k, w1_k, w2_k, pe_v, w1_v, w2_v):
    B, S, H, Dh = q.shape
    G = NSA_KV_GROUPS
    R = H // G
    Lc, st, Ls, W = NSA_CMP_BLOCK, NSA_CMP_STRIDE, NSA_SLC_BLOCK, NSA_WINDOW
    t = jnp.arange(S)
    qg = (q * (Dh ** -0.5)).reshape(B, S, G, R, Dh).transpose(0, 2, 3, 1, 4)
    kv = lambda z: z.transpose(0, 2, 1, 3)

    nc = (S - Lc) // st + 1
    c_start = np.arange(nc) * st
    c_idx = c_start[:, None] + np.arange(Lc)[None, :]

    def compress(z, pe, w1, w2):
        blocks = kv(z)[:, :, c_idx] + pe
        return jax.nn.gelu(blocks.reshape(B, G, nc, Lc * Dh) @ w1) @ w2

    k_c = compress(k_cmp_in, pe_k, w1_k, w2_k)
    v_c = compress(v_cmp_in, pe_v, w1_v, w2_v)
    c_end = jnp.asarray(c_start + Lc - 1)
    p_cmp = masked_softmax(jnp.einsum('bgrtd,bgcd->bgrtc', qg, k_c), c_end[None, :] <= t[:, None])
    o_cmp = jnp.einsum('bgrtc,bgcd->bgrtd', p_cmp, v_c)

    ns = S // Ls
    s_start = np.arange(ns) * Ls
    overlap = ((c_start[:, None] <= s_start[None, :] + Ls - 1)
               & (c_start[:, None] + Lc - 1 >= s_start[None, :])).astype(np.float32)
    p_slc = jnp.einsum('bgrtc,cj->bgtj', p_cmp, jnp.asarray(overlap))
    j = jnp.arange(ns)[None, :]
    own = (t // Ls)[:, None]
    score = jnp.where((j == own) | (j == 0), jnp.inf, jnp.where(j > own, -jnp.inf, p_slc))
    n_top = min(NSA_SLC_TOPN, ns)
    sel_score, sel_idx = lax.top_k(score, n_top)
    sel_ok = sel_score > -jnp.inf
    ks_b = kv(k_slc).reshape(B, G, ns, Ls, Dh)
    vs_b = kv(v_slc).reshape(B, G, ns, Ls, Dh)
    Qc = NSA_Q_CHUNK
    nq = S // Qc
    bi = jnp.arange(B)[:, None, None, None]
    gi = jnp.arange(G)[None, :, None, None]

    def sel_chunk(args):
        c, q_c, idx_c, ok_c = args
        t_c = c * Qc + jnp.arange(Qc)
        k_s = ks_b[bi, gi, idx_c]
        v_s = vs_b[bi, gi, idx_c]
        pos = idx_c[..., None] * Ls + jnp.arange(Ls)
        mask = ok_c[..., None] & (pos <= t_c[None, None, :, None, None])
        s = jnp.einsum('bgrqd,bgqnld->bgrqnl', q_c, k_s).reshape(B, G, R, Qc, n_top * Ls)
        p = masked_softmax(s, mask.reshape(B, G, 1, Qc, n_top * Ls))
        return jnp.einsum('bgrqnl,bgqnld->bgrqd', p.reshape(B, G, R, Qc, n_top, Ls), v_s)

    o_slc = lax.map(sel_chunk, (jnp.arange(nq),
                                jnp.moveaxis(qg.reshape(B, G, R, nq, Qc, Dh), 3, 0),
                                jnp.moveaxis(sel_idx.reshape(B, G, nq, Qc, n_top), 2, 0),
                                jnp.moveaxis(sel_ok.reshape(B, G, nq, Qc, n_top), 2, 0)))
    o_slc = jnp.moveaxis(o_slc, 0, 3).reshape(B, G, R, S, Dh)

    Qw = WIN_Q_BLOCK
    nw = S // Qw
    kw_p = jnp.pad(kv(k_win), ((0, 0), (0, 0), (W, 0), (0, 0)))
    vw_p = jnp.pad(kv(v_win), ((0, 0), (0, 0), (W, 0), (0, 0)))

    def win_block(args):
        c, q_c = args
        s0 = c * Qw
        k_w = lax.dynamic_slice_in_dim(kw_p, s0, Qw + W, axis=2)
        v_w = lax.dynamic_slice_in_dim(vw_p, s0, Qw + W, axis=2)
        t_c = s0 + jnp.arange(Qw)
        s_pos = s0 - W + jnp.arange(Qw + W)
        d = t_c[:, None] - s_pos[None, :]
        mask = (d >= 0) & (d < W) & (s_pos[None, :] >= 0)
        p = masked_softmax(jnp.einsum('bgrqd,bgkd->bgrqk', q_c, k_w), mask)
        return jnp.einsum('bgrqk,bgkd->bgrqd', p, v_w)

    o_win = lax.map(win_block, (jnp.arange(nw), jnp.moveaxis(qg.reshape(B, G, R, nw, Qw, Dh), 3, 0)))
    o_win = jnp.moveaxis(o_win, 0, 3).reshape(B, G, R, S, Dh)

    g = jnp.moveaxis(gates, 1, 2).reshape(B, G, R, S, 3)
    o = g[..., 0:1] * o_cmp + g[..., 1:2] * o_slc + g[..., 2:3] * o_win
    return o.reshape(B, H, S, Dh).transpose(0, 2, 1, 3).reshape(B, S, H * Dh)


def even_mixer(h, w_in, shift_mu, w0, w_up, a0, a_up, g_up, k_k, k_a, r_k, ln_g, ln_b, w_out):
    B, S, _ = h.shape
    qa, ka, va, zb = split_cols(h @ w_in, EVEN_SPLITS)
    heads = lambda u: u.reshape(B, S, -1, HEAD_DIM)
    o_a = moba_attention(heads(qa), heads(ka), heads(va))
    zb = zb + (token_shift(zb) - zb) * shift_mu
    r, kb, vb, w_lo, a_lo, g_lo = split_cols(zb, RWKV_SPLITS)
    o_b = rwkv7_time_mix(r, kb, vb, w_lo, a_lo, g_lo, w0, w_up, a0, a_up, g_up, k_k, k_a, r_k, ln_g, ln_b)
    return (jnp.concatenate([o_a, o_b], axis=-1) @ w_out).astype(h.dtype)


def odd_mixer(h, w_in, pe_k, w1_k, w2_k, pe_v, w1_v, w2_v, w_out):
    B, S, _ = h.shape
    rq, rk, rv, rg, nq, kc, vc, ks, vs, kw, vw, ng = split_cols(h @ w_in, ODD_SPLITS)
    o_c = retention(rq.reshape(B, S, RET_HEADS, RET_QK_DIM), rk.reshape(B, S, RET_HEADS, RET_QK_DIM),
                    rv.reshape(B, S, RET_HEADS, RET_V_DIM))
    o_c = jax.nn.silu(rg) * o_c.reshape(B, S, RET_W)
    hd = lambda u: u.reshape(B, S, -1, HEAD_DIM)
    gates = jax.nn.sigmoid(ng.reshape(B, S, NSA_HEADS, 3))
    o_d = nsa_attention(hd(nq), hd(kc), hd(vc), hd(ks), hd(vs), hd(kw), hd(vw), gates,
                        pe_k, w1_k, w2_k, pe_v, w1_v, w2_v)
    return (jnp.concatenate([o_c, o_d], axis=-1) @ w_out).astype(h.dtype)


def setup_inputs(seed: int = 0) -> dict:
    key = jax.random.key(seed)
    keys = list(jax.random.split(key, 32))

    def nrm(shape, scale):
        return jax.random.normal(keys.pop(), shape, jnp.float32) * scale

    def uni(shape, lo, hi):
        return jax.random.uniform(keys.pop(), shape, jnp.float32, lo, hi)

    E, O, D = N_EVEN, N_ODD, D_MODEL
    cmp_in = NSA_CMP_BLOCK * HEAD_DIM
    return {
        'x': nrm((BATCH, SEQ, D), 1.0),
        'mix_norm': 1.0 + nrm((DEPTH, D), 0.02),
        'ffn_norm': 1.0 + nrm((DEPTH, D), 0.02),
        'even_w_in': nrm((E, D, EVEN_IN), D ** -0.5),
        'even_shift_mu': uni((E, RWKV_SHIFT_W), 0.0, 1.0),
        'even_w0': uni((E, RWKV_W), -6.0, -1.0),
        'even_w_up': nrm((E, RWKV_DECAY_LORA, RWKV_W), 0.1 * RWKV_DECAY_LORA ** -0.5),
        'even_a0': nrm((E, RWKV_W), 0.1),
        'even_a_up': nrm((E, RWKV_ICLR_LORA, RWKV_W), 0.1 * RWKV_ICLR_LORA ** -0.5),
        'even_g_up': nrm((E, RWKV_GATE_LORA, RWKV_W), RWKV_GATE_LORA ** -0.5),
        'even_k_k': 0.85 + nrm((E, RWKV_W), 0.05),
        'even_k_a': 1.0 + nrm((E, RWKV_W), 0.05),
        'even_r_k': nrm((E, RWKV_HEADS, HEAD_DIM), 0.1),
        'even_ln_g': 1.0 + nrm((E, RWKV_W), 0.02),
        'even_ln_b': nrm((E, RWKV_W), 0.02),
        'even_w_out': nrm((E, MOBA_W + RWKV_W, D), (MOBA_W + RWKV_W) ** -0.5),
        'odd_w_in': nrm((O, D, ODD_IN), D ** -0.5),
        'odd_cmp_pe_k': nrm((O, NSA_CMP_BLOCK, HEAD_DIM), 0.02),
        'odd_cmp_w1_k': nrm((O, cmp_in, NSA_CMP_HIDDEN), cmp_in ** -0.5),
        'odd_cmp_w2_k': nrm((O, NSA_CMP_HIDDEN, HEAD_DIM), NSA_CMP_HIDDEN ** -0.5),
        'odd_cmp_pe_v': nrm((O, NSA_CMP_BLOCK, HEAD_DIM), 0.02),
        'odd_cmp_w1_v': nrm((O, cmp_in, NSA_CMP_HIDDEN), cmp_in ** -0.5),
        'odd_cmp_w2_v': nrm((O, NSA_CMP_HIDDEN, HEAD_DIM), NSA_CMP_HIDDEN ** -0.5),
        'odd_w_out': nrm((O, RET_W + NSA_W, D), (RET_W + NSA_W) ** -0.5),
        'ffn_w1': nrm((DEPTH, D, FFN_HIDDEN), D ** -0.5),
        'ffn_w3': nrm((DEPTH, D, FFN_HIDDEN), D ** -0.5),
        'ffn_w2': nrm((DEPTH, FFN_HIDDEN, D), FFN_HIDDEN ** -0.5),
        'final_norm': 1.0 + nrm((D,), 0.02),
    }


def reference(x, mix_norm, ffn_norm, even_w_in, even_shift_mu, even_w0, even_w_up, even_a0, even_a_up,
              even_g_up, even_k_k, even_k_a, even_r_k, even_ln_g, even_ln_b, even_w_out, odd_w_in,
              odd_cmp_pe_k, odd_cmp_w1_k, odd_cmp_w2_k, odd_cmp_pe_v, odd_cmp_w1_v, odd_cmp_w2_v, odd_w_out,
              ffn_w1, ffn_w3, ffn_w2, final_norm):
    for layer in range(DEPTH):
        i = layer // 2
        h = rms_norm(x, mix_norm[layer])
        if layer % 2 == 0:
            mix = even_mixer(h, even_w_in[i], even_shift_mu[i], even_w0[i], even_w_up[i], even_a0[i],
                             even_a_up[i], even_g_up[i], even_k_k[i], even_k_a[i], even_r_k[i],
                             even_ln_g[i], even_ln_b[i], even_w_out[i])
        else:
            mix = odd_mixer(h, odd_w_in[i], odd_cmp_pe_k[i], odd_cmp_w1_k[i], odd_cmp_w2_k[i],
                            odd_cmp_pe_v[i], odd_cmp_w1_v[i], odd_cmp_w2_v[i], odd_w_out[i])
        x = x + mix
        x = x + swiglu(rms_norm(x, ffn_norm[layer]), ffn_w1[layer], ffn_w3[layer], ffn_w2[layer]).astype(x.dtype)
    return rms_norm(x, final_norm)
```

```cpp
#include <hip/hip_runtime.h>
#include <hip/hip_cooperative_groups.h>
#include <cstdio>
#include <cmath>
namespace cg = cooperative_groups;
namespace pg8 {
#define PG8_LAS __attribute__((address_space(3)))
typedef unsigned short bf16_t;
typedef short bf16x8 __attribute__((ext_vector_type(8)));
typedef float f32x4 __attribute__((ext_vector_type(4)));
typedef unsigned u32x4 __attribute__((ext_vector_type(4)));
constexpr int BM = 256, BK = 64, HALF = 128, HTB = HALF * BK * 2  , STAGE_BYTES = 8 * HTB, NXCD = 8, WGM = 8;

__host__ __device__ __forceinline__ int lds_byte(int r, int c) { const int st = (r >> 4) * 2 + (c >> 5), rr = r & 15, cc = c & 31, ob = rr * 64 + cc * 2; return st * 1024 + (ob ^ (((ob >> 9) & 1) << 5)); }
__host__ __device__ __forceinline__ void stage_rc(int b, int& R, int& C) { const int st = b / 1024, sb = b % 1024, swz = sb ^ (((sb >> 9) & 1) << 5); R = (st >> 1) * 16 + swz / 64; C = (st & 1) * 32 + (swz % 64) / 2; }
__host__ __device__ __forceinline__ int perm32(int rho) { const int n = rho >> 4, i = rho & 15; return 8 * (i >> 2) + 4 * n + (i & 3); }

struct Unit { int pm, pn; };
struct Gemm { const bf16_t* A; const bf16_t* Bt; int M, N, K; };

struct StaticOrder {
    int nM, nN, nwg, G, c;
    __host__ __device__ void init(int M, int N, int G_, int c_) { nM = M / BM; nN = N / BM; nwg = nM * nN; G = G_; c = c_; }
    __host__ __device__ bool next(int i, Unit& u) const {
        const long L = (long)i * G + c; if (L >= nwg) return false;
        int wgid = (int)L; { const int q = nwg / NXCD, r = nwg % NXCD, xcd = wgid % NXCD, off = wgid / NXCD; wgid = (xcd < r ? xcd * (q + 1) : r * (q + 1) + (xcd - r) * q) + off; }
        const int nig = WGM * nN, gid = wgid / nig, fm = gid * WGM, gsz = (nM - fm) < WGM ? (nM - fm) : WGM;
        u.pm = fm + ((wgid % nig) % gsz); u.pn = (wgid % nig) / gsz; return true;
    }
    __device__ __forceinline__ void a_ready(const Unit&) const {}
    __device__ __forceinline__ void done(const Unit&) const {}
};
__device__ __forceinline__ unsigned cvt_pk_bf16(float lo, float hi) { unsigned r; asm volatile("v_cvt_pk_bf16_f32 %0, %1, %2" : "=v"(r) : "v"(lo), "v"(hi)); return r; }
template <class Epi, class Sched, bool STAMP = false>
__device__ __forceinline__ void gemm_phase(PG8_LAS unsigned char* lds, const Gemm g, const Sched& S, const Epi& E, unsigned long long* stamps) {
    int tid = threadIdx.x; asm volatile("" : "+v"(tid)); const int wid = __builtin_amdgcn_readfirstlane(tid >> 6), lane = tid & 63, wr = wid >> 2, wc = wid & 3, fr = lane & 15, fq = lane >> 4;
    const int K = g.K, nt = K / BK;
    int ts_lo = 0, ts_hi = 0, nts = 0; const unsigned long long rt_entry = STAMP ? (unsigned long long)wall_clock64() : 0ull;
#define PG8_STAMP() do { if (STAMP && wid == 0 && nts < 64) { const unsigned long long _c = (unsigned long long)clock64(); \
        ts_lo = (lane == nts) ? (int)(unsigned)_c : ts_lo; ts_hi = (lane == nts) ? (int)(unsigned)(_c >> 32) : ts_hi; ++nts; } } while (0)
    PG8_STAMP();
    unsigned voffA[2], voffB[2];
#pragma unroll
    for (int i = 0; i < 2; ++i) { int R, C; stage_rc(tid * 16 + i * 8192, R, C); const int Rb = Epi::PERM ? ((R & ~31) + perm32(R & 31)) : R;
        voffA[i] = (unsigned)(R * K + C) * 2u; voffB[i] = (unsigned)(Rb * K + C) * 2u; }
    const size_t kstep = (size_t)(BK * 2);
    const size_t hstep = (size_t)HALF * K * 2;
    const size_t tstep = 2 * hstep;
    const unsigned ldsw = (unsigned)wid * 1024u;
    const int aoff = lds_byte(wr * 64 + fr, fq * 8), boff = lds_byte(wc * 32 + fr, fq * 8);
#define PG8_SA(b, h) (((b) * 2 + (h)) * HTB)
#define PG8_SB(b, h) ((4 + (b) * 2 + (h)) * HTB)
#define PG8_STAGE(bufoff, gbase, voff) do { _Pragma("unroll") for (int _i = 0; _i < 2; ++_i) \
        __builtin_amdgcn_global_load_lds((const unsigned*)((const char*)(gbase) + (voff)[_i]), (PG8_LAS unsigned*)(lds + (bufoff) + ldsw + _i * 8192), 16, 0, 0); } while (0)
#define PG8_LDA(dst, b, h) do { _Pragma("unroll") for (int m = 0; m < 4; ++m) _Pragma("unroll") for (int k = 0; k < 2; ++k) dst[m][k] = *(const PG8_LAS bf16x8*)(lds + PG8_SA(b, h) + aoff + m * 2048 + k * 1024); } while (0)
#define PG8_LDB(dst, b, h) do { _Pragma("unroll") for (int n = 0; n < 2; ++n) _Pragma("unroll") for (int k = 0; k < 2; ++k) dst[n][k] = *(const PG8_LAS bf16x8*)(lds + PG8_SB(b, h) + boff + n * 2048 + k * 1024); } while (0)
#define PG8_MMA(ai, bj, At, Bt) do { __builtin_amdgcn_s_setprio(1); _Pragma("unroll") for (int m = 0; m < 4; ++m) _Pragma("unroll") for (int n = 0; n < 2; ++n) _Pragma("unroll") for (int k = 0; k < 2; ++k) \
        acc[ai][bj][m][n] = __builtin_amdgcn_mfma_f32_16x16x32_bf16(Bt[n][k], At[m][k], acc[ai][bj][m][n], 0, 0, 0); __builtin_amdgcn_s_setprio(0); } while (0)
#define PG8_WAIT_V(n) asm volatile("s_waitcnt vmcnt(" #n ")" ::: "memory")
#define PG8_WAIT_L(n) asm volatile("s_waitcnt lgkmcnt(" #n ")" ::: "memory")
#define PG8_BAR __builtin_amdgcn_s_barrier()
#define PG8_SCHED __builtin_amdgcn_sched_barrier(0)
    Unit cur, nxt; int ui = 0;
    if (!S.next(0, cur)) return;
    f32x4 acc[2][2][4][2];
#pragma unroll
    for (int a = 0; a < 2; ++a)
#pragma unroll
        for (int b = 0; b < 2; ++b)
#pragma unroll
            for (int m = 0; m < 4; ++m)
#pragma unroll
                for (int n = 0; n < 2; ++n) acc[a][b][m][n] = (f32x4){0.f, 0.f, 0.f, 0.f};
    bf16x8 At[4][2], B0[2][2], B1[2][2];
    const char* cA = (const char*)g.A + (size_t)cur.pm * tstep; const char* cB = (const char*)g.Bt + (size_t)cur.pn * tstep;
    S.a_ready(cur);
    PG8_STAGE(PG8_SB(0, 0), cB, voffB); PG8_STAGE(PG8_SA(0, 0), cA, voffA); PG8_STAGE(PG8_SB(0, 1), cB + hstep, voffB); PG8_STAGE(PG8_SA(0, 1), cA + hstep, voffA);
    if (wr == 1) PG8_BAR;
    PG8_WAIT_V(4); PG8_BAR;
    PG8_STAGE(PG8_SB(1, 0), cB + kstep, voffB); PG8_STAGE(PG8_SA(1, 0), cA + kstep, voffA); PG8_STAGE(PG8_SB(1, 1), cB + hstep + kstep, voffB);
    PG8_WAIT_V(6); PG8_BAR;
    PG8_STAMP();
    for (;;) {
        const bool has_next = S.next(ui + 1, nxt);
        const char* nA = has_next ? (const char*)g.A + (size_t)nxt.pm * tstep : cA; const char* nB = has_next ? (const char*)g.Bt + (size_t)nxt.pn * tstep : cB;
        for (int t = 0; t < nt; t += 2) {
            const bool last = (t == nt - 2);
            const char* a1 = cA + (size_t)(t + 1) * kstep;
            const char* a2 = last ? nA : cA + (size_t)(t + 2) * kstep; const char* b2 = last ? nB : cB + (size_t)(t + 2) * kstep;
            const char* a3 = a2 + kstep; const char* b3 = b2 + kstep;
            if (last && has_next) S.a_ready(nxt);
            PG8_LDB(B0, 0, 0); PG8_SCHED; PG8_LDA(At, 0, 0); PG8_STAGE(PG8_SA(1, 1), a1 + hstep, voffA);
            PG8_WAIT_L(8); PG8_BAR; PG8_WAIT_L(0); PG8_MMA(0, 0, At, B0); PG8_BAR; PG8_SCHED;
            PG8_LDB(B1, 0, 1); PG8_STAGE(PG8_SB(0, 0), b2, voffB);
            PG8_BAR; PG8_WAIT_L(0); PG8_MMA(0, 1, At, B1); PG8_BAR;
            PG8_LDA(At, 0, 1); PG8_STAGE(PG8_SA(0, 0), a2, voffA);
            PG8_BAR; PG8_WAIT_L(0); PG8_MMA(1, 0, At, B0); PG8_BAR; PG8_SCHED;
            PG8_STAGE(PG8_SB(0, 1), b2 + hstep, voffB);
            PG8_WAIT_V(6); PG8_BAR; PG8_MMA(1, 1, At, B1); PG8_BAR;
            PG8_LDB(B0, 1, 0); PG8_SCHED; PG8_LDA(At, 1, 0); PG8_STAGE(PG8_SA(0, 1), a2 + hstep, voffA);
            PG8_WAIT_L(8); PG8_BAR; PG8_WAIT_L(0); PG8_MMA(0, 0, At, B0); PG8_BAR; PG8_SCHED;
            PG8_LDB(B1, 1, 1); PG8_STAGE(PG8_SB(1, 0), b3, voffB);
            PG8_BAR; PG8_WAIT_L(0); PG8_MMA(0, 1, At, B1); PG8_BAR;
            PG8_LDA(At, 1, 1); PG8_STAGE(PG8_SA(1, 0), a3, voffA);
            PG8_BAR; PG8_WAIT_L(0); PG8_MMA(1, 0, At, B0); PG8_BAR; PG8_SCHED;
            PG8_STAGE(PG8_SB(1, 1), b3 + hstep, voffB);
            PG8_WAIT_V(6); PG8_BAR; PG8_MMA(1, 1, At, B1); PG8_BAR;
        }
        PG8_STAMP();
        if constexpr (!Epi::AFTER_DRAIN) { E(acc, cur, wr, wc, fr, fq); S.done(cur); }
        PG8_STAMP();
        if (!has_next) break;
#pragma unroll
        for (int a = 0; a < 2; ++a)
#pragma unroll
            for (int b = 0; b < 2; ++b)
#pragma unroll
                for (int m = 0; m < 4; ++m)
#pragma unroll
                    for (int n = 0; n < 2; ++n) acc[a][b][m][n] = (f32x4){0.f, 0.f, 0.f, 0.f};
        cur = nxt; cA = nA; cB = nB; ++ui;
    }
    PG8_WAIT_V(0);
    if (wr == 0) PG8_BAR;
    PG8_BAR;
    if constexpr (Epi::AFTER_DRAIN) { E.fused(acc, cur, wr, wc, fr, fq, lds, wid, lane); S.done(cur); }
    PG8_STAMP();
    if (STAMP && wid == 0) { stamps[lane] = lane < nts ? (((unsigned long long)(unsigned)ts_hi << 32) | (unsigned)ts_lo) : 0ull;
        if (lane == 62) stamps[62] = rt_entry; if (lane == 63) stamps[63] = (unsigned long long)wall_clock64(); }
#undef PG8_STAMP
#undef PG8_SA
#undef PG8_SB
#undef PG8_STAGE
#undef PG8_LDA
#undef PG8_LDB
#undef PG8_MMA
#undef PG8_WAIT_V
#undef PG8_WAIT_L
#undef PG8_BAR
#undef PG8_SCHED
}
}

typedef unsigned short bf16_t;
typedef short bf16x8 __attribute__((ext_vector_type(8)));
typedef short s16x4 __attribute__((ext_vector_type(4)));
typedef float f32x4 __attribute__((ext_vector_type(4)));
typedef float f32x2 __attribute__((ext_vector_type(2)));
typedef unsigned u32x4 __attribute__((ext_vector_type(4)));
typedef unsigned u32x2 __attribute__((ext_vector_type(2)));
#define LAS __attribute__((address_space(3)))

constexpr int T_ = 32768, D_ = 2048, S_ = 2048, B_ = 16, FF_ = 5632;
constexpr int EIN = 6400, OIN = 5680, OLD = 5888;
constexpr float EPS_ = 1e-6f;

constexpr size_t AL256(size_t x) { return (x + 255) & ~(size_t)255; }
constexpr size_t OFF_CTRL = 0;
constexpr size_t OFF_WT_EIN = 4096;
constexpr size_t OFF_WT_EOUT = OFF_WT_EIN + (size_t)EIN * D_ * 2;
constexpr size_t OFF_WT_OIN = OFF_WT_EOUT + (size_t)D_ * D_ * 2;
constexpr size_t OFF_WT_OOUT = OFF_WT_OIN + (size_t)OLD * D_ * 2;
constexpr size_t OFF_WT13_0 = OFF_WT_OOUT + (size_t)D_ * D_ * 2;
constexpr size_t OFF_WT13_1 = OFF_WT13_0 + (size_t)2 * FF_ * D_ * 2;
constexpr size_t OFF_WT2_0 = OFF_WT13_1 + (size_t)2 * FF_ * D_ * 2;
constexpr size_t OFF_WT2_1 = OFF_WT2_0 + (size_t)D_ * FF_ * 2;
constexpr size_t OFF_W1T_K = OFF_WT2_1 + (size_t)D_ * FF_ * 2;
constexpr size_t OFF_W1T_V = OFF_W1T_K + (size_t)128 * 2048 * 2;
constexpr size_t OFF_W2T_K = OFF_W1T_V + (size_t)128 * 2048 * 2;
constexpr size_t OFF_W2T_V = OFF_W2T_K + (size_t)64 * 128 * 2;
constexpr size_t OFF_BIAS1 = OFF_W2T_V + (size_t)64 * 128 * 2;
constexpr size_t OFF_ROPE = OFF_BIAS1 + 1024;
constexpr size_t OFF_KMEAN = OFF_ROPE + (size_t)2048 * 32 * 8;
constexpr size_t OFF_KC = OFF_KMEAN + (size_t)16 * 16 * 8 * 64 * 4;
constexpr size_t OFF_VC = OFF_KC + (size_t)16 * 4 * 128 * 64 * 2;
constexpr size_t OFF_SEL = OFF_VC + (size_t)16 * 4 * 128 * 64 * 2;
constexpr size_t OFF_H = OFF_SEL + (size_t)16 * 4 * 2048 * 4;
constexpr size_t OFF_Z = OFF_H + (size_t)T_ * D_ * 2;
constexpr size_t OFF_CAT = OFF_Z + (size_t)T_ * EIN * 2;
constexpr size_t WS_END = OFF_CAT + (size_t)T_ * D_ * 2;

constexpr int LDS_BYTES = 131072;
constexpr int NPHASE = 18;

struct Params {
    const float* in[28];
    float* out;
    unsigned char* ws;
    double inv_freq[32];
    int ph_lo, ph_hi;
};

__device__ __forceinline__ float bf2f(unsigned short b) { return __uint_as_float(((unsigned)b) << 16); }
typedef __bf16 bf16x2_t __attribute__((ext_vector_type(2)));
__device__ __forceinline__ unsigned pk2(float lo, float hi) { f32x2 v; v[0] = lo; v[1] = hi; const bf16x2_t r = __builtin_convertvector(v, bf16x2_t); return __builtin_bit_cast(unsigned, r); }
__device__ __forceinline__ float wave_sum(float v) {
#pragma unroll
    for (int o = 1; o < 64; o <<= 1) v += __shfl_xor(v, o);
    return v;
}
template <int CTRL> __device__ __forceinline__ float dppf(float x) {
    return __int_as_float(__builtin_amdgcn_update_dpp(0, __float_as_int(x), CTRL, 0xf, 0xf, false));
}
__device__ __forceinline__ float rowsum16(float x) {
    x += dppf<0x128>(x);
    x += dppf<0x124>(x);
    x += dppf<0x4E>(x);
    x += dppf<0xB1>(x);
    return x;
}
__device__ __forceinline__ float fexp2(float x) { return __builtin_amdgcn_exp2f(x); }
__device__ __forceinline__ float fexp(float x) { return __builtin_amdgcn_exp2f(x * 1.4426950408889634f); }
__device__ __forceinline__ float sigmoidf_(float x) { return 1.f / (1.f + fexp(-x)); }
__device__ __forceinline__ void lds_wait() { asm volatile("s_waitcnt lgkmcnt(0)" ::: "memory"); }
__device__ __forceinline__ void unpack8(u32x4 v, float (&f)[8]) {
    f[0] = __uint_as_float(v.x << 16); f[1] = __uint_as_float(v.x & 0xffff0000u);
    f[2] = __uint_as_float(v.y << 16); f[3] = __uint_as_float(v.y & 0xffff0000u);
    f[4] = __uint_as_float(v.z << 16); f[5] = __uint_as_float(v.z & 0xffff0000u);
    f[6] = __uint_as_float(v.w << 16); f[7] = __uint_as_float(v.w & 0xffff0000u);
}
__device__ __forceinline__ bf16x8 as_bf16x8(u32x4 v) { return __builtin_bit_cast(bf16x8, v); }
__device__ __forceinline__ f32x4 mfma16(bf16x8 a, bf16x8 b, f32x4 c) { return __builtin_amdgcn_mfma_f32_16x16x32_bf16(a, b, c, 0, 0, 0); }

struct EpiAll {
    static constexpr bool PERM = true, AFTER_DRAIN = false;
    int mode; bf16_t* O; int ldc; const float* Xin; float* Xout;
    __device__ __forceinline__ void operator()(const pg8::f32x4 (&acc)[2][2][4][2], const pg8::Unit& u, int wr, int wc, int fr, int fq) const {
        const int row0 = u.pm * 256 + wr * 64 + fr;
        if (mode == 0) {
            const int col0 = u.pn * 256 + wc * 32 + 8 * fq;
#pragma unroll
            for (int ai = 0; ai < 2; ++ai)
#pragma unroll
                for (int m = 0; m < 4; ++m) {
                    bf16_t* rowp = O + (size_t)(row0 + ai * 128 + m * 16) * ldc + col0;
#pragma unroll
                    for (int bj = 0; bj < 2; ++bj) {
                        const pg8::f32x4 v0 = acc[ai][bj][m][0], v1 = acc[ai][bj][m][1];
                        u32x4 w; w.x = pk2(v0[0], v0[1]); w.y = pk2(v0[2], v0[3]); w.z = pk2(v1[0], v1[1]); w.w = pk2(v1[2], v1[3]);
                        *(u32x4*)(rowp + bj * 128) = w;
                    }
                }
        } else if (mode == 1) {
            const int col0 = u.pn * 256 + wc * 32 + 8 * fq;
#pragma unroll
            for (int ai = 0; ai < 2; ++ai)
#pragma unroll
                for (int m = 0; m < 4; ++m) {
                    const size_t off = (size_t)(row0 + ai * 128 + m * 16) * D_ + col0;
#pragma unroll
                    for (int bj = 0; bj < 2; ++bj)
#pragma unroll
                        for (int n = 0; n < 2; ++n) {
                            const size_t idx = off + bj * 128 + n * 4;
                            const f32x4 x = *(const f32x4*)(Xin + idx);
                            f32x4 r; r[0] = x[0] + acc[ai][bj][m][n][0]; r[1] = x[1] + acc[ai][bj][m][n][1]; r[2] = x[2] + acc[ai][bj][m][n][2]; r[3] = x[3] + acc[ai][bj][m][n][3];
                            *(f32x4*)(Xout + idx) = r;
                        }
                }
        } else {
            const int col0 = u.pn * 128 + wc * 32 + 8 * fq;
#pragma unroll
            for (int ai = 0; ai < 2; ++ai)
#pragma unroll
                for (int m = 0; m < 4; ++m) {
                    bf16_t* rowp = O + (size_t)(row0 + ai * 128 + m * 16) * FF_ + col0;
                    float hv[8];
#pragma unroll
                    for (int n = 0; n < 2; ++n)
#pragma unroll
                        for (int j = 0; j < 4; ++j) { const float g = acc[ai][0][m][n][j], up = acc[ai][1][m][n][j]; hv[n * 4 + j] = g * sigmoidf_(g) * up; }
                    u32x4 w; w.x = pk2(hv[0], hv[1]); w.y = pk2(hv[2], hv[3]); w.z = pk2(hv[4], hv[5]); w.w = pk2(hv[6], hv[7]);
                    *(u32x4*)rowp = w;
                }
        }
    }
};

template <int MODE>
__device__ __forceinline__ void prep_w(const float* Wa, const float* Wb, int K, int Nsrc, bf16_t* WT, int nOutBlocks, float* scr, int gw, int ngw, int lane) {
    const int nkb = K / 64, nitems = nkb * nOutBlocks;
    for (int it = gw; it < nitems; it += ngw) {
        const int ob = it % nOutBlocks, kb = it / nOutBlocks, k0 = kb * 64;
        const float* src; int c0;
        if (MODE == 0) { src = Wa; c0 = ob * 32; }
        else { const int pn = ob >> 3, sb = ob & 7; src = (sb < 4) ? Wa : Wb; c0 = (pn * 4 + (sb & 3)) * 32; }
        const int col = c0 + (lane & 31);
#pragma unroll 8
        for (int i = 0; i < 32; ++i) { const int kk = 2 * i + (lane >> 5); scr[kk * 33 + (lane & 31)] = (col < Nsrc) ? src[(size_t)(k0 + kk) * Nsrc + col] : 0.f; }
        lds_wait();
        const int c = lane & 7;
#pragma unroll
        for (int j = 0; j < 4; ++j) {
            const int n = (lane >> 3) + 8 * j; const float* s = scr + (8 * c) * 33 + n;
            u32x4 o; o.x = pk2(s[0 * 33], s[1 * 33]); o.y = pk2(s[2 * 33], s[3 * 33]); o.z = pk2(s[4 * 33], s[5 * 33]); o.w = pk2(s[6 * 33], s[7 * 33]);
            *(u32x4*)(WT + (size_t)(ob * 32 + n) * K + k0 + 8 * c) = o;
        }
        lds_wait();
    }
}

__device__ __forceinline__ void rmsnorm_rows(const float* X, const float* g, bf16_t* H, float* OutF, int gw, int ngw, int lane) {
    for (int m = gw; m < T_; m += ngw) {
        const f32x4* xr = (const f32x4*)(X + (size_t)m * D_) + lane;
        f32x4 v[8]; float ss = 0.f;
#pragma unroll
        for (int j = 0; j < 8; ++j) { v[j] = xr[64 * j]; ss += (v[j][0] * v[j][0] + v[j][1] * v[j][1]) + (v[j][2] * v[j][2] + v[j][3] * v[j][3]); }
        ss = wave_sum(ss);
        const float rstd = rsqrtf(ss * (1.f / D_) + EPS_);
#pragma unroll
        for (int j = 0; j < 8; ++j) {
            const f32x4 gv = ((const f32x4*)g)[lane + 64 * j];
            const float y0 = v[j][0] * rstd * gv[0], y1 = v[j][1] * rstd * gv[1], y2 = v[j][2] * rstd * gv[2], y3 = v[j][3] * rstd * gv[3];
            if (H) { u32x2 o; o.x = pk2(y0, y1); o.y = pk2(y2, y3); *(u32x2*)(H + (size_t)m * D_ + (lane + 64 * j) * 4) = o; }
            if (OutF) { f32x4 o; o[0] = y0; o[1] = y1; o[2] = y2; o[3] = y3; *((f32x4*)(OutF + (size_t)m * D_) + lane + 64 * j) = o; }
        }
    }
}

__device__ __forceinline__ void phase0(const Params& p, unsigned char* smem, int tid, int bid, int nblk) {
    const int lane = tid & 63, wave = tid >> 6;
    const int gw = bid * 8 + wave, ngw = nblk * 8;
    float* scr = (float*)(smem + wave * 8448);
    unsigned char* ws = p.ws;
    prep_w<0>(p.in[3], nullptr, D_, EIN, (bf16_t*)(ws + OFF_WT_EIN), EIN / 32, scr, gw, ngw, lane);
    prep_w<0>(p.in[15], nullptr, D_, D_, (bf16_t*)(ws + OFF_WT_EOUT), D_ / 32, scr, gw, ngw, lane);
    prep_w<0>(p.in[16], nullptr, D_, OIN, (bf16_t*)(ws + OFF_WT_OIN), OLD / 32, scr, gw, ngw, lane);
    prep_w<0>(p.in[23], nullptr, D_, D_, (bf16_t*)(ws + OFF_WT_OOUT), D_ / 32, scr, gw, ngw, lane);
    prep_w<1>(p.in[24], p.in[25], D_, FF_, (bf16_t*)(ws + OFF_WT13_0), 2 * FF_ / 32, scr, gw, ngw, lane);
    prep_w<1>(p.in[24] + (size_t)D_ * FF_, p.in[25] + (size_t)D_ * FF_, D_, FF_, (bf16_t*)(ws + OFF_WT13_1), 2 * FF_ / 32, scr, gw, ngw, lane);
    prep_w<0>(p.in[26], nullptr, FF_, D_, (bf16_t*)(ws + OFF_WT2_0), D_ / 32, scr, gw, ngw, lane);
    prep_w<0>(p.in[26] + (size_t)FF_ * D_, nullptr, FF_, D_, (bf16_t*)(ws + OFF_WT2_1), D_ / 32, scr, gw, ngw, lane);
    prep_w<0>(p.in[18], nullptr, 2048, 128, (bf16_t*)(ws + OFF_W1T_K), 4, scr, gw, ngw, lane);
    prep_w<0>(p.in[21], nullptr, 2048, 128, (bf16_t*)(ws + OFF_W1T_V), 4, scr, gw, ngw, lane);
    prep_w<0>(p.in[19], nullptr, 128, 64, (bf16_t*)(ws + OFF_W2T_K), 2, scr, gw, ngw, lane);
    prep_w<0>(p.in[22], nullptr, 128, 64, (bf16_t*)(ws + OFF_W2T_V), 2, scr, gw, ngw, lane);
    if (gw < 256) {
        const int kv = gw >> 7, n = gw & 127;
        const float* pe = p.in[kv ? 20 : 17]; const float* w1 = p.in[kv ? 21 : 18];
        float s = 0.f;
        for (int k = lane; k < 2048; k += 64) s += pe[k] * w1[(size_t)k * 128 + n];
        s = wave_sum(s);
        if (lane == 0) ((float*)(ws + OFF_BIAS1))[gw] = s;
    }
    {
        f32x2* rope = (f32x2*)(ws + OFF_ROPE);
        for (int e = bid * 512 + tid; e < 2048 * 32; e += nblk * 512) {
            const int pos = e >> 5, i = e & 31;
            const double ang = (double)pos * p.inv_freq[i];
            const double kq = rint(ang * 0.63661977236758134308);
            double r = fma(-kq, 1.57079632679489655800e+00, ang);
            r = fma(-kq, 6.12323399573676603587e-17, r);
            const float rf = (float)r;
            const float r2 = rf * rf;
            const float sn = rf * (1.f + r2 * (-1.6666667e-1f + r2 * (8.3333333e-3f + r2 * (-1.9841270e-4f + r2 * 2.7557319e-6f))));
            const float cs = 1.f + r2 * (-0.5f + r2 * (4.1666667e-2f + r2 * (-1.3888889e-3f + r2 * (2.4801587e-5f + r2 * -2.7557319e-7f))));
            const int q = ((int)kq) & 3;
            float c, s;
            if (q == 0) { c = cs; s = sn; } else if (q == 1) { c = -sn; s = cs; } else if (q == 2) { c = -cs; s = -sn; } else { c = sn; s = -cs; }
            f32x2 o; o[0] = c; o[1] = s; rope[e] = o;
        }
    }
    rmsnorm_rows(p.in[0], p.in[1], (bf16_t*)(ws + OFF_H), nullptr, gw, ngw, lane);
}

enum { M_MOBA = 0, M_SLC = 1, M_WIN = 2, M_CMP = 3, M_RET = 4 };
template <int MODE, int DV>
__device__ __forceinline__ void attn_pass(unsigned char* smem, const bf16_t* Qb, int ldq, const bf16_t* Kb, int ldk, const bf16_t* Vb, int ldv,
                                          int q0, unsigned rowmask, float log2g, f32x4 (&o)[DV / 16], int tid) {
    constexpr int VST = DV + 8;
    const int lane = tid & 63, wave = tid >> 6, lq = lane & 15, quad = lane >> 4;
    const int t = q0 + wave * 16 + lq;
    bf16_t* Ks = (bf16_t*)smem;
    bf16_t* Vs = (bf16_t*)(smem + 64 * 72 * 2);
    bf16x8 qf[2];
#pragma unroll
    for (int ks = 0; ks < 2; ++ks) qf[ks] = as_bf16x8(*(const u32x4*)(Qb + (size_t)t * ldq + quad * 8 + 32 * ks));
    float m = -INFINITY, l = 0.f;
#pragma unroll
    for (int c = 0; c < DV / 16; ++c) o[c] = (f32x4){0.f, 0.f, 0.f, 0.f};
    int kt_lo = 0, kt_hi = (q0 + 127) >> 6;
    if (MODE == M_WIN) { const int lo = q0 - 511; kt_lo = (lo > 0 ? lo : 0) >> 6; }
    if (MODE == M_CMP) { kt_hi = 1; }
    constexpr float SC = 0.125f * 1.4426950408889634f;
    const int q4 = lq >> 2, pp = lq & 3;
    for (int kt = kt_lo; kt <= kt_hi; ++kt) {
        __syncthreads();
        { const int r = tid >> 3, ch = tid & 7; const u32x4 v = *(const u32x4*)(Kb + (size_t)(kt * 64 + r) * ldk + ch * 8); *(u32x4*)(Ks + r * 72 + ch * 8) = v; }
#pragma unroll
        for (int i = 0; i < DV / 64; ++i) { const int idx = tid + i * 512; const int r = idx / (DV / 8), ch = idx % (DV / 8);
            const u32x4 v = *(const u32x4*)(Vb + (size_t)(kt * 64 + r) * ldv + ch * 8); *(u32x4*)(Vs + r * VST + ch * 8) = v; }
        __syncthreads();
        const int kbase = kt * 64;
        bool lane_any;
        if (MODE == M_MOBA) lane_any = (kbase <= t) && ((rowmask >> (kt >> 2)) & 1u);
        else if (MODE == M_SLC) lane_any = (kbase <= t) && ((rowmask >> kt) & 1u);
        else if (MODE == M_WIN) lane_any = (kbase <= t) && (kbase + 63 > t - 512);
        else if (MODE == M_CMP) lane_any = (kbase * 16 + 31 <= t);
        else lane_any = (kbase <= t);
        if (!__any(lane_any ? 1 : 0)) continue;
        f32x4 s[4];
#pragma unroll
        for (int sub = 0; sub < 4; ++sub) {
            s[sub] = (f32x4){0.f, 0.f, 0.f, 0.f};
#pragma unroll
            for (int ks = 0; ks < 2; ++ks) { const bf16x8 a = as_bf16x8(*(const u32x4*)(Ks + (16 * sub + lq) * 72 + quad * 8 + 32 * ks)); s[sub] = mfma16(a, qf[ks], s[sub]); }
        }
        float pv[4][4];
        if (MODE != M_RET) {
            float mx = -INFINITY;
#pragma unroll
            for (int sub = 0; sub < 4; ++sub)
#pragma unroll
                for (int j = 0; j < 4; ++j) {
                    const int key = kbase + 16 * sub + 4 * quad + j;
                    bool valid;
                    if (MODE == M_MOBA || MODE == M_SLC) valid = lane_any && (key <= t);
                    else if (MODE == M_WIN) valid = (key <= t) && (key > t - 512);
                    else valid = (key * 16 + 31 <= t);
                    const float sv = valid ? s[sub][j] * SC : -INFINITY;
                    pv[sub][j] = sv; mx = fmaxf(mx, sv);
                }
            mx = fmaxf(mx, __shfl_xor(mx, 16)); mx = fmaxf(mx, __shfl_xor(mx, 32));
            const float m_new = fmaxf(m, mx);
            const float m_use = (m_new == -INFINITY) ? 0.f : m_new;
            const float alpha = fexp2(m - m_use);
            float rs = 0.f;
#pragma unroll
            for (int sub = 0; sub < 4; ++sub)
#pragma unroll
                for (int j = 0; j < 4; ++j) { const float e = fexp2(pv[sub][j] - m_use); pv[sub][j] = e; rs += e; }
            l = l * alpha + rs; m = m_new;
#pragma unroll
            for (int c = 0; c < DV / 16; ++c) { o[c][0] *= alpha; o[c][1] *= alpha; o[c][2] *= alpha; o[c][3] *= alpha; }
        } else {
#pragma unroll
            for (int sub = 0; sub < 4; ++sub)
#pragma unroll
                for (int j = 0; j < 4; ++j) {
                    const int key = kbase + 16 * sub + 4 * quad + j;
                    const float dec = fexp2((float)(t - key) * log2g);
                    pv[sub][j] = (key <= t) ? s[sub][j] * 0.125f * dec : 0.f;
                }
        }
        bf16x8 pb[2];
#pragma unroll
        for (int s2 = 0; s2 < 2; ++s2) {
            u32x4 w; w.x = pk2(pv[2 * s2][0], pv[2 * s2][1]); w.y = pk2(pv[2 * s2][2], pv[2 * s2][3]); w.z = pk2(pv[2 * s2 + 1][0], pv[2 * s2 + 1][1]); w.w = pk2(pv[2 * s2 + 1][2], pv[2 * s2 + 1][3]);
            pb[s2] = as_bf16x8(w);
        }
#pragma unroll
        for (int c = 0; c < DV / 16; ++c)
#pragma unroll
            for (int s2 = 0; s2 < 2; ++s2) {
                const s16x4 t1 = __builtin_amdgcn_ds_read_tr16_b64_v4i16((LAS s16x4*)(Vs + (32 * s2 + 4 * quad + q4) * VST + 16 * c + 4 * pp));
                const s16x4 t2 = __builtin_amdgcn_ds_read_tr16_b64_v4i16((LAS s16x4*)(Vs + (32 * s2 + 16 + 4 * quad + q4) * VST + 16 * c + 4 * pp));
                bf16x8 a; a[0] = t1[0]; a[1] = t1[1]; a[2] = t1[2]; a[3] = t1[3]; a[4] = t2[0]; a[5] = t2[1]; a[6] = t2[2]; a[7] = t2[3];
                o[c] = mfma16(a, pb[s2], o[c]);
            }
    }
    if (MODE != M_RET) {
        l += __shfl_xor(l, 16); l += __shfl_xor(l, 32);
        const float inv = (l > 0.f) ? 1.f / l : 1.f;
#pragma unroll
        for (int c = 0; c < DV / 16; ++c) { o[c][0] *= inv; o[c][1] *= inv; o[c][2] *= inv; o[c][3] *= inv; }
    }
}

__device__ __forceinline__ void kmean_phase(const Params& p, int tid, int bid, int nblk) {
    const bf16_t* Z = (const bf16_t*)(p.ws + OFF_Z);
    float* km = (float*)(p.ws + OFF_KMEAN);
    for (int it = bid; it < 256; it += nblk) {
        const int b = it >> 4, n = (it >> 1) & 7, half = it & 1;
        const int ch = half * 512 + tid;
        const bf16_t* src = Z + ((size_t)(b * S_ + n * 256)) * EIN + 1024 + ch;
        float s = 0.f;
#pragma unroll 8
        for (int tt = 0; tt < 256; ++tt) s += bf2f(src[(size_t)tt * EIN]);
        const int h = ch >> 6, d = ch & 63;
        km[((size_t)(b * 16 + h) * 8 + n) * 64 + d] = s * (1.f / 256.f);
    }
}

__device__ __forceinline__ void moba_item(const Params& p, unsigned char* smem, int b, int h, int qt, int tid) {
    const int lane = tid & 63, wave = tid >> 6, lq = lane & 15, quad = lane >> 4;
    const bf16_t* Z = (const bf16_t*)(p.ws + OFF_Z) + (size_t)b * S_ * EIN;
    const int q0 = qt * 128, t = q0 + wave * 16 + lq, own = q0 >> 8;
    unsigned rowmask = 1u << own;
    if (own > 0) {
        const float* km = (const float*)(p.ws + OFF_KMEAN) + (size_t)(b * 16 + h) * 8 * 64;
        float gsc[7];
#pragma unroll
        for (int n = 0; n < 7; ++n) gsc[n] = 0.f;
#pragma unroll 1
        for (int c8 = 0; c8 < 8; ++c8) {
            float f[8]; unpack8(*(const u32x4*)(Z + (size_t)t * EIN + h * 64 + c8 * 8), f);
#pragma unroll
            for (int n = 0; n < 7; ++n) {
                const f32x4 k0 = *(const f32x4*)(km + n * 64 + c8 * 8), k1 = *(const f32x4*)(km + n * 64 + c8 * 8 + 4);
                gsc[n] += (f[0] * k0[0] + f[1] * k0[1]) + (f[2] * k0[2] + f[3] * k0[3]) + (f[4] * k1[0] + f[5] * k1[1]) + (f[6] * k1[2] + f[7] * k1[3]);
            }
        }
#pragma unroll
        for (int n = 0; n < 7; ++n) {
            int cnt = 0;
#pragma unroll
            for (int n2 = 0; n2 < 7; ++n2) { if (n2 != n) { const bool beats = (gsc[n2] > gsc[n]) || (gsc[n2] == gsc[n] && n2 < n); cnt += (n2 < own && beats) ? 1 : 0; } }
            if (n < own && cnt < 3) rowmask |= (1u << n);
        }
    }
    f32x4 o[4];
    attn_pass<M_MOBA, 64>(smem, Z + h * 64, EIN, Z + 1024 + h * 64, EIN, Z + 2048 + h * 64, EIN, q0, rowmask, 0.f, o, tid);
    bf16_t* cat = (bf16_t*)(p.ws + OFF_CAT) + (size_t)(b * S_ + t) * D_ + h * 64;
#pragma unroll
    for (int c = 0; c < 4; ++c) { u32x2 w; w.x = pk2(o[c][0], o[c][1]); w.y = pk2(o[c][2], o[c][3]); *(u32x2*)(cat + 16 * c + 4 * quad) = w; }
}

__device__ __forceinline__ void rwkv_item(const Params& p, unsigned char* smem, int b, int h, int tid) {
    const int lane = tid & 63, wave = tid >> 6, lq = lane & 15, quad = lane >> 4;
    constexpr int ZB = 3072;
    const bf16_t* Z = (const bf16_t*)(p.ws + OFF_Z) + (size_t)b * S_ * EIN;
    const float* mu = p.in[4];
    float* R = (float*)smem;
    float* KP = R + 2048; float* V = KP + 2048; float* DEC = V + 2048; float* NKK = DEC + 2048; float* KKA = NKK + 2048;
    float* GG = KKA + 2048; float* Y = GG + 2048; float* AA = Y + 2048; float* BC = AA + 2048;
    bf16_t* TW = (bf16_t*)(BC + 64);
    bf16_t* AL = TW + 32 * 72;
    bf16_t* GL = AL + 32 * 72;
    const int mt = wave >> 2, nt = wave & 3;
    const int chn = h * 64 + 16 * nt + lq;
    bf16x8 bw[2], ba[2], bg[4];
    {
        const float* wup = p.in[6]; const float* aup = p.in[8]; const float* gup = p.in[9];
#pragma unroll
        for (int ks = 0; ks < 2; ++ks) {
            float fw[8], fa[8];
#pragma unroll
            for (int i = 0; i < 8; ++i) { const int k = 32 * ks + quad * 8 + i; fw[i] = wup[(size_t)k * 1024 + chn]; fa[i] = aup[(size_t)k * 1024 + chn]; }
            u32x4 w; w.x = pk2(fw[0], fw[1]); w.y = pk2(fw[2], fw[3]); w.z = pk2(fw[4], fw[5]); w.w = pk2(fw[6], fw[7]); bw[ks] = as_bf16x8(w);
            u32x4 a; a.x = pk2(fa[0], fa[1]); a.y = pk2(fa[2], fa[3]); a.z = pk2(fa[4], fa[5]); a.w = pk2(fa[6], fa[7]); ba[ks] = as_bf16x8(a);
        }
#pragma unroll
        for (int ks = 0; ks < 4; ++ks) {
            float fg[8];
#pragma unroll
            for (int i = 0; i < 8; ++i) { const int k = 32 * ks + quad * 8 + i; fg[i] = gup[(size_t)k * 1024 + chn]; }
            u32x4 g; g.x = pk2(fg[0], fg[1]); g.y = pk2(fg[2], fg[3]); g.z = pk2(fg[4], fg[5]); g.w = pk2(fg[6], fg[7]); bg[ks] = as_bf16x8(g);
        }
    }
    const float w0c = p.in[5][chn], a0c = p.in[7][chn];
    const int cs = tid & 15, ttC = tid >> 4;
    const f32x4 kkc = *(const f32x4*)(p.in[10] + h * 64 + 4 * cs), kac = *(const f32x4*)(p.in[11] + h * 64 + 4 * cs), rkc = *(const f32x4*)(p.in[12] + h * 64 + 4 * cs);
    const f32x4 lng = *(const f32x4*)(p.in[13] + h * 64 + 4 * cs), lnb = *(const f32x4*)(p.in[14] + h * 64 + 4 * cs);
    const int js = tid & 15, rp = tid >> 4;
    f32x4 S0 = (f32x4){0.f, 0.f, 0.f, 0.f}, S1 = (f32x4){0.f, 0.f, 0.f, 0.f};
    bf16_t* cat = (bf16_t*)(p.ws + OFF_CAT) + (size_t)b * S_ * D_ + 1024 + h * 64;

    for (int t0 = 0; t0 < S_; t0 += 32) {
        __syncthreads();
        for (int idx = tid; idx < 32 * 56; idx += 512) {
            const int tt = idx / 56, cv = idx % 56, t = t0 + tt;
            int zc;
            if (cv < 8) zc = ZB + h * 64 + cv * 8;
            else if (cv < 16) zc = ZB + 1024 + h * 64 + (cv - 8) * 8;
            else if (cv < 24) zc = ZB + 2048 + h * 64 + (cv - 16) * 8;
            else zc = ZB + 3072 + (cv - 24) * 8;
            float cur[8], prv[8];
            unpack8(*(const u32x4*)(Z + (size_t)t * EIN + zc), cur);
            if (t > 0) unpack8(*(const u32x4*)(Z + (size_t)(t - 1) * EIN + zc), prv);
            else {
#pragma unroll
                for (int e = 0; e < 8; ++e) prv[e] = 0.f; }
            const f32x4 m0 = *(const f32x4*)(mu + (zc - ZB)), m1 = *(const f32x4*)(mu + (zc - ZB) + 4);
            float val[8];
#pragma unroll
            for (int e = 0; e < 4; ++e) { val[e] = cur[e] + (prv[e] - cur[e]) * m0[e]; val[4 + e] = cur[4 + e] + (prv[4 + e] - cur[4 + e]) * m1[e]; }
            if (cv < 24) {
                float* dst = (cv < 8 ? R : (cv < 16 ? KP : V)) + tt * 64 + (cv & 7) * 8;
                *(f32x4*)dst = (f32x4){val[0], val[1], val[2], val[3]}; *(f32x4*)(dst + 4) = (f32x4){val[4], val[5], val[6], val[7]};
            } else {
                if (cv < 32) {
#pragma unroll
                    for (int e = 0; e < 8; ++e) { const float ex = fexp(2.f * val[e]); val[e] = 1.f - 2.f / (ex + 1.f); } }
                else if (cv >= 40) {
#pragma unroll
                    for (int e = 0; e < 8; ++e) val[e] = sigmoidf_(val[e]); }
                u32x4 w; w.x = pk2(val[0], val[1]); w.y = pk2(val[2], val[3]); w.z = pk2(val[4], val[5]); w.w = pk2(val[6], val[7]);
                bf16_t* dst = (cv < 32) ? (TW + tt * 72 + (cv - 24) * 8) : ((cv < 40) ? (AL + tt * 72 + (cv - 32) * 8) : (GL + tt * 136 + (cv - 40) * 8));
                *(u32x4*)dst = w;
            }
        }
        __syncthreads();
        {
            f32x4 cw = (f32x4){0.f, 0.f, 0.f, 0.f}, ca = cw, cg_ = cw;
#pragma unroll
            for (int ks = 0; ks < 2; ++ks) {
                const bf16x8 a1 = as_bf16x8(*(const u32x4*)(TW + (16 * mt + lq) * 72 + quad * 8 + 32 * ks));
                const bf16x8 a2 = as_bf16x8(*(const u32x4*)(AL + (16 * mt + lq) * 72 + quad * 8 + 32 * ks));
                cw = mfma16(a1, bw[ks], cw); ca = mfma16(a2, ba[ks], ca);
            }
#pragma unroll
            for (int ks = 0; ks < 4; ++ks) { const bf16x8 a3 = as_bf16x8(*(const u32x4*)(GL + (16 * mt + lq) * 136 + quad * 8 + 32 * ks)); cg_ = mfma16(a3, bg[ks], cg_); }
#pragma unroll
            for (int j = 0; j < 4; ++j) {
                const int tt = 16 * mt + 4 * quad + j, ch = 16 * nt + lq;
                const float wf = cw[j] + w0c;
                const float sp = (wf < -15.f) ? -wf : __logf(1.f + fexp(-wf));
                const float wv = -sp - 0.5f;
                DEC[tt * 64 + ch] = fexp(-fexp(wv));
                AA[tt * 64 + ch] = sigmoidf_(ca[j] + a0c);
                GG[tt * 64 + ch] = cg_[j];
            }
        }
        __syncthreads();
        {
            const f32x4 k4 = *(const f32x4*)(KP + ttC * 64 + 4 * cs), a4 = *(const f32x4*)(AA + ttC * 64 + 4 * cs), r4 = *(const f32x4*)(R + ttC * 64 + 4 * cs);
            f32x4 kkv; float ss = 0.f;
#pragma unroll
            for (int e = 0; e < 4; ++e) { kkv[e] = k4[e] * kkc[e]; ss += kkv[e] * kkv[e]; }
            ss = rowsum16(ss);
            const float inv = 1.f / fmaxf(sqrtf(ss), 1e-12f);
            f32x4 nk, ka, kp; float bc = 0.f;
#pragma unroll
            for (int e = 0; e < 4; ++e) { const float kk = kkv[e] * inv; nk[e] = -kk; ka[e] = kk * a4[e]; kp[e] = k4[e] * (1.f + (a4[e] - 1.f) * kac[e]); bc += r4[e] * kp[e] * rkc[e]; }
            bc = rowsum16(bc);
            *(f32x4*)(NKK + ttC * 64 + 4 * cs) = nk; *(f32x4*)(KKA + ttC * 64 + 4 * cs) = ka; *(f32x4*)(KP + ttC * 64 + 4 * cs) = kp;
            if (cs == 0) BC[ttC] = bc;
        }
        __syncthreads();
#pragma unroll 2
        for (int tt = 0; tt < 32; ++tt) {
            const f32x4 nk = *(const f32x4*)(NKK + tt * 64 + 4 * js), wd = *(const f32x4*)(DEC + tt * 64 + 4 * js), ka = *(const f32x4*)(KKA + tt * 64 + 4 * js);
            const f32x4 kp = *(const f32x4*)(KP + tt * 64 + 4 * js), rr = *(const f32x4*)(R + tt * 64 + 4 * js);
            const f32x2 vv = *(const f32x2*)(V + tt * 64 + 2 * rp);
            float sa0 = (S0[0] * nk[0] + S0[1] * nk[1]) + (S0[2] * nk[2] + S0[3] * nk[3]);
            float sa1 = (S1[0] * nk[0] + S1[1] * nk[1]) + (S1[2] * nk[2] + S1[3] * nk[3]);
            sa0 = rowsum16(sa0); sa1 = rowsum16(sa1);
#pragma unroll
            for (int e = 0; e < 4; ++e) { S0[e] = S0[e] * wd[e] + (sa0 * ka[e] + vv[0] * kp[e]); S1[e] = S1[e] * wd[e] + (sa1 * ka[e] + vv[1] * kp[e]); }
            float y0 = (S0[0] * rr[0] + S0[1] * rr[1]) + (S0[2] * rr[2] + S0[3] * rr[3]);
            float y1 = (S1[0] * rr[0] + S1[1] * rr[1]) + (S1[2] * rr[2] + S1[3] * rr[3]);
            y0 = rowsum16(y0); y1 = rowsum16(y1);
            if (js == 0) { f32x2 yy; yy[0] = y0; yy[1] = y1; *(f32x2*)(Y + tt * 64 + 2 * rp) = yy; }
        }
        __syncthreads();
        {
            const f32x4 y4 = *(const f32x4*)(Y + ttC * 64 + 4 * cs), v4 = *(const f32x4*)(V + ttC * 64 + 4 * cs), g4 = *(const f32x4*)(GG + ttC * 64 + 4 * cs);
            float sm = (y4[0] + y4[1]) + (y4[2] + y4[3]);
            sm = rowsum16(sm);
            const float mean = sm * (1.f / 64.f);
            float dv[4], sq = 0.f;
#pragma unroll
            for (int e = 0; e < 4; ++e) { dv[e] = y4[e] - mean; sq += dv[e] * dv[e]; }
            sq = rowsum16(sq);
            const float rstd = rsqrtf(sq * (1.f / 64.f) + 6.4e-4f);
            const float bc = BC[ttC];
            float ov[4];
#pragma unroll
            for (int e = 0; e < 4; ++e) ov[e] = (dv[e] * rstd * lng[e] + lnb[e] + bc * v4[e]) * g4[e];
            u32x2 w; w.x = pk2(ov[0], ov[1]); w.y = pk2(ov[2], ov[3]);
            *(u32x2*)(cat + (size_t)(t0 + ttC) * D_ + 4 * cs) = w;
        }
    }
}

__device__ __forceinline__ void even_mixer_phase(const Params& p, unsigned char* smem, int tid, int bid, int nblk) {
    for (int it = bid; it < 256; it += nblk) rwkv_item(p, smem, it >> 4, it & 15, tid);
    for (int it = bid; it < 4096; it += nblk) {
        const int qt = 15 - (it >> 8), bh = it & 255;
        moba_item(p, smem, bh >> 4, bh & 15, qt, tid);
    }
}

__device__ __forceinline__ void gelu_tanh4(f32x4& v) {
#pragma unroll
    for (int j = 0; j < 4; ++j) { const float x = v[j]; const float u = 0.7978845608028654f * (x + 0.044715f * x * x * x); const float ex = fexp(2.f * u); const float th = 1.f - 2.f / (ex + 1.f); v[j] = 0.5f * x * (1.f + th); }
}

__device__ __forceinline__ void odd_prep_phase(const Params& p, unsigned char* smem, int tid, int bid, int nblk) {
    const int lane = tid & 63, wave = tid >> 6, lq = lane & 15, quad = lane >> 4;
    bf16_t* Z = (bf16_t*)(p.ws + OFF_Z);
    {
        const f32x2* rope = (const f32x2*)(p.ws + OFF_ROPE);
        const int nthreads = nblk * 512;
        for (int it = bid * 512 + tid; it < T_ * 64; it += nthreads) {
            const int row = it >> 6, wh = (it >> 2) & 15, cidx = it & 3;
            const int pos = row & (S_ - 1);
            bf16_t* base = Z + (size_t)row * OLD + wh * 64 + cidx * 8;
            float z1[8], z2[8];
            unpack8(*(const u32x4*)base, z1); unpack8(*(const u32x4*)(base + 32), z2);
            float o1[8], o2[8];
#pragma unroll
            for (int e = 0; e < 8; ++e) { const f32x2 cs = rope[pos * 32 + cidx * 8 + e]; o1[e] = z1[e] * cs[0] - z2[e] * cs[1]; o2[e] = z1[e] * cs[1] + z2[e] * cs[0]; }
            u32x4 w1; w1.x = pk2(o1[0], o1[1]); w1.y = pk2(o1[2], o1[3]); w1.z = pk2(o1[4], o1[5]); w1.w = pk2(o1[6], o1[7]);
            u32x4 w2; w2.x = pk2(o2[0], o2[1]); w2.y = pk2(o2[2], o2[3]); w2.z = pk2(o2[4], o2[5]); w2.w = pk2(o2[6], o2[7]);
            *(u32x4*)base = w1; *(u32x4*)(base + 32) = w2;
        }
    }
    {
        const int gw = bid * 8 + wave, ngw = nblk * 8;
        bf16_t* hid = (bf16_t*)(smem + wave * (16 * 136 * 2));
        for (int task = gw; task < 1024; task += ngw) {
            const int kv = task >> 9, b = (task >> 5) & 15, g = (task >> 3) & 3, ct = task & 7;
            const bf16_t* Zs = Z + (size_t)b * S_ * OLD + (kv ? 4352 : 4096) + g * 64;
            const bf16_t* w1t = (const bf16_t*)(p.ws + (kv ? OFF_W1T_V : OFF_W1T_K));
            const bf16_t* w2t = (const bf16_t*)(p.ws + (kv ? OFF_W2T_V : OFF_W2T_K));
            const float* bias1 = (const float*)(p.ws + OFF_BIAS1) + kv * 128;
            f32x4 acc[8];
#pragma unroll
            for (int n = 0; n < 8; ++n) acc[n] = (f32x4){0.f, 0.f, 0.f, 0.f};
            const int c = ct * 16 + lq;
            for (int ks = 0; ks < 64; ++ks) {
                const int l = ks >> 1, d0 = (ks & 1) * 32 + quad * 8;
                int row = 16 * c + l; row = row > 2047 ? 2047 : row;
                const bf16x8 a = as_bf16x8(*(const u32x4*)(Zs + (size_t)row * OLD + d0));
#pragma unroll
                for (int n = 0; n < 8; ++n) { const bf16x8 bb = as_bf16x8(*(const u32x4*)(w1t + (size_t)(16 * n + lq) * 2048 + ks * 32 + quad * 8)); acc[n] = mfma16(a, bb, acc[n]); }
            }
#pragma unroll
            for (int n = 0; n < 8; ++n) {
                const float bv = bias1[16 * n + lq];
                f32x4 hv = acc[n]; hv[0] += bv; hv[1] += bv; hv[2] += bv; hv[3] += bv;
                gelu_tanh4(hv);
#pragma unroll
                for (int j = 0; j < 4; ++j) { const unsigned pk = pk2(hv[j], 0.f); hid[(4 * quad + j) * 136 + 16 * n + lq] = (bf16_t)(pk & 0xffffu); }
            }
            lds_wait();
            f32x4 acc2[4];
#pragma unroll
            for (int n = 0; n < 4; ++n) acc2[n] = (f32x4){0.f, 0.f, 0.f, 0.f};
#pragma unroll
            for (int ks = 0; ks < 4; ++ks) {
                const bf16x8 a = as_bf16x8(*(const u32x4*)(hid + lq * 136 + quad * 8 + 32 * ks));
#pragma unroll
                for (int n = 0; n < 4; ++n) { const bf16x8 bb = as_bf16x8(*(const u32x4*)(w2t + (size_t)(16 * n + lq) * 128 + ks * 32 + quad * 8)); acc2[n] = mfma16(a, bb, acc2[n]); }
            }
            lds_wait();
            bf16_t* dst = (bf16_t*)(p.ws + (kv ? OFF_VC : OFF_KC)) + (size_t)((b * 4 + g) * 128) * 64;
#pragma unroll
            for (int n = 0; n < 4; ++n)
#pragma unroll
                for (int j = 0; j < 4; ++j) {
                    const int cc = ct * 16 + 4 * quad + j;
                    const float v = (cc < 127) ? acc2[n][j] : 0.f;
                    dst[(size_t)cc * 64 + 16 * n + lq] = (bf16_t)(pk2(v, 0.f) & 0xffffu);
                }
        }
    }
}

__device__ __forceinline__ void select_phase(const Params& p, unsigned char* smem, int tid, int bid, int nblk) {
    const int lane = tid & 63, wave = tid >> 6, lq = lane & 15, quad = lane >> 4;
    const bf16_t* Z = (const bf16_t*)(p.ws + OFF_Z);
    const int gw = bid * 8 + wave, ngw = nblk * 8;
    float* PS = (float*)(smem + wave * 2048);
    constexpr float SC = 0.125f * 1.4426950408889634f;
    for (int task = gw; task < 8192; task += ngw) {
        const int b = task >> 9, g = (task >> 7) & 3, qt = task & 127;
        const int t = qt * 16 + lq;
        const bf16_t* kc = (const bf16_t*)(p.ws + OFF_KC) + (size_t)((b * 4 + g) * 128) * 64;
        const int cmax = (t - 31) >> 4;
        f32x4 psum[8];
#pragma unroll
        for (int sub = 0; sub < 8; ++sub) psum[sub] = (f32x4){0.f, 0.f, 0.f, 0.f};
        for (int r = 0; r < 4; ++r) {
            const int head = g * 4 + r;
            bf16x8 qf[2];
#pragma unroll
            for (int ks = 0; ks < 2; ++ks) qf[ks] = as_bf16x8(*(const u32x4*)(Z + (size_t)(b * S_ + t) * OLD + 3072 + head * 64 + quad * 8 + 32 * ks));
            f32x4 s[8]; float mx = -INFINITY;
#pragma unroll
            for (int sub = 0; sub < 8; ++sub) {
                s[sub] = (f32x4){0.f, 0.f, 0.f, 0.f};
#pragma unroll
                for (int ks = 0; ks < 2; ++ks) { const bf16x8 a = as_bf16x8(*(const u32x4*)(kc + (size_t)(16 * sub + lq) * 64 + quad * 8 + 32 * ks)); s[sub] = mfma16(a, qf[ks], s[sub]); }
#pragma unroll
                for (int j = 0; j < 4; ++j) { const int key = 16 * sub + 4 * quad + j; const float sv = (key <= cmax) ? s[sub][j] * SC : -INFINITY; s[sub][j] = sv; mx = fmaxf(mx, sv); }
            }
            mx = fmaxf(mx, __shfl_xor(mx, 16)); mx = fmaxf(mx, __shfl_xor(mx, 32));
            const float m_use = (mx == -INFINITY) ? 0.f : mx;
            float rs = 0.f;
#pragma unroll
            for (int sub = 0; sub < 8; ++sub)
#pragma unroll
                for (int j = 0; j < 4; ++j) { const float e = fexp2(s[sub][j] - m_use); s[sub][j] = e; rs += e; }
            rs += __shfl_xor(rs, 16); rs += __shfl_xor(rs, 32);
            const float inv = (rs > 0.f) ? 1.f / rs : 0.f;
#pragma unroll
            for (int sub = 0; sub < 8; ++sub)
#pragma unroll
                for (int j = 0; j < 4; ++j) psum[sub][j] += s[sub][j] * inv;
        }
        float pslc[8], tprev[8];
#pragma unroll
        for (int sub = 0; sub < 8; ++sub) tprev[sub] = __shfl(psum[sub][3], (lane + 48) & 63);
#pragma unroll
        for (int sub = 0; sub < 8; ++sub) {
            float extra;
            if (quad >= 1) extra = tprev[sub]; else extra = (sub >= 1) ? tprev[sub >= 1 ? sub - 1 : 0] : 0.f;
            pslc[sub] = ((psum[sub][0] + psum[sub][1]) + (psum[sub][2] + psum[sub][3])) + extra;
            PS[lq * 32 + 4 * sub + quad] = pslc[sub];
        }
        lds_wait();
        float pvv[32];
#pragma unroll
        for (int q = 0; q < 8; ++q) { const f32x4 v = *(const f32x4*)(PS + lq * 32 + 4 * q); pvv[4 * q] = v[0]; pvv[4 * q + 1] = v[1]; pvv[4 * q + 2] = v[2]; pvv[4 * q + 3] = v[3]; }
        lds_wait();
        const int own = t >> 6;
        unsigned bits = 0;
#pragma unroll
        for (int sub = 0; sub < 8; ++sub) {
            const int j = 4 * sub + quad; const float mv = pslc[sub];
            int cnt = 0;
#pragma unroll
            for (int j2 = 1; j2 < 32; ++j2) { const bool beats = (pvv[j2] > mv) || (pvv[j2] == mv && j2 < j); cnt += (j2 < own && j2 != j && beats) ? 1 : 0; }
            const bool sel = (j == 0) || (j == own) || (j >= 1 && j < own && cnt < 14);
            if (sel) bits |= (1u << j);
        }
        bits |= (unsigned)__shfl_xor((int)bits, 16); bits |= (unsigned)__shfl_xor((int)bits, 32);
        if (quad == 0) ((unsigned*)(p.ws + OFF_SEL))[(size_t)(b * 4 + g) * S_ + t] = bits;
    }
}

__device__ __forceinline__ void nsa_item(const Params& p, unsigned char* smem, int b, int head, int qt, int tid) {
    const int lane = tid & 63, wave = tid >> 6, lq = lane & 15, quad = lane >> 4;
    const int g = head >> 2, q0 = qt * 128, t = q0 + wave * 16 + lq;
    const bf16_t* Z = (const bf16_t*)(p.ws + OFF_Z) + (size_t)b * S_ * OLD;
    const unsigned rowmask = ((const unsigned*)(p.ws + OFF_SEL))[(size_t)(b * 4 + g) * S_ + t];
    float gate[3];
#pragma unroll
    for (int i = 0; i < 3; ++i) gate[i] = sigmoidf_(bf2f(Z[(size_t)t * OLD + 5632 + head * 3 + i]));
    f32x4 o[4], tot[4];
    const bf16_t* kc = (const bf16_t*)(p.ws + OFF_KC) + (size_t)((b * 4 + g) * 128) * 64;
    const bf16_t* vc = (const bf16_t*)(p.ws + OFF_VC) + (size_t)((b * 4 + g) * 128) * 64;
#ifndef NSA_PASSES
#define NSA_PASSES 7
#endif
    if (NSA_PASSES & 1) attn_pass<M_CMP, 64>(smem, Z + 3072 + head * 64, OLD, kc, 64, vc, 64, q0, 0u, 0.f, o, tid);
    else { o[0] = o[1] = o[2] = o[3] = (f32x4){0.f, 0.f, 0.f, 0.f}; }
#pragma unroll
    for (int c = 0; c < 4; ++c) { tot[c][0] = gate[0] * o[c][0]; tot[c][1] = gate[0] * o[c][1]; tot[c][2] = gate[0] * o[c][2]; tot[c][3] = gate[0] * o[c][3]; }
    if (NSA_PASSES & 2) attn_pass<M_SLC, 64>(smem, Z + 3072 + head * 64, OLD, Z + 4608 + g * 64, OLD, Z + 4864 + g * 64, OLD, q0, rowmask, 0.f, o, tid);
#pragma unroll
    for (int c = 0; c < 4; ++c) { tot[c][0] += gate[1] * o[c][0]; tot[c][1] += gate[1] * o[c][1]; tot[c][2] += gate[1] * o[c][2]; tot[c][3] += gate[1] * o[c][3]; }
    if (NSA_PASSES & 4) attn_pass<M_WIN, 64>(smem, Z + 3072 + head * 64, OLD, Z + 5120 + g * 64, OLD, Z + 5376 + g * 64, OLD, q0, 0u, 0.f, o, tid);
#pragma unroll
    for (int c = 0; c < 4; ++c) { tot[c][0] += gate[2] * o[c][0]; tot[c][1] += gate[2] * o[c][1]; tot[c][2] += gate[2] * o[c][2]; tot[c][3] += gate[2] * o[c][3]; }
    bf16_t* cat = (bf16_t*)(p.ws + OFF_CAT) + (size_t)(b * S_ + t) * D_ + 1024 + head * 64;
#pragma unroll
    for (int c = 0; c < 4; ++c) { u32x2 w; w.x = pk2(tot[c][0], tot[c][1]); w.y = pk2(tot[c][2], tot[c][3]); *(u32x2*)(cat + 16 * c + 4 * quad) = w; }
}

__device__ __forceinline__ void ret_item(const Params& p, unsigned char* smem, int b, int h, int qt, int tid) {
    const int lane = tid & 63, wave = tid >> 6, lq = lane & 15, quad = lane >> 4;
    const int q0 = qt * 128, t = q0 + wave * 16 + lq;
    const bf16_t* Z = (const bf16_t*)(p.ws + OFF_Z) + (size_t)b * S_ * OLD;
    const float log2g = log2f(1.f - exp2f(-5.f - (float)h));
    f32x4 o[8];
    attn_pass<M_RET, 128>(smem, Z + h * 64, OLD, Z + 512 + h * 64, OLD, Z + 1024 + h * 128, OLD, q0, 0u, log2g, o, tid);
    float sm = 0.f;
#pragma unroll
    for (int c = 0; c < 8; ++c) sm += (o[c][0] + o[c][1]) + (o[c][2] + o[c][3]);
    sm += __shfl_xor(sm, 16); sm += __shfl_xor(sm, 32);
    const float mean = sm * (1.f / 128.f);
    float sq = 0.f;
#pragma unroll
    for (int c = 0; c < 8; ++c)
#pragma unroll
        for (int j = 0; j < 4; ++j) { o[c][j] -= mean; sq += o[c][j] * o[c][j]; }
    sq += __shfl_xor(sq, 16); sq += __shfl_xor(sq, 32);
    const float rstd = rsqrtf(sq * (1.f / 128.f) + 1e-6f);
    const bf16_t* rg = Z + (size_t)t * OLD + 2048 + h * 128;
    bf16_t* cat = (bf16_t*)(p.ws + OFF_CAT) + (size_t)(b * S_ + t) * D_ + h * 128;
#pragma unroll
    for (int c = 0; c < 8; ++c) {
        const u32x2 gv = *(const u32x2*)(rg + 16 * c + 4 * quad);
        const float g0 = __uint_as_float(gv.x << 16), g1 = __uint_as_float(gv.x & 0xffff0000u), g2 = __uint_as_float(gv.y << 16), g3 = __uint_as_float(gv.y & 0xffff0000u);
        const float r0 = g0 * sigmoidf_(g0) * o[c][0] * rstd, r1 = g1 * sigmoidf_(g1) * o[c][1] * rstd, r2 = g2 * sigmoidf_(g2) * o[c][2] * rstd, r3 = g3 * sigmoidf_(g3) * o[c][3] * rstd;
        u32x2 w; w.x = pk2(r0, r1); w.y = pk2(r2, r3);
        *(u32x2*)(cat + 16 * c + 4 * quad) = w;
    }
}

__device__ __forceinline__ void odd_mixer_phase(const Params& p, unsigned char* smem, int tid, int bid, int nblk) {
    for (int it = bid; it < 6144; it += nblk) {
        const int lvl = it / 384, r = it % 384, qt = 15 - lvl;
#ifndef NO_RET
        if (r < 128) ret_item(p, smem, r >> 3, r & 7, qt, tid);
#endif
#ifndef NO_NSA
        if (r >= 128) { const int bh = r - 128; nsa_item(p, smem, bh >> 4, bh & 15, qt, tid); }
#endif
    }
}

#ifndef ONLYMASK
#define ONLYMASK 0xFFFFFFu
#endif
#define PH_ON(n) ((ONLYMASK >> (n)) & 1u)
__device__ __forceinline__ const Params& opaque_params() {
    const Params* pp = (const Params*)__builtin_amdgcn_kernarg_segment_ptr(); asm volatile("" : "+s"(pp)); return *pp;
}
__device__ __forceinline__ void run_gemm(unsigned char* smem, int ph, int bid, int nblk) {
    const Params& p = opaque_params();
    unsigned char* ws = p.ws;
    pg8::Gemm g; EpiAll E; g.M = T_;
    E.O = (bf16_t*)(ws + OFF_Z); E.ldc = EIN; E.Xin = p.out; E.Xout = p.out; E.mode = 0;
    if (ph == 1) { g.A = (const bf16_t*)(ws + OFF_H); g.Bt = (const bf16_t*)(ws + OFF_WT_EIN); g.N = EIN; g.K = D_; E.mode = 0; E.ldc = EIN; }
    else if (ph == 9) { g.A = (const bf16_t*)(ws + OFF_H); g.Bt = (const bf16_t*)(ws + OFF_WT_OIN); g.N = OLD; g.K = D_; E.mode = 0; E.ldc = OLD; }
    else if (ph == 4) { g.A = (const bf16_t*)(ws + OFF_CAT); g.Bt = (const bf16_t*)(ws + OFF_WT_EOUT); g.N = D_; g.K = D_; E.mode = 1; E.Xin = p.in[0]; }
    else if (ph == 13) { g.A = (const bf16_t*)(ws + OFF_CAT); g.Bt = (const bf16_t*)(ws + OFF_WT_OOUT); g.N = D_; g.K = D_; E.mode = 1; }
    else if (ph == 7) { g.A = (const bf16_t*)(ws + OFF_Z); g.Bt = (const bf16_t*)(ws + OFF_WT2_0); g.N = D_; g.K = FF_; E.mode = 1; }
    else if (ph == 16) { g.A = (const bf16_t*)(ws + OFF_Z); g.Bt = (const bf16_t*)(ws + OFF_WT2_1); g.N = D_; g.K = FF_; E.mode = 1; }
    else if (ph == 6) { g.A = (const bf16_t*)(ws + OFF_H); g.Bt = (const bf16_t*)(ws + OFF_WT13_0); g.N = 2 * FF_; g.K = D_; E.mode = 2; }
    else { g.A = (const bf16_t*)(ws + OFF_H); g.Bt = (const bf16_t*)(ws + OFF_WT13_1); g.N = 2 * FF_; g.K = D_; E.mode = 2; }
    pg8::StaticOrder So; So.init(g.M, g.N, (int)nblk, (int)bid);
    pg8::gemm_phase<EpiAll, pg8::StaticOrder, false>((PG8_LAS unsigned char*)smem, g, So, E, nullptr);
}
__device__ __forceinline__ void run_norm(int ph, int tid, int bid, int nblk) {
    const Params& p = opaque_params();
    const int lane = tid & 63, wave = tid >> 6;
    const int gw = bid * 8 + wave, ngw = nblk * 8;
    bf16_t* H = (bf16_t*)(p.ws + OFF_H);
#ifdef SKEL
    if (ph == 17) rmsnorm_rows(p.in[0], p.in[27], nullptr, p.out, gw, ngw, lane);
    else if (ph == 5) {}
#else
    if (ph == 17) rmsnorm_rows(p.out, p.in[27], nullptr, p.out, gw, ngw, lane);
#endif
    else rmsnorm_rows(p.out, (ph == 8 ? p.in[1] + D_ : p.in[2] + (ph == 14 ? D_ : 0)), H, nullptr, gw, ngw, lane);
}
__global__ void __launch_bounds__(512, 2) mega(Params pk) {
    extern __shared__ __attribute__((aligned(16))) unsigned char smem[];
    cg::grid_group grid = cg::this_grid();
    const int ph_lo = ((const Params*)__builtin_amdgcn_kernarg_segment_ptr())->ph_lo, ph_hi = ((const Params*)__builtin_amdgcn_kernarg_segment_ptr())->ph_hi;
#pragma nounroll
    for (int ph = ph_lo; ph < ph_hi; ++ph) {
        int tid = threadIdx.x; asm volatile("" : "+v"(tid));
        int bid = __builtin_amdgcn_workgroup_id_x(); asm volatile("" : "+s"(bid));
        int nblk = (int)__builtin_amdgcn_grid_size_x() / 512; asm volatile("" : "+s"(nblk));
        if (ph == 0) { if (PH_ON(0)) phase0(opaque_params(), smem, tid, bid, nblk); }
        else if (ph == 2) { if (PH_ON(2)) kmean_phase(opaque_params(), tid, bid, nblk); }
        else if (ph == 3) { if (PH_ON(3)) even_mixer_phase(opaque_params(), smem, tid, bid, nblk); }
        else if (ph == 10) { if (PH_ON(10)) odd_prep_phase(opaque_params(), smem, tid, bid, nblk); }
        else if (ph == 11) { if (PH_ON(11)) select_phase(opaque_params(), smem, tid, bid, nblk); }
        else if (ph == 12) { if (PH_ON(12)) odd_mixer_phase(opaque_params(), smem, tid, bid, nblk); }
#ifdef SKEL
        else if (ph == 17) { run_norm(ph, tid, bid, nblk); }
        else if (ph == 5 || ph == 8 || ph == 14) { }
#else
        else if (ph == 5 || ph == 8 || ph == 14 || ph == 17) { if (PH_ON(5)) run_norm(ph, tid, bid, nblk); }
#endif
        else { if (PH_ON(1)) run_gemm(smem, ph, bid, nblk); }
        if (ph + 1 < ph_hi) grid.sync();
    }
}

extern "C" void kernel_launch(void* const* d_in, const int* in_sizes, int n_in, void* d_out, int out_size, void* d_ws, size_t ws_size, hipStream_t stream) {
    static int grid = 0;
    if (grid == 0) {
        if (n_in != 28 || out_size != T_ * D_ || ws_size < WS_END) { fprintf(stderr, "kernel_launch: unexpected shapes (n_in %d out %d ws %zu need %zu)\n", n_in, out_size, ws_size, (size_t)WS_END); grid = -1; return; }
        int dev = 0, cus = 0, per_cu = 0;
        hipGetDevice(&dev);
        hipDeviceGetAttribute(&cus, hipDeviceAttributeMultiprocessorCount, dev);
        if (hipFuncSetAttribute((const void*)mega, hipFuncAttributeMaxDynamicSharedMemorySize, LDS_BYTES) != hipSuccess) { fprintf(stderr, "kernel_launch: hipFuncSetAttribute failed\n"); grid = -1; return; }
        hipOccupancyMaxActiveBlocksPerMultiprocessor(&per_cu, (const void*)mega, 512, LDS_BYTES);
        if (per_cu < 1) { fprintf(stderr, "kernel_launch: occupancy query says %d blocks per CU\n", per_cu); per_cu = 1; }
        (void)hipGetLastError();
        grid = cus;
    }
    if (grid < 0) return;
    Params p{};
    for (int i = 0; i < 28; ++i) p.in[i] = (const float*)d_in[i];
    p.out = (float*)d_out; p.ws = (unsigned char*)d_ws;
    for (int i = 0; i < 32; ++i) p.inv_freq[i] = pow(10000.0, -(double)i / 32.0);
    p.ph_lo = 0; p.ph_hi = NPHASE;
#ifdef ZEROCAT
    (void)hipMemsetAsync((char*)d_ws + OFF_CAT, 0, (size_t)T_ * D_ * 2, stream);
#endif
    void* args[] = {&p};
    hipError_t e = hipLaunchCooperativeKernel((const void*)mega, dim3(grid), dim3(512), args, LDS_BYTES, stream);
    if (e != hipSuccess) fprintf(stderr, "kernel_launch: cooperative launch failed: %s (grid %d)\n", hipGetErrorString(e), grid);
}
```

```cpp
#include <hip/hip_runtime.h>
#include <hip/hip_cooperative_groups.h>
#include <cstdio>
#include <cmath>
namespace cg = cooperative_groups;
namespace pg8 {
#define PG8_LAS __attribute__((address_space(3)))
typedef unsigned short bf16_t;
typedef short bf16x8 __attribute__((ext_vector_type(8)));
typedef float f32x4 __attribute__((ext_vector_type(4)));
typedef unsigned u32x4 __attribute__((ext_vector_type(4)));
constexpr int BM = 256, BK = 64, HALF = 128, HTB = HALF * BK * 2  , STAGE_BYTES = 8 * HTB, NXCD = 8, WGM = 8;

__host__ __device__ __forceinline__ int lds_byte(int r, int c) { const int st = (r >> 4) * 2 + (c >> 5), rr = r & 15, cc = c & 31, ob = rr * 64 + cc * 2; return st * 1024 + (ob ^ (((ob >> 9) & 1) << 5)); }
__host__ __device__ __forceinline__ void stage_rc(int b, int& R, int& C) { const int st = b / 1024, sb = b % 1024, swz = sb ^ (((sb >> 9) & 1) << 5); R = (st >> 1) * 16 + swz / 64; C = (st & 1) * 32 + (swz % 64) / 2; }
__host__ __device__ __forceinline__ int perm32(int rho) { const int n = rho >> 4, i = rho & 15; return 8 * (i >> 2) + 4 * n + (i & 3); }

struct Unit { int pm, pn; };
struct Gemm { const bf16_t* A; const bf16_t* Bt; int M, N, K; };

struct StaticOrder {
    int nM, nN, nwg, G, c;
    __host__ __device__ void init(int M, int N, int G_, int c_) { nM = M / BM; nN = N / BM; nwg = nM * nN; G = G_; c = c_; }
    __host__ __device__ bool next(int i, Unit& u) const {
        const long L = (long)i * G + c; if (L >= nwg) return false;
        int wgid = (int)L; { const int q = nwg / NXCD, r = nwg % NXCD, xcd = wgid % NXCD, off = wgid / NXCD; wgid = (xcd < r ? xcd * (q + 1) : r * (q + 1) + (xcd - r) * q) + off; }
        const int nig = WGM * nN, gid = wgid / nig, fm = gid * WGM, gsz = (nM - fm) < WGM ? (nM - fm) : WGM;
        u.pm = fm + ((wgid % nig) % gsz); u.pn = (wgid % nig) / gsz; return true;
    }
    __device__ __forceinline__ void a_ready(const Unit&) const {}
    __device__ __forceinline__ void done(const Unit&) const {}
};
__device__ __forceinline__ unsigned cvt_pk_bf16(float lo, float hi) { unsigned r; asm volatile("v_cvt_pk_bf16_f32 %0, %1, %2" : "=v"(r) : "v"(lo), "v"(hi)); return r; }
template <class Epi, class Sched, bool STAMP = false>
__device__ __forceinline__ void gemm_phase(PG8_LAS unsigned char* lds, const Gemm g, const Sched& S, const Epi& E, unsigned long long* stamps) {
    int tid = threadIdx.x; asm volatile("" : "+v"(tid)); const int wid = __builtin_amdgcn_readfirstlane(tid >> 6), lane = tid & 63, wr = wid >> 2, wc = wid & 3, fr = lane & 15, fq = lane >> 4;
    const int K = g.K, nt = K / BK;
    int ts_lo = 0, ts_hi = 0, nts = 0; const unsigned long long rt_entry = STAMP ? (unsigned long long)wall_clock64() : 0ull;
#define PG8_STAMP() do { if (STAMP && wid == 0 && nts < 64) { const unsigned long long _c = (unsigned long long)clock64(); \
        ts_lo = (lane == nts) ? (int)(unsigned)_c : ts_lo; ts_hi = (lane == nts) ? (int)(unsigned)(_c >> 32) : ts_hi; ++nts; } } while (0)
    PG8_STAMP();
    unsigned voffA[2], voffB[2];
#pragma unroll
    for (int i = 0; i < 2; ++i) { int R, C; stage_rc(tid * 16 + i * 8192, R, C); const int Rb = Epi::PERM ? ((R & ~31) + perm32(R & 31)) : R;
        voffA[i] = (unsigned)(R * K + C) * 2u; voffB[i] = (unsigned)(Rb * K + C) * 2u; }
    const size_t kstep = (size_t)(BK * 2);
    const size_t hstep = (size_t)HALF * K * 2;
    const size_t tstep = 2 * hstep;
    const unsigned ldsw = (unsigned)wid * 1024u;
    const int aoff = lds_byte(wr * 64 + fr, fq * 8), boff = lds_byte(wc * 32 + fr, fq * 8);
#define PG8_SA(b, h) (((b) * 2 + (h)) * HTB)
#define PG8_SB(b, h) ((4 + (b) * 2 + (h)) * HTB)
#define PG8_STAGE(bufoff, gbase, voff) do { _Pragma("unroll") for (int _i = 0; _i < 2; ++_i) \
        __builtin_amdgcn_global_load_lds((const unsigned*)((const char*)(gbase) + (voff)[_i]), (PG8_LAS unsigned*)(lds + (bufoff) + ldsw + _i * 8192), 16, 0, 0); } while (0)
#define PG8_LDA(dst, b, h) do { _Pragma("unroll") for (int m = 0; m < 4; ++m) _Pragma("unroll") for (int k = 0; k < 2; ++k) dst[m][k] = *(const PG8_LAS bf16x8*)(lds + PG8_SA(b, h) + aoff + m * 2048 + k * 1024); } while (0)
#define PG8_LDB(dst, b, h) do { _Pragma("unroll") for (int n = 0; n < 2; ++n) _Pragma("unroll") for (int k = 0; k < 2; ++k) dst[n][k] = *(const PG8_LAS bf16x8*)(lds + PG8_SB(b, h) + boff + n * 2048 + k * 1024); } while (0)
#define PG8_MMA(ai, bj, At, Bt) do { __builtin_amdgcn_s_setprio(1); _Pragma("unroll") for (int m = 0; m < 4; ++m) _Pragma("unroll") for (int n = 0; n < 2; ++n) _Pragma("unroll") for (int k = 0; k < 2; ++k) \
        acc[ai][bj][m][n] = __builtin_amdgcn_mfma_f32_16x16x32_bf16(Bt[n][k], At[m][k], acc[ai][bj][m][n], 0, 0, 0); __builtin_amdgcn_s_setprio(0); } while (0)
#define PG8_WAIT_V(n) asm volatile("s_waitcnt vmcnt(" #n ")" ::: "memory")
#define PG8_WAIT_L(n) asm volatile("s_waitcnt lgkmcnt(" #n ")" ::: "memory")
#define PG8_BAR __builtin_amdgcn_s_barrier()
#define PG8_SCHED __builtin_amdgcn_sched_barrier(0)
    Unit cur, nxt; int ui = 0;
    if (!S.next(0, cur)) return;
    f32x4 acc[2][2][4][2];
#pragma unroll
    for (int a = 0; a < 2; ++a)
#pragma unroll
        for (int b = 0; b < 2; ++b)
#pragma unroll
            for (int m = 0; m < 4; ++m)
#pragma unroll
                for (int n = 0; n < 2; ++n) acc[a][b][m][n] = (f32x4){0.f, 0.f, 0.f, 0.f};
    bf16x8 At[4][2], B0[2][2], B1[2][2];
    const char* cA = (const char*)g.A + (size_t)cur.pm * tstep; const char* cB = (const char*)g.Bt + (size_t)cur.pn * tstep;
    S.a_ready(cur);
    PG8_STAGE(PG8_SB(0, 0), cB, voffB); PG8_STAGE(PG8_SA(0, 0), cA, voffA); PG8_STAGE(PG8_SB(0, 1), cB + hstep, voffB); PG8_STAGE(PG8_SA(0, 1), cA + hstep, voffA);
    if (wr == 1) PG8_BAR;
    PG8_WAIT_V(4); PG8_BAR;
    PG8_STAGE(PG8_SB(1, 0), cB + kstep, voffB); PG8_STAGE(PG8_SA(1, 0), cA + kstep, voffA); PG8_STAGE(PG8_SB(1, 1), cB + hstep + kstep, voffB);
    PG8_WAIT_V(6); PG8_BAR;
    PG8_STAMP();
    for (;;) {
        const bool has_next = S.next(ui + 1, nxt);
        const char* nA = has_next ? (const char*)g.A + (size_t)nxt.pm * tstep : cA; const char* nB = has_next ? (const char*)g.Bt + (size_t)nxt.pn * tstep : cB;
        for (int t = 0; t < nt; t += 2) {
            const bool last = (t == nt - 2);
            const char* a1 = cA + (size_t)(t + 1) * kstep;
            const char* a2 = last ? nA : cA + (size_t)(t + 2) * kstep; const char* b2 = last ? nB : cB + (size_t)(t + 2) * kstep;
            const char* a3 = a2 + kstep; const char* b3 = b2 + kstep;
            if (last && has_next) S.a_ready(nxt);
            PG8_LDB(B0, 0, 0); PG8_SCHED; PG8_LDA(At, 0, 0); PG8_STAGE(PG8_SA(1, 1), a1 + hstep, voffA);
            PG8_WAIT_L(8); PG8_BAR; PG8_WAIT_L(0); PG8_MMA(0, 0, At, B0); PG8_BAR; PG8_SCHED;
            PG8_LDB(B1, 0, 1); PG8_STAGE(PG8_SB(0, 0), b2, voffB);
            PG8_BAR; PG8_WAIT_L(0); PG8_MMA(0, 1, At, B1); PG8_BAR;
            PG8_LDA(At, 0, 1); PG8_STAGE(PG8_SA(0, 0), a2, voffA);
            PG8_BAR; PG8_WAIT_L(0); PG8_MMA(1, 0, At, B0); PG8_BAR; PG8_SCHED;
            PG8_STAGE(PG8_SB(0, 1), b2 + hstep, voffB);
            PG8_WAIT_V(6); PG8_BAR; PG8_MMA(1, 1, At, B1); PG8_BAR;
            PG8_LDB(B0, 1, 0); PG8_SCHED; PG8_LDA(At, 1, 0); PG8_STAGE(PG8_SA(0, 1), a2 + hstep, voffA);
            PG8_WAIT_L(8); PG8_BAR; PG8_WAIT_L(0); PG8_MMA(0, 0, At, B0); PG8_BAR; PG8_SCHED;
            PG8_LDB(B1, 1, 1); PG8_STAGE(PG8_SB(1, 0), b3, voffB);
            PG8_BAR; PG8_WAIT_L(0); PG8_MMA(0, 1, At, B1); PG8_BAR;
            PG8_LDA(At, 1, 1); PG8_STAGE(PG8_SA(1, 0), a3, voffA);
            PG8_BAR; PG8_WAIT_L(0); PG8_MMA(1, 0, At, B0); PG8_BAR; PG8_SCHED;
            PG8_STAGE(PG8_SB(1, 1), b3 + hstep, voffB);
            PG8_WAIT_V(6); PG8_BAR; PG8_MMA(1, 1, At, B1); PG8_BAR;
        }
        PG8_STAMP();
        if constexpr (!Epi::AFTER_DRAIN) { E(acc, cur, wr, wc, fr, fq); S.done(cur); }
        PG8_STAMP();
        if (!has_next) break;
#pragma unroll
        for (int a = 0; a < 2; ++a)
#pragma unroll
            for (int b = 0; b < 2; ++b)
#pragma unroll
                for (int m = 0; m < 4; ++m)
#pragma unroll
                    for (int n = 0; n < 2; ++n) acc[a][b][m][n] = (f32x4){0.f, 0.f, 0.f, 0.f};
        cur = nxt; cA = nA; cB = nB; ++ui;
    }
    PG8_WAIT_V(0);
    if (wr == 0) PG8_BAR;
    PG8_BAR;
    if constexpr (Epi::AFTER_DRAIN) { E.fused(acc, cur, wr, wc, fr, fq, lds, wid, lane); S.done(cur); }
    PG8_STAMP();
    if (STAMP && wid == 0) { stamps[lane] = lane < nts ? (((unsigned long long)(unsigned)ts_hi << 32) | (unsigned)ts_lo) : 0ull;
        if (lane == 62) stamps[62] = rt_entry; if (lane == 63) stamps[63] = (unsigned long long)wall_clock64(); }
#undef PG8_STAMP
#undef PG8_SA
#undef PG8_SB
#undef PG8_STAGE
#undef PG8_LDA
#undef PG8_LDB
#undef PG8_MMA
#undef PG8_WAIT_V
#undef PG8_WAIT_L
#undef PG8_BAR
#undef PG8_SCHED
}
}

typedef unsigned short bf16_t;
typedef short bf16x8 __attribute__((ext_vector_type(8)));
typedef short s16x4 __attribute__((ext_vector_type(4)));
typedef float f32x4 __attribute__((ext_vector_type(4)));
typedef float f32x2 __attribute__((ext_vector_type(2)));
typedef unsigned u32x4 __attribute__((ext_vector_type(4)));
typedef unsigned u32x2 __attribute__((ext_vector_type(2)));
#define LAS __attribute__((address_space(3)))
#define GAS __attribute__((address_space(1)))
#define GLD(T, ptr) (*(const GAS T*)(ptr))
#define GST(T, ptr) (*(GAS T*)(ptr))

constexpr int T_ = 32768, D_ = 2048, S_ = 2048, B_ = 16, FF_ = 5632;
constexpr int EIN = 6400, OIN = 5680, OLD = 5888;
constexpr float EPS_ = 1e-6f;

constexpr size_t AL256(size_t x) { return (x + 255) & ~(size_t)255; }
constexpr size_t OFF_CTRL = 0;
constexpr size_t OFF_WT_EIN = 4096;
constexpr size_t OFF_WT_EOUT = OFF_WT_EIN + (size_t)EIN * D_ * 2;
constexpr size_t OFF_WT_OIN = OFF_WT_EOUT + (size_t)D_ * D_ * 2;
constexpr size_t OFF_WT_OOUT = OFF_WT_OIN + (size_t)OLD * D_ * 2;
constexpr size_t OFF_WT13_0 = OFF_WT_OOUT + (size_t)D_ * D_ * 2;
constexpr size_t OFF_WT13_1 = OFF_WT13_0 + (size_t)2 * FF_ * D_ * 2;
constexpr size_t OFF_WT2_0 = OFF_WT13_1 + (size_t)2 * FF_ * D_ * 2;
constexpr size_t OFF_WT2_1 = OFF_WT2_0 + (size_t)D_ * FF_ * 2;
constexpr size_t OFF_W1T_K = OFF_WT2_1 + (size_t)D_ * FF_ * 2;
constexpr size_t OFF_W1T_V = OFF_W1T_K + (size_t)128 * 2048 * 2;
constexpr size_t OFF_W2T_K = OFF_W1T_V + (size_t)128 * 2048 * 2;
constexpr size_t OFF_W2T_V = OFF_W2T_K + (size_t)64 * 128 * 2;
constexpr size_t OFF_BIAS1 = OFF_W2T_V + (size_t)64 * 128 * 2;
constexpr size_t OFF_ROPE = OFF_BIAS1 + 1024;
constexpr size_t OFF_KMEAN = OFF_ROPE + (size_t)2048 * 32 * 8;
constexpr size_t OFF_KC = OFF_KMEAN + (size_t)16 * 16 * 8 * 64 * 4;
constexpr size_t OFF_VC = OFF_KC + (size_t)16 * 4 * 128 * 64 * 2;
constexpr size_t OFF_SEL = OFF_VC + (size_t)16 * 4 * 128 * 64 * 2;
constexpr size_t OFF_H = OFF_SEL + (size_t)16 * 4 * 2048 * 4;
constexpr size_t OFF_Z = OFF_H + (size_t)T_ * D_ * 2;
constexpr size_t OFF_CAT = OFF_Z + (size_t)T_ * EIN * 2;
constexpr size_t OFF_BAR = OFF_CAT + (size_t)T_ * D_ * 2;
constexpr size_t WS_END = OFF_BAR + 16384;

constexpr int LDS_BYTES = 131072 + 16;
constexpr int NPHASE = 18;
#ifndef REP_P0
#define REP_P0 1
#endif
#ifndef REP_RWKV
#define REP_RWKV 1
#endif
#ifndef REP_MOBA
#define REP_MOBA 1
#endif
#ifndef REP_RET
#define REP_RET 1
#endif
#ifndef REP_NSA
#define REP_NSA 1
#endif
#ifndef REP_GEMM
#define REP_GEMM 1
#endif
#ifndef REP_NORM
#define REP_NORM 1
#endif
#ifndef REP_SEL
#define REP_SEL 1
#endif

struct Params {
    const float* in[28];
    float* out;
    unsigned char* ws;
    double inv_freq[32];
    int ph_lo, ph_hi;
};

__device__ __forceinline__ float bf2f(unsigned short b) { return __uint_as_float(((unsigned)b) << 16); }
typedef __bf16 bf16x2_t __attribute__((ext_vector_type(2)));
__device__ __forceinline__ unsigned pk2(float lo, float hi) { f32x2 v; v[0] = lo; v[1] = hi; const bf16x2_t r = __builtin_convertvector(v, bf16x2_t); return __builtin_bit_cast(unsigned, r); }
__device__ __forceinline__ float wave_sum(float v) {
#pragma unroll
    for (int o = 1; o < 64; o <<= 1) v += __shfl_xor(v, o);
    return v;
}
template <int CTRL> __device__ __forceinline__ float dppf(float x) {
    return __int_as_float(__builtin_amdgcn_update_dpp(0, __float_as_int(x), CTRL, 0xf, 0xf, false));
}
__device__ __forceinline__ float rowsum16(float x) {
    x += dppf<0x128>(x);
    x += dppf<0x124>(x);
    x += dppf<0x4E>(x);
    x += dppf<0xB1>(x);
    return x;
}
__device__ __forceinline__ void rowsum16x4(float& a, float& b, float& c, float& d) {
    asm volatile("" : "+v"(a), "+v"(b), "+v"(c), "+v"(d));
    a += dppf<0x128>(a); b += dppf<0x128>(b); c += dppf<0x128>(c); d += dppf<0x128>(d); asm volatile("" : "+v"(a), "+v"(b), "+v"(c), "+v"(d));
    a += dppf<0x124>(a); b += dppf<0x124>(b); c += dppf<0x124>(c); d += dppf<0x124>(d); asm volatile("" : "+v"(a), "+v"(b), "+v"(c), "+v"(d));
    a += dppf<0x4E>(a); b += dppf<0x4E>(b); c += dppf<0x4E>(c); d += dppf<0x4E>(d); asm volatile("" : "+v"(a), "+v"(b), "+v"(c), "+v"(d));
    a += dppf<0xB1>(a); b += dppf<0xB1>(b); c += dppf<0xB1>(c); d += dppf<0xB1>(d); asm volatile("" : "+v"(a), "+v"(b), "+v"(c), "+v"(d));
}
__device__ __forceinline__ float fexp2(float x) { return __builtin_amdgcn_exp2f(x); }
__device__ __forceinline__ float fexp(float x) { return __builtin_amdgcn_exp2f(x * 1.4426950408889634f); }
__device__ __forceinline__ float frcp(float x) { return __builtin_amdgcn_rcpf(x); }
__device__ __forceinline__ float sigmoidf_(float x) { return frcp(1.f + fexp(-x)); }
__device__ __forceinline__ void lds_wait() { asm volatile("s_waitcnt lgkmcnt(0)" ::: "memory"); }
__device__ __forceinline__ void unpack8(u32x4 v, float (&f)[8]) {
    f[0] = __uint_as_float(v.x << 16); f[1] = __uint_as_float(v.x & 0xffff0000u);
    f[2] = __uint_as_float(v.y << 16); f[3] = __uint_as_float(v.y & 0xffff0000u);
    f[4] = __uint_as_float(v.z << 16); f[5] = __uint_as_float(v.z & 0xffff0000u);
    f[6] = __uint_as_float(v.w << 16); f[7] = __uint_as_float(v.w & 0xffff0000u);
}
__device__ __forceinline__ bf16x8 as_bf16x8(u32x4 v) { return __builtin_bit_cast(bf16x8, v); }
__device__ __forceinline__ f32x4 mfma16(bf16x8 a, bf16x8 b, f32x4 c) { return __builtin_amdgcn_mfma_f32_16x16x32_bf16(a, b, c, 0, 0, 0); }

struct EpiAll {
    static constexpr bool PERM = true, AFTER_DRAIN = false;
    int mode; bf16_t* O; int ldc; const float* Xin; float* Xout;
    __device__ __forceinline__ void operator()(const pg8::f32x4 (&acc)[2][2][4][2], const pg8::Unit& u, int wr, int wc, int fr, int fq) const {
        const int row0 = u.pm * 256 + wr * 64 + fr;
        if (mode == 0) {
            const int col0 = u.pn * 256 + wc * 32 + 8 * fq;
#pragma unroll
            for (int ai = 0; ai < 2; ++ai)
#pragma unroll
                for (int m = 0; m < 4; ++m) {
                    bf16_t* rowp = O + (size_t)(row0 + ai * 128 + m * 16) * ldc + col0;
#pragma unroll
                    for (int bj = 0; bj < 2; ++bj) {
                        const pg8::f32x4 v0 = acc[ai][bj][m][0], v1 = acc[ai][bj][m][1];
                        u32x4 w; w.x = pk2(v0[0], v0[1]); w.y = pk2(v0[2], v0[3]); w.z = pk2(v1[0], v1[1]); w.w = pk2(v1[2], v1[3]);
                        GST(u32x4, rowp + bj * 128) = w;
                    }
                }
        } else if (mode == 1) {
            const int col0 = u.pn * 256 + wc * 32 + 8 * fq;
#pragma unroll
            for (int ai = 0; ai < 2; ++ai)
#pragma unroll
                for (int m = 0; m < 4; ++m) {
                    const size_t off = (size_t)(row0 + ai * 128 + m * 16) * D_ + col0;
#pragma unroll
                    for (int bj = 0; bj < 2; ++bj)
#pragma unroll
                        for (int n = 0; n < 2; ++n) {
                            const size_t idx = off + bj * 128 + n * 4;
                            const f32x4 x = GLD(f32x4, Xin + idx);
                            f32x4 r; r[0] = x[0] + acc[ai][bj][m][n][0]; r[1] = x[1] + acc[ai][bj][m][n][1]; r[2] = x[2] + acc[ai][bj][m][n][2]; r[3] = x[3] + acc[ai][bj][m][n][3];
                            GST(f32x4, Xout + idx) = r;
                        }
                }
        } else {
            const int col0 = u.pn * 128 + wc * 32 + 8 * fq;
#pragma unroll
            for (int ai = 0; ai < 2; ++ai)
#pragma unroll
                for (int m = 0; m < 4; ++m) {
                    bf16_t* rowp = O + (size_t)(row0 + ai * 128 + m * 16) * FF_ + col0;
                    float hv[8];
#pragma unroll
                    for (int n = 0; n < 2; ++n)
#pragma unroll
                        for (int j = 0; j < 4; ++j) { const float g = acc[ai][0][m][n][j], up = acc[ai][1][m][n][j]; hv[n * 4 + j] = g * sigmoidf_(g) * up; }
                    u32x4 w; w.x = pk2(hv[0], hv[1]); w.y = pk2(hv[2], hv[3]); w.z = pk2(hv[4], hv[5]); w.w = pk2(hv[6], hv[7]);
                    GST(u32x4, rowp) = w;
                }
        }
    }
};

template <int MODE>
__device__ __forceinline__ void prep_w(const float* Wa, const float* Wb, int K, int Nsrc, bf16_t* WT, int nOutBlocks, float* scr, int gw, int ngw, int lane, const float* gain) {
    const int nkb = K / 64, nitems = nkb * nOutBlocks;
    const int lr = lane >> 3, lc = (lane & 7) * 4;
    f32x4 cur[8], nxt[8];
    auto locate = [&](int it, const float*& src, int& c0, int& k0, int& ob) {
        ob = it % nOutBlocks; k0 = (it / nOutBlocks) * 64;
        if (MODE == 0) { src = Wa; c0 = ob * 32; }
        else { const int pn = ob >> 3, sb = ob & 7; src = (sb < 4) ? Wa : Wb; c0 = (pn * 4 + (sb & 3)) * 32; }
    };
    auto load = [&](int it, f32x4 (&v)[8]) {
        const float* src; int c0, k0, ob; locate(it, src, c0, k0, ob);
        const int col = c0 + lc;
#pragma unroll
        for (int i = 0; i < 8; ++i) v[i] = (col < Nsrc) ? GLD(f32x4, src + (size_t)(k0 + 8 * i + lr) * Nsrc + col) : (f32x4){0.f, 0.f, 0.f, 0.f};
    };
    int it = gw;
    if (it < nitems) load(it, cur);
    for (; it < nitems; it += ngw) {
        const int itn = it + ngw;
        if (itn < nitems) load(itn, nxt);
        const float* src; int c0, k0, ob; locate(it, src, c0, k0, ob);
#pragma unroll
        for (int i = 0; i < 8; ++i) {
            const int kk = 8 * i + lr; const float gk = gain ? gain[k0 + kk] : 1.f;
            float* d = scr + kk * 33 + lc;
            d[0] = cur[i][0] * gk; d[1] = cur[i][1] * gk; d[2] = cur[i][2] * gk; d[3] = cur[i][3] * gk;
        }
        lds_wait();
        const int c = lane & 7;
#pragma unroll
        for (int j = 0; j < 4; ++j) {
            const int n = (lane >> 3) + 8 * j; const float* sp = scr + (8 * c) * 33 + n;
            u32x4 o; o.x = pk2(sp[0 * 33], sp[1 * 33]); o.y = pk2(sp[2 * 33], sp[3 * 33]); o.z = pk2(sp[4 * 33], sp[5 * 33]); o.w = pk2(sp[6 * 33], sp[7 * 33]);
            GST(u32x4, WT + (size_t)(ob * 32 + n) * K + k0 + 8 * c) = o;
        }
        lds_wait();
#pragma unroll
        for (int i = 0; i < 8; ++i) cur[i] = nxt[i];
    }
}

__device__ __forceinline__ void rmsnorm_rows(const float* X, const float* g, bf16_t* H, float* OutF, int gw, int ngw, int lane) {
    f32x4 gv[8];
#pragma unroll
    for (int j = 0; j < 8; ++j) gv[j] = GLD(f32x4, (const f32x4*)g + lane + 64 * j);
    f32x4 v[8], vn[8];
    int m = gw;
    if (m < T_) {
#pragma unroll
        for (int j = 0; j < 8; ++j) v[j] = GLD(f32x4, (const f32x4*)(X + (size_t)m * D_) + lane + 64 * j);
    }
    for (; m < T_; m += ngw) {
        const int mn = m + ngw;
        if (mn < T_) {
#pragma unroll
            for (int j = 0; j < 8; ++j) vn[j] = GLD(f32x4, (const f32x4*)(X + (size_t)mn * D_) + lane + 64 * j);
        }
        float ss = 0.f;
#pragma unroll
        for (int j = 0; j < 8; ++j) ss += (v[j][0] * v[j][0] + v[j][1] * v[j][1]) + (v[j][2] * v[j][2] + v[j][3] * v[j][3]);
        ss = wave_sum(ss);
        const float rstd = rsqrtf(ss * (1.f / D_) + EPS_);
#pragma unroll
        for (int j = 0; j < 8; ++j) {
            const float y0 = v[j][0] * rstd * gv[j][0], y1 = v[j][1] * rstd * gv[j][1], y2 = v[j][2] * rstd * gv[j][2], y3 = v[j][3] * rstd * gv[j][3];
            if (H) { u32x2 o; o.x = pk2(y0, y1); o.y = pk2(y2, y3); GST(u32x2, H + (size_t)m * D_ + (lane + 64 * j) * 4) = o; }
            if (OutF) { f32x4 o; o[0] = y0; o[1] = y1; o[2] = y2; o[3] = y3; GST(f32x4, (f32x4*)(OutF + (size_t)m * D_) + lane + 64 * j) = o; }
        }
#pragma unroll
        for (int j = 0; j < 8; ++j) v[j] = vn[j];
    }
}

__device__ __forceinline__ void phase0(const Params& p, unsigned char* smem, int tid, int bid, int nblk) {
    const int lane = tid & 63, wave = tid >> 6;
    const int gw = bid * 8 + wave, ngw = nblk * 8;
    float* scr = (float*)(smem + wave * 8448);
    unsigned char* ws = p.ws;
    prep_w<0>(p.in[3], nullptr, D_, EIN, (bf16_t*)(ws + OFF_WT_EIN), EIN / 32, scr, gw, ngw, lane, nullptr);
    prep_w<0>(p.in[15], nullptr, D_, D_, (bf16_t*)(ws + OFF_WT_EOUT), D_ / 32, scr, gw, ngw, lane, nullptr);
    prep_w<0>(p.in[16], nullptr, D_, OIN, (bf16_t*)(ws + OFF_WT_OIN), OLD / 32, scr, gw, ngw, lane, nullptr);
    prep_w<0>(p.in[23], nullptr, D_, D_, (bf16_t*)(ws + OFF_WT_OOUT), D_ / 32, scr, gw, ngw, lane, nullptr);
    prep_w<1>(p.in[24], p.in[25], D_, FF_, (bf16_t*)(ws + OFF_WT13_0), 2 * FF_ / 32, scr, gw, ngw, lane, nullptr);
    prep_w<1>(p.in[24] + (size_t)D_ * FF_, p.in[25] + (size_t)D_ * FF_, D_, FF_, (bf16_t*)(ws + OFF_WT13_1), 2 * FF_ / 32, scr, gw, ngw, lane, nullptr);
    prep_w<0>(p.in[26], nullptr, FF_, D_, (bf16_t*)(ws + OFF_WT2_0), D_ / 32, scr, gw, ngw, lane, nullptr);
    prep_w<0>(p.in[26] + (size_t)FF_ * D_, nullptr, FF_, D_, (bf16_t*)(ws + OFF_WT2_1), D_ / 32, scr, gw, ngw, lane, nullptr);
    prep_w<0>(p.in[18], nullptr, 2048, 128, (bf16_t*)(ws + OFF_W1T_K), 4, scr, gw, ngw, lane, nullptr);
    prep_w<0>(p.in[21], nullptr, 2048, 128, (bf16_t*)(ws + OFF_W1T_V), 4, scr, gw, ngw, lane, nullptr);
    prep_w<0>(p.in[19], nullptr, 128, 64, (bf16_t*)(ws + OFF_W2T_K), 2, scr, gw, ngw, lane, nullptr);
    prep_w<0>(p.in[22], nullptr, 128, 64, (bf16_t*)(ws + OFF_W2T_V), 2, scr, gw, ngw, lane, nullptr);
    if (gw < 256) {
        const int kv = gw >> 7, n = gw & 127;
        const float* pe = p.in[kv ? 20 : 17]; const float* w1 = p.in[kv ? 21 : 18];
        float s = 0.f;
        for (int k = lane; k < 2048; k += 64) s += pe[k] * w1[(size_t)k * 128 + n];
        s = wave_sum(s);
        if (lane == 0) ((float*)(ws + OFF_BIAS1))[gw] = s;
    }
    {
        f32x2* rope = (f32x2*)(ws + OFF_ROPE);
        for (int e = bid * 512 + tid; e < 2048 * 32; e += nblk * 512) {
            const int pos = e >> 5, i = e & 31;
            const double ang = (double)pos * p.inv_freq[i];
            const double kq = rint(ang * 0.63661977236758134308);
            double r = fma(-kq, 1.57079632679489655800e+00, ang);
            r = fma(-kq, 6.12323399573676603587e-17, r);
            const float rf = (float)r;
            const float r2 = rf * rf;
            const float sn = rf * (1.f + r2 * (-1.6666667e-1f + r2 * (8.3333333e-3f + r2 * (-1.9841270e-4f + r2 * 2.7557319e-6f))));
            const float cs = 1.f + r2 * (-0.5f + r2 * (4.1666667e-2f + r2 * (-1.3888889e-3f + r2 * (2.4801587e-5f + r2 * -2.7557319e-7f))));
            const int q = ((int)kq) & 3;
            float c, s;
            if (q == 0) { c = cs; s = sn; } else if (q == 1) { c = -sn; s = cs; } else if (q == 2) { c = -cs; s = -sn; } else { c = sn; s = -cs; }
            f32x2 o; o[0] = c; o[1] = s; rope[e] = o;
        }
    }
    rmsnorm_rows(p.in[0], p.in[1], (bf16_t*)(ws + OFF_H), nullptr, gw, ngw, lane);
}

enum { M_MOBA = 0, M_SLC = 1, M_WIN = 2, M_CMP = 3, M_RET = 4 };
template <int MODE, int DV>
__device__ __forceinline__ void attn_pass(unsigned char* smem, const bf16_t* Qb, int ldq, const bf16_t* Kb, int ldk, const bf16_t* Vb, int ldv,
                                          int q0, unsigned rowmask, float log2g, f32x4 (&o)[DV / 16], int tid) {
    constexpr int VST = DV + 8;
    const int lane = tid & 63, wave = tid >> 6, lq = lane & 15, quad = lane >> 4;
    const int t = q0 + wave * 16 + lq;
    constexpr int KSZ = 64 * 72 * 2, BUFSZ = KSZ + 64 * VST * 2;
    bf16x8 qf[2];
#pragma unroll
    for (int ks = 0; ks < 2; ++ks) qf[ks] = as_bf16x8(GLD(u32x4, Qb + (size_t)t * ldq + quad * 8 + 32 * ks));
    float m = -INFINITY, l = 0.f;
#pragma unroll
    for (int c = 0; c < DV / 16; ++c) o[c] = (f32x4){0.f, 0.f, 0.f, 0.f};
    int kt_lo = 0, kt_hi = (q0 + 127) >> 6;
    if (MODE == M_WIN) { const int lo = q0 - 511; kt_lo = (lo > 0 ? lo : 0) >> 6; }
    if (MODE == M_CMP) { kt_hi = (q0 + 127 >= 64 * 16 + 31) ? 1 : 0; }
    constexpr float SC = 0.125f * 1.4426950408889634f;
    const int q4 = lq >> 2, pp = lq & 3;
    float dk[4][4];
#pragma unroll
    for (int sub = 0; sub < 4; ++sub)
#pragma unroll
        for (int j = 0; j < 4; ++j) dk[sub][j] = (MODE == M_RET) ? 0.125f * fexp2(-(float)(16 * sub + 4 * quad + j) * log2g) : 0.f;
    const int rk_ = tid >> 3, chk_ = tid & 7;
    u32x4 kreg, vreg[DV / 64];
    auto gload = [&](int kt) {
        kreg = GLD(u32x4, Kb + (size_t)(kt * 64 + rk_) * ldk + chk_ * 8);
#pragma unroll
        for (int i = 0; i < DV / 64; ++i) { const int idx = tid + i * 512; const int r = idx / (DV / 8), ch = idx % (DV / 8); vreg[i] = GLD(u32x4, Vb + (size_t)(kt * 64 + r) * ldv + ch * 8); }
    };
    auto lstore = [&](int b) {
        bf16_t* Ks_ = (bf16_t*)(smem + b * BUFSZ); bf16_t* Vs_ = (bf16_t*)(smem + b * BUFSZ + KSZ);
        *(u32x4*)(Ks_ + rk_ * 72 + chk_ * 8) = kreg;
#pragma unroll
        for (int i = 0; i < DV / 64; ++i) { const int idx = tid + i * 512; const int r = idx / (DV / 8), ch = idx % (DV / 8); *(u32x4*)(Vs_ + r * VST + ch * 8) = vreg[i]; }
    };
    gload(kt_lo);
    __syncthreads();
    lstore(0);
    if (kt_lo + 1 <= kt_hi) gload(kt_lo + 1);
    __syncthreads();
    int bsel = 0;
    for (int kt = kt_lo; kt <= kt_hi; ++kt, bsel ^= 1) {
        if (kt + 1 <= kt_hi) lstore(bsel ^ 1);
        if (kt + 2 <= kt_hi) gload(kt + 2);
        const bf16_t* Ks = (const bf16_t*)(smem + bsel * BUFSZ); const bf16_t* Vs = (const bf16_t*)(smem + bsel * BUFSZ + KSZ);
        const int kbase = kt * 64;
        bool lane_any;
        if (MODE == M_MOBA) lane_any = (kbase <= t) && ((rowmask >> (kt >> 2)) & 1u);
        else if (MODE == M_SLC) lane_any = (kbase <= t) && ((rowmask >> kt) & 1u);
        else if (MODE == M_WIN) lane_any = (kbase <= t) && (kbase + 63 > t - 512);
        else if (MODE == M_CMP) lane_any = (kbase * 16 + 31 <= t);
        else lane_any = (kbase <= t);
        if (__any(lane_any ? 1 : 0)) {
        f32x4 s[4];
#pragma unroll
        for (int sub = 0; sub < 4; ++sub) {
            s[sub] = (f32x4){0.f, 0.f, 0.f, 0.f};
#pragma unroll
            for (int ks = 0; ks < 2; ++ks) { const bf16x8 a = as_bf16x8(*(const u32x4*)(Ks + (16 * sub + lq) * 72 + quad * 8 + 32 * ks)); s[sub] = mfma16(a, qf[ks], s[sub]); }
        }
        float pv[4][4];
        const int t_min = q0 + wave * 16;
        bool need_mask;
        if (MODE == M_WIN) need_mask = (kbase + 63 > t_min) || (kbase <= t_min + 15 - 512);
        else if (MODE == M_CMP) need_mask = true;
        else need_mask = (kbase + 63 > t_min);
        if (MODE != M_RET) {
            float mx = -INFINITY;
            if (need_mask) {
#pragma unroll
                for (int sub = 0; sub < 4; ++sub)
#pragma unroll
                    for (int j = 0; j < 4; ++j) {
                        const int key = kbase + 16 * sub + 4 * quad + j;
                        bool valid;
                        if (MODE == M_MOBA || MODE == M_SLC) valid = lane_any && (key <= t);
                        else if (MODE == M_WIN) valid = (key <= t) && (key > t - 512);
                        else valid = (key * 16 + 31 <= t);
                        const float sv = valid ? s[sub][j] : -INFINITY;
                        pv[sub][j] = sv; mx = fmaxf(mx, sv);
                    }
            } else if (MODE == M_MOBA || MODE == M_SLC) {
#pragma unroll
                for (int sub = 0; sub < 4; ++sub)
#pragma unroll
                    for (int j = 0; j < 4; ++j) { const float sv = lane_any ? s[sub][j] : -INFINITY; pv[sub][j] = sv; mx = fmaxf(mx, sv); }
            } else {
#pragma unroll
                for (int sub = 0; sub < 4; ++sub)
#pragma unroll
                    for (int j = 0; j < 4; ++j) { pv[sub][j] = s[sub][j]; mx = fmaxf(mx, s[sub][j]); }
            }
            mx = fmaxf(mx, __shfl_xor(mx, 16)); mx = fmaxf(mx, __shfl_xor(mx, 32));
            const float m_new = fmaxf(m, mx * SC);
            const float m_use = (m_new == -INFINITY) ? 0.f : m_new;
            const float alpha = fexp2(m - m_use);
            float rs = 0.f;
#pragma unroll
            for (int sub = 0; sub < 4; ++sub)
#pragma unroll
                for (int j = 0; j < 4; ++j) { const float e = fexp2(__builtin_fmaf(pv[sub][j], SC, -m_use)); pv[sub][j] = e; rs += e; }
            l = l * alpha + rs; m = m_new;
            if (__any(alpha != 1.f ? 1 : 0)) {
#pragma unroll
                for (int c = 0; c < DV / 16; ++c) { o[c][0] *= alpha; o[c][1] *= alpha; o[c][2] *= alpha; o[c][3] *= alpha; }
            }
        } else {
            const float rowfac = fexp2((float)(t - kbase) * log2g);
            if (need_mask) {
#pragma unroll
                for (int sub = 0; sub < 4; ++sub)
#pragma unroll
                    for (int j = 0; j < 4; ++j) { const int key = kbase + 16 * sub + 4 * quad + j; pv[sub][j] = (key <= t) ? (s[sub][j] * dk[sub][j]) * rowfac : 0.f; }
            } else {
#pragma unroll
                for (int sub = 0; sub < 4; ++sub)
#pragma unroll
                    for (int j = 0; j < 4; ++j) pv[sub][j] = (s[sub][j] * dk[sub][j]) * rowfac;
            }
        }
        bf16x8 pb[2];
#pragma unroll
        for (int s2 = 0; s2 < 2; ++s2) {
            u32x4 w; w.x = pk2(pv[2 * s2][0], pv[2 * s2][1]); w.y = pk2(pv[2 * s2][2], pv[2 * s2][3]); w.z = pk2(pv[2 * s2 + 1][0], pv[2 * s2 + 1][1]); w.w = pk2(pv[2 * s2 + 1][2], pv[2 * s2 + 1][3]);
            pb[s2] = as_bf16x8(w);
        }
#pragma unroll
        for (int c = 0; c < DV / 16; ++c)
#pragma unroll
            for (int s2 = 0; s2 < 2; ++s2) {
                const s16x4 t1 = __builtin_amdgcn_ds_read_tr16_b64_v4i16((LAS s16x4*)(Vs + (32 * s2 + 4 * quad + q4) * VST + 16 * c + 4 * pp));
                const s16x4 t2 = __builtin_amdgcn_ds_read_tr16_b64_v4i16((LAS s16x4*)(Vs + (32 * s2 + 16 + 4 * quad + q4) * VST + 16 * c + 4 * pp));
                bf16x8 a; a[0] = t1[0]; a[1] = t1[1]; a[2] = t1[2]; a[3] = t1[3]; a[4] = t2[0]; a[5] = t2[1]; a[6] = t2[2]; a[7] = t2[3];
                o[c] = mfma16(a, pb[s2], o[c]);
            }
            }
        __syncthreads();
    }
    if (MODE != M_RET) {
        l += __shfl_xor(l, 16); l += __shfl_xor(l, 32);
        const float inv = (l > 0.f) ? 1.f / l : 1.f;
#pragma unroll
        for (int c = 0; c < DV / 16; ++c) { o[c][0] *= inv; o[c][1] *= inv; o[c][2] *= inv; o[c][3] *= inv; }
    }
}

__device__ __forceinline__ void kmean_phase(const Params& p, int tid, int bid, int nblk) {
    const bf16_t* Z = (const bf16_t*)(p.ws + OFF_Z);
    float* km = (float*)(p.ws + OFF_KMEAN);
    for (int it = bid; it < 256; it += nblk) {
        const int b = it >> 4, n = (it >> 1) & 7, half = it & 1;
        const int ch = half * 512 + tid;
        const bf16_t* src = Z + ((size_t)(b * S_ + n * 256)) * EIN + 1024 + ch;
        float s = 0.f;
#pragma unroll 8
        for (int tt = 0; tt < 256; ++tt) s += bf2f(GLD(bf16_t, src + (size_t)tt * EIN));
        const int h = ch >> 6, d = ch & 63;
        GST(float, km + ((size_t)(b * 16 + h) * 8 + n) * 64 + d) = s * (1.f / 256.f);
    }
}

__device__ __forceinline__ void moba_item(const Params& p, unsigned char* smem, int b, int h, int qt, int tid) {
    const int lane = tid & 63, wave = tid >> 6, lq = lane & 15, quad = lane >> 4;
    const bf16_t* Z = (const bf16_t*)(p.ws + OFF_Z) + (size_t)b * S_ * EIN;
    const int q0 = qt * 128, t = q0 + wave * 16 + lq, own = q0 >> 8;
    unsigned rowmask = 1u << own;
    if (own > 0) {
        const float* km = (const float*)(p.ws + OFF_KMEAN) + (size_t)(b * 16 + h) * 8 * 64;
        float gsc[7];
#pragma unroll
        for (int n = 0; n < 7; ++n) gsc[n] = 0.f;
#pragma unroll 1
        for (int c8 = 0; c8 < 8; ++c8) {
            float f[8]; unpack8(GLD(u32x4, Z + (size_t)t * EIN + h * 64 + c8 * 8), f);
#pragma unroll
            for (int n = 0; n < 7; ++n) {
                const f32x4 k0 = GLD(f32x4, km + n * 64 + c8 * 8), k1 = GLD(f32x4, km + n * 64 + c8 * 8 + 4);
                gsc[n] += (f[0] * k0[0] + f[1] * k0[1]) + (f[2] * k0[2] + f[3] * k0[3]) + (f[4] * k1[0] + f[5] * k1[1]) + (f[6] * k1[2] + f[7] * k1[3]);
            }
        }
#pragma unroll
        for (int n = 0; n < 7; ++n) {
            int cnt = 0;
#pragma unroll
            for (int n2 = 0; n2 < 7; ++n2) { if (n2 != n) { const bool beats = (gsc[n2] > gsc[n]) || (gsc[n2] == gsc[n] && n2 < n); cnt += (n2 < own && beats) ? 1 : 0; } }
            if (n < own && cnt < 3) rowmask |= (1u << n);
        }
    }
    f32x4 o[4];
    attn_pass<M_MOBA, 64>(smem, Z + h * 64, EIN, Z + 1024 + h * 64, EIN, Z + 2048 + h * 64, EIN, q0, rowmask, 0.f, o, tid);
    bf16_t* cat = (bf16_t*)(p.ws + OFF_CAT) + (size_t)(b * S_ + t) * D_ + h * 64;
#pragma unroll
    for (int c = 0; c < 4; ++c) { u32x2 w; w.x = pk2(o[c][0], o[c][1]); w.y = pk2(o[c][2], o[c][3]); GST(u32x2, cat + 16 * c + 4 * quad) = w; }
}

__device__ __forceinline__ void rwkv_item(const Params& p, unsigned char* smem, int b, int h, int tid) {
    const int lane = tid & 63, wave = tid >> 6, lq = lane & 15, quad = lane >> 4;
    constexpr int ZB = 3072;
    const bf16_t* Z = (const bf16_t*)(p.ws + OFF_Z) + (size_t)b * S_ * EIN;
    const float* mu = p.in[4];
    float* R = (float*)smem;
    float* KP = R + 2048; float* V = KP + 2048; float* DEC = V + 2048; float* NKK = DEC + 2048; float* KKA = NKK + 2048;
    float* GG = KKA + 2048; float* Y = GG + 2048; float* AA = Y + 2048; float* BC = AA + 2048;
    bf16_t* TW = (bf16_t*)(BC + 64);
    bf16_t* AL = TW + 32 * 72;
    bf16_t* GL = AL + 32 * 72;
    const int mt = wave >> 2, nt = wave & 3;
    const int chn = h * 64 + 16 * nt + lq;
    bf16x8 bw[2], ba[2], bg[4];
    {
        const float* wup = p.in[6]; const float* aup = p.in[8]; const float* gup = p.in[9];
#pragma unroll
        for (int ks = 0; ks < 2; ++ks) {
            float fw[8], fa[8];
#pragma unroll
            for (int i = 0; i < 8; ++i) { const int k = 32 * ks + quad * 8 + i; fw[i] = wup[(size_t)k * 1024 + chn]; fa[i] = aup[(size_t)k * 1024 + chn]; }
            u32x4 w; w.x = pk2(fw[0], fw[1]); w.y = pk2(fw[2], fw[3]); w.z = pk2(fw[4], fw[5]); w.w = pk2(fw[6], fw[7]); bw[ks] = as_bf16x8(w);
            u32x4 a; a.x = pk2(fa[0], fa[1]); a.y = pk2(fa[2], fa[3]); a.z = pk2(fa[4], fa[5]); a.w = pk2(fa[6], fa[7]); ba[ks] = as_bf16x8(a);
        }
#pragma unroll
        for (int ks = 0; ks < 4; ++ks) {
            float fg[8];
#pragma unroll
            for (int i = 0; i < 8; ++i) { const int k = 32 * ks + quad * 8 + i; fg[i] = gup[(size_t)k * 1024 + chn]; }
            u32x4 g; g.x = pk2(fg[0], fg[1]); g.y = pk2(fg[2], fg[3]); g.z = pk2(fg[4], fg[5]); g.w = pk2(fg[6], fg[7]); bg[ks] = as_bf16x8(g);
        }
    }
    const float w0c = p.in[5][chn], a0c = p.in[7][chn];
    const int cs = tid & 15, ttC = tid >> 4;
    const f32x4 kkc = *(const f32x4*)(p.in[10] + h * 64 + 4 * cs), kac = *(const f32x4*)(p.in[11] + h * 64 + 4 * cs), rkc = *(const f32x4*)(p.in[12] + h * 64 + 4 * cs);
    const f32x4 lng = *(const f32x4*)(p.in[13] + h * 64 + 4 * cs), lnb = *(const f32x4*)(p.in[14] + h * 64 + 4 * cs);
    const int js = tid & 15, rp = tid >> 4;
    f32x2 P[4];
#pragma unroll
    for (int e = 0; e < 4; ++e) P[e] = (f32x2){0.f, 0.f};
    bf16_t* cat = (bf16_t*)(p.ws + OFF_CAT) + (size_t)b * S_ * D_ + 1024 + h * 64;

    int a_off[4];
#pragma unroll
    for (int i = 0; i < 4; ++i) {
        const int idx = tid + 512 * i; const int tt = idx / 56, cv = idx % 56;
        int zc;
        if (cv < 8) zc = ZB + h * 64 + cv * 8;
        else if (cv < 16) zc = ZB + 1024 + h * 64 + (cv - 8) * 8;
        else if (cv < 24) zc = ZB + 2048 + h * 64 + (cv - 16) * 8;
        else zc = ZB + 3072 + (cv - 24) * 8;
        a_off[i] = (idx < 1792) ? (tt * EIN + zc) : zc;
    }
    u32x4 a_cur[4], a_prv[4];
#pragma unroll
    for (int i = 0; i < 4; ++i) {
        const bool act = (i < 3) || (tid < 256);
        a_cur[i] = (u32x4){0u, 0u, 0u, 0u}; a_prv[i] = (u32x4){0u, 0u, 0u, 0u};
        if (act) { a_cur[i] = GLD(u32x4, Z + a_off[i]); if (a_off[i] >= EIN) a_prv[i] = GLD(u32x4, Z + a_off[i] - EIN); }
    }
    for (int t0 = 0; t0 < S_; t0 += 32) {
        __syncthreads();
#pragma unroll
        for (int i = 0; i < 4; ++i) {
            const int idx = tid + 512 * i;
            if ((i < 3) || (tid < 256)) {
            const int tt = idx / 56, cv = idx % 56;
            const int zc = a_off[i] - tt * EIN;
            float cur[8], prv[8];
            unpack8(a_cur[i], cur); unpack8(a_prv[i], prv);
            const f32x4 m0 = GLD(f32x4, mu + (zc - ZB)), m1 = GLD(f32x4, mu + (zc - ZB) + 4);
            float val[8];
#pragma unroll
            for (int e = 0; e < 4; ++e) { val[e] = cur[e] + (prv[e] - cur[e]) * m0[e]; val[4 + e] = cur[4 + e] + (prv[4 + e] - cur[4 + e]) * m1[e]; }
            if (cv < 24) {
                float* dst = (cv < 8 ? R : (cv < 16 ? KP : V)) + tt * 64 + (cv & 7) * 8;
                *(f32x4*)dst = (f32x4){val[0], val[1], val[2], val[3]}; *(f32x4*)(dst + 4) = (f32x4){val[4], val[5], val[6], val[7]};
            } else {
                if (cv < 32) {
#pragma unroll
                    for (int e = 0; e < 8; ++e) { const float ex = fexp(2.f * val[e]); val[e] = 1.f - 2.f * frcp(ex + 1.f); } }
                else if (cv >= 40) {
#pragma unroll
                    for (int e = 0; e < 8; ++e) val[e] = sigmoidf_(val[e]); }
                u32x4 w; w.x = pk2(val[0], val[1]); w.y = pk2(val[2], val[3]); w.z = pk2(val[4], val[5]); w.w = pk2(val[6], val[7]);
                bf16_t* dst = (cv < 32) ? (TW + tt * 72 + (cv - 24) * 8) : ((cv < 40) ? (AL + tt * 72 + (cv - 32) * 8) : (GL + tt * 136 + (cv - 40) * 8));
                *(u32x4*)dst = w;
            }
            }
        }
        __syncthreads();
        if (t0 + 32 < S_) {
#pragma unroll
            for (int i = 0; i < 4; ++i) {
                if ((i < 3) || (tid < 256)) { const size_t o = (size_t)(t0 + 32) * EIN + a_off[i]; a_cur[i] = GLD(u32x4, Z + o); a_prv[i] = GLD(u32x4, Z + o - EIN); }
            }
        }
        {
            f32x4 cw = (f32x4){0.f, 0.f, 0.f, 0.f}, ca = cw, cg_ = cw;
#pragma unroll
            for (int ks = 0; ks < 2; ++ks) {
                const bf16x8 a1 = as_bf16x8(*(const u32x4*)(TW + (16 * mt + lq) * 72 + quad * 8 + 32 * ks));
                const bf16x8 a2 = as_bf16x8(*(const u32x4*)(AL + (16 * mt + lq) * 72 + quad * 8 + 32 * ks));
                cw = mfma16(a1, bw[ks], cw); ca = mfma16(a2, ba[ks], ca);
            }
#pragma unroll
            for (int ks = 0; ks < 4; ++ks) { const bf16x8 a3 = as_bf16x8(*(const u32x4*)(GL + (16 * mt + lq) * 136 + quad * 8 + 32 * ks)); cg_ = mfma16(a3, bg[ks], cg_); }
#pragma unroll
            for (int j = 0; j < 4; ++j) {
                const int tt = 16 * mt + 4 * quad + j, ch = 16 * nt + lq;
                const float wf = cw[j] + w0c;
                const float sp = (wf < -15.f) ? -wf : __logf(1.f + fexp(-wf));
                const float wv = -sp - 0.5f;
                DEC[tt * 64 + ch] = fexp(-fexp(wv));
                AA[tt * 64 + ch] = sigmoidf_(ca[j] + a0c);
                GG[tt * 64 + ch] = cg_[j];
            }
        }
        __syncthreads();
        {
            const f32x4 k4 = *(const f32x4*)(KP + ttC * 64 + 4 * cs), a4 = *(const f32x4*)(AA + ttC * 64 + 4 * cs), r4 = *(const f32x4*)(R + ttC * 64 + 4 * cs);
            f32x4 kkv; float ss = 0.f;
#pragma unroll
            for (int e = 0; e < 4; ++e) { kkv[e] = k4[e] * kkc[e]; ss += kkv[e] * kkv[e]; }
            ss = rowsum16(ss);
            const float inv = fminf(__builtin_amdgcn_rsqf(ss), 1e12f);
            f32x4 nk, ka, kp; float bc = 0.f;
#pragma unroll
            for (int e = 0; e < 4; ++e) { const float kk = kkv[e] * inv; nk[e] = -kk; ka[e] = kk * a4[e]; kp[e] = k4[e] * (1.f + (a4[e] - 1.f) * kac[e]); bc += r4[e] * kp[e] * rkc[e]; }
            bc = rowsum16(bc);
            *(f32x4*)(NKK + ttC * 64 + 4 * cs) = nk; *(f32x4*)(KKA + ttC * 64 + 4 * cs) = ka; *(f32x4*)(KP + ttC * 64 + 4 * cs) = kp;
            if (cs == 0) BC[ttC] = bc;
        }
        __syncthreads();
        {
            f32x4 nk = *(const f32x4*)(NKK + 4 * js), wd = *(const f32x4*)(DEC + 4 * js), ka = *(const f32x4*)(KKA + 4 * js);
            f32x4 kp = *(const f32x4*)(KP + 4 * js), rr = *(const f32x4*)(R + 4 * js);
            f32x2 vv = *(const f32x2*)(V + 2 * rp);
            float yq0 = 0.f, yq1 = 0.f;
#pragma unroll 4
            for (int tt = 0; tt < 32; ++tt) {
                const int tn = (tt < 31) ? tt + 1 : 31;
                const f32x4 nk2 = *(const f32x4*)(NKK + tn * 64 + 4 * js), wd2 = *(const f32x4*)(DEC + tn * 64 + 4 * js), ka2 = *(const f32x4*)(KKA + tn * 64 + 4 * js);
                const f32x4 kp2 = *(const f32x4*)(KP + tn * 64 + 4 * js), rr2 = *(const f32x4*)(R + tn * 64 + 4 * js);
                const f32x2 vv2 = *(const f32x2*)(V + tn * 64 + 2 * rp);
                f32x2 sa = (P[0] * nk[0] + P[1] * nk[1]) + (P[2] * nk[2] + P[3] * nk[3]);
                float sa0 = sa[0], sa1 = sa[1];
                rowsum16x4(sa0, sa1, yq0, yq1);
                if (tt > 0 && js == 0) { f32x2 yy; yy[0] = yq0; yy[1] = yq1; *(f32x2*)(Y + (tt - 1) * 64 + 2 * rp) = yy; }
                f32x2 sav; sav[0] = sa0; sav[1] = sa1;
#pragma unroll
                for (int e = 0; e < 4; ++e) P[e] = P[e] * wd[e] + (sav * ka[e] + vv * kp[e]);
                const f32x2 yv = (P[0] * rr[0] + P[1] * rr[1]) + (P[2] * rr[2] + P[3] * rr[3]);
                yq0 = yv[0]; yq1 = yv[1];
                nk = nk2; wd = wd2; ka = ka2; kp = kp2; rr = rr2; vv = vv2;
            }
            yq0 = rowsum16(yq0); yq1 = rowsum16(yq1);
            if (js == 0) { f32x2 yy; yy[0] = yq0; yy[1] = yq1; *(f32x2*)(Y + 31 * 64 + 2 * rp) = yy; }
        }
        __syncthreads();
        {
            const f32x4 y4 = *(const f32x4*)(Y + ttC * 64 + 4 * cs), v4 = *(const f32x4*)(V + ttC * 64 + 4 * cs), g4 = *(const f32x4*)(GG + ttC * 64 + 4 * cs);
            float sm = (y4[0] + y4[1]) + (y4[2] + y4[3]);
            sm = rowsum16(sm);
            const float mean = sm * (1.f / 64.f);
            float dv[4], sq = 0.f;
#pragma unroll
            for (int e = 0; e < 4; ++e) { dv[e] = y4[e] - mean; sq += dv[e] * dv[e]; }
            sq = rowsum16(sq);
            const float rstd = rsqrtf(sq * (1.f / 64.f) + 6.4e-4f);
            const float bc = BC[ttC];
            float ov[4];
#pragma unroll
            for (int e = 0; e < 4; ++e) ov[e] = (dv[e] * rstd * lng[e] + lnb[e] + bc * v4[e]) * g4[e];
            u32x2 w; w.x = pk2(ov[0], ov[1]); w.y = pk2(ov[2], ov[3]);
            GST(u32x2, cat + (size_t)(t0 + ttC) * D_ + 4 * cs) = w;
        }
    }
}

__device__ __forceinline__ void even_mixer_phase(const Params& p, unsigned char* smem, int tid, int bid, int nblk) {
    for (int rep = 0; rep < REP_RWKV; ++rep)
    for (int it = bid; it < 256; it += nblk) rwkv_item(p, smem, it >> 4, it & 15, tid);
    for (int rep = 0; rep < REP_MOBA; ++rep)
    for (int it = bid; it < 4096; it += nblk) {
        const int qt = 15 - (it >> 8), bh = it & 255;
        moba_item(p, smem, bh >> 4, bh & 15, qt, tid);
    }
}

__device__ __forceinline__ void gelu_tanh4(f32x4& v) {
#pragma unroll
    for (int j = 0; j < 4; ++j) { const float x = v[j]; const float u = 0.7978845608028654f * (x + 0.044715f * x * x * x); const float ex = fexp(2.f * u); const float th = 1.f - 2.f * frcp(ex + 1.f); v[j] = 0.5f * x * (1.f + th); }
}

__device__ __forceinline__ void odd_prep_phase(const Params& p, unsigned char* smem, int tid, int bid, int nblk) {
    const int lane = tid & 63, wave = tid >> 6, lq = lane & 15, quad = lane >> 4;
    bf16_t* Z = (bf16_t*)(p.ws + OFF_Z);
    {
        const f32x2* rope = (const f32x2*)(p.ws + OFF_ROPE);
        const int nthreads = nblk * 512;
        for (int it = bid * 512 + tid; it < T_ * 64; it += nthreads) {
            const int row = it >> 6, wh = (it >> 2) & 15, cidx = it & 3;
            const int pos = row & (S_ - 1);
            bf16_t* base = Z + (size_t)row * OLD + wh * 64 + cidx * 8;
            float z1[8], z2[8];
            unpack8(GLD(u32x4, base), z1); unpack8(GLD(u32x4, base + 32), z2);
            float o1[8], o2[8];
#pragma unroll
            for (int e = 0; e < 8; ++e) { const f32x2 cs = GLD(f32x2, rope + pos * 32 + cidx * 8 + e); o1[e] = z1[e] * cs[0] - z2[e] * cs[1]; o2[e] = z1[e] * cs[1] + z2[e] * cs[0]; }
            u32x4 w1; w1.x = pk2(o1[0], o1[1]); w1.y = pk2(o1[2], o1[3]); w1.z = pk2(o1[4], o1[5]); w1.w = pk2(o1[6], o1[7]);
            u32x4 w2; w2.x = pk2(o2[0], o2[1]); w2.y = pk2(o2[2], o2[3]); w2.z = pk2(o2[4], o2[5]); w2.w = pk2(o2[6], o2[7]);
            GST(u32x4, base) = w1; GST(u32x4, base + 32) = w2;
        }
    }
    {
        const int gw = bid * 8 + wave, ngw = nblk * 8;
        bf16_t* hid = (bf16_t*)(smem + wave * (16 * 136 * 2));
        for (int task = gw; task < 1024; task += ngw) {
            const int kv = task >> 9, b = (task >> 5) & 15, g = (task >> 3) & 3, ct = task & 7;
            const bf16_t* Zs = Z + (size_t)b * S_ * OLD + (kv ? 4352 : 4096) + g * 64;
            const bf16_t* w1t = (const bf16_t*)(p.ws + (kv ? OFF_W1T_V : OFF_W1T_K));
            const bf16_t* w2t = (const bf16_t*)(p.ws + (kv ? OFF_W2T_V : OFF_W2T_K));
            const float* bias1 = (const float*)(p.ws + OFF_BIAS1) + kv * 128;
            f32x4 acc[8];
#pragma unroll
            for (int n = 0; n < 8; ++n) acc[n] = (f32x4){0.f, 0.f, 0.f, 0.f};
            const int c = ct * 16 + lq;
            bf16x8 a_c, b_c[8], a_n, b_n[8];
            auto cload = [&](int ks, bf16x8& a, bf16x8 (&bb)[8]) {
                const int l = ks >> 1, d0 = (ks & 1) * 32 + quad * 8;
                int row = 16 * c + l; row = row > 2047 ? 2047 : row;
                a = as_bf16x8(GLD(u32x4, Zs + (size_t)row * OLD + d0));
#pragma unroll
                for (int n = 0; n < 8; ++n) bb[n] = as_bf16x8(GLD(u32x4, w1t + (size_t)(16 * n + lq) * 2048 + ks * 32 + quad * 8));
            };
            cload(0, a_c, b_c);
            for (int ks = 0; ks < 64; ++ks) {
                if (ks + 1 < 64) cload(ks + 1, a_n, b_n);
#pragma unroll
                for (int n = 0; n < 8; ++n) acc[n] = mfma16(a_c, b_c[n], acc[n]);
                a_c = a_n;
#pragma unroll
                for (int n = 0; n < 8; ++n) b_c[n] = b_n[n];
            }
#pragma unroll
            for (int n = 0; n < 8; ++n) {
                const float bv = GLD(float, bias1 + 16 * n + lq);
                f32x4 hv = acc[n]; hv[0] += bv; hv[1] += bv; hv[2] += bv; hv[3] += bv;
                gelu_tanh4(hv);
#pragma unroll
                for (int j = 0; j < 4; ++j) { const unsigned pk = pk2(hv[j], 0.f); hid[(4 * quad + j) * 136 + 16 * n + lq] = (bf16_t)(pk & 0xffffu); }
            }
            lds_wait();
            f32x4 acc2[4];
#pragma unroll
            for (int n = 0; n < 4; ++n) acc2[n] = (f32x4){0.f, 0.f, 0.f, 0.f};
#pragma unroll
            for (int ks = 0; ks < 4; ++ks) {
                const bf16x8 a = as_bf16x8(*(const u32x4*)(hid + lq * 136 + quad * 8 + 32 * ks));
#pragma unroll
                for (int n = 0; n < 4; ++n) { const bf16x8 bb = as_bf16x8(GLD(u32x4, w2t + (size_t)(16 * n + lq) * 128 + ks * 32 + quad * 8)); acc2[n] = mfma16(a, bb, acc2[n]); }
            }
            lds_wait();
            bf16_t* dst = (bf16_t*)(p.ws + (kv ? OFF_VC : OFF_KC)) + (size_t)((b * 4 + g) * 128) * 64;
#pragma unroll
            for (int n = 0; n < 4; ++n)
#pragma unroll
                for (int j = 0; j < 4; ++j) {
                    const int cc = ct * 16 + 4 * quad + j;
                    const float v = (cc < 127) ? acc2[n][j] : 0.f;
                    GST(bf16_t, dst + (size_t)cc * 64 + 16 * n + lq) = (bf16_t)(pk2(v, 0.f) & 0xffffu);
                }
        }
    }
}

__device__ __forceinline__ void select_phase(const Params& p, unsigned char* smem, int tid, int bid, int nblk) {
    const int lane = tid & 63, wave = tid >> 6, lq = lane & 15, quad = lane >> 4;
    const bf16_t* Z = (const bf16_t*)(p.ws + OFF_Z);
    const int gw = bid * 8 + wave, ngw = nblk * 8;
    float* PS = (float*)(smem + wave * 2048);
    constexpr float SC = 0.125f * 1.4426950408889634f;
    for (int task = gw; task < 8192; task += ngw) {
        const int b = task >> 9, g = (task >> 7) & 3, qt = task & 127;
        const int t = qt * 16 + lq;
        const bf16_t* kc = (const bf16_t*)(p.ws + OFF_KC) + (size_t)((b * 4 + g) * 128) * 64;
        const int cmax = (t - 31) >> 4;
        f32x4 psum[8];
#pragma unroll
        for (int sub = 0; sub < 8; ++sub) psum[sub] = (f32x4){0.f, 0.f, 0.f, 0.f};
        bf16x8 kfr[8][2], qfr[4][2];
#pragma unroll
        for (int sub = 0; sub < 8; ++sub)
#pragma unroll
            for (int ks = 0; ks < 2; ++ks) kfr[sub][ks] = as_bf16x8(GLD(u32x4, kc + (size_t)(16 * sub + lq) * 64 + quad * 8 + 32 * ks));
#pragma unroll
        for (int r = 0; r < 4; ++r)
#pragma unroll
            for (int ks = 0; ks < 2; ++ks) qfr[r][ks] = as_bf16x8(GLD(u32x4, Z + (size_t)(b * S_ + t) * OLD + 3072 + (g * 4 + r) * 64 + quad * 8 + 32 * ks));
#pragma unroll
        for (int r = 0; r < 4; ++r) {
            f32x4 s[8]; float mx = -INFINITY;
#pragma unroll
            for (int sub = 0; sub < 8; ++sub) {
                s[sub] = (f32x4){0.f, 0.f, 0.f, 0.f};
#pragma unroll
                for (int ks = 0; ks < 2; ++ks) s[sub] = mfma16(kfr[sub][ks], qfr[r][ks], s[sub]);
#pragma unroll
                for (int j = 0; j < 4; ++j) { const int key = 16 * sub + 4 * quad + j; const float sv = (key <= cmax) ? s[sub][j] * SC : -INFINITY; s[sub][j] = sv; mx = fmaxf(mx, sv); }
            }
            mx = fmaxf(mx, __shfl_xor(mx, 16)); mx = fmaxf(mx, __shfl_xor(mx, 32));
            const float m_use = (mx == -INFINITY) ? 0.f : mx;
            float rs = 0.f;
#pragma unroll
            for (int sub = 0; sub < 8; ++sub)
#pragma unroll
                for (int j = 0; j < 4; ++j) { const float e = fexp2(s[sub][j] - m_use); s[sub][j] = e; rs += e; }
            rs += __shfl_xor(rs, 16); rs += __shfl_xor(rs, 32);
            const float inv = (rs > 0.f) ? 1.f / rs : 0.f;
#pragma unroll
            for (int sub = 0; sub < 8; ++sub)
#pragma unroll
                for (int j = 0; j < 4; ++j) psum[sub][j] += s[sub][j] * inv;
        }
        float pslc[8], tprev[8];
#pragma unroll
        for (int sub = 0; sub < 8; ++sub) tprev[sub] = __shfl(psum[sub][3], (lane + 48) & 63);
#pragma unroll
        for (int sub = 0; sub < 8; ++sub) {
            float extra;
            if (quad >= 1) extra = tprev[sub]; else extra = (sub >= 1) ? tprev[sub >= 1 ? sub - 1 : 0] : 0.f;
            pslc[sub] = ((psum[sub][0] + psum[sub][1]) + (psum[sub][2] + psum[sub][3])) + extra;
            PS[lq * 32 + 4 * sub + quad] = pslc[sub];
        }
        lds_wait();
        float pvv[32];
#pragma unroll
        for (int q = 0; q < 8; ++q) { const f32x4 v = *(const f32x4*)(PS + lq * 32 + 4 * q); pvv[4 * q] = v[0]; pvv[4 * q + 1] = v[1]; pvv[4 * q + 2] = v[2]; pvv[4 * q + 3] = v[3]; }
        lds_wait();
        const int own = t >> 6;
        unsigned bits = 0;
#pragma unroll
        for (int sub = 0; sub < 8; ++sub) {
            const int j = 4 * sub + quad; const float mv = pslc[sub];
            int cnt = 0;
#pragma unroll
            for (int j2 = 1; j2 < 32; ++j2) { const bool beats = (pvv[j2] > mv) || (pvv[j2] == mv && j2 < j); cnt += (j2 < own && j2 != j && beats) ? 1 : 0; }
            const bool sel = (j == 0) || (j == own) || (j >= 1 && j < own && cnt < 14);
            if (sel) bits |= (1u << j);
        }
        bits |= (unsigned)__shfl_xor((int)bits, 16); bits |= (unsigned)__shfl_xor((int)bits, 32);
        if (quad == 0) GST(unsigned, (unsigned*)(p.ws + OFF_SEL) + (size_t)(b * 4 + g) * S_ + t) = bits;
    }
}

__device__ __forceinline__ void nsa_item(const Params& p, unsigned char* smem, int b, int head, int qt, int tid) {
    const int lane = tid & 63, wave = tid >> 6, lq = lane & 15, quad = lane >> 4;
    const int g = head >> 2, q0 = qt * 128, t = q0 + wave * 16 + lq;
    const bf16_t* Z = (const bf16_t*)(p.ws + OFF_Z) + (size_t)b * S_ * OLD;
    const unsigned rowmask = GLD(unsigned, (const unsigned*)(p.ws + OFF_SEL) + (size_t)(b * 4 + g) * S_ + t);
    float gate[3];
#pragma unroll
    for (int i = 0; i < 3; ++i) gate[i] = sigmoidf_(bf2f(GLD(bf16_t, Z + (size_t)t * OLD + 5632 + head * 3 + i)));
    f32x4 o[4], tot[4];
    const bf16_t* kc = (const bf16_t*)(p.ws + OFF_KC) + (size_t)((b * 4 + g) * 128) * 64;
    const bf16_t* vc = (const bf16_t*)(p.ws + OFF_VC) + (size_t)((b * 4 + g) * 128) * 64;
#ifndef NSA_PASSES
#define NSA_PASSES 7
#endif
    if (NSA_PASSES & 1) attn_pass<M_CMP, 64>(smem, Z + 3072 + head * 64, OLD, kc, 64, vc, 64, q0, 0u, 0.f, o, tid);
    else { o[0] = o[1] = o[2] = o[3] = (f32x4){0.f, 0.f, 0.f, 0.f}; }
#pragma unroll
    for (int c = 0; c < 4; ++c) { tot[c][0] = gate[0] * o[c][0]; tot[c][1] = gate[0] * o[c][1]; tot[c][2] = gate[0] * o[c][2]; tot[c][3] = gate[0] * o[c][3]; }
    if (NSA_PASSES & 2) attn_pass<M_SLC, 64>(smem, Z + 3072 + head * 64, OLD, Z + 4608 + g * 64, OLD, Z + 4864 + g * 64, OLD, q0, rowmask, 0.f, o, tid);
#pragma unroll
    for (int c = 0; c < 4; ++c) { tot[c][0] += gate[1] * o[c][0]; tot[c][1] += gate[1] * o[c][1]; tot[c][2] += gate[1] * o[c][2]; tot[c][3] += gate[1] * o[c][3]; }
    if (NSA_PASSES & 4) attn_pass<M_WIN, 64>(smem, Z + 3072 + head * 64, OLD, Z + 5120 + g * 64, OLD, Z + 5376 + g * 64, OLD, q0, 0u, 0.f, o, tid);
#pragma unroll
    for (int c = 0; c < 4; ++c) { tot[c][0] += gate[2] * o[c][0]; tot[c][1] += gate[2] * o[c][1]; tot[c][2] += gate[2] * o[c][2]; tot[c][3] += gate[2] * o[c][3]; }
    bf16_t* cat = (bf16_t*)(p.ws + OFF_CAT) + (size_t)(b * S_ + t) * D_ + 1024 + head * 64;
#pragma unroll
    for (int c = 0; c < 4; ++c) { u32x2 w; w.x = pk2(tot[c][0], tot[c][1]); w.y = pk2(tot[c][2], tot[c][3]); GST(u32x2, cat + 16 * c + 4 * quad) = w; }
}

__device__ __forceinline__ void ret_item(const Params& p, unsigned char* smem, int b, int h, int qt, int tid) {
    const int lane = tid & 63, wave = tid >> 6, lq = lane & 15, quad = lane >> 4;
    const int q0 = qt * 128, t = q0 + wave * 16 + lq;
    const bf16_t* Z = (const bf16_t*)(p.ws + OFF_Z) + (size_t)b * S_ * OLD;
    const float log2g = log2f(1.f - exp2f(-5.f - (float)h));
    f32x4 o[8];
    attn_pass<M_RET, 128>(smem, Z + h * 64, OLD, Z + 512 + h * 64, OLD, Z + 1024 + h * 128, OLD, q0, 0u, log2g, o, tid);
    float sm = 0.f;
#pragma unroll
    for (int c = 0; c < 8; ++c) sm += (o[c][0] + o[c][1]) + (o[c][2] + o[c][3]);
    sm += __shfl_xor(sm, 16); sm += __shfl_xor(sm, 32);
    const float mean = sm * (1.f / 128.f);
    float sq = 0.f;
#pragma unroll
    for (int c = 0; c < 8; ++c)
#pragma unroll
        for (int j = 0; j < 4; ++j) { o[c][j] -= mean; sq += o[c][j] * o[c][j]; }
    sq += __shfl_xor(sq, 16); sq += __shfl_xor(sq, 32);
    const float rstd = rsqrtf(sq * (1.f / 128.f) + 1e-6f);
    const bf16_t* rg = Z + (size_t)t * OLD + 2048 + h * 128;
    bf16_t* cat = (bf16_t*)(p.ws + OFF_CAT) + (size_t)(b * S_ + t) * D_ + h * 128;
#pragma unroll
    for (int c = 0; c < 8; ++c) {
        const u32x2 gv = GLD(u32x2, rg + 16 * c + 4 * quad);
        const float g0 = __uint_as_float(gv.x << 16), g1 = __uint_as_float(gv.x & 0xffff0000u), g2 = __uint_as_float(gv.y << 16), g3 = __uint_as_float(gv.y & 0xffff0000u);
        const float r0 = g0 * sigmoidf_(g0) * o[c][0] * rstd, r1 = g1 * sigmoidf_(g1) * o[c][1] * rstd, r2 = g2 * sigmoidf_(g2) * o[c][2] * rstd, r3 = g3 * sigmoidf_(g3) * o[c][3] * rstd;
        u32x2 w; w.x = pk2(r0, r1); w.y = pk2(r2, r3);
        GST(u32x2, cat + 16 * c + 4 * quad) = w;
    }
}

__device__ __forceinline__ void odd_mixer_phase(const Params& p, unsigned char* smem, int tid, int bid, int nblk) {
    for (int it = bid; it < 6144; it += nblk) {
        const int lvl = it / 384, r = it % 384, qt = 15 - lvl;
        if (r < 128) { for (int rep = 0; rep < REP_RET; ++rep) ret_item(p, smem, r >> 3, r & 7, qt, tid); }
        else { const int bh = r - 128; for (int rep = 0; rep < REP_NSA; ++rep) nsa_item(p, smem, bh >> 4, bh & 15, qt, tid); }
    }
}

#define XB_TMO      128
#define XB_XCNT(j)  (256  + 64 * (j))
#define XB_XSUB(j)  (1280 + 64 * (j))
#define XB_XGEN(j)  (2304 + 64 * (j))
#define XB_TOP      3328
#define XB_TOPGEN   3392
#define XCD_BAR_WORDS 3456
#define XB_SPIN_CAP (1u << 18)

__device__ __forceinline__ unsigned xb_ld(unsigned* p)              { return __hip_atomic_load(p, __ATOMIC_RELAXED, __HIP_MEMORY_SCOPE_AGENT); }
__device__ __forceinline__ unsigned xb_add(unsigned* p, unsigned v) { return __hip_atomic_fetch_add(p, v, __ATOMIC_RELAXED, __HIP_MEMORY_SCOPE_AGENT); }
__device__ __forceinline__ unsigned xb_xcc_id() { return (unsigned)__builtin_amdgcn_s_getreg((3 << 11) | 20) & 0xFu; }
#define XB_SPIN(cond, bar) do { unsigned _sp = 0; while (cond) { __builtin_amdgcn_s_sleep(1); \
    if ((++_sp & 255u) == 0u) { if (xb_ld(&(bar)[XB_TMO])) break; if (_sp > XB_SPIN_CAP) { atomicAdd(&(bar)[XB_TMO], 1u); break; } } } } while (0)

struct XcdBarrier {
    unsigned* bar; unsigned x;
    volatile LAS unsigned* st;
};

__device__ __forceinline__ XcdBarrier xcd_barrier_post(unsigned* bar, volatile LAS unsigned* st) {
    XcdBarrier b; b.bar = bar; b.x = xb_xcc_id(); b.st = st;
    if (threadIdx.x == 0) (void)xb_add(&bar[XB_XCNT(b.x)], 1u);
    return b;
}
__device__ __forceinline__ void xcd_barrier_complete(unsigned* bar, unsigned x, unsigned& nloc, unsigned& nx) {
    const unsigned G = gridDim.x * gridDim.y * gridDim.z;
    unsigned sum, cnt, mine, sp = 0u;
    for (;;) {
        sum = 0u; cnt = 0u; mine = 0u;
#pragma unroll
        for (unsigned j = 0; j < 16; ++j) { const unsigned c = xb_ld(&bar[XB_XCNT(j)]); sum += c; cnt += (c > 0u) ? 1u : 0u; mine = (j == x) ? c : mine; }
        if (sum == G) break;
        __builtin_amdgcn_s_sleep(1);
        if ((++sp & 255u) == 0u) { if (xb_ld(&bar[XB_TMO])) break; if (sp > XB_SPIN_CAP) { atomicAdd(&bar[XB_TMO], 1u); break; } }
    }
    nloc = mine > 0u ? mine : 1u; nx = cnt > 0u ? cnt : 1u;
}

__device__ __forceinline__ void xcd_barrier(const XcdBarrier& b) {
    asm volatile("s_waitcnt vmcnt(0)" ::: "memory");
    __syncthreads();
    if (threadIdx.x == 0) {
        unsigned* bar = b.bar;
        __builtin_amdgcn_s_waitcnt(0);
        unsigned nloc = b.st[0], nx = b.st[1];
        if (nloc == 0u) { xcd_barrier_complete(bar, b.x, nloc, nx); b.st[0] = nloc; b.st[1] = nx; }
        const unsigned old = xb_add(&bar[XB_XSUB(b.x)], 1u);
        const unsigned gen = old / nloc;
        if (old + 1u == (gen + 1u) * nloc) {
            __builtin_amdgcn_fence(__ATOMIC_RELEASE, "agent");
            asm volatile("s_waitcnt vmcnt(0)" ::: "memory");
            const unsigned og = xb_add(&bar[XB_TOP], 1u);
            const unsigned tg = og / nx;
            if (og + 1u == (tg + 1u) * nx) xb_add(&bar[XB_TOPGEN], 1u);
            else XB_SPIN(xb_ld(&bar[XB_TOPGEN]) == tg, bar);
            __builtin_amdgcn_fence(__ATOMIC_ACQUIRE, "agent");
            xb_add(&bar[XB_XGEN(b.x)], 1u);
            asm volatile("s_waitcnt vmcnt(0)" ::: "memory");
        } else {
            XB_SPIN(xb_ld(&bar[XB_XGEN(b.x)]) == gen, bar);
            __builtin_amdgcn_fence(__ATOMIC_ACQUIRE, "agent");
            asm volatile("s_waitcnt vmcnt(0)" ::: "memory");
        }
    }
    __syncthreads();
}

#ifndef ONLYMASK
#define ONLYMASK 0xFFFFFFu
#endif
#define PH_ON(n) ((ONLYMASK >> (n)) & 1u)
__device__ __forceinline__ const Params& opaque_params() {
    const Params* pp = (const Params*)__builtin_amdgcn_kernarg_segment_ptr(); asm volatile("" : "+s"(pp)); return *pp;
}
__device__ __forceinline__ void run_gemm(unsigned char* smem, int ph, int bid, int nblk) {
    const Params& p = opaque_params();
    unsigned char* ws = p.ws;
    pg8::Gemm g; EpiAll E; g.M = T_;
    E.O = (bf16_t*)(ws + OFF_Z); E.ldc = EIN; E.Xin = p.out; E.Xout = p.out; E.mode = 0;
    if (ph == 1) { g.A = (const bf16_t*)(ws + OFF_H); g.Bt = (const bf16_t*)(ws + OFF_WT_EIN); g.N = EIN; g.K = D_; E.mode = 0; E.ldc = EIN; }
    else if (ph == 9) { g.A = (const bf16_t*)(ws + OFF_H); g.Bt = (const bf16_t*)(ws + OFF_WT_OIN); g.N = OLD; g.K = D_; E.mode = 0; E.ldc = OLD; }
    else if (ph == 4) { g.A = (const bf16_t*)(ws + OFF_CAT); g.Bt = (const bf16_t*)(ws + OFF_WT_EOUT); g.N = D_; g.K = D_; E.mode = 1; E.Xin = p.in[0]; }
    else if (ph == 13) { g.A = (const bf16_t*)(ws + OFF_CAT); g.Bt = (const bf16_t*)(ws + OFF_WT_OOUT); g.N = D_; g.K = D_; E.mode = 1; }
    else if (ph == 7) { g.A = (const bf16_t*)(ws + OFF_Z); g.Bt = (const bf16_t*)(ws + OFF_WT2_0); g.N = D_; g.K = FF_; E.mode = 1; }
    else if (ph == 16) { g.A = (const bf16_t*)(ws + OFF_Z); g.Bt = (const bf16_t*)(ws + OFF_WT2_1); g.N = D_; g.K = FF_; E.mode = 1; }
    else if (ph == 6) { g.A = (const bf16_t*)(ws + OFF_H); g.Bt = (const bf16_t*)(ws + OFF_WT13_0); g.N = 2 * FF_; g.K = D_; E.mode = 2; }
    else { g.A = (const bf16_t*)(ws + OFF_H); g.Bt = (const bf16_t*)(ws + OFF_WT13_1); g.N = 2 * FF_; g.K = D_; E.mode = 2; }
    pg8::StaticOrder So; So.init(g.M, g.N, (int)nblk, (int)bid);
    pg8::gemm_phase<EpiAll, pg8::StaticOrder, false>((PG8_LAS unsigned char*)smem, g, So, E, nullptr);
}
__device__ __forceinline__ void run_norm(int ph, int tid, int bid, int nblk) {
    const Params& p = opaque_params();
    const int lane = tid & 63, wave = tid >> 6;
    const int gw = bid * 8 + wave, ngw = nblk * 8;
    bf16_t* H = (bf16_t*)(p.ws + OFF_H);
#ifdef SKEL
    if (ph == 17) rmsnorm_rows(p.in[0], p.in[27], nullptr, p.out, gw, ngw, lane);
    else if (ph == 5) {}
#else
    if (ph == 17) rmsnorm_rows(p.out, p.in[27], nullptr, p.out, gw, ngw, lane);
#endif
    else rmsnorm_rows(p.out, (ph == 8 ? p.in[1] + D_ : p.in[2] + (ph == 14 ? D_ : 0)), H, nullptr, gw, ngw, lane);
}
__global__ void __launch_bounds__(512, 2) mega(Params pk) {
    extern __shared__ __attribute__((aligned(16))) unsigned char smem[];
    cg::grid_group grid = cg::this_grid();
    {
        volatile LAS unsigned* st0 = (volatile LAS unsigned*)(smem + 131072);
        if (threadIdx.x == 0) { st0[0] = 0u; st0[1] = 0u; }
        __syncthreads();
        (void)xcd_barrier_post((unsigned*)(opaque_params().ws + OFF_BAR), st0);
    }
    const int ph_lo = ((const Params*)__builtin_amdgcn_kernarg_segment_ptr())->ph_lo, ph_hi = ((const Params*)__builtin_amdgcn_kernarg_segment_ptr())->ph_hi;
#pragma nounroll
    for (int ph = ph_lo; ph < ph_hi; ++ph) {
        int tid = threadIdx.x; asm volatile("" : "+v"(tid));
        int bid = __builtin_amdgcn_workgroup_id_x(); asm volatile("" : "+s"(bid));
        int nblk = (int)__builtin_amdgcn_grid_size_x() / 512; asm volatile("" : "+s"(nblk));
        if (ph == 0) { for (int rep = 0; rep < REP_P0; ++rep) { phase0(opaque_params(), smem, tid, bid, nblk); __syncthreads(); } }
        else if (ph == 2) { if (PH_ON(2)) kmean_phase(opaque_params(), tid, bid, nblk); }
        else if (ph == 3) { if (PH_ON(3)) even_mixer_phase(opaque_params(), smem, tid, bid, nblk); }
        else if (ph == 10) { if (PH_ON(10)) odd_prep_phase(opaque_params(), smem, tid, bid, nblk); }
        else if (ph == 11) { for (int rep = 0; rep < REP_SEL; ++rep) select_phase(opaque_params(), smem, tid, bid, nblk); }
        else if (ph == 12) { if (PH_ON(12)) odd_mixer_phase(opaque_params(), smem, tid, bid, nblk); }
#ifdef SKEL
        else if (ph == 17) { run_norm(ph, tid, bid, nblk); }
        else if (ph == 5 || ph == 8 || ph == 14) { }
#else
        else if (ph == 5 || ph == 8 || ph == 14 || ph == 17) { const int nrep = (ph == 5) ? REP_NORM : 1; for (int rep = 0; rep < nrep; ++rep) run_norm(ph, tid, bid, nblk); }
#endif
        else { const int nrep = (ph == 1 || ph == 6 || ph == 9 || ph == 15) ? REP_GEMM : 1; for (int rep = 0; rep < nrep; ++rep) { run_gemm(smem, ph, bid, nblk); __syncthreads(); } }
        if (ph + 1 < ph_hi) {
            if (ph_hi > 1000) grid.sync();
            { XcdBarrier xb; xb.bar = (unsigned*)(opaque_params().ws + OFF_BAR); xb.x = xb_xcc_id(); xb.st = (volatile LAS unsigned*)(smem + 131072); xcd_barrier(xb); }
        }
    }
}

extern "C" void kernel_launch(void* const* d_in, const int* in_sizes, int n_in, void* d_out, int out_size, void* d_ws, size_t ws_size, hipStream_t stream) {
    static int grid = 0;
    if (grid == 0) {
        if (n_in != 28 || out_size != T_ * D_ || ws_size < WS_END) { fprintf(stderr, "kernel_launch: unexpected shapes (n_in %d out %d ws %zu need %zu)\n", n_in, out_size, ws_size, (size_t)WS_END); grid = -1; return; }
        int dev = 0, cus = 0, per_cu = 0;
        hipGetDevice(&dev);
        hipDeviceGetAttribute(&cus, hipDeviceAttributeMultiprocessorCount, dev);
        if (hipFuncSetAttribute((const void*)mega, hipFuncAttributeMaxDynamicSharedMemorySize, LDS_BYTES) != hipSuccess) { fprintf(stderr, "kernel_launch: hipFuncSetAttribute failed\n"); grid = -1; return; }
        hipOccupancyMaxActiveBlocksPerMultiprocessor(&per_cu, (const void*)mega, 512, LDS_BYTES);
        if (per_cu < 1) { fprintf(stderr, "kernel_launch: occupancy query says %d blocks per CU\n", per_cu); per_cu = 1; }
        (void)hipGetLastError();
        grid = cus;
    }
    if (grid < 0) return;
    Params p{};
    for (int i = 0; i < 28; ++i) p.in[i] = (const float*)d_in[i];
    p.out = (float*)d_out; p.ws = (unsigned char*)d_ws;
    for (int i = 0; i < 32; ++i) p.inv_freq[i] = pow(10000.0, -(double)i / 32.0);
    p.ph_lo = 0; p.ph_hi = NPHASE;
#ifdef ZEROCAT
    (void)hipMemsetAsync((char*)d_ws + OFF_CAT, 0, (size_t)T_ * D_ * 2, stream);
#endif
    if (hipMemsetAsync((char*)d_ws + OFF_BAR, 0, XCD_BAR_WORDS * sizeof(unsigned), stream) != hipSuccess) { fprintf(stderr, "kernel_launch: memset of barrier words failed\n"); return; }
    void* args[] = {&p};
    hipError_t e = hipLaunchCooperativeKernel((const void*)mega, dim3(grid), dim3(512), args, LDS_BYTES, stream);
    if (e != hipSuccess) fprintf(stderr, "kernel_launch: cooperative launch failed: %s (grid %d)\n", hipGetErrorString(e), grid);
}
```

```cpp
#include <hip/hip_runtime.h>
#include <hip/hip_cooperative_groups.h>
#include <cstdio>
#include <cmath>
namespace cg = cooperative_groups;
namespace pg8 {
#define PG8_LAS __attribute__((address_space(3)))
typedef unsigned short bf16_t;
typedef short bf16x8 __attribute__((ext_vector_type(8)));
typedef float f32x4 __attribute__((ext_vector_type(4)));
typedef unsigned u32x4 __attribute__((ext_vector_type(4)));
constexpr int BM = 256, BK = 64, HALF = 128, HTB = HALF * BK * 2  , STAGE_BYTES = 8 * HTB, NXCD = 8, WGM = 8;

__host__ __device__ __forceinline__ int lds_byte(int r, int c) { const int st = (r >> 4) * 2 + (c >> 5), rr = r & 15, cc = c & 31, ob = rr * 64 + cc * 2; return st * 1024 + (ob ^ (((ob >> 9) & 1) << 5)); }
__host__ __device__ __forceinline__ void stage_rc(int b, int& R, int& C) { const int st = b / 1024, sb = b % 1024, swz = sb ^ (((sb >> 9) & 1) << 5); R = (st >> 1) * 16 + swz / 64; C = (st & 1) * 32 + (swz % 64) / 2; }
__host__ __device__ __forceinline__ int perm32(int rho) { const int n = rho >> 4, i = rho & 15; return 8 * (i >> 2) + 4 * n + (i & 3); }

struct Unit { int pm, pn; };
struct Gemm { const bf16_t* A; const bf16_t* Bt; int M, N, K; };

struct StaticOrder {
    int nM, nN, nwg, G, c;
    __host__ __device__ void init(int M, int N, int G_, int c_) { nM = M / BM; nN = N / BM; nwg = nM * nN; G = G_; c = c_; }
    __host__ __device__ bool next(int i, Unit& u) const {
        const long L = (long)i * G + c; if (L >= nwg) return false;
        int wgid = (int)L; { const int q = nwg / NXCD, r = nwg % NXCD, xcd = wgid % NXCD, off = wgid / NXCD; wgid = (xcd < r ? xcd * (q + 1) : r * (q + 1) + (xcd - r) * q) + off; }
        const int nig = WGM * nN, gid = wgid / nig, fm = gid * WGM, gsz = (nM - fm) < WGM ? (nM - fm) : WGM;
        u.pm = fm + ((wgid % nig) % gsz); u.pn = (wgid % nig) / gsz; return true;
    }
    __device__ __forceinline__ void a_ready(const Unit&) const {}
    __device__ __forceinline__ void done(const Unit&) const {}
};
__device__ __forceinline__ unsigned cvt_pk_bf16(float lo, float hi) { unsigned r; asm volatile("v_cvt_pk_bf16_f32 %0, %1, %2" : "=v"(r) : "v"(lo), "v"(hi)); return r; }
template <class Epi, class Sched, bool STAMP = false>
__device__ __forceinline__ void gemm_phase(PG8_LAS unsigned char* lds, const Gemm g, const Sched& S, const Epi& E, unsigned long long* stamps) {
    int tid = threadIdx.x; asm volatile("" : "+v"(tid)); const int wid = __builtin_amdgcn_readfirstlane(tid >> 6), lane = tid & 63, wr = wid >> 2, wc = wid & 3, fr = lane & 15, fq = lane >> 4;
    const int K = g.K, nt = K / BK;
    int ts_lo = 0, ts_hi = 0, nts = 0; const unsigned long long rt_entry = STAMP ? (unsigned long long)wall_clock64() : 0ull;
#define PG8_STAMP() do { if (STAMP && wid == 0 && nts < 64) { const unsigned long long _c = (unsigned long long)clock64(); \
        ts_lo = (lane == nts) ? (int)(unsigned)_c : ts_lo; ts_hi = (lane == nts) ? (int)(unsigned)(_c >> 32) : ts_hi; ++nts; } } while (0)
    PG8_STAMP();
    unsigned voffA[2], voffB[2];
#pragma unroll
    for (int i = 0; i < 2; ++i) { int R, C; stage_rc(tid * 16 + i * 8192, R, C); const int Rb = Epi::PERM ? ((R & ~31) + perm32(R & 31)) : R;
        voffA[i] = (unsigned)(R * K + C) * 2u; voffB[i] = (unsigned)(Rb * K + C) * 2u; }
    const size_t kstep = (size_t)(BK * 2);
    const size_t hstep = (size_t)HALF * K * 2;
    const size_t tstep = 2 * hstep;
    const unsigned ldsw = (unsigned)wid * 1024u;
    const int aoff = lds_byte(wr * 64 + fr, fq * 8), boff = lds_byte(wc * 32 + fr, fq * 8);
#define PG8_SA(b, h) (((b) * 2 + (h)) * HTB)
#define PG8_SB(b, h) ((4 + (b) * 2 + (h)) * HTB)
#define PG8_STAGE(bufoff, gbase, voff) do { _Pragma("unroll") for (int _i = 0; _i < 2; ++_i) \
        __builtin_amdgcn_global_load_lds((const unsigned*)((const char*)(gbase) + (voff)[_i]), (PG8_LAS unsigned*)(lds + (bufoff) + ldsw + _i * 8192), 16, 0, 0); } while (0)
#define PG8_LDA(dst, b, h) do { _Pragma("unroll") for (int m = 0; m < 4; ++m) _Pragma("unroll") for (int k = 0; k < 2; ++k) dst[m][k] = *(const PG8_LAS bf16x8*)(lds + PG8_SA(b, h) + aoff + m * 2048 + k * 1024); } while (0)
#define PG8_LDB(dst, b, h) do { _Pragma("unroll") for (int n = 0; n < 2; ++n) _Pragma("unroll") for (int k = 0; k < 2; ++k) dst[n][k] = *(const PG8_LAS bf16x8*)(lds + PG8_SB(b, h) + boff + n * 2048 + k * 1024); } while (0)
#define PG8_MMA(ai, bj, At, Bt) do { __builtin_amdgcn_s_setprio(1); _Pragma("unroll") for (int m = 0; m < 4; ++m) _Pragma("unroll") for (int n = 0; n < 2; ++n) _Pragma("unroll") for (int k = 0; k < 2; ++k) \
        acc[ai][bj][m][n] = __builtin_amdgcn_mfma_f32_16x16x32_bf16(Bt[n][k], At[m][k], acc[ai][bj][m][n], 0, 0, 0); __builtin_amdgcn_s_setprio(0); } while (0)
#define PG8_WAIT_V(n) asm volatile("s_waitcnt vmcnt(" #n ")" ::: "memory")
#define PG8_WAIT_L(n) asm volatile("s_waitcnt lgkmcnt(" #n ")" ::: "memory")
#define PG8_BAR __builtin_amdgcn_s_barrier()
#define PG8_SCHED __builtin_amdgcn_sched_barrier(0)
    Unit cur, nxt; int ui = 0;
    if (!S.next(0, cur)) return;
    f32x4 acc[2][2][4][2];
#pragma unroll
    for (int a = 0; a < 2; ++a)
#pragma unroll
        for (int b = 0; b < 2; ++b)
#pragma unroll
            for (int m = 0; m < 4; ++m)
#pragma unroll
                for (int n = 0; n < 2; ++n) acc[a][b][m][n] = (f32x4){0.f, 0.f, 0.f, 0.f};
    bf16x8 At[4][2], B0[2][2], B1[2][2];
    const char* cA = (const char*)g.A + (size_t)cur.pm * tstep; const char* cB = (const char*)g.Bt + (size_t)cur.pn * tstep;
    S.a_ready(cur);
    PG8_STAGE(PG8_SB(0, 0), cB, voffB); PG8_STAGE(PG8_SA(0, 0), cA, voffA); PG8_STAGE(PG8_SB(0, 1), cB + hstep, voffB); PG8_STAGE(PG8_SA(0, 1), cA + hstep, voffA);
    if (wr == 1) PG8_BAR;
    PG8_WAIT_V(4); PG8_BAR;
    PG8_STAGE(PG8_SB(1, 0), cB + kstep, voffB); PG8_STAGE(PG8_SA(1, 0), cA + kstep, voffA); PG8_STAGE(PG8_SB(1, 1), cB + hstep + kstep, voffB);
    PG8_WAIT_V(6); PG8_BAR;
    PG8_STAMP();
    for (;;) {
        const bool has_next = S.next(ui + 1, nxt);
        const char* nA = has_next ? (const char*)g.A + (size_t)nxt.pm * tstep : cA; const char* nB = has_next ? (const char*)g.Bt + (size_t)nxt.pn * tstep : cB;
        for (int t = 0; t < nt; t += 2) {
            const bool last = (t == nt - 2);
            const char* a1 = cA + (size_t)(t + 1) * kstep;
            const char* a2 = last ? nA : cA + (size_t)(t + 2) * kstep; const char* b2 = last ? nB : cB + (size_t)(t + 2) * kstep;
            const char* a3 = a2 + kstep; const char* b3 = b2 + kstep;
            if (last && has_next) S.a_ready(nxt);
            PG8_LDB(B0, 0, 0); PG8_SCHED; PG8_LDA(At, 0, 0); PG8_STAGE(PG8_SA(1, 1), a1 + hstep, voffA);
            PG8_WAIT_L(8); PG8_BAR; PG8_WAIT_L(0); PG8_MMA(0, 0, At, B0); PG8_BAR; PG8_SCHED;
            PG8_LDB(B1, 0, 1); PG8_STAGE(PG8_SB(0, 0), b2, voffB);
            PG8_BAR; PG8_WAIT_L(0); PG8_MMA(0, 1, At, B1); PG8_BAR;
            PG8_LDA(At, 0, 1); PG8_STAGE(PG8_SA(0, 0), a2, voffA);
            PG8_BAR; PG8_WAIT_L(0); PG8_MMA(1, 0, At, B0); PG8_BAR; PG8_SCHED;
            PG8_STAGE(PG8_SB(0, 1), b2 + hstep, voffB);
            PG8_WAIT_V(6); PG8_BAR; PG8_MMA(1, 1, At, B1); PG8_BAR;
            PG8_LDB(B0, 1, 0); PG8_SCHED; PG8_LDA(At, 1, 0); PG8_STAGE(PG8_SA(0, 1), a2 + hstep, voffA);
            PG8_WAIT_L(8); PG8_BAR; PG8_WAIT_L(0); PG8_MMA(0, 0, At, B0); PG8_BAR; PG8_SCHED;
            PG8_LDB(B1, 1, 1); PG8_STAGE(PG8_SB(1, 0), b3, voffB);
            PG8_BAR; PG8_WAIT_L(0); PG8_MMA(0, 1, At, B1); PG8_BAR;
            PG8_LDA(At, 1, 1); PG8_STAGE(PG8_SA(1, 0), a3, voffA);
            PG8_BAR; PG8_WAIT_L(0); PG8_MMA(1, 0, At, B0); PG8_BAR; PG8_SCHED;
            PG8_STAGE(PG8_SB(1, 1), b3 + hstep, voffB);
            PG8_WAIT_V(6); PG8_BAR; PG8_MMA(1, 1, At, B1); PG8_BAR;
        }
        PG8_STAMP();
        if constexpr (!Epi::AFTER_DRAIN) { E(acc, cur, wr, wc, fr, fq); S.done(cur); }
        PG8_STAMP();
        if (!has_next) break;
#pragma unroll
        for (int a = 0; a < 2; ++a)
#pragma unroll
            for (int b = 0; b < 2; ++b)
#pragma unroll
                for (int m = 0; m < 4; ++m)
#pragma unroll
                    for (int n = 0; n < 2; ++n) acc[a][b][m][n] = (f32x4){0.f, 0.f, 0.f, 0.f};
        cur = nxt; cA = nA; cB = nB; ++ui;
    }
    PG8_WAIT_V(0);
    if (wr == 0) PG8_BAR;
    PG8_BAR;
    if constexpr (Epi::AFTER_DRAIN) { E.fused(acc, cur, wr, wc, fr, fq, lds, wid, lane); S.done(cur); }
    PG8_STAMP();
    if (STAMP && wid == 0) { stamps[lane] = lane < nts ? (((unsigned long long)(unsigned)ts_hi << 32) | (unsigned)ts_lo) : 0ull;
        if (lane == 62) stamps[62] = rt_entry; if (lane == 63) stamps[63] = (unsigned long long)wall_clock64(); }
#undef PG8_STAMP
#undef PG8_SA
#undef PG8_SB
#undef PG8_STAGE
#undef PG8_LDA
#undef PG8_LDB
#undef PG8_MMA
#undef PG8_WAIT_V
#undef PG8_WAIT_L
#undef PG8_BAR
#undef PG8_SCHED
}
}

typedef unsigned short bf16_t;
typedef short bf16x8 __attribute__((ext_vector_type(8)));
typedef short s16x4 __attribute__((ext_vector_type(4)));
typedef float f32x4 __attribute__((ext_vector_type(4)));
typedef float f32x2 __attribute__((ext_vector_type(2)));
typedef unsigned u32x4 __attribute__((ext_vector_type(4)));
typedef unsigned u32x2 __attribute__((ext_vector_type(2)));
#define LAS __attribute__((address_space(3)))
#define GAS __attribute__((address_space(1)))
#define GLD(T, ptr) (*(const GAS T*)(ptr))
#define GST(T, ptr) (*(GAS T*)(ptr))

constexpr int T_ = 32768, D_ = 2048, S_ = 2048, B_ = 16, FF_ = 5632;
constexpr int EIN = 6400, OIN = 5680, OLD = 5888;
constexpr float EPS_ = 1e-6f;

constexpr size_t AL256(size_t x) { return (x + 255) & ~(size_t)255; }
constexpr size_t OFF_CTRL = 0;
constexpr size_t OFF_WT_EIN = 4096;
constexpr size_t OFF_WT_EOUT = OFF_WT_EIN + (size_t)EIN * D_ * 2;
constexpr size_t OFF_WT_OIN = OFF_WT_EOUT + (size_t)D_ * D_ * 2;
constexpr size_t OFF_WT_OOUT = OFF_WT_OIN + (size_t)OLD * D_ * 2;
constexpr size_t OFF_WT13_0 = OFF_WT_OOUT + (size_t)D_ * D_ * 2;
constexpr size_t OFF_WT13_1 = OFF_WT13_0 + (size_t)2 * FF_ * D_ * 2;
constexpr size_t OFF_WT2_0 = OFF_WT13_1 + (size_t)2 * FF_ * D_ * 2;
constexpr size_t OFF_WT2_1 = OFF_WT2_0 + (size_t)D_ * FF_ * 2;
constexpr size_t OFF_W1T_K = OFF_WT2_1 + (size_t)D_ * FF_ * 2;
constexpr size_t OFF_W1T_V = OFF_W1T_K + (size_t)128 * 2048 * 2;
constexpr size_t OFF_W2T_K = OFF_W1T_V + (size_t)128 * 2048 * 2;
constexpr size_t OFF_W2T_V = OFF_W2T_K + (size_t)64 * 128 * 2;
constexpr size_t OFF_BIAS1 = OFF_W2T_V + (size_t)64 * 128 * 2;
constexpr size_t OFF_ROPE = OFF_BIAS1 + 1024;
constexpr size_t OFF_KMEAN = OFF_ROPE + (size_t)2048 * 32 * 8;
constexpr size_t OFF_KC = OFF_KMEAN + (size_t)16 * 16 * 8 * 64 * 4;
constexpr size_t OFF_VC = OFF_KC + (size_t)16 * 4 * 128 * 64 * 2;
constexpr size_t OFF_SEL = OFF_VC + (size_t)16 * 4 * 128 * 64 * 2;
constexpr size_t OFF_H = OFF_SEL + (size_t)16 * 4 * 2048 * 4;
constexpr size_t OFF_Z = OFF_H + (size_t)T_ * D_ * 2;
constexpr size_t OFF_CAT = OFF_Z + (size_t)T_ * EIN * 2;
constexpr size_t OFF_BAR = OFF_CAT + (size_t)T_ * D_ * 2;
constexpr size_t WS_END = OFF_BAR + 16384;

constexpr int LDS_BYTES = 131072 + 16;
constexpr int NPHASE = 18;
#ifndef REP_P0
#define REP_P0 1
#endif
#ifndef REP_RWKV
#define REP_RWKV 1
#endif
#ifndef REP_MOBA
#define REP_MOBA 1
#endif
#ifndef REP_RET
#define REP_RET 1
#endif
#ifndef REP_NSA
#define REP_NSA 1
#endif
#ifndef REP_GEMM
#define REP_GEMM 1
#endif
#ifndef REP_NORM
#define REP_NORM 1
#endif
#ifndef REP_SEL
#define REP_SEL 1
#endif

struct Params {
    const float* in[28];
    float* out;
    unsigned char* ws;
    double inv_freq[32];
    int ph_lo, ph_hi;
};

__device__ __forceinline__ float bf2f(unsigned short b) { return __uint_as_float(((unsigned)b) << 16); }
typedef __bf16 bf16x2_t __attribute__((ext_vector_type(2)));
__device__ __forceinline__ unsigned pk2(float lo, float hi) { f32x2 v; v[0] = lo; v[1] = hi; const bf16x2_t r = __builtin_convertvector(v, bf16x2_t); return __builtin_bit_cast(unsigned, r); }
__device__ __forceinline__ float wave_sum(float v) {
#pragma unroll
    for (int o = 1; o < 64; o <<= 1) v += __shfl_xor(v, o);
    return v;
}
template <int CTRL> __device__ __forceinline__ float dppf(float x) {
    return __int_as_float(__builtin_amdgcn_update_dpp(0, __float_as_int(x), CTRL, 0xf, 0xf, false));
}
__device__ __forceinline__ float rowsum16(float x) {
    x += dppf<0x128>(x);
    x += dppf<0x124>(x);
    x += dppf<0x4E>(x);
    x += dppf<0xB1>(x);
    return x;
}
__device__ __forceinline__ void rowsum16x4(float& a, float& b, float& c, float& d) {
    asm volatile("" : "+v"(a), "+v"(b), "+v"(c), "+v"(d));
    a += dppf<0x128>(a); b += dppf<0x128>(b); c += dppf<0x128>(c); d += dppf<0x128>(d); asm volatile("" : "+v"(a), "+v"(b), "+v"(c), "+v"(d));
    a += dppf<0x124>(a); b += dppf<0x124>(b); c += dppf<0x124>(c); d += dppf<0x124>(d); asm volatile("" : "+v"(a), "+v"(b), "+v"(c), "+v"(d));
    a += dppf<0x4E>(a); b += dppf<0x4E>(b); c += dppf<0x4E>(c); d += dppf<0x4E>(d); asm volatile("" : "+v"(a), "+v"(b), "+v"(c), "+v"(d));
    a += dppf<0xB1>(a); b += dppf<0xB1>(b); c += dppf<0xB1>(c); d += dppf<0xB1>(d); asm volatile("" : "+v"(a), "+v"(b), "+v"(c), "+v"(d));
}
__device__ __forceinline__ float fexp2(float x) { return __builtin_amdgcn_exp2f(x); }
__device__ __forceinline__ float fexp(float x) { return __builtin_amdgcn_exp2f(x * 1.4426950408889634f); }
__device__ __forceinline__ float frcp(float x) { return __builtin_amdgcn_rcpf(x); }
__device__ __forceinline__ float sigmoidf_(float x) { return frcp(1.f + fexp(-x)); }
__device__ __forceinline__ void lds_wait() { asm volatile("s_waitcnt lgkmcnt(0)" ::: "memory"); }
__device__ __forceinline__ void unpack8(u32x4 v, float (&f)[8]) {
    f[0] = __uint_as_float(v.x << 16); f[1] = __uint_as_float(v.x & 0xffff0000u);
    f[2] = __uint_as_float(v.y << 16); f[3] = __uint_as_float(v.y & 0xffff0000u);
    f[4] = __uint_as_float(v.z << 16); f[5] = __uint_as_float(v.z & 0xffff0000u);
    f[6] = __uint_as_float(v.w << 16); f[7] = __uint_as_float(v.w & 0xffff0000u);
}
__device__ __forceinline__ bf16x8 as_bf16x8(u32x4 v) { return __builtin_bit_cast(bf16x8, v); }
__device__ __forceinline__ f32x4 mfma16(bf16x8 a, bf16x8 b, f32x4 c) { return __builtin_amdgcn_mfma_f32_16x16x32_bf16(a, b, c, 0, 0, 0); }

struct EpiAll {
    static constexpr bool PERM = true, AFTER_DRAIN = false;
    int mode; bf16_t* O; int ldc; const float* Xin; float* Xout;
    __device__ __forceinline__ void operator()(const pg8::f32x4 (&acc)[2][2][4][2], const pg8::Unit& u, int wr, int wc, int fr, int fq) const {
        const int row0 = u.pm * 256 + wr * 64 + fr;
        if (mode == 0) {
            const int col0 = u.pn * 256 + wc * 32 + 8 * fq;
#pragma unroll
            for (int ai = 0; ai < 2; ++ai)
#pragma unroll
                for (int m = 0; m < 4; ++m) {
                    bf16_t* rowp = O + (size_t)(row0 + ai * 128 + m * 16) * ldc + col0;
#pragma unroll
                    for (int bj = 0; bj < 2; ++bj) {
                        const pg8::f32x4 v0 = acc[ai][bj][m][0], v1 = acc[ai][bj][m][1];
                        u32x4 w; w.x = pk2(v0[0], v0[1]); w.y = pk2(v0[2], v0[3]); w.z = pk2(v1[0], v1[1]); w.w = pk2(v1[2], v1[3]);
                        GST(u32x4, rowp + bj * 128) = w;
                    }
                }
        } else if (mode == 1) {
            const int col0 = u.pn * 256 + wc * 32 + 8 * fq;
#pragma unroll
            for (int ai = 0; ai < 2; ++ai)
#pragma unroll
                for (int m = 0; m < 4; ++m) {
                    const size_t off = (size_t)(row0 + ai * 128 + m * 16) * D_ + col0;
#pragma unroll
                    for (int bj = 0; bj < 2; ++bj)
#pragma unroll
                        for (int n = 0; n < 2; ++n) {
                            const size_t idx = off + bj * 128 + n * 4;
                            const f32x4 x = GLD(f32x4, Xin + idx);
                            f32x4 r; r[0] = x[0] + acc[ai][bj][m][n][0]; r[1] = x[1] + acc[ai][bj][m][n][1]; r[2] = x[2] + acc[ai][bj][m][n][2]; r[3] = x[3] + acc[ai][bj][m][n][3];
                            GST(f32x4, Xout + idx) = r;
                        }
                }
        } else {
            const int col0 = u.pn * 128 + wc * 32 + 8 * fq;
#pragma unroll
            for (int ai = 0; ai < 2; ++ai)
#pragma unroll
                for (int m = 0; m < 4; ++m) {
                    bf16_t* rowp = O + (size_t)(row0 + ai * 128 + m * 16) * FF_ + col0;
                    float hv[8];
#pragma unroll
                    for (int n = 0; n < 2; ++n)
#pragma unroll
                        for (int j = 0; j < 4; ++j) { const float g = acc[ai][0][m][n][j], up = acc[ai][1][m][n][j]; hv[n * 4 + j] = g * sigmoidf_(g) * up; }
                    u32x4 w; w.x = pk2(hv[0], hv[1]); w.y = pk2(hv[2], hv[3]); w.z = pk2(hv[4], hv[5]); w.w = pk2(hv[6], hv[7]);
                    GST(u32x4, rowp) = w;
                }
        }
    }
};

template <int MODE>
__device__ __forceinline__ void prep_w(const float* Wa, const float* Wb, int K, int Nsrc, bf16_t* WT, int nOutBlocks, float* scr, int gw, int ngw, int lane, const float* gain) {
    const int nkb = K / 64, nitems = nkb * nOutBlocks;
    const int lr = lane >> 3, lc = (lane & 7) * 4;
    f32x4 cur[8], nxt[8];
    auto locate = [&](int it, const float*& src, int& c0, int& k0, int& ob) {
        ob = it % nOutBlocks; k0 = (it / nOutBlocks) * 64;
        if (MODE == 0) { src = Wa; c0 = ob * 32; }
        else { const int pn = ob >> 3, sb = ob & 7; src = (sb < 4) ? Wa : Wb; c0 = (pn * 4 + (sb & 3)) * 32; }
    };
    auto load = [&](int it, f32x4 (&v)[8]) {
        const float* src; int c0, k0, ob; locate(it, src, c0, k0, ob);
        const int col = c0 + lc;
#pragma unroll
        for (int i = 0; i < 8; ++i) v[i] = (col < Nsrc) ? GLD(f32x4, src + (size_t)(k0 + 8 * i + lr) * Nsrc + col) : (f32x4){0.f, 0.f, 0.f, 0.f};
    };
    int it = gw;
    if (it < nitems) load(it, cur);
    for (; it < nitems; it += ngw) {
        const int itn = it + ngw;
        if (itn < nitems) load(itn, nxt);
        const float* src; int c0, k0, ob; locate(it, src, c0, k0, ob);
#pragma unroll
        for (int i = 0; i < 8; ++i) {
            const int kk = 8 * i + lr; const float gk = gain ? gain[k0 + kk] : 1.f;
            float* d = scr + kk * 33 + lc;
            d[0] = cur[i][0] * gk; d[1] = cur[i][1] * gk; d[2] = cur[i][2] * gk; d[3] = cur[i][3] * gk;
        }
        lds_wait();
        const int c = lane & 7;
#pragma unroll
        for (int j = 0; j < 4; ++j) {
            const int n = (lane >> 3) + 8 * j; const float* sp = scr + (8 * c) * 33 + n;
            u32x4 o; o.x = pk2(sp[0 * 33], sp[1 * 33]); o.y = pk2(sp[2 * 33], sp[3 * 33]); o.z = pk2(sp[4 * 33], sp[5 * 33]); o.w = pk2(sp[6 * 33], sp[7 * 33]);
            GST(u32x4, WT + (size_t)(ob * 32 + n) * K + k0 + 8 * c) = o;
        }
        lds_wait();
#pragma unroll
        for (int i = 0; i < 8; ++i) cur[i] = nxt[i];
    }
}

__device__ __forceinline__ void rmsnorm_rows(const float* X, const float* g, bf16_t* H, float* OutF, int gw, int ngw, int lane) {
    f32x4 gv[8];
#pragma unroll
    for (int j = 0; j < 8; ++j) gv[j] = GLD(f32x4, (const f32x4*)g + lane + 64 * j);
    f32x4 v[8], vn[8];
    int m = gw;
    if (m < T_) {
#pragma unroll
        for (int j = 0; j < 8; ++j) v[j] = GLD(f32x4, (const f32x4*)(X + (size_t)m * D_) + lane + 64 * j);
    }
    for (; m < T_; m += ngw) {
        const int mn = m + ngw;
        if (mn < T_) {
#pragma unroll
            for (int j = 0; j < 8; ++j) vn[j] = GLD(f32x4, (const f32x4*)(X + (size_t)mn * D_) + lane + 64 * j);
        }
        float ss = 0.f;
#pragma unroll
        for (int j = 0; j < 8; ++j) ss += (v[j][0] * v[j][0] + v[j][1] * v[j][1]) + (v[j][2] * v[j][2] + v[j][3] * v[j][3]);
        ss = wave_sum(ss);
        const float rstd = rsqrtf(ss * (1.f / D_) + EPS_);
#pragma unroll
        for (int j = 0; j < 8; ++j) {
            const float y0 = v[j][0] * rstd * gv[j][0], y1 = v[j][1] * rstd * gv[j][1], y2 = v[j][2] * rstd * gv[j][2], y3 = v[j][3] * rstd * gv[j][3];
            if (H) { u32x2 o; o.x = pk2(y0, y1); o.y = pk2(y2, y3); GST(u32x2, H + (size_t)m * D_ + (lane + 64 * j) * 4) = o; }
            if (OutF) { f32x4 o; o[0] = y0; o[1] = y1; o[2] = y2; o[3] = y3; GST(f32x4, (f32x4*)(OutF + (size_t)m * D_) + lane + 64 * j) = o; }
        }
#pragma unroll
        for (int j = 0; j < 8; ++j) v[j] = vn[j];
    }
}

__device__ __forceinline__ void phase0(const Params& p, unsigned char* smem, int tid, int bid, int nblk) {
    const int lane = tid & 63, wave = tid >> 6;
    const int gw = bid * 8 + wave, ngw = nblk * 8;
    float* scr = (float*)(smem + wave * 8448);
    unsigned char* ws = p.ws;
    prep_w<0>(p.in[3], nullptr, D_, EIN, (bf16_t*)(ws + OFF_WT_EIN), EIN / 32, scr, gw, ngw, lane, nullptr);
    prep_w<0>(p.in[15], nullptr, D_, D_, (bf16_t*)(ws + OFF_WT_EOUT), D_ / 32, scr, gw, ngw, lane, nullptr);
    prep_w<0>(p.in[16], nullptr, D_, OIN, (bf16_t*)(ws + OFF_WT_OIN), OLD / 32, scr, gw, ngw, lane, nullptr);
    prep_w<0>(p.in[23], nullptr, D_, D_, (bf16_t*)(ws + OFF_WT_OOUT), D_ / 32, scr, gw, ngw, lane, nullptr);
    prep_w<1>(p.in[24], p.in[25], D_, FF_, (bf16_t*)(ws + OFF_WT13_0), 2 * FF_ / 32, scr, gw, ngw, lane, nullptr);
    prep_w<1>(p.in[24] + (size_t)D_ * FF_, p.in[25] + (size_t)D_ * FF_, D_, FF_, (bf16_t*)(ws + OFF_WT13_1), 2 * FF_ / 32, scr, gw, ngw, lane, nullptr);
    prep_w<0>(p.in[26], nullptr, FF_, D_, (bf16_t*)(ws + OFF_WT2_0), D_ / 32, scr, gw, ngw, lane, nullptr);
    prep_w<0>(p.in[26] + (size_t)FF_ * D_, nullptr, FF_, D_, (bf16_t*)(ws + OFF_WT2_1), D_ / 32, scr, gw, ngw, lane, nullptr);
    prep_w<0>(p.in[18], nullptr, 2048, 128, (bf16_t*)(ws + OFF_W1T_K), 4, scr, gw, ngw, lane, nullptr);
    prep_w<0>(p.in[21], nullptr, 2048, 128, (bf16_t*)(ws + OFF_W1T_V), 4, scr, gw, ngw, lane, nullptr);
    prep_w<0>(p.in[19], nullptr, 128, 64, (bf16_t*)(ws + OFF_W2T_K), 2, scr, gw, ngw, lane, nullptr);
    prep_w<0>(p.in[22], nullptr, 128, 64, (bf16_t*)(ws + OFF_W2T_V), 2, scr, gw, ngw, lane, nullptr);
    if (gw < 256) {
        const int kv = gw >> 7, n = gw & 127;
        const float* pe = p.in[kv ? 20 : 17]; const float* w1 = p.in[kv ? 21 : 18];
        float s = 0.f;
        for (int k = lane; k < 2048; k += 64) s += pe[k] * w1[(size_t)k * 128 + n];
        s = wave_sum(s);
        if (lane == 0) ((float*)(ws + OFF_BIAS1))[gw] = s;
    }
    {
        f32x2* rope = (f32x2*)(ws + OFF_ROPE);
        for (int e = bid * 512 + tid; e < 2048 * 32; e += nblk * 512) {
            const int pos = e >> 5, i = e & 31;
            const double ang = (double)pos * p.inv_freq[i];
            const double kq = rint(ang * 0.63661977236758134308);
            double r = fma(-kq, 1.57079632679489655800e+00, ang);
            r = fma(-kq, 6.12323399573676603587e-17, r);
            const float rf = (float)r;
            const float r2 = rf * rf;
            const float sn = rf * (1.f + r2 * (-1.6666667e-1f + r2 * (8.3333333e-3f + r2 * (-1.9841270e-4f + r2 * 2.7557319e-6f))));
            const float cs = 1.f + r2 * (-0.5f + r2 * (4.1666667e-2f + r2 * (-1.3888889e-3f + r2 * (2.4801587e-5f + r2 * -2.7557319e-7f))));
            const int q = ((int)kq) & 3;
            float c, s;
            if (q == 0) { c = cs; s = sn; } else if (q == 1) { c = -sn; s = cs; } else if (q == 2) { c = -cs; s = -sn; } else { c = sn; s = -cs; }
            f32x2 o; o[0] = c; o[1] = s; rope[e] = o;
        }
    }
    rmsnorm_rows(p.in[0], p.in[1], (bf16_t*)(ws + OFF_H), nullptr, gw, ngw, lane);
}

enum { M_MOBA = 0, M_SLC = 1, M_WIN = 2, M_CMP = 3, M_RET = 4 };
template <int MODE, int DV>
__device__ __forceinline__ void attn_pass(unsigned char* smem, const bf16_t* Qb, int ldq, const bf16_t* Kb, int ldk, const bf16_t* Vb, int ldv,
                                          int q0, unsigned rowmask, float log2g, f32x4 (&o)[DV / 16], int tid) {
    constexpr int VST = DV + 8;
    const int lane = tid & 63, wave = tid >> 6, lq = lane & 15, quad = lane >> 4;
    const int t = q0 + wave * 16 + lq;
    constexpr int KSZ = 64 * 72 * 2, BUFSZ = KSZ + 64 * VST * 2;
    bf16x8 qf[2];
#pragma unroll
    for (int ks = 0; ks < 2; ++ks) qf[ks] = as_bf16x8(GLD(u32x4, Qb + (size_t)t * ldq + quad * 8 + 32 * ks));
    float m = -INFINITY, l = 0.f;
#pragma unroll
    for (int c = 0; c < DV / 16; ++c) o[c] = (f32x4){0.f, 0.f, 0.f, 0.f};
    int kt_lo = 0, kt_hi = (q0 + 127) >> 6;
    if (MODE == M_WIN) { const int lo = q0 - 511; kt_lo = (lo > 0 ? lo : 0) >> 6; }
    if (MODE == M_CMP) { kt_hi = 1; }
    constexpr float SC = 0.125f * 1.4426950408889634f;
    const int q4 = lq >> 2, pp = lq & 3;
    float dk[4][4];
#pragma unroll
    for (int sub = 0; sub < 4; ++sub)
#pragma unroll
        for (int j = 0; j < 4; ++j) dk[sub][j] = (MODE == M_RET) ? 0.125f * fexp2(-(float)(16 * sub + 4 * quad + j) * log2g) : 0.f;
    const int rk_ = tid >> 3, chk_ = tid & 7;
    u32x4 kreg, vreg[DV / 64];
    auto gload = [&](int kt) {
        kreg = GLD(u32x4, Kb + (size_t)(kt * 64 + rk_) * ldk + chk_ * 8);
#pragma unroll
        for (int i = 0; i < DV / 64; ++i) { const int idx = tid + i * 512; const int r = idx / (DV / 8), ch = idx % (DV / 8); vreg[i] = GLD(u32x4, Vb + (size_t)(kt * 64 + r) * ldv + ch * 8); }
    };
    auto lstore = [&](int b) {
        bf16_t* Ks_ = (bf16_t*)(smem + b * BUFSZ); bf16_t* Vs_ = (bf16_t*)(smem + b * BUFSZ + KSZ);
        *(u32x4*)(Ks_ + rk_ * 72 + chk_ * 8) = kreg;
#pragma unroll
        for (int i = 0; i < DV / 64; ++i) { const int idx = tid + i * 512; const int r = idx / (DV / 8), ch = idx % (DV / 8); *(u32x4*)(Vs_ + r * VST + ch * 8) = vreg[i]; }
    };
    gload(kt_lo);
    __syncthreads();
    lstore(0);
    if (kt_lo + 1 <= kt_hi) gload(kt_lo + 1);
    __syncthreads();
    int bsel = 0;
    for (int kt = kt_lo; kt <= kt_hi; ++kt, bsel ^= 1) {
        if (kt + 1 <= kt_hi) lstore(bsel ^ 1);
        if (kt + 2 <= kt_hi) gload(kt + 2);
        const bf16_t* Ks = (const bf16_t*)(smem + bsel * BUFSZ); const bf16_t* Vs = (const bf16_t*)(smem + bsel * BUFSZ + KSZ);
        const int kbase = kt * 64;
        bool lane_any;
        if (MODE == M_MOBA) lane_any = (kbase <= t) && ((rowmask >> (kt >> 2)) & 1u);
        else if (MODE == M_SLC) lane_any = (kbase <= t) && ((rowmask >> kt) & 1u);
        else if (MODE == M_WIN) lane_any = (kbase <= t) && (kbase + 63 > t - 512);
        else if (MODE == M_CMP) lane_any = (kbase * 16 + 31 <= t);
        else lane_any = (kbase <= t);
        if (__any(lane_any ? 1 : 0)) {
        f32x4 s[4];
#pragma unroll
        for (int sub = 0; sub < 4; ++sub) {
            s[sub] = (f32x4){0.f, 0.f, 0.f, 0.f};
#pragma unroll
            for (int ks = 0; ks < 2; ++ks) { const bf16x8 a = as_bf16x8(*(const u32x4*)(Ks + (16 * sub + lq) * 72 + quad * 8 + 32 * ks)); s[sub] = mfma16(a, qf[ks], s[sub]); }
        }
        float pv[4][4];
        const int t_min = q0 + wave * 16;
        bool need_mask;
        if (MODE == M_WIN) need_mask = (kbase + 63 > t_min) || (kbase <= t_min + 15 - 512);
        else if (MODE == M_CMP) need_mask = true;
        else need_mask = (kbase + 63 > t_min);
        if (MODE != M_RET) {
            float mx = -INFINITY;
            if (need_mask) {
#pragma unroll
                for (int sub = 0; sub < 4; ++sub)
#pragma unroll
                    for (int j = 0; j < 4; ++j) {
                        const int key = kbase + 16 * sub + 4 * quad + j;
                        bool valid;
                        if (MODE == M_MOBA || MODE == M_SLC) valid = lane_any && (key <= t);
                        else if (MODE == M_WIN) valid = (key <= t) && (key > t - 512);
                        else valid = (key * 16 + 31 <= t);
                        const float sv = valid ? s[sub][j] : -INFINITY;
                        pv[sub][j] = sv; mx = fmaxf(mx, sv);
                    }
            } else if (MODE == M_MOBA || MODE == M_SLC) {
#pragma unroll
                for (int sub = 0; sub < 4; ++sub)
#pragma unroll
                    for (int j = 0; j < 4; ++j) { const float sv = lane_any ? s[sub][j] : -INFINITY; pv[sub][j] = sv; mx = fmaxf(mx, sv); }
            } else {
#pragma unroll
                for (int sub = 0; sub < 4; ++sub)
#pragma unroll
                    for (int j = 0; j < 4; ++j) { pv[sub][j] = s[sub][j]; mx = fmaxf(mx, s[sub][j]); }
            }
            mx = fmaxf(mx, __shfl_xor(mx, 16)); mx = fmaxf(mx, __shfl_xor(mx, 32));
            const float m_new = fmaxf(m, mx * SC);
            const float m_use = (m_new == -INFINITY) ? 0.f : m_new;
            const float alpha = fexp2(m - m_use);
            float rs = 0.f;
#pragma unroll
            for (int sub = 0; sub < 4; ++sub)
#pragma unroll
                for (int j = 0; j < 4; ++j) { const float e = fexp2(__builtin_fmaf(pv[sub][j], SC, -m_use)); pv[sub][j] = e; rs += e; }
            l = l * alpha + rs; m = m_new;
#pragma unroll
            for (int c = 0; c < DV / 16; ++c) { o[c][0] *= alpha; o[c][1] *= alpha; o[c][2] *= alpha; o[c][3] *= alpha; }
        } else {
            const float rowfac = fexp2((float)(t - kbase) * log2g);
            if (need_mask) {
#pragma unroll
                for (int sub = 0; sub < 4; ++sub)
#pragma unroll
                    for (int j = 0; j < 4; ++j) { const int key = kbase + 16 * sub + 4 * quad + j; pv[sub][j] = (key <= t) ? (s[sub][j] * dk[sub][j]) * rowfac : 0.f; }
            } else {
#pragma unroll
                for (int sub = 0; sub < 4; ++sub)
#pragma unroll
                    for (int j = 0; j < 4; ++j) pv[sub][j] = (s[sub][j] * dk[sub][j]) * rowfac;
            }
        }
        bf16x8 pb[2];
#pragma unroll
        for (int s2 = 0; s2 < 2; ++s2) {
            u32x4 w; w.x = pk2(pv[2 * s2][0], pv[2 * s2][1]); w.y = pk2(pv[2 * s2][2], pv[2 * s2][3]); w.z = pk2(pv[2 * s2 + 1][0], pv[2 * s2 + 1][1]); w.w = pk2(pv[2 * s2 + 1][2], pv[2 * s2 + 1][3]);
            pb[s2] = as_bf16x8(w);
        }
#pragma unroll
        for (int c = 0; c < DV / 16; ++c)
#pragma unroll
            for (int s2 = 0; s2 < 2; ++s2) {
                const s16x4 t1 = __builtin_amdgcn_ds_read_tr16_b64_v4i16((LAS s16x4*)(Vs + (32 * s2 + 4 * quad + q4) * VST + 16 * c + 4 * pp));
                const s16x4 t2 = __builtin_amdgcn_ds_read_tr16_b64_v4i16((LAS s16x4*)(Vs + (32 * s2 + 16 + 4 * quad + q4) * VST + 16 * c + 4 * pp));
                bf16x8 a; a[0] = t1[0]; a[1] = t1[1]; a[2] = t1[2]; a[3] = t1[3]; a[4] = t2[0]; a[5] = t2[1]; a[6] = t2[2]; a[7] = t2[3];
                o[c] = mfma16(a, pb[s2], o[c]);
            }
            }
        __syncthreads();
    }
    if (MODE != M_RET) {
        l += __shfl_xor(l, 16); l += __shfl_xor(l, 32);
        const float inv = (l > 0.f) ? 1.f / l : 1.f;
#pragma unroll
        for (int c = 0; c < DV / 16; ++c) { o[c][0] *= inv; o[c][1] *= inv; o[c][2] *= inv; o[c][3] *= inv; }
    }
}

__device__ __forceinline__ void kmean_phase(const Params& p, int tid, int bid, int nblk) {
    const bf16_t* Z = (const bf16_t*)(p.ws + OFF_Z);
    float* km = (float*)(p.ws + OFF_KMEAN);
    for (int it = bid; it < 256; it += nblk) {
        const int b = it >> 4, n = (it >> 1) & 7, half = it & 1;
        const int ch = half * 512 + tid;
        const bf16_t* src = Z + ((size_t)(b * S_ + n * 256)) * EIN + 1024 + ch;
        float s = 0.f;
#pragma unroll 8
        for (int tt = 0; tt < 256; ++tt) s += bf2f(GLD(bf16_t, src + (size_t)tt * EIN));
        const int h = ch >> 6, d = ch & 63;
        GST(float, km + ((size_t)(b * 16 + h) * 8 + n) * 64 + d) = s * (1.f / 256.f);
    }
}

__device__ __forceinline__ void moba_item(const Params& p, unsigned char* smem, int b, int h, int qt, int tid) {
    const int lane = tid & 63, wave = tid >> 6, lq = lane & 15, quad = lane >> 4;
    const bf16_t* Z = (const bf16_t*)(p.ws + OFF_Z) + (size_t)b * S_ * EIN;
    const int q0 = qt * 128, t = q0 + wave * 16 + lq, own = q0 >> 8;
    unsigned rowmask = 1u << own;
    if (own > 0) {
        const float* km = (const float*)(p.ws + OFF_KMEAN) + (size_t)(b * 16 + h) * 8 * 64;
        float gsc[7];
#pragma unroll
        for (int n = 0; n < 7; ++n) gsc[n] = 0.f;
#pragma unroll 1
        for (int c8 = 0; c8 < 8; ++c8) {
            float f[8]; unpack8(GLD(u32x4, Z + (size_t)t * EIN + h * 64 + c8 * 8), f);
#pragma unroll
            for (int n = 0; n < 7; ++n) {
                const f32x4 k0 = GLD(f32x4, km + n * 64 + c8 * 8), k1 = GLD(f32x4, km + n * 64 + c8 * 8 + 4);
                gsc[n] += (f[0] * k0[0] + f[1] * k0[1]) + (f[2] * k0[2] + f[3] * k0[3]) + (f[4] * k1[0] + f[5] * k1[1]) + (f[6] * k1[2] + f[7] * k1[3]);
            }
        }
#pragma unroll
        for (int n = 0; n < 7; ++n) {
            int cnt = 0;
#pragma unroll
            for (int n2 = 0; n2 < 7; ++n2) { if (n2 != n) { const bool beats = (gsc[n2] > gsc[n]) || (gsc[n2] == gsc[n] && n2 < n); cnt += (n2 < own && beats) ? 1 : 0; } }
            if (n < own && cnt < 3) rowmask |= (1u << n);
        }
    }
    f32x4 o[4];
    attn_pass<M_MOBA, 64>(smem, Z + h * 64, EIN, Z + 1024 + h * 64, EIN, Z + 2048 + h * 64, EIN, q0, rowmask, 0.f, o, tid);
    bf16_t* cat = (bf16_t*)(p.ws + OFF_CAT) + (size_t)(b * S_ + t) * D_ + h * 64;
#pragma unroll
    for (int c = 0; c < 4; ++c) { u32x2 w; w.x = pk2(o[c][0], o[c][1]); w.y = pk2(o[c][2], o[c][3]); GST(u32x2, cat + 16 * c + 4 * quad) = w; }
}

__device__ __forceinline__ void rwkv_item(const Params& p, unsigned char* smem, int b, int h, int tid) {
    const int lane = tid & 63, wave = tid >> 6, lq = lane & 15, quad = lane >> 4;
    constexpr int ZB = 3072;
    const bf16_t* Z = (const bf16_t*)(p.ws + OFF_Z) + (size_t)b * S_ * EIN;
    const float* mu = p.in[4];
    float* R = (float*)smem;
    float* KP = R + 2048; float* V = KP + 2048; float* DEC = V + 2048; float* NKK = DEC + 2048; float* KKA = NKK + 2048;
    float* GG = KKA + 2048; float* Y = GG + 2048; float* AA = Y + 2048; float* BC = AA + 2048;
    bf16_t* TW = (bf16_t*)(BC + 64);
    bf16_t* AL = TW + 32 * 72;
    bf16_t* GL = AL + 32 * 72;
    const int mt = wave >> 2, nt = wave & 3;
    const int chn = h * 64 + 16 * nt + lq;
    bf16x8 bw[2], ba[2], bg[4];
    {
        const float* wup = p.in[6]; const float* aup = p.in[8]; const float* gup = p.in[9];
#pragma unroll
        for (int ks = 0; ks < 2; ++ks) {
            float fw[8], fa[8];
#pragma unroll
            for (int i = 0; i < 8; ++i) { const int k = 32 * ks + quad * 8 + i; fw[i] = wup[(size_t)k * 1024 + chn]; fa[i] = aup[(size_t)k * 1024 + chn]; }
            u32x4 w; w.x = pk2(fw[0], fw[1]); w.y = pk2(fw[2], fw[3]); w.z = pk2(fw[4], fw[5]); w.w = pk2(fw[6], fw[7]); bw[ks] = as_bf16x8(w);
            u32x4 a; a.x = pk2(fa[0], fa[1]); a.y = pk2(fa[2], fa[3]); a.z = pk2(fa[4], fa[5]); a.w = pk2(fa[6], fa[7]); ba[ks] = as_bf16x8(a);
        }
#pragma unroll
        for (int ks = 0; ks < 4; ++ks) {
            float fg[8];
#pragma unroll
            for (int i = 0; i < 8; ++i) { const int k = 32 * ks + quad * 8 + i; fg[i] = gup[(size_t)k * 1024 + chn]; }
            u32x4 g; g.x = pk2(fg[0], fg[1]); g.y = pk2(fg[2], fg[3]); g.z = pk2(fg[4], fg[5]); g.w = pk2(fg[6], fg[7]); bg[ks] = as_bf16x8(g);
        }
    }
    const float w0c = p.in[5][chn], a0c = p.in[7][chn];
    const int cs = tid & 15, ttC = tid >> 4;
    const f32x4 kkc = *(const f32x4*)(p.in[10] + h * 64 + 4 * cs), kac = *(const f32x4*)(p.in[11] + h * 64 + 4 * cs), rkc = *(const f32x4*)(p.in[12] + h * 64 + 4 * cs);
    const f32x4 lng = *(const f32x4*)(p.in[13] + h * 64 + 4 * cs), lnb = *(const f32x4*)(p.in[14] + h * 64 + 4 * cs);
    const int js = tid & 15, rp = tid >> 4;
    f32x2 P[4];
#pragma unroll
    for (int e = 0; e < 4; ++e) P[e] = (f32x2){0.f, 0.f};
    bf16_t* cat = (bf16_t*)(p.ws + OFF_CAT) + (size_t)b * S_ * D_ + 1024 + h * 64;

    int a_off[4];
#pragma unroll
    for (int i = 0; i < 4; ++i) {
        const int idx = tid + 512 * i; const int tt = idx / 56, cv = idx % 56;
        int zc;
        if (cv < 8) zc = ZB + h * 64 + cv * 8;
        else if (cv < 16) zc = ZB + 1024 + h * 64 + (cv - 8) * 8;
        else if (cv < 24) zc = ZB + 2048 + h * 64 + (cv - 16) * 8;
        else zc = ZB + 3072 + (cv - 24) * 8;
        a_off[i] = (idx < 1792) ? (tt * EIN + zc) : zc;
    }
    u32x4 a_cur[4], a_prv[4];
#pragma unroll
    for (int i = 0; i < 4; ++i) {
        const bool act = (i < 3) || (tid < 256);
        a_cur[i] = (u32x4){0u, 0u, 0u, 0u}; a_prv[i] = (u32x4){0u, 0u, 0u, 0u};
        if (act) { a_cur[i] = GLD(u32x4, Z + a_off[i]); if (a_off[i] >= EIN) a_prv[i] = GLD(u32x4, Z + a_off[i] - EIN); }
    }
    for (int t0 = 0; t0 < S_; t0 += 32) {
        __syncthreads();
#pragma unroll
        for (int i = 0; i < 4; ++i) {
            const int idx = tid + 512 * i;
            if ((i < 3) || (tid < 256)) {
            const int tt = idx / 56, cv = idx % 56;
            const int zc = a_off[i] - tt * EIN;
            float cur[8], prv[8];
            unpack8(a_cur[i], cur); unpack8(a_prv[i], prv);
            const f32x4 m0 = GLD(f32x4, mu + (zc - ZB)), m1 = GLD(f32x4, mu + (zc - ZB) + 4);
            float val[8];
#pragma unroll
            for (int e = 0; e < 4; ++e) { val[e] = cur[e] + (prv[e] - cur[e]) * m0[e]; val[4 + e] = cur[4 + e] + (prv[4 + e] - cur[4 + e]) * m1[e]; }
            if (cv < 24) {
                float* dst = (cv < 8 ? R : (cv < 16 ? KP : V)) + tt * 64 + (cv & 7) * 8;
                *(f32x4*)dst = (f32x4){val[0], val[1], val[2], val[3]}; *(f32x4*)(dst + 4) = (f32x4){val[4], val[5], val[6], val[7]};
            } else {
                if (cv < 32) {
#pragma unroll
                    for (int e = 0; e < 8; ++e) { const float ex = fexp(2.f * val[e]); val[e] = 1.f - 2.f * frcp(ex + 1.f); } }
                else if (cv >= 40) {
#pragma unroll
                    for (int e = 0; e < 8; ++e) val[e] = sigmoidf_(val[e]); }
                u32x4 w; w.x = pk2(val[0], val[1]); w.y = pk2(val[2], val[3]); w.z = pk2(val[4], val[5]); w.w = pk2(val[6], val[7]);
                bf16_t* dst = (cv < 32) ? (TW + tt * 72 + (cv - 24) * 8) : ((cv < 40) ? (AL + tt * 72 + (cv - 32) * 8) : (GL + tt * 136 + (cv - 40) * 8));
                *(u32x4*)dst = w;
            }
            }
        }
        __syncthreads();
        if (t0 + 32 < S_) {
#pragma unroll
            for (int i = 0; i < 4; ++i) {
                if ((i < 3) || (tid < 256)) { const size_t o = (size_t)(t0 + 32) * EIN + a_off[i]; a_cur[i] = GLD(u32x4, Z + o); a_prv[i] = GLD(u32x4, Z + o - EIN); }
            }
        }
        {
            f32x4 cw = (f32x4){0.f, 0.f, 0.f, 0.f}, ca = cw, cg_ = cw;
#pragma unroll
            for (int ks = 0; ks < 2; ++ks) {
                const bf16x8 a1 = as_bf16x8(*(const u32x4*)(TW + (16 * mt + lq) * 72 + quad * 8 + 32 * ks));
                const bf16x8 a2 = as_bf16x8(*(const u32x4*)(AL + (16 * mt + lq) * 72 + quad * 8 + 32 * ks));
                cw = mfma16(a1, bw[ks], cw); ca = mfma16(a2, ba[ks], ca);
            }
#pragma unroll
            for (int ks = 0; ks < 4; ++ks) { const bf16x8 a3 = as_bf16x8(*(const u32x4*)(GL + (16 * mt + lq) * 136 + quad * 8 + 32 * ks)); cg_ = mfma16(a3, bg[ks], cg_); }
#pragma unroll
            for (int j = 0; j < 4; ++j) {
                const int tt = 16 * mt + 4 * quad + j, ch = 16 * nt + lq;
                const float wf = cw[j] + w0c;
                const float sp = (wf < -15.f) ? -wf : __logf(1.f + fexp(-wf));
                const float wv = -sp - 0.5f;
                DEC[tt * 64 + ch] = fexp(-fexp(wv));
                AA[tt * 64 + ch] = sigmoidf_(ca[j] + a0c);
                GG[tt * 64 + ch] = cg_[j];
            }
        }
        __syncthreads();
        {
            const f32x4 k4 = *(const f32x4*)(KP + ttC * 64 + 4 * cs), a4 = *(const f32x4*)(AA + ttC * 64 + 4 * cs), r4 = *(const f32x4*)(R + ttC * 64 + 4 * cs);
            f32x4 kkv; float ss = 0.f;
#pragma unroll
            for (int e = 0; e < 4; ++e) { kkv[e] = k4[e] * kkc[e]; ss += kkv[e] * kkv[e]; }
            ss = rowsum16(ss);
            const float inv = fminf(__builtin_amdgcn_rsqf(ss), 1e12f);
            f32x4 nk, ka, kp; float bc = 0.f;
#pragma unroll
            for (int e = 0; e < 4; ++e) { const float kk = kkv[e] * inv; nk[e] = -kk; ka[e] = kk * a4[e]; kp[e] = k4[e] * (1.f + (a4[e] - 1.f) * kac[e]); bc += r4[e] * kp[e] * rkc[e]; }
            bc = rowsum16(bc);
            *(f32x4*)(NKK + ttC * 64 + 4 * cs) = nk; *(f32x4*)(KKA + ttC * 64 + 4 * cs) = ka; *(f32x4*)(KP + ttC * 64 + 4 * cs) = kp;
            if (cs == 0) BC[ttC] = bc;
        }
        __syncthreads();
        {
            f32x4 nk = *(const f32x4*)(NKK + 4 * js), wd = *(const f32x4*)(DEC + 4 * js), ka = *(const f32x4*)(KKA + 4 * js);
            f32x4 kp = *(const f32x4*)(KP + 4 * js), rr = *(const f32x4*)(R + 4 * js);
            f32x2 vv = *(const f32x2*)(V + 2 * rp);
            float yq0 = 0.f, yq1 = 0.f;
#pragma unroll 8
            for (int tt = 0; tt < 32; ++tt) {
                const int tn = (tt < 31) ? tt + 1 : 31;
                const f32x4 nk2 = *(const f32x4*)(NKK + tn * 64 + 4 * js), wd2 = *(const f32x4*)(DEC + tn * 64 + 4 * js), ka2 = *(const f32x4*)(KKA + tn * 64 + 4 * js);
                const f32x4 kp2 = *(const f32x4*)(KP + tn * 64 + 4 * js), rr2 = *(const f32x4*)(R + tn * 64 + 4 * js);
                const f32x2 vv2 = *(const f32x2*)(V + tn * 64 + 2 * rp);
                f32x2 sa = (P[0] * nk[0] + P[1] * nk[1]) + (P[2] * nk[2] + P[3] * nk[3]);
                float sa0 = sa[0], sa1 = sa[1];
                rowsum16x4(sa0, sa1, yq0, yq1);
                if (tt > 0 && js == 0) { f32x2 yy; yy[0] = yq0; yy[1] = yq1; *(f32x2*)(Y + (tt - 1) * 64 + 2 * rp) = yy; }
                f32x2 sav; sav[0] = sa0; sav[1] = sa1;
#pragma unroll
                for (int e = 0; e < 4; ++e) P[e] = P[e] * wd[e] + (sav * ka[e] + vv * kp[e]);
                const f32x2 yv = (P[0] * rr[0] + P[1] * rr[1]) + (P[2] * rr[2] + P[3] * rr[3]);
                yq0 = yv[0]; yq1 = yv[1];
                nk = nk2; wd = wd2; ka = ka2; kp = kp2; rr = rr2; vv = vv2;
            }
            yq0 = rowsum16(yq0); yq1 = rowsum16(yq1);
            if (js == 0) { f32x2 yy; yy[0] = yq0; yy[1] = yq1; *(f32x2*)(Y + 31 * 64 + 2 * rp) = yy; }
        }
        __syncthreads();
        {
            const f32x4 y4 = *(const f32x4*)(Y + ttC * 64 + 4 * cs), v4 = *(const f32x4*)(V + ttC * 64 + 4 * cs), g4 = *(const f32x4*)(GG + ttC * 64 + 4 * cs);
            float sm = (y4[0] + y4[1]) + (y4[2] + y4[3]);
            sm = rowsum16(sm);
            const float mean = sm * (1.f / 64.f);
            float dv[4], sq = 0.f;
#pragma unroll
            for (int e = 0; e < 4; ++e) { dv[e] = y4[e] - mean; sq += dv[e] * dv[e]; }
            sq = rowsum16(sq);
            const float rstd = rsqrtf(sq * (1.f / 64.f) + 6.4e-4f);
            const float bc = BC[ttC];
            float ov[4];
#pragma unroll
            for (int e = 0; e < 4; ++e) ov[e] = (dv[e] * rstd * lng[e] + lnb[e] + bc * v4[e]) * g4[e];
            u32x2 w; w.x = pk2(ov[0], ov[1]); w.y = pk2(ov[2], ov[3]);
            GST(u32x2, cat + (size_t)(t0 + ttC) * D_ + 4 * cs) = w;
        }
    }
}

__device__ __forceinline__ void even_mixer_phase(const Params& p, unsigned char* smem, int tid, int bid, int nblk) {
    for (int rep = 0; rep < REP_RWKV; ++rep)
    for (int it = bid; it < 256; it += nblk) rwkv_item(p, smem, it >> 4, it & 15, tid);
    for (int rep = 0; rep < REP_MOBA; ++rep)
    for (int it = bid; it < 4096; it += nblk) {
        const int qt = 15 - (it >> 8), bh = it & 255;
        moba_item(p, smem, bh >> 4, bh & 15, qt, tid);
    }
}

__device__ __forceinline__ void gelu_tanh4(f32x4& v) {
#pragma unroll
    for (int j = 0; j < 4; ++j) { const float x = v[j]; const float u = 0.7978845608028654f * (x + 0.044715f * x * x * x); const float ex = fexp(2.f * u); const float th = 1.f - 2.f * frcp(ex + 1.f); v[j] = 0.5f * x * (1.f + th); }
}

__device__ __forceinline__ void odd_prep_phase(const Params& p, unsigned char* smem, int tid, int bid, int nblk) {
    const int lane = tid & 63, wave = tid >> 6, lq = lane & 15, quad = lane >> 4;
    bf16_t* Z = (bf16_t*)(p.ws + OFF_Z);
    {
        const f32x2* rope = (const f32x2*)(p.ws + OFF_ROPE);
        const int nthreads = nblk * 512;
        for (int it = bid * 512 + tid; it < T_ * 64; it += nthreads) {
            const int row = it >> 6, wh = (it >> 2) & 15, cidx = it & 3;
            const int pos = row & (S_ - 1);
            bf16_t* base = Z + (size_t)row * OLD + wh * 64 + cidx * 8;
            float z1[8], z2[8];
            unpack8(GLD(u32x4, base), z1); unpack8(GLD(u32x4, base + 32), z2);
            float o1[8], o2[8];
#pragma unroll
            for (int e = 0; e < 8; ++e) { const f32x2 cs = GLD(f32x2, rope + pos * 32 + cidx * 8 + e); o1[e] = z1[e] * cs[0] - z2[e] * cs[1]; o2[e] = z1[e] * cs[1] + z2[e] * cs[0]; }
            u32x4 w1; w1.x = pk2(o1[0], o1[1]); w1.y = pk2(o1[2], o1[3]); w1.z = pk2(o1[4], o1[5]); w1.w = pk2(o1[6], o1[7]);
            u32x4 w2; w2.x = pk2(o2[0], o2[1]); w2.y = pk2(o2[2], o2[3]); w2.z = pk2(o2[4], o2[5]); w2.w = pk2(o2[6], o2[7]);
            GST(u32x4, base) = w1; GST(u32x4, base + 32) = w2;
        }
    }
    {
        const int gw = bid * 8 + wave, ngw = nblk * 8;
        bf16_t* hid = (bf16_t*)(smem + wave * (16 * 136 * 2));
        for (int task = gw; task < 1024; task += ngw) {
            const int kv = task >> 9, b = (task >> 5) & 15, g = (task >> 3) & 3, ct = task & 7;
            const bf16_t* Zs = Z + (size_t)b * S_ * OLD + (kv ? 4352 : 4096) + g * 64;
            const bf16_t* w1t = (const bf16_t*)(p.ws + (kv ? OFF_W1T_V : OFF_W1T_K));
            const bf16_t* w2t = (const bf16_t*)(p.ws + (kv ? OFF_W2T_V : OFF_W2T_K));
            const float* bias1 = (const float*)(p.ws + OFF_BIAS1) + kv * 128;
            f32x4 acc[8];
#pragma unroll
            for (int n = 0; n < 8; ++n) acc[n] = (f32x4){0.f, 0.f, 0.f, 0.f};
            const int c = ct * 16 + lq;
            bf16x8 a_c, b_c[8], a_n, b_n[8];
            auto cload = [&](int ks, bf16x8& a, bf16x8 (&bb)[8]) {
                const int l = ks >> 1, d0 = (ks & 1) * 32 + quad * 8;
                int row = 16 * c + l; row = row > 2047 ? 2047 : row;
                a = as_bf16x8(GLD(u32x4, Zs + (size_t)row * OLD + d0));
#pragma unroll
                for (int n = 0; n < 8; ++n) bb[n] = as_bf16x8(GLD(u32x4, w1t + (size_t)(16 * n + lq) * 2048 + ks * 32 + quad * 8));
            };
            cload(0, a_c, b_c);
            for (int ks = 0; ks < 64; ++ks) {
                if (ks + 1 < 64) cload(ks + 1, a_n, b_n);
#pragma unroll
                for (int n = 0; n < 8; ++n) acc[n] = mfma16(a_c, b_c[n], acc[n]);
                a_c = a_n;
#pragma unroll
                for (int n = 0; n < 8; ++n) b_c[n] = b_n[n];
            }
#pragma unroll
            for (int n = 0; n < 8; ++n) {
                const float bv = GLD(float, bias1 + 16 * n + lq);
                f32x4 hv = acc[n]; hv[0] += bv; hv[1] += bv; hv[2] += bv; hv[3] += bv;
                gelu_tanh4(hv);
#pragma unroll
                for (int j = 0; j < 4; ++j) { const unsigned pk = pk2(hv[j], 0.f); hid[(4 * quad + j) * 136 + 16 * n + lq] = (bf16_t)(pk & 0xffffu); }
            }
            lds_wait();
            f32x4 acc2[4];
#pragma unroll
            for (int n = 0; n < 4; ++n) acc2[n] = (f32x4){0.f, 0.f, 0.f, 0.f};
#pragma unroll
            for (int ks = 0; ks < 4; ++ks) {
                const bf16x8 a = as_bf16x8(*(const u32x4*)(hid + lq * 136 + quad * 8 + 32 * ks));
#pragma unroll
                for (int n = 0; n < 4; ++n) { const bf16x8 bb = as_bf16x8(GLD(u32x4, w2t + (size_t)(16 * n + lq) * 128 + ks * 32 + quad * 8)); acc2[n] = mfma16(a, bb, acc2[n]); }
            }
            lds_wait();
            bf16_t* dst = (bf16_t*)(p.ws + (kv ? OFF_VC : OFF_KC)) + (size_t)((b * 4 + g) * 128) * 64;
#pragma unroll
            for (int n = 0; n < 4; ++n)
#pragma unroll
                for (int j = 0; j < 4; ++j) {
                    const int cc = ct * 16 + 4 * quad + j;
                    const float v = (cc < 127) ? acc2[n][j] : 0.f;
                    GST(bf16_t, dst + (size_t)cc * 64 + 16 * n + lq) = (bf16_t)(pk2(v, 0.f) & 0xffffu);
                }
        }
    }
}

__device__ __forceinline__ void select_phase(const Params& p, unsigned char* smem, int tid, int bid, int nblk) {
    const int lane = tid & 63, wave = tid >> 6, lq = lane & 15, quad = lane >> 4;
    const bf16_t* Z = (const bf16_t*)(p.ws + OFF_Z);
    const int gw = bid * 8 + wave, ngw = nblk * 8;
    float* PS = (float*)(smem + wave * 2048);
    constexpr float SC = 0.125f * 1.4426950408889634f;
    for (int task = gw; task < 8192; task += ngw) {
        const int b = task >> 9, g = (task >> 7) & 3, qt = task & 127;
        const int t = qt * 16 + lq;
        const bf16_t* kc = (const bf16_t*)(p.ws + OFF_KC) + (size_t)((b * 4 + g) * 128) * 64;
        const int cmax = (t - 31) >> 4;
        f32x4 psum[8];
#pragma unroll
        for (int sub = 0; sub < 8; ++sub) psum[sub] = (f32x4){0.f, 0.f, 0.f, 0.f};
        bf16x8 kfr[8][2], qfr[4][2];
#pragma unroll
        for (int sub = 0; sub < 8; ++sub)
#pragma unroll
            for (int ks = 0; ks < 2; ++ks) kfr[sub][ks] = as_bf16x8(GLD(u32x4, kc + (size_t)(16 * sub + lq) * 64 + quad * 8 + 32 * ks));
#pragma unroll
        for (int r = 0; r < 4; ++r)
#pragma unroll
            for (int ks = 0; ks < 2; ++ks) qfr[r][ks] = as_bf16x8(GLD(u32x4, Z + (size_t)(b * S_ + t) * OLD + 3072 + (g * 4 + r) * 64 + quad * 8 + 32 * ks));
#pragma unroll
        for (int r = 0; r < 4; ++r) {
            f32x4 s[8]; float mx = -INFINITY;
#pragma unroll
            for (int sub = 0; sub < 8; ++sub) {
                s[sub] = (f32x4){0.f, 0.f, 0.f, 0.f};
#pragma unroll
                for (int ks = 0; ks < 2; ++ks) s[sub] = mfma16(kfr[sub][ks], qfr[r][ks], s[sub]);
#pragma unroll
                for (int j = 0; j < 4; ++j) { const int key = 16 * sub + 4 * quad + j; const float sv = (key <= cmax) ? s[sub][j] * SC : -INFINITY; s[sub][j] = sv; mx = fmaxf(mx, sv); }
            }
            mx = fmaxf(mx, __shfl_xor(mx, 16)); mx = fmaxf(mx, __shfl_xor(mx, 32));
            const float m_use = (mx == -INFINITY) ? 0.f : mx;
            float rs = 0.f;
#pragma unroll
            for (int sub = 0; sub < 8; ++sub)
#pragma unroll
                for (int j = 0; j < 4; ++j) { const float e = fexp2(s[sub][j] - m_use); s[sub][j] = e; rs += e; }
            rs += __shfl_xor(rs, 16); rs += __shfl_xor(rs, 32);
            const float inv = (rs > 0.f) ? 1.f / rs : 0.f;
#pragma unroll
            for (int sub = 0; sub < 8; ++sub)
#pragma unroll
                for (int j = 0; j < 4; ++j) psum[sub][j] += s[sub][j] * inv;
        }
        float pslc[8], tprev[8];
#pragma unroll
        for (int sub = 0; sub < 8; ++sub) tprev[sub] = __shfl(psum[sub][3], (lane + 48) & 63);
#pragma unroll
        for (int sub = 0; sub < 8; ++sub) {
            float extra;
            if (quad >= 1) extra = tprev[sub]; else extra = (sub >= 1) ? tprev[sub >= 1 ? sub - 1 : 0] : 0.f;
            pslc[sub] = ((psum[sub][0] + psum[sub][1]) + (psum[sub][2] + psum[sub][3])) + extra;
            PS[lq * 32 + 4 * sub + quad] = pslc[sub];
        }
        lds_wait();
        float pvv[32];
#pragma unroll
        for (int q = 0; q < 8; ++q) { const f32x4 v = *(const f32x4*)(PS + lq * 32 + 4 * q); pvv[4 * q] = v[0]; pvv[4 * q + 1] = v[1]; pvv[4 * q + 2] = v[2]; pvv[4 * q + 3] = v[3]; }
        lds_wait();
        const int own = t >> 6;
        unsigned bits = 0;
#pragma unroll
        for (int sub = 0; sub < 8; ++sub) {
            const int j = 4 * sub + quad; const float mv = pslc[sub];
            int cnt = 0;
#pragma unroll
            for (int j2 = 1; j2 < 32; ++j2) { const bool beats = (pvv[j2] > mv) || (pvv[j2] == mv && j2 < j); cnt += (j2 < own && j2 != j && beats) ? 1 : 0; }
            const bool sel = (j == 0) || (j == own) || (j >= 1 && j < own && cnt < 14);
            if (sel) bits |= (1u << j);
        }
        bits |= (unsigned)__shfl_xor((int)bits, 16); bits |= (unsigned)__shfl_xor((int)bits, 32);
        if (quad == 0) GST(unsigned, (unsigned*)(p.ws + OFF_SEL) + (size_t)(b * 4 + g) * S_ + t) = bits;
    }
}

__device__ __forceinline__ void nsa_item(const Params& p, unsigned char* smem, int b, int head, int qt, int tid) {
    const int lane = tid & 63, wave = tid >> 6, lq = lane & 15, quad = lane >> 4;
    const int g = head >> 2, q0 = qt * 128, t = q0 + wave * 16 + lq;
    const bf16_t* Z = (const bf16_t*)(p.ws + OFF_Z) + (size_t)b * S_ * OLD;
    const unsigned rowmask = GLD(unsigned, (const unsigned*)(p.ws + OFF_SEL) + (size_t)(b * 4 + g) * S_ + t);
    float gate[3];
#pragma unroll
    for (int i = 0; i < 3; ++i) gate[i] = sigmoidf_(bf2f(GLD(bf16_t, Z + (size_t)t * OLD + 5632 + head * 3 + i)));
    f32x4 o[4], tot[4];
    const bf16_t* kc = (const bf16_t*)(p.ws + OFF_KC) + (size_t)((b * 4 + g) * 128) * 64;
    const bf16_t* vc = (const bf16_t*)(p.ws + OFF_VC) + (size_t)((b * 4 + g) * 128) * 64;
#ifndef NSA_PASSES
#define NSA_PASSES 7
#endif
    if (NSA_PASSES & 1) attn_pass<M_CMP, 64>(smem, Z + 3072 + head * 64, OLD, kc, 64, vc, 64, q0, 0u, 0.f, o, tid);
    else { o[0] = o[1] = o[2] = o[3] = (f32x4){0.f, 0.f, 0.f, 0.f}; }
#pragma unroll
    for (int c = 0; c < 4; ++c) { tot[c][0] = gate[0] * o[c][0]; tot[c][1] = gate[0] * o[c][1]; tot[c][2] = gate[0] * o[c][2]; tot[c][3] = gate[0] * o[c][3]; }
    if (NSA_PASSES & 2) attn_pass<M_SLC, 64>(smem, Z + 3072 + head * 64, OLD, Z + 4608 + g * 64, OLD, Z + 4864 + g * 64, OLD, q0, rowmask, 0.f, o, tid);
#pragma unroll
    for (int c = 0; c < 4; ++c) { tot[c][0] += gate[1] * o[c][0]; tot[c][1] += gate[1] * o[c][1]; tot[c][2] += gate[1] * o[c][2]; tot[c][3] += gate[1] * o[c][3]; }
    if (NSA_PASSES & 4) attn_pass<M_WIN, 64>(smem, Z + 3072 + head * 64, OLD, Z + 5120 + g * 64, OLD, Z + 5376 + g * 64, OLD, q0, 0u, 0.f, o, tid);
#pragma unroll
    for (int c = 0; c < 4; ++c) { tot[c][0] += gate[2] * o[c][0]; tot[c][1] += gate[2] * o[c][1]; tot[c][2] += gate[2] * o[c][2]; tot[c][3] += gate[2] * o[c][3]; }
    bf16_t* cat = (bf16_t*)(p.ws + OFF_CAT) + (size_t)(b * S_ + t) * D_ + 1024 + head * 64;
#pragma unroll
    for (int c = 0; c < 4; ++c) { u32x2 w; w.x = pk2(tot[c][0], tot[c][1]); w.y = pk2(tot[c][2], tot[c][3]); GST(u32x2, cat + 16 * c + 4 * quad) = w; }
}

__device__ __forceinline__ void ret_item(const Params& p, unsigned char* smem, int b, int h, int qt, int tid) {
    const int lane = tid & 63, wave = tid >> 6, lq = lane & 15, quad = lane >> 4;
    const int q0 = qt * 128, t = q0 + wave * 16 + lq;
    const bf16_t* Z = (const bf16_t*)(p.ws + OFF_Z) + (size_t)b * S_ * OLD;
    const float log2g = log2f(1.f - exp2f(-5.f - (float)h));
    f32x4 o[8];
    attn_pass<M_RET, 128>(smem, Z + h * 64, OLD, Z + 512 + h * 64, OLD, Z + 1024 + h * 128, OLD, q0, 0u, log2g, o, tid);
    float sm = 0.f;
#pragma unroll
    for (int c = 0; c < 8; ++c) sm += (o[c][0] + o[c][1]) + (o[c][2] + o[c][3]);
    sm += __shfl_xor(sm, 16); sm += __shfl_xor(sm, 32);
    const float mean = sm * (1.f / 128.f);
    float sq = 0.f;
#pragma unroll
    for (int c = 0; c < 8; ++c)
#pragma unroll
        for (int j = 0; j < 4; ++j) { o[c][j] -= mean; sq += o[c][j] * o[c][j]; }
    sq += __shfl_xor(sq, 16); sq += __shfl_xor(sq, 32);
    const float rstd = rsqrtf(sq * (1.f / 128.f) + 1e-6f);
    const bf16_t* rg = Z + (size_t)t * OLD + 2048 + h * 128;
    bf16_t* cat = (bf16_t*)(p.ws + OFF_CAT) + (size_t)(b * S_ + t) * D_ + h * 128;
#pragma unroll
    for (int c = 0; c < 8; ++c) {
        const u32x2 gv = GLD(u32x2, rg + 16 * c + 4 * quad);
        const float g0 = __uint_as_float(gv.x << 16), g1 = __uint_as_float(gv.x & 0xffff0000u), g2 = __uint_as_float(gv.y << 16), g3 = __uint_as_float(gv.y & 0xffff0000u);
        const float r0 = g0 * sigmoidf_(g0) * o[c][0] * rstd, r1 = g1 * sigmoidf_(g1) * o[c][1] * rstd, r2 = g2 * sigmoidf_(g2) * o[c][2] * rstd, r3 = g3 * sigmoidf_(g3) * o[c][3] * rstd;
        u32x2 w; w.x = pk2(r0, r1); w.y = pk2(r2, r3);
        GST(u32x2, cat + 16 * c + 4 * quad) = w;
    }
}

__device__ __forceinline__ void odd_mixer_phase(const Params& p, unsigned char* smem, int tid, int bid, int nblk) {
    for (int it = bid; it < 6144; it += nblk) {
        const int lvl = it / 384, r = it % 384, qt = 15 - lvl;
        if (r < 128) { for (int rep = 0; rep < REP_RET; ++rep) ret_item(p, smem, r >> 3, r & 7, qt, tid); }
        else { const int bh = r - 128; for (int rep = 0; rep < REP_NSA; ++rep) nsa_item(p, smem, bh >> 4, bh & 15, qt, tid); }
    }
}

#define XB_TMO      128
#define XB_XCNT(j)  (256  + 64 * (j))
#define XB_XSUB(j)  (1280 + 64 * (j))
#define XB_XGEN(j)  (2304 + 64 * (j))
#define XB_TOP      3328
#define XB_TOPGEN   3392
#define XCD_BAR_WORDS 3456
#define XB_SPIN_CAP (1u << 18)

__device__ __forceinline__ unsigned xb_ld(unsigned* p)              { return __hip_atomic_load(p, __ATOMIC_RELAXED, __HIP_MEMORY_SCOPE_AGENT); }
__device__ __forceinline__ unsigned xb_add(unsigned* p, unsigned v) { return __hip_atomic_fetch_add(p, v, __ATOMIC_RELAXED, __HIP_MEMORY_SCOPE_AGENT); }
__device__ __forceinline__ unsigned xb_xcc_id() { return (unsigned)__builtin_amdgcn_s_getreg((3 << 11) | 20) & 0xFu; }
#define XB_SPIN(cond, bar) do { unsigned _sp = 0; while (cond) { __builtin_amdgcn_s_sleep(1); \
    if ((++_sp & 255u) == 0u) { if (xb_ld(&(bar)[XB_TMO])) break; if (_sp > XB_SPIN_CAP) { atomicAdd(&(bar)[XB_TMO], 1u); break; } } } } while (0)

struct XcdBarrier {
    unsigned* bar; unsigned x;
    volatile LAS unsigned* st;
};

__device__ __forceinline__ XcdBarrier xcd_barrier_post(unsigned* bar, volatile LAS unsigned* st) {
    XcdBarrier b; b.bar = bar; b.x = xb_xcc_id(); b.st = st;
    if (threadIdx.x == 0) (void)xb_add(&bar[XB_XCNT(b.x)], 1u);
    return b;
}
__device__ __forceinline__ void xcd_barrier_complete(unsigned* bar, unsigned x, unsigned& nloc, unsigned& nx) {
    const unsigned G = gridDim.x * gridDim.y * gridDim.z;
    unsigned sum, cnt, mine, sp = 0u;
    for (;;) {
        sum = 0u; cnt = 0u; mine = 0u;
#pragma unroll
        for (unsigned j = 0; j < 16; ++j) { const unsigned c = xb_ld(&bar[XB_XCNT(j)]); sum += c; cnt += (c > 0u) ? 1u : 0u; mine = (j == x) ? c : mine; }
        if (sum == G) break;
        __builtin_amdgcn_s_sleep(1);
        if ((++sp & 255u) == 0u) { if (xb_ld(&bar[XB_TMO])) break; if (sp > XB_SPIN_CAP) { atomicAdd(&bar[XB_TMO], 1u); break; } }
    }
    nloc = mine > 0u ? mine : 1u; nx = cnt > 0u ? cnt : 1u;
}

__device__ __forceinline__ void xcd_barrier(const XcdBarrier& b) {
    asm volatile("s_waitcnt vmcnt(0)" ::: "memory");
    __syncthreads();
    if (threadIdx.x == 0) {
        unsigned* bar = b.bar;
        __builtin_amdgcn_s_waitcnt(0);
        unsigned nloc = b.st[0], nx = b.st[1];
        if (nloc == 0u) { xcd_barrier_complete(bar, b.x, nloc, nx); b.st[0] = nloc; b.st[1] = nx; }
        const unsigned old = xb_add(&bar[XB_XSUB(b.x)], 1u);
        const unsigned gen = old / nloc;
        if (old + 1u == (gen + 1u) * nloc) {
            __builtin_amdgcn_fence(__ATOMIC_RELEASE, "agent");
            asm volatile("s_waitcnt vmcnt(0)" ::: "memory");
            const unsigned og = xb_add(&bar[XB_TOP], 1u);
            const unsigned tg = og / nx;
            if (og + 1u == (tg + 1u) * nx) xb_add(&bar[XB_TOPGEN], 1u);
            else XB_SPIN(xb_ld(&bar[XB_TOPGEN]) == tg, bar);
            __builtin_amdgcn_fence(__ATOMIC_ACQUIRE, "agent");
            xb_add(&bar[XB_XGEN(b.x)], 1u);
            asm volatile("s_waitcnt vmcnt(0)" ::: "memory");
        } else {
            XB_SPIN(xb_ld(&bar[XB_XGEN(b.x)]) == gen, bar);
            __builtin_amdgcn_fence(__ATOMIC_ACQUIRE, "agent");
            asm volatile("s_waitcnt vmcnt(0)" ::: "memory");
        }
    }
    __syncthreads();
}

#ifndef ONLYMASK
#define ONLYMASK 0xFFFFFFu
#endif
#define PH_ON(n) ((ONLYMASK >> (n)) & 1u)
__device__ __forceinline__ const Params& opaque_params() {
    const Params* pp = (const Params*)__builtin_amdgcn_kernarg_segment_ptr(); asm volatile("" : "+s"(pp)); return *pp;
}
__device__ __forceinline__ void run_gemm(unsigned char* smem, int ph, int bid, int nblk) {
    const Params& p = opaque_params();
    unsigned char* ws = p.ws;
    pg8::Gemm g; EpiAll E; g.M = T_;
    E.O = (bf16_t*)(ws + OFF_Z); E.ldc = EIN; E.Xin = p.out; E.Xout = p.out; E.mode = 0;
    if (ph == 1) { g.A = (const bf16_t*)(ws + OFF_H); g.Bt = (const bf16_t*)(ws + OFF_WT_EIN); g.N = EIN; g.K = D_; E.mode = 0; E.ldc = EIN; }
    else if (ph == 9) { g.A = (const bf16_t*)(ws + OFF_H); g.Bt = (const bf16_t*)(ws + OFF_WT_OIN); g.N = OLD; g.K = D_; E.mode = 0; E.ldc = OLD; }
    else if (ph == 4) { g.A = (const bf16_t*)(ws + OFF_CAT); g.Bt = (const bf16_t*)(ws + OFF_WT_EOUT); g.N = D_; g.K = D_; E.mode = 1; E.Xin = p.in[0]; }
    else if (ph == 13) { g.A = (const bf16_t*)(ws + OFF_CAT); g.Bt = (const bf16_t*)(ws + OFF_WT_OOUT); g.N = D_; g.K = D_; E.mode = 1; }
    else if (ph == 7) { g.A = (const bf16_t*)(ws + OFF_Z); g.Bt = (const bf16_t*)(ws + OFF_WT2_0); g.N = D_; g.K = FF_; E.mode = 1; }
    else if (ph == 16) { g.A = (const bf16_t*)(ws + OFF_Z); g.Bt = (const bf16_t*)(ws + OFF_WT2_1); g.N = D_; g.K = FF_; E.mode = 1; }
    else if (ph == 6) { g.A = (const bf16_t*)(ws + OFF_H); g.Bt = (const bf16_t*)(ws + OFF_WT13_0); g.N = 2 * FF_; g.K = D_; E.mode = 2; }
    else { g.A = (const bf16_t*)(ws + OFF_H); g.Bt = (const bf16_t*)(ws + OFF_WT13_1); g.N = 2 * FF_; g.K = D_; E.mode = 2; }
    pg8::StaticOrder So; So.init(g.M, g.N, (int)nblk, (int)bid);
    pg8::gemm_phase<EpiAll, pg8::StaticOrder, false>((PG8_LAS unsigned char*)smem, g, So, E, nullptr);
}
__device__ __forceinline__ void run_norm(int ph, int tid, int bid, int nblk) {
    const Params& p = opaque_params();
    const int lane = tid & 63, wave = tid >> 6;
    const int gw = bid * 8 + wave, ngw = nblk * 8;
    bf16_t* H = (bf16_t*)(p.ws + OFF_H);
#ifdef SKEL
    if (ph == 17) rmsnorm_rows(p.in[0], p.in[27], nullptr, p.out, gw, ngw, lane);
    else if (ph == 5) {}
#else
    if (ph == 17) rmsnorm_rows(p.out, p.in[27], nullptr, p.out, gw, ngw, lane);
#endif
    else rmsnorm_rows(p.out, (ph == 8 ? p.in[1] + D_ : p.in[2] + (ph == 14 ? D_ : 0)), H, nullptr, gw, ngw, lane);
}
__global__ void __launch_bounds__(512, 2) mega(Params pk) {
    extern __shared__ __attribute__((aligned(16))) unsigned char smem[];
    cg::grid_group grid = cg::this_grid();
    {
        volatile LAS unsigned* st0 = (volatile LAS unsigned*)(smem + 131072);
        if (threadIdx.x == 0) { st0[0] = 0u; st0[1] = 0u; }
        __syncthreads();
        (void)xcd_barrier_post((unsigned*)(opaque_params().ws + OFF_BAR), st0);
    }
    const int ph_lo = ((const Params*)__builtin_amdgcn_kernarg_segment_ptr())->ph_lo, ph_hi = ((const Params*)__builtin_amdgcn_kernarg_segment_ptr())->ph_hi;
#pragma nounroll
    for (int ph = ph_lo; ph < ph_hi; ++ph) {
        int tid = threadIdx.x; asm volatile("" : "+v"(tid));
        int bid = __builtin_amdgcn_workgroup_id_x(); asm volatile("" : "+s"(bid));
        int nblk = (int)__builtin_amdgcn_grid_size_x() / 512; asm volatile("" : "+s"(nblk));
        if (ph == 0) { for (int rep = 0; rep < REP_P0; ++rep) { phase0(opaque_params(), smem, tid, bid, nblk); __syncthreads(); } }
        else if (ph == 2) { if (PH_ON(2)) kmean_phase(opaque_params(), tid, bid, nblk); }
        else if (ph == 3) { if (PH_ON(3)) even_mixer_phase(opaque_params(), smem, tid, bid, nblk); }
        else if (ph == 10) { if (PH_ON(10)) odd_prep_phase(opaque_params(), smem, tid, bid, nblk); }
        else if (ph == 11) { for (int rep = 0; rep < REP_SEL; ++rep) select_phase(opaque_params(), smem, tid, bid, nblk); }
        else if (ph == 12) { if (PH_ON(12)) odd_mixer_phase(opaque_params(), smem, tid, bid, nblk); }
#ifdef SKEL
        else if (ph == 17) { run_norm(ph, tid, bid, nblk); }
        else if (ph == 5 || ph == 8 || ph == 14) { }
#else
        else if (ph == 5 || ph == 8 || ph == 14 || ph == 17) { const int nrep = (ph == 5) ? REP_NORM : 1; for (int rep = 0; rep < nrep; ++rep) run_norm(ph, tid, bid, nblk); }
#endif
        else { const int nrep = (ph == 1 || ph == 6 || ph == 9 || ph == 15) ? REP_GEMM : 1; for (int rep = 0; rep < nrep; ++rep) { run_gemm(smem, ph, bid, nblk); __syncthreads(); } }
        if (ph + 1 < ph_hi) {
            if (ph == 0) grid.sync();
            else { XcdBarrier xb; xb.bar = (unsigned*)(opaque_params().ws + OFF_BAR); xb.x = xb_xcc_id(); xb.st = (volatile LAS unsigned*)(smem + 131072); xcd_barrier(xb); }
        }
    }
}

extern "C" void kernel_launch(void* const* d_in, const int* in_sizes, int n_in, void* d_out, int out_size, void* d_ws, size_t ws_size, hipStream_t stream) {
    static int grid = 0;
    if (grid == 0) {
        if (n_in != 28 || out_size != T_ * D_ || ws_size < WS_END) { fprintf(stderr, "kernel_launch: unexpected shapes (n_in %d out %d ws %zu need %zu)\n", n_in, out_size, ws_size, (size_t)WS_END); grid = -1; return; }
        int dev = 0, cus = 0, per_cu = 0;
        hipGetDevice(&dev);
        hipDeviceGetAttribute(&cus, hipDeviceAttributeMultiprocessorCount, dev);
        if (hipFuncSetAttribute((const void*)mega, hipFuncAttributeMaxDynamicSharedMemorySize, LDS_BYTES) != hipSuccess) { fprintf(stderr, "kernel_launch: hipFuncSetAttribute failed\n"); grid = -1; return; }
        hipOccupancyMaxActiveBlocksPerMultiprocessor(&per_cu, (const void*)mega, 512, LDS_BYTES);
        if (per_cu < 1) { fprintf(stderr, "kernel_launch: occupancy query says %d blocks per CU\n", per_cu); per_cu = 1; }
        (void)hipGetLastError();
        grid = cus;
    }
    if (grid < 0) return;
    Params p{};
    for (int i = 0; i < 28; ++i) p.in[i] = (const float*)d_in[i];
    p.out = (float*)d_out; p.ws = (unsigned char*)d_ws;
    for (int i = 0; i < 32; ++i) p.inv_freq[i] = pow(10000.0, -(double)i / 32.0);
    p.ph_lo = 0; p.ph_hi = NPHASE;
#ifdef ZEROCAT
    (void)hipMemsetAsync((char*)d_ws + OFF_CAT, 0, (size_t)T_ * D_ * 2, stream);
#endif
    if (hipMemsetAsync((char*)d_ws + OFF_BAR, 0, XCD_BAR_WORDS * sizeof(unsigned), stream) != hipSuccess) { fprintf(stderr, "kernel_launch: memset of barrier words failed\n"); return; }
    void* args[] = {&p};
    hipError_t e = hipLaunchCooperativeKernel((const void*)mega, dim3(grid), dim3(512), args, LDS_BYTES, stream);
    if (e != hipSuccess) fprintf(stderr, "kernel_launch: cooperative launch failed: %s (grid %d)\n", hipGetErrorString(e), grid);
}
```

```cpp
#include <hip/hip_runtime.h>
#include <hip/hip_cooperative_groups.h>
#include <cstdio>
#include <cmath>
namespace cg = cooperative_groups;
namespace pg8 {
#define PG8_LAS __attribute__((address_space(3)))
typedef unsigned short bf16_t;
typedef short bf16x8 __attribute__((ext_vector_type(8)));
typedef float f32x4 __attribute__((ext_vector_type(4)));
typedef unsigned u32x4 __attribute__((ext_vector_type(4)));
constexpr int BM = 256, BK = 64, HALF = 128, HTB = HALF * BK * 2  , STAGE_BYTES = 8 * HTB, NXCD = 8, WGM = 8;

__host__ __device__ __forceinline__ int lds_byte(int r, int c) { const int st = (r >> 4) * 2 + (c >> 5), rr = r & 15, cc = c & 31, ob = rr * 64 + cc * 2; return st * 1024 + (ob ^ (((ob >> 9) & 1) << 5)); }
__host__ __device__ __forceinline__ void stage_rc(int b, int& R, int& C) { const int st = b / 1024, sb = b % 1024, swz = sb ^ (((sb >> 9) & 1) << 5); R = (st >> 1) * 16 + swz / 64; C = (st & 1) * 32 + (swz % 64) / 2; }
__host__ __device__ __forceinline__ int perm32(int rho) { const int n = rho >> 4, i = rho & 15; return 8 * (i >> 2) + 4 * n + (i & 3); }

struct Unit { int pm, pn; };
struct Gemm { const bf16_t* A; const bf16_t* Bt; int M, N, K; };

struct StaticOrder {
    int nM, nN, nwg, G, c;
    __host__ __device__ void init(int M, int N, int G_, int c_) { nM = M / BM; nN = N / BM; nwg = nM * nN; G = G_; c = c_; }
    __host__ __device__ bool next(int i, Unit& u) const {
        const long L = (long)i * G + c; if (L >= nwg) return false;
        int wgid = (int)L; { const int q = nwg / NXCD, r = nwg % NXCD, xcd = wgid % NXCD, off = wgid / NXCD; wgid = (xcd < r ? xcd * (q + 1) : r * (q + 1) + (xcd - r) * q) + off; }
        const int nig = WGM * nN, gid = wgid / nig, fm = gid * WGM, gsz = (nM - fm) < WGM ? (nM - fm) : WGM;
        u.pm = fm + ((wgid % nig) % gsz); u.pn = (wgid % nig) / gsz; return true;
    }
    __device__ __forceinline__ void a_ready(const Unit&) const {}
    __device__ __forceinline__ void done(const Unit&) const {}
};
__device__ __forceinline__ unsigned cvt_pk_bf16(float lo, float hi) { unsigned r; asm volatile("v_cvt_pk_bf16_f32 %0, %1, %2" : "=v"(r) : "v"(lo), "v"(hi)); return r; }
template <class Epi, class Sched, bool STAMP = false>
__device__ __forceinline__ void gemm_phase(PG8_LAS unsigned char* lds, const Gemm g, const Sched& S, const Epi& E, unsigned long long* stamps) {
    int tid = threadIdx.x; asm volatile("" : "+v"(tid)); const int wid = __builtin_amdgcn_readfirstlane(tid >> 6), lane = tid & 63, wr = wid >> 2, wc = wid & 3, fr = lane & 15, fq = lane >> 4;
    const int K = g.K, nt = K / BK;
    int ts_lo = 0, ts_hi = 0, nts = 0; const unsigned long long rt_entry = STAMP ? (unsigned long long)wall_clock64() : 0ull;
#define PG8_STAMP() do { if (STAMP && wid == 0 && nts < 64) { const unsigned long long _c = (unsigned long long)clock64(); \
        ts_lo = (lane == nts) ? (int)(unsigned)_c : ts_lo; ts_hi = (lane == nts) ? (int)(unsigned)(_c >> 32) : ts_hi; ++nts; } } while (0)
    PG8_STAMP();
    unsigned voffA[2], voffB[2];
#pragma unroll
    for (int i = 0; i < 2; ++i) { int R, C; stage_rc(tid * 16 + i * 8192, R, C); const int Rb = Epi::PERM ? ((R & ~31) + perm32(R & 31)) : R;
        voffA[i] = (unsigned)(R * K + C) * 2u; voffB[i] = (unsigned)(Rb * K + C) * 2u; }
    const size_t kstep = (size_t)(BK * 2);
    const size_t hstep = (size_t)HALF * K * 2;
    const size_t tstep = 2 * hstep;
    const unsigned ldsw = (unsigned)wid * 1024u;
    const int aoff = lds_byte(wr * 64 + fr, fq * 8), boff = lds_byte(wc * 32 + fr, fq * 8);
#define PG8_SA(b, h) (((b) * 2 + (h)) * HTB)
#define PG8_SB(b, h) ((4 + (b) * 2 + (h)) * HTB)
#define PG8_STAGE(bufoff, gbase, voff) do { _Pragma("unroll") for (int _i = 0; _i < 2; ++_i) \
        __builtin_amdgcn_global_load_lds((const unsigned*)((const char*)(gbase) + (voff)[_i]), (PG8_LAS unsigned*)(lds + (bufoff) + ldsw + _i * 8192), 16, 0, 0); } while (0)
#define PG8_LDA(dst, b, h) do { _Pragma("unroll") for (int m = 0; m < 4; ++m) _Pragma("unroll") for (int k = 0; k < 2; ++k) dst[m][k] = *(const PG8_LAS bf16x8*)(lds + PG8_SA(b, h) + aoff + m * 2048 + k * 1024); } while (0)
#define PG8_LDB(dst, b, h) do { _Pragma("unroll") for (int n = 0; n < 2; ++n) _Pragma("unroll") for (int k = 0; k < 2; ++k) dst[n][k] = *(const PG8_LAS bf16x8*)(lds + PG8_SB(b, h) + boff + n * 2048 + k * 1024); } while (0)
#define PG8_MMA(ai, bj, At, Bt) do { __builtin_amdgcn_s_setprio(1); _Pragma("unroll") for (int m = 0; m < 4; ++m) _Pragma("unroll") for (int n = 0; n < 2; ++n) _Pragma("unroll") for (int k = 0; k < 2; ++k) \
        acc[ai][bj][m][n] = __builtin_amdgcn_mfma_f32_16x16x32_bf16(Bt[n][k], At[m][k], acc[ai][bj][m][n], 0, 0, 0); __builtin_amdgcn_s_setprio(0); } while (0)
#define PG8_WAIT_V(n) asm volatile("s_waitcnt vmcnt(" #n ")" ::: "memory")
#define PG8_WAIT_L(n) asm volatile("s_waitcnt lgkmcnt(" #n ")" ::: "memory")
#define PG8_BAR __builtin_amdgcn_s_barrier()
#define PG8_SCHED __builtin_amdgcn_sched_barrier(0)
    Unit cur, nxt; int ui = 0;
    if (!S.next(0, cur)) return;
    f32x4 acc[2][2][4][2];
#pragma unroll
    for (int a = 0; a < 2; ++a)
#pragma unroll
        for (int b = 0; b < 2; ++b)
#pragma unroll
            for (int m = 0; m < 4; ++m)
#pragma unroll
                for (int n = 0; n < 2; ++n) acc[a][b][m][n] = (f32x4){0.f, 0.f, 0.f, 0.f};
    bf16x8 At[4][2], B0[2][2], B1[2][2];
    const char* cA = (const char*)g.A + (size_t)cur.pm * tstep; const char* cB = (const char*)g.Bt + (size_t)cur.pn * tstep;
    S.a_ready(cur);
    PG8_STAGE(PG8_SB(0, 0), cB, voffB); PG8_STAGE(PG8_SA(0, 0), cA, voffA); PG8_STAGE(PG8_SB(0, 1), cB + hstep, voffB); PG8_STAGE(PG8_SA(0, 1), cA + hstep, voffA);
    if (wr == 1) PG8_BAR;
    PG8_WAIT_V(4); PG8_BAR;
    PG8_STAGE(PG8_SB(1, 0), cB + kstep, voffB); PG8_STAGE(PG8_SA(1, 0), cA + kstep, voffA); PG8_STAGE(PG8_SB(1, 1), cB + hstep + kstep, voffB);
    PG8_WAIT_V(6); PG8_BAR;
    PG8_STAMP();
    for (;;) {
        const bool has_next = S.next(ui + 1, nxt);
        const char* nA = has_next ? (const char*)g.A + (size_t)nxt.pm * tstep : cA; const char* nB = has_next ? (const char*)g.Bt + (size_t)nxt.pn * tstep : cB;
        for (int t = 0; t < nt; t += 2) {
            const bool last = (t == nt - 2);
            const char* a1 = cA + (size_t)(t + 1) * kstep;
            const char* a2 = last ? nA : cA + (size_t)(t + 2) * kstep; const char* b2 = last ? nB : cB + (size_t)(t + 2) * kstep;
            const char* a3 = a2 + kstep; const char* b3 = b2 + kstep;
            if (last && has_next) S.a_ready(nxt);
            PG8_LDB(B0, 0, 0); PG8_SCHED; PG8_LDA(At, 0, 0); PG8_STAGE(PG8_SA(1, 1), a1 + hstep, voffA);
            PG8_WAIT_L(8); PG8_BAR; PG8_WAIT_L(0); PG8_MMA(0, 0, At, B0); PG8_BAR; PG8_SCHED;
            PG8_LDB(B1, 0, 1); PG8_STAGE(PG8_SB(0, 0), b2, voffB);
            PG8_BAR; PG8_WAIT_L(0); PG8_MMA(0, 1, At, B1); PG8_BAR;
            PG8_LDA(At, 0, 1); PG8_STAGE(PG8_SA(0, 0), a2, voffA);
            PG8_BAR; PG8_WAIT_L(0); PG8_MMA(1, 0, At, B0); PG8_BAR; PG8_SCHED;
            PG8_STAGE(PG8_SB(0, 1), b2 + hstep, voffB);
            PG8_WAIT_V(6); PG8_BAR; PG8_MMA(1, 1, At, B1); PG8_BAR;
            PG8_LDB(B0, 1, 0); PG8_SCHED; PG8_LDA(At, 1, 0); PG8_STAGE(PG8_SA(0, 1), a2 + hstep, voffA);
            PG8_WAIT_L(8); PG8_BAR; PG8_WAIT_L(0); PG8_MMA(0, 0, At, B0); PG8_BAR; PG8_SCHED;
            PG8_LDB(B1, 1, 1); PG8_STAGE(PG8_SB(1, 0), b3, voffB);
            PG8_BAR; PG8_WAIT_L(0); PG8_MMA(0, 1, At, B1); PG8_BAR;
            PG8_LDA(At, 1, 1); PG8_STAGE(PG8_SA(1, 0), a3, voffA);
            PG8_BAR; PG8_WAIT_L(0); PG8_MMA(1, 0, At, B0); PG8_BAR; PG8_SCHED;
            PG8_STAGE(PG8_SB(1, 1), b3 + hstep, voffB);
            PG8_WAIT_V(6); PG8_BAR; PG8_MMA(1, 1, At, B1); PG8_BAR;
        }
        PG8_STAMP();
        if constexpr (!Epi::AFTER_DRAIN) { E(acc, cur, wr, wc, fr, fq); S.done(cur); }
        PG8_STAMP();
        if (!has_next) break;
#pragma unroll
        for (int a = 0; a < 2; ++a)
#pragma unroll
            for (int b = 0; b < 2; ++b)
#pragma unroll
                for (int m = 0; m < 4; ++m)
#pragma unroll
                    for (int n = 0; n < 2; ++n) acc[a][b][m][n] = (f32x4){0.f, 0.f, 0.f, 0.f};
        cur = nxt; cA = nA; cB = nB; ++ui;
    }
    PG8_WAIT_V(0);
    if (wr == 0) PG8_BAR;
    PG8_BAR;
    if constexpr (Epi::AFTER_DRAIN) { E.fused(acc, cur, wr, wc, fr, fq, lds, wid, lane); S.done(cur); }
    PG8_STAMP();
    if (STAMP && wid == 0) { stamps[lane] = lane < nts ? (((unsigned long long)(unsigned)ts_hi << 32) | (unsigned)ts_lo) : 0ull;
        if (lane == 62) stamps[62] = rt_entry; if (lane == 63) stamps[63] = (unsigned long long)wall_clock64(); }
#undef PG8_STAMP
#undef PG8_SA
#undef PG8_SB
#undef PG8_STAGE
#undef PG8_LDA
#undef PG8_LDB
#undef PG8_MMA
#undef PG8_WAIT_V
#undef PG8_WAIT_L
#undef PG8_BAR
#undef PG8_SCHED
}
}

typedef unsigned short bf16_t;
typedef short bf16x8 __attribute__((ext_vector_type(8)));
typedef short s16x4 __attribute__((ext_vector_type(4)));
typedef float f32x4 __attribute__((ext_vector_type(4)));
typedef float f32x2 __attribute__((ext_vector_type(2)));
typedef unsigned u32x4 __attribute__((ext_vector_type(4)));
typedef unsigned u32x2 __attribute__((ext_vector_type(2)));
#define LAS __attribute__((address_space(3)))
#define GAS __attribute__((address_space(1)))
#define GLD(T, ptr) (*(const GAS T*)(ptr))
#define GST(T, ptr) (*(GAS T*)(ptr))

constexpr int T_ = 32768, D_ = 2048, S_ = 2048, B_ = 16, FF_ = 5632;
constexpr int EIN = 6400, OIN = 5680, OLD = 5888;
constexpr float EPS_ = 1e-6f;

constexpr size_t AL256(size_t x) { return (x + 255) & ~(size_t)255; }
constexpr size_t OFF_CTRL = 0;
constexpr size_t OFF_WT_EIN = 4096;
constexpr size_t OFF_WT_EOUT = OFF_WT_EIN + (size_t)EIN * D_ * 2;
constexpr size_t OFF_WT_OIN = OFF_WT_EOUT + (size_t)D_ * D_ * 2;
constexpr size_t OFF_WT_OOUT = OFF_WT_OIN + (size_t)OLD * D_ * 2;
constexpr size_t OFF_WT13_0 = OFF_WT_OOUT + (size_t)D_ * D_ * 2;
constexpr size_t OFF_WT13_1 = OFF_WT13_0 + (size_t)2 * FF_ * D_ * 2;
constexpr size_t OFF_WT2_0 = OFF_WT13_1 + (size_t)2 * FF_ * D_ * 2;
constexpr size_t OFF_WT2_1 = OFF_WT2_0 + (size_t)D_ * FF_ * 2;
constexpr size_t OFF_W1T_K = OFF_WT2_1 + (size_t)D_ * FF_ * 2;
constexpr size_t OFF_W1T_V = OFF_W1T_K + (size_t)128 * 2048 * 2;
constexpr size_t OFF_W2T_K = OFF_W1T_V + (size_t)128 * 2048 * 2;
constexpr size_t OFF_W2T_V = OFF_W2T_K + (size_t)64 * 128 * 2;
constexpr size_t OFF_BIAS1 = OFF_W2T_V + (size_t)64 * 128 * 2;
constexpr size_t OFF_ROPE = OFF_BIAS1 + 1024;
constexpr size_t OFF_KMEAN = OFF_ROPE + (size_t)2048 * 32 * 8;
constexpr size_t OFF_KC = OFF_KMEAN + (size_t)16 * 16 * 8 * 64 * 4;
constexpr size_t OFF_VC = OFF_KC + (size_t)16 * 4 * 128 * 64 * 2;
constexpr size_t OFF_SEL = OFF_VC + (size_t)16 * 4 * 128 * 64 * 2;
constexpr size_t OFF_H = OFF_SEL + (size_t)16 * 4 * 2048 * 4;
constexpr size_t OFF_Z = OFF_H + (size_t)T_ * D_ * 2;
constexpr size_t OFF_CAT = OFF_Z + (size_t)T_ * EIN * 2;
constexpr size_t OFF_BAR = OFF_CAT + (size_t)T_ * D_ * 2;
constexpr size_t WS_END = OFF_BAR + 16384;

constexpr int LDS_BYTES = 131072 + 16;
constexpr int NPHASE = 18;
#ifndef REP_P0
#define REP_P0 1
#endif
#ifndef REP_RWKV
#define REP_RWKV 1
#endif
#ifndef REP_MOBA
#define REP_MOBA 1
#endif
#ifndef REP_RET
#define REP_RET 1
#endif
#ifndef REP_NSA
#define REP_NSA 1
#endif
#ifndef REP_GEMM
#define REP_GEMM 1
#endif
#ifndef REP_NORM
#define REP_NORM 1
#endif
#ifndef REP_SEL
#define REP_SEL 1
#endif

struct Params {
    const float* in[28];
    float* out;
    unsigned char* ws;
    double inv_freq[32];
    int ph_lo, ph_hi;
};

__device__ __forceinline__ float bf2f(unsigned short b) { return __uint_as_float(((unsigned)b) << 16); }
typedef __bf16 bf16x2_t __attribute__((ext_vector_type(2)));
__device__ __forceinline__ unsigned pk2(float lo, float hi) { f32x2 v; v[0] = lo; v[1] = hi; const bf16x2_t r = __builtin_convertvector(v, bf16x2_t); return __builtin_bit_cast(unsigned, r); }
__device__ __forceinline__ float wave_sum(float v) {
#pragma unroll
    for (int o = 1; o < 64; o <<= 1) v += __shfl_xor(v, o);
    return v;
}
template <int CTRL> __device__ __forceinline__ float dppf(float x) {
    return __int_as_float(__builtin_amdgcn_update_dpp(0, __float_as_int(x), CTRL, 0xf, 0xf, false));
}
__device__ __forceinline__ float rowsum16(float x) {
    x += dppf<0x128>(x);
    x += dppf<0x124>(x);
    x += dppf<0x4E>(x);
    x += dppf<0xB1>(x);
    return x;
}
__device__ __forceinline__ void rowsum16x4(float& a, float& b, float& c, float& d) {
    asm volatile("" : "+v"(a), "+v"(b), "+v"(c), "+v"(d));
    a += dppf<0x128>(a); b += dppf<0x128>(b); c += dppf<0x128>(c); d += dppf<0x128>(d); asm volatile("" : "+v"(a), "+v"(b), "+v"(c), "+v"(d));
    a += dppf<0x124>(a); b += dppf<0x124>(b); c += dppf<0x124>(c); d += dppf<0x124>(d); asm volatile("" : "+v"(a), "+v"(b), "+v"(c), "+v"(d));
    a += dppf<0x4E>(a); b += dppf<0x4E>(b); c += dppf<0x4E>(c); d += dppf<0x4E>(d); asm volatile("" : "+v"(a), "+v"(b), "+v"(c), "+v"(d));
    a += dppf<0xB1>(a); b += dppf<0xB1>(b); c += dppf<0xB1>(c); d += dppf<0xB1>(d); asm volatile("" : "+v"(a), "+v"(b), "+v"(c), "+v"(d));
}
__device__ __forceinline__ float fexp2(float x) { return __builtin_amdgcn_exp2f(x); }
__device__ __forceinline__ float fexp(float x) { return __builtin_amdgcn_exp2f(x * 1.4426950408889634f); }
__device__ __forceinline__ float frcp(float x) { return __builtin_amdgcn_rcpf(x); }
__device__ __forceinline__ float sigmoidf_(float x) { return frcp(1.f + fexp(-x)); }
__device__ __forceinline__ void lds_wait() { asm volatile("s_waitcnt lgkmcnt(0)" ::: "memory"); }
__device__ __forceinline__ void unpack8(u32x4 v, float (&f)[8]) {
    f[0] = __uint_as_float(v.x << 16); f[1] = __uint_as_float(v.x & 0xffff0000u);
    f[2] = __uint_as_float(v.y << 16); f[3] = __uint_as_float(v.y & 0xffff0000u);
    f[4] = __uint_as_float(v.z << 16); f[5] = __uint_as_float(v.z & 0xffff0000u);
    f[6] = __uint_as_float(v.w << 16); f[7] = __uint_as_float(v.w & 0xffff0000u);
}
__device__ __forceinline__ bf16x8 as_bf16x8(u32x4 v) { return __builtin_bit_cast(bf16x8, v); }
__device__ __forceinline__ f32x4 mfma16(bf16x8 a, bf16x8 b, f32x4 c) { return __builtin_amdgcn_mfma_f32_16x16x32_bf16(a, b, c, 0, 0, 0); }

struct EpiAll {
    static constexpr bool PERM = true, AFTER_DRAIN = false;
    int mode; bf16_t* O; int ldc; const float* Xin; float* Xout;
    __device__ __forceinline__ void operator()(const pg8::f32x4 (&acc)[2][2][4][2], const pg8::Unit& u, int wr, int wc, int fr, int fq) const {
        const int row0 = u.pm * 256 + wr * 64 + fr;
        if (mode == 0) {
            const int col0 = u.pn * 256 + wc * 32 + 8 * fq;
#pragma unroll
            for (int ai = 0; ai < 2; ++ai)
#pragma unroll
                for (int m = 0; m < 4; ++m) {
                    bf16_t* rowp = O + (size_t)(row0 + ai * 128 + m * 16) * ldc + col0;
#pragma unroll
                    for (int bj = 0; bj < 2; ++bj) {
                        const pg8::f32x4 v0 = acc[ai][bj][m][0], v1 = acc[ai][bj][m][1];
                        u32x4 w; w.x = pk2(v0[0], v0[1]); w.y = pk2(v0[2], v0[3]); w.z = pk2(v1[0], v1[1]); w.w = pk2(v1[2], v1[3]);
                        GST(u32x4, rowp + bj * 128) = w;
                    }
                }
        } else if (mode == 1) {
            const int col0 = u.pn * 256 + wc * 32 + 8 * fq;
#pragma unroll
            for (int ai = 0; ai < 2; ++ai)
#pragma unroll
                for (int m = 0; m < 4; ++m) {
                    const size_t off = (size_t)(row0 + ai * 128 + m * 16) * D_ + col0;
#pragma unroll
                    for (int bj = 0; bj < 2; ++bj)
#pragma unroll
                        for (int n = 0; n < 2; ++n) {
                            const size_t idx = off + bj * 128 + n * 4;
                            const f32x4 x = GLD(f32x4, Xin + idx);
                            f32x4 r; r[0] = x[0] + acc[ai][bj][m][n][0]; r[1] = x[1] + acc[ai][bj][m][n][1]; r[2] = x[2] + acc[ai][bj][m][n][2]; r[3] = x[3] + acc[ai][bj][m][n][3];
                            GST(f32x4, Xout + idx) = r;
                        }
                }
        } else {
            const int col0 = u.pn * 128 + wc * 32 + 8 * fq;
#pragma unroll
            for (int ai = 0; ai < 2; ++ai)
#pragma unroll
                for (int m = 0; m < 4; ++m) {
                    bf16_t* rowp = O + (size_t)(row0 + ai * 128 + m * 16) * FF_ + col0;
                    float hv[8];
#pragma unroll
                    for (int n = 0; n < 2; ++n)
#pragma unroll
                        for (int j = 0; j < 4; ++j) { const float g = acc[ai][0][m][n][j], up = acc[ai][1][m][n][j]; hv[n * 4 + j] = g * sigmoidf_(g) * up; }
                    u32x4 w; w.x = pk2(hv[0], hv[1]); w.y = pk2(hv[2], hv[3]); w.z = pk2(hv[4], hv[5]); w.w = pk2(hv[6], hv[7]);
                    GST(u32x4, rowp) = w;
                }
        }
    }
};

template <int MODE>
__device__ __forceinline__ void prep_w(const float* Wa, const float* Wb, int K, int Nsrc, bf16_t* WT, int nOutBlocks, float* scr, int gw, int ngw, int lane, const float* gain) {
    const int nkb = K / 64, nitems = nkb * nOutBlocks;
    const int lr = lane >> 3, lc = (lane & 7) * 4;
    f32x4 cur[8], nxt[8];
    auto locate = [&](int it, const float*& src, int& c0, int& k0, int& ob) {
        ob = it % nOutBlocks; k0 = (it / nOutBlocks) * 64;
        if (MODE == 0) { src = Wa; c0 = ob * 32; }
        else { const int pn = ob >> 3, sb = ob & 7; src = (sb < 4) ? Wa : Wb; c0 = (pn * 4 + (sb & 3)) * 32; }
    };
    auto load = [&](int it, f32x4 (&v)[8]) {
        const float* src; int c0, k0, ob; locate(it, src, c0, k0, ob);
        const int col = c0 + lc;
#pragma unroll
        for (int i = 0; i < 8; ++i) v[i] = (col < Nsrc) ? GLD(f32x4, src + (size_t)(k0 + 8 * i + lr) * Nsrc + col) : (f32x4){0.f, 0.f, 0.f, 0.f};
    };
    int it = gw;
    if (it < nitems) load(it, cur);
    for (; it < nitems; it += ngw) {
        const int itn = it + ngw;
        if (itn < nitems) load(itn, nxt);
        const float* src; int c0, k0, ob; locate(it, src, c0, k0, ob);
#pragma unroll
        for (int i = 0; i < 8; ++i) {
            const int kk = 8 * i + lr; const float gk = gain ? gain[k0 + kk] : 1.f;
            float* d = scr + kk * 33 + lc;
            d[0] = cur[i][0] * gk; d[1] = cur[i][1] * gk; d[2] = cur[i][2] * gk; d[3] = cur[i][3] * gk;
        }
        lds_wait();
        const int c = lane & 7;
#pragma unroll
        for (int j = 0; j < 4; ++j) {
            const int n = (lane >> 3) + 8 * j; const float* sp = scr + (8 * c) * 33 + n;
            u32x4 o; o.x = pk2(sp[0 * 33], sp[1 * 33]); o.y = pk2(sp[2 * 33], sp[3 * 33]); o.z = pk2(sp[4 * 33], sp[5 * 33]); o.w = pk2(sp[6 * 33], sp[7 * 33]);
            GST(u32x4, WT + (size_t)(ob * 32 + n) * K + k0 + 8 * c) = o;
        }
        lds_wait();
#pragma unroll
        for (int i = 0; i < 8; ++i) cur[i] = nxt[i];
    }
}

__device__ __forceinline__ void rmsnorm_rows(const float* X, const float* g, bf16_t* H, float* OutF, int gw, int ngw, int lane) {
    f32x4 gv[8];
#pragma unroll
    for (int j = 0; j < 8; ++j) gv[j] = GLD(f32x4, (const f32x4*)g + lane + 64 * j);
    f32x4 v[8], vn[8];
    int m = gw;
    if (m < T_) {
#pragma unroll
        for (int j = 0; j < 8; ++j) v[j] = GLD(f32x4, (const f32x4*)(X + (size_t)m * D_) + lane + 64 * j);
    }
    for (; m < T_; m += ngw) {
        const int mn = m + ngw;
        if (mn < T_) {
#pragma unroll
            for (int j = 0; j < 8; ++j) vn[j] = GLD(f32x4, (const f32x4*)(X + (size_t)mn * D_) + lane + 64 * j);
        }
        float ss = 0.f;
#pragma unroll
        for (int j = 0; j < 8; ++j) ss += (v[j][0] * v[j][0] + v[j][1] * v[j][1]) + (v[j][2] * v[j][2] + v[j][3] * v[j][3]);
        ss = wave_sum(ss);
        const float rstd = rsqrtf(ss * (1.f / D_) + EPS_);
#pragma unroll
        for (int j = 0; j < 8; ++j) {
            const float y0 = v[j][0] * rstd * gv[j][0], y1 = v[j][1] * rstd * gv[j][1], y2 = v[j][2] * rstd * gv[j][2], y3 = v[j][3] * rstd * gv[j][3];
            if (H) { u32x2 o; o.x = pk2(y0, y1); o.y = pk2(y2, y3); GST(u32x2, H + (size_t)m * D_ + (lane + 64 * j) * 4) = o; }
            if (OutF) { f32x4 o; o[0] = y0; o[1] = y1; o[2] = y2; o[3] = y3; GST(f32x4, (f32x4*)(OutF + (size_t)m * D_) + lane + 64 * j) = o; }
        }
#pragma unroll
        for (int j = 0; j < 8; ++j) v[j] = vn[j];
    }
}

__device__ __forceinline__ void phase0(const Params& p, unsigned char* smem, int tid, int bid, int nblk) {
    const int lane = tid & 63, wave = tid >> 6;
    const int gw = bid * 8 + wave, ngw = nblk * 8;
    float* scr = (float*)(smem + wave * 8448);
    unsigned char* ws = p.ws;
    prep_w<0>(p.in[3], nullptr, D_, EIN, (bf16_t*)(ws + OFF_WT_EIN), EIN / 32, scr, gw, ngw, lane, nullptr);
    prep_w<0>(p.in[15], nullptr, D_, D_, (bf16_t*)(ws + OFF_WT_EOUT), D_ / 32, scr, gw, ngw, lane, nullptr);
    prep_w<0>(p.in[16], nullptr, D_, OIN, (bf16_t*)(ws + OFF_WT_OIN), OLD / 32, scr, gw, ngw, lane, nullptr);
    prep_w<0>(p.in[23], nullptr, D_, D_, (bf16_t*)(ws + OFF_WT_OOUT), D_ / 32, scr, gw, ngw, lane, nullptr);
    prep_w<1>(p.in[24], p.in[25], D_, FF_, (bf16_t*)(ws + OFF_WT13_0), 2 * FF_ / 32, scr, gw, ngw, lane, nullptr);
    prep_w<1>(p.in[24] + (size_t)D_ * FF_, p.in[25] + (size_t)D_ * FF_, D_, FF_, (bf16_t*)(ws + OFF_WT13_1), 2 * FF_ / 32, scr, gw, ngw, lane, nullptr);
    prep_w<0>(p.in[26], nullptr, FF_, D_, (bf16_t*)(ws + OFF_WT2_0), D_ / 32, scr, gw, ngw, lane, nullptr);
    prep_w<0>(p.in[26] + (size_t)FF_ * D_, nullptr, FF_, D_, (bf16_t*)(ws + OFF_WT2_1), D_ / 32, scr, gw, ngw, lane, nullptr);
    prep_w<0>(p.in[18], nullptr, 2048, 128, (bf16_t*)(ws + OFF_W1T_K), 4, scr, gw, ngw, lane, nullptr);
    prep_w<0>(p.in[21], nullptr, 2048, 128, (bf16_t*)(ws + OFF_W1T_V), 4, scr, gw, ngw, lane, nullptr);
    prep_w<0>(p.in[19], nullptr, 128, 64, (bf16_t*)(ws + OFF_W2T_K), 2, scr, gw, ngw, lane, nullptr);
    prep_w<0>(p.in[22], nullptr, 128, 64, (bf16_t*)(ws + OFF_W2T_V), 2, scr, gw, ngw, lane, nullptr);
    if (gw < 256) {
        const int kv = gw >> 7, n = gw & 127;
        const float* pe = p.in[kv ? 20 : 17]; const float* w1 = p.in[kv ? 21 : 18];
        float s = 0.f;
        for (int k = lane; k < 2048; k += 64) s += pe[k] * w1[(size_t)k * 128 + n];
        s = wave_sum(s);
        if (lane == 0) ((float*)(ws + OFF_BIAS1))[gw] = s;
    }
    {
        f32x2* rope = (f32x2*)(ws + OFF_ROPE);
        for (int e = bid * 512 + tid; e < 2048 * 32; e += nblk * 512) {
            const int pos = e >> 5, i = e & 31;
            const double ang = (double)pos * p.inv_freq[i];
            const double kq = rint(ang * 0.63661977236758134308);
            double r = fma(-kq, 1.57079632679489655800e+00, ang);
            r = fma(-kq, 6.12323399573676603587e-17, r);
            const float rf = (float)r;
            const float r2 = rf * rf;
            const float sn = rf * (1.f + r2 * (-1.6666667e-1f + r2 * (8.3333333e-3f + r2 * (-1.9841270e-4f + r2 * 2.7557319e-6f))));
            const float cs = 1.f + r2 * (-0.5f + r2 * (4.1666667e-2f + r2 * (-1.3888889e-3f + r2 * (2.4801587e-5f + r2 * -2.7557319e-7f))));
            const int q = ((int)kq) & 3;
            float c, s;
            if (q == 0) { c = cs; s = sn; } else if (q == 1) { c = -sn; s = cs; } else if (q == 2) { c = -cs; s = -sn; } else { c = sn; s = -cs; }
            f32x2 o; o[0] = c; o[1] = s; rope[e] = o;
        }
    }
    rmsnorm_rows(p.in[0], p.in[1], (bf16_t*)(ws + OFF_H), nullptr, gw, ngw, lane);
}

enum { M_MOBA = 0, M_SLC = 1, M_WIN = 2, M_CMP = 3, M_RET = 4 };
template <int MODE, int DV>
__device__ __forceinline__ void attn_pass(unsigned char* smem, const bf16_t* Qb, int ldq, const bf16_t* Kb, int ldk, const bf16_t* Vb, int ldv,
                                          int q0, unsigned rowmask, float log2g, f32x4 (&o)[DV / 16], int tid) {
    constexpr int VST = DV + 8;
    const int lane = tid & 63, wave = tid >> 6, lq = lane & 15, quad = lane >> 4;
    const int t = q0 + wave * 16 + lq;
    constexpr int KSZ = 64 * 72 * 2, BUFSZ = KSZ + 64 * VST * 2;
    bf16x8 qf[2];
#pragma unroll
    for (int ks = 0; ks < 2; ++ks) qf[ks] = as_bf16x8(GLD(u32x4, Qb + (size_t)t * ldq + quad * 8 + 32 * ks));
    float m = -INFINITY, l = 0.f;
#pragma unroll
    for (int c = 0; c < DV / 16; ++c) o[c] = (f32x4){0.f, 0.f, 0.f, 0.f};
    int kt_lo = 0, kt_hi = (q0 + 127) >> 6;
    if (MODE == M_WIN) { const int lo = q0 - 511; kt_lo = (lo > 0 ? lo : 0) >> 6; }
    if (MODE == M_CMP) { kt_hi = 1; }
    constexpr float SC = 0.125f * 1.4426950408889634f;
    const int q4 = lq >> 2, pp = lq & 3;
    float dk[4][4];
#pragma unroll
    for (int sub = 0; sub < 4; ++sub)
#pragma unroll
        for (int j = 0; j < 4; ++j) dk[sub][j] = (MODE == M_RET) ? 0.125f * fexp2(-(float)(16 * sub + 4 * quad + j) * log2g) : 0.f;
    const int rk_ = tid >> 3, chk_ = tid & 7;
    u32x4 kreg, vreg[DV / 64];
    auto gload = [&](int kt) {
        kreg = GLD(u32x4, Kb + (size_t)(kt * 64 + rk_) * ldk + chk_ * 8);
#pragma unroll
        for (int i = 0; i < DV / 64; ++i) { const int idx = tid + i * 512; const int r = idx / (DV / 8), ch = idx % (DV / 8); vreg[i] = GLD(u32x4, Vb + (size_t)(kt * 64 + r) * ldv + ch * 8); }
    };
    auto lstore = [&](int b) {
        bf16_t* Ks_ = (bf16_t*)(smem + b * BUFSZ); bf16_t* Vs_ = (bf16_t*)(smem + b * BUFSZ + KSZ);
        *(u32x4*)(Ks_ + rk_ * 72 + chk_ * 8) = kreg;
#pragma unroll
        for (int i = 0; i < DV / 64; ++i) { const int idx = tid + i * 512; const int r = idx / (DV / 8), ch = idx % (DV / 8); *(u32x4*)(Vs_ + r * VST + ch * 8) = vreg[i]; }
    };
    gload(kt_lo);
    __syncthreads();
    lstore(0);
    if (kt_lo + 1 <= kt_hi) gload(kt_lo + 1);
    __syncthreads();
    int bsel = 0;
    for (int kt = kt_lo; kt <= kt_hi; ++kt, bsel ^= 1) {
        if (kt + 1 <= kt_hi) lstore(bsel ^ 1);
        if (kt + 2 <= kt_hi) gload(kt + 2);
        const bf16_t* Ks = (const bf16_t*)(smem + bsel * BUFSZ); const bf16_t* Vs = (const bf16_t*)(smem + bsel * BUFSZ + KSZ);
        const int kbase = kt * 64;
        bool lane_any;
        if (MODE == M_MOBA) lane_any = (kbase <= t) && ((rowmask >> (kt >> 2)) & 1u);
        else if (MODE == M_SLC) lane_any = (kbase <= t) && ((rowmask >> kt) & 1u);
        else if (MODE == M_WIN) lane_any = (kbase <= t) && (kbase + 63 > t - 512);
        else if (MODE == M_CMP) lane_any = (kbase * 16 + 31 <= t);
        else lane_any = (kbase <= t);
        if (__any(lane_any ? 1 : 0)) {
        f32x4 s[4];
#pragma unroll
        for (int sub = 0; sub < 4; ++sub) {
            s[sub] = (f32x4){0.f, 0.f, 0.f, 0.f};
#pragma unroll
            for (int ks = 0; ks < 2; ++ks) { const bf16x8 a = as_bf16x8(*(const u32x4*)(Ks + (16 * sub + lq) * 72 + quad * 8 + 32 * ks)); s[sub] = mfma16(a, qf[ks], s[sub]); }
        }
        float pv[4][4];
        const int t_min = q0 + wave * 16;
        bool need_mask;
        if (MODE == M_WIN) need_mask = (kbase + 63 > t_min) || (kbase <= t_min + 15 - 512);
        else if (MODE == M_CMP) need_mask = true;
        else need_mask = (kbase + 63 > t_min);
        if (MODE != M_RET) {
            float mx = -INFINITY;
            if (need_mask) {
#pragma unroll
                for (int sub = 0; sub < 4; ++sub)
#pragma unroll
                    for (int j = 0; j < 4; ++j) {
                        const int key = kbase + 16 * sub + 4 * quad + j;
                        bool valid;
                        if (MODE == M_MOBA || MODE == M_SLC) valid = lane_any && (key <= t);
                        else if (MODE == M_WIN) valid = (key <= t) && (key > t - 512);
                        else valid = (key * 16 + 31 <= t);
                        const float sv = valid ? s[sub][j] : -INFINITY;
                        pv[sub][j] = sv; mx = fmaxf(mx, sv);
                    }
            } else if (MODE == M_MOBA || MODE == M_SLC) {
#pragma unroll
                for (int sub = 0; sub < 4; ++sub)
#pragma unroll
                    for (int j = 0; j < 4; ++j) { const float sv = lane_any ? s[sub][j] : -INFINITY; pv[sub][j] = sv; mx = fmaxf(mx, sv); }
            } else {
#pragma unroll
                for (int sub = 0; sub < 4; ++sub)
#pragma unroll
                    for (int j = 0; j < 4; ++j) { pv[sub][j] = s[sub][j]; mx = fmaxf(mx, s[sub][j]); }
            }
            mx = fmaxf(mx, __shfl_xor(mx, 16)); mx = fmaxf(mx, __shfl_xor(mx, 32));
            const float m_new = fmaxf(m, mx * SC);
            const float m_use = (m_new == -INFINITY) ? 0.f : m_new;
            const float alpha = fexp2(m - m_use);
            float rs = 0.f;
#pragma unroll
            for (int sub = 0; sub < 4; ++sub)
#pragma unroll
                for (int j = 0; j < 4; ++j) { const float e = fexp2(__builtin_fmaf(pv[sub][j], SC, -m_use)); pv[sub][j] = e; rs += e; }
            l = l * alpha + rs; m = m_new;
#pragma unroll
            for (int c = 0; c < DV / 16; ++c) { o[c][0] *= alpha; o[c][1] *= alpha; o[c][2] *= alpha; o[c][3] *= alpha; }
        } else {
            const float rowfac = fexp2((float)(t - kbase) * log2g);
            if (need_mask) {
#pragma unroll
                for (int sub = 0; sub < 4; ++sub)
#pragma unroll
                    for (int j = 0; j < 4; ++j) { const int key = kbase + 16 * sub + 4 * quad + j; pv[sub][j] = (key <= t) ? (s[sub][j] * dk[sub][j]) * rowfac : 0.f; }
            } else {
#pragma unroll
                for (int sub = 0; sub < 4; ++sub)
#pragma unroll
                    for (int j = 0; j < 4; ++j) pv[sub][j] = (s[sub][j] * dk[sub][j]) * rowfac;
            }
        }
        bf16x8 pb[2];
#pragma unroll
        for (int s2 = 0; s2 < 2; ++s2) {
            u32x4 w; w.x = pk2(pv[2 * s2][0], pv[2 * s2][1]); w.y = pk2(pv[2 * s2][2], pv[2 * s2][3]); w.z = pk2(pv[2 * s2 + 1][0], pv[2 * s2 + 1][1]); w.w = pk2(pv[2 * s2 + 1][2], pv[2 * s2 + 1][3]);
            pb[s2] = as_bf16x8(w);
        }
#pragma unroll
        for (int c = 0; c < DV / 16; ++c)
#pragma unroll
            for (int s2 = 0; s2 < 2; ++s2) {
                const s16x4 t1 = __builtin_amdgcn_ds_read_tr16_b64_v4i16((LAS s16x4*)(Vs + (32 * s2 + 4 * quad + q4) * VST + 16 * c + 4 * pp));
                const s16x4 t2 = __builtin_amdgcn_ds_read_tr16_b64_v4i16((LAS s16x4*)(Vs + (32 * s2 + 16 + 4 * quad + q4) * VST + 16 * c + 4 * pp));
                bf16x8 a; a[0] = t1[0]; a[1] = t1[1]; a[2] = t1[2]; a[3] = t1[3]; a[4] = t2[0]; a[5] = t2[1]; a[6] = t2[2]; a[7] = t2[3];
                o[c] = mfma16(a, pb[s2], o[c]);
            }
            }
        __syncthreads();
    }
    if (MODE != M_RET) {
        l += __shfl_xor(l, 16); l += __shfl_xor(l, 32);
        const float inv = (l > 0.f) ? 1.f / l : 1.f;
#pragma unroll
        for (int c = 0; c < DV / 16; ++c) { o[c][0] *= inv; o[c][1] *= inv; o[c][2] *= inv; o[c][3] *= inv; }
    }
}

__device__ __forceinline__ void kmean_phase(const Params& p, int tid, int bid, int nblk) {
    const bf16_t* Z = (const bf16_t*)(p.ws + OFF_Z);
    float* km = (float*)(p.ws + OFF_KMEAN);
    for (int it = bid; it < 256; it += nblk) {
        const int b = it >> 4, n = (it >> 1) & 7, half = it & 1;
        const int ch = half * 512 + tid;
        const bf16_t* src = Z + ((size_t)(b * S_ + n * 256)) * EIN + 1024 + ch;
        float s = 0.f;
#pragma unroll 8
        for (int tt = 0; tt < 256; ++tt) s += bf2f(GLD(bf16_t, src + (size_t)tt * EIN));
        const int h = ch >> 6, d = ch & 63;
        GST(float, km + ((size_t)(b * 16 + h) * 8 + n) * 64 + d) = s * (1.f / 256.f);
    }
}

__device__ __forceinline__ void moba_item(const Params& p, unsigned char* smem, int b, int h, int qt, int tid) {
    const int lane = tid & 63, wave = tid >> 6, lq = lane & 15, quad = lane >> 4;
    const bf16_t* Z = (const bf16_t*)(p.ws + OFF_Z) + (size_t)b * S_ * EIN;
    const int q0 = qt * 128, t = q0 + wave * 16 + lq, own = q0 >> 8;
    unsigned rowmask = 1u << own;
    if (own > 0) {
        const float* km = (const float*)(p.ws + OFF_KMEAN) + (size_t)(b * 16 + h) * 8 * 64;
        u32x4 zq[8];
#pragma unroll
        for (int c8 = 0; c8 < 8; ++c8) zq[c8] = GLD(u32x4, Z + (size_t)t * EIN + h * 64 + c8 * 8);
        float g2[2] = {0.f, 0.f};
#pragma unroll
        for (int i = 0; i < 2; ++i) {
            const int n = quad + 4 * i;
            if (n < own) {
                f32x4 kv[16];
#pragma unroll
                for (int d4 = 0; d4 < 16; ++d4) kv[d4] = GLD(f32x4, km + n * 64 + d4 * 4);
                float acc = 0.f;
#pragma unroll
                for (int c8 = 0; c8 < 8; ++c8) {
                    float f[8]; unpack8(zq[c8], f);
                    acc += (f[0] * kv[2 * c8][0] + f[1] * kv[2 * c8][1]) + (f[2] * kv[2 * c8][2] + f[3] * kv[2 * c8][3])
                         + (f[4] * kv[2 * c8 + 1][0] + f[5] * kv[2 * c8 + 1][1]) + (f[6] * kv[2 * c8 + 1][2] + f[7] * kv[2 * c8 + 1][3]);
                }
                g2[i] = acc;
            }
        }
        float gsc[7];
#pragma unroll
        for (int n = 0; n < 7; ++n) gsc[n] = __shfl((n >> 2) ? g2[1] : g2[0], lq + 16 * (n & 3));
#pragma unroll
        for (int n = 0; n < 7; ++n) {
            int cnt = 0;
#pragma unroll
            for (int n2 = 0; n2 < 7; ++n2) { if (n2 != n) { const bool beats = (gsc[n2] > gsc[n]) || (gsc[n2] == gsc[n] && n2 < n); cnt += (n2 < own && beats) ? 1 : 0; } }
            if (n < own && cnt < 3) rowmask |= (1u << n);
        }
    }
    f32x4 o[4];
    attn_pass<M_MOBA, 64>(smem, Z + h * 64, EIN, Z + 1024 + h * 64, EIN, Z + 2048 + h * 64, EIN, q0, rowmask, 0.f, o, tid);
    bf16_t* cat = (bf16_t*)(p.ws + OFF_CAT) + (size_t)(b * S_ + t) * D_ + h * 64;
#pragma unroll
    for (int c = 0; c < 4; ++c) { u32x2 w; w.x = pk2(o[c][0], o[c][1]); w.y = pk2(o[c][2], o[c][3]); GST(u32x2, cat + 16 * c + 4 * quad) = w; }
}

__device__ __forceinline__ void rwkv_item(const Params& p, unsigned char* smem, int b, int h, int tid) {
    const int lane = tid & 63, wave = tid >> 6, lq = lane & 15, quad = lane >> 4;
    constexpr int ZB = 3072;
    const bf16_t* Z = (const bf16_t*)(p.ws + OFF_Z) + (size_t)b * S_ * EIN;
    const float* mu = p.in[4];
    float* R = (float*)smem;
    float* KP = R + 2048; float* V = KP + 2048; float* DEC = V + 2048; float* NKK = DEC + 2048; float* KKA = NKK + 2048;
    float* GG = KKA + 2048; float* Y = GG + 2048; float* AA = Y + 2048; float* BC = AA + 2048;
    bf16_t* TW = (bf16_t*)(BC + 64);
    bf16_t* AL = TW + 32 * 72;
    bf16_t* GL = AL + 32 * 72;
    const int mt = wave >> 2, nt = wave & 3;
    const int chn = h * 64 + 16 * nt + lq;
    bf16x8 bw[2], ba[2], bg[4];
    {
        const float* wup = p.in[6]; const float* aup = p.in[8]; const float* gup = p.in[9];
#pragma unroll
        for (int ks = 0; ks < 2; ++ks) {
            float fw[8], fa[8];
#pragma unroll
            for (int i = 0; i < 8; ++i) { const int k = 32 * ks + quad * 8 + i; fw[i] = wup[(size_t)k * 1024 + chn]; fa[i] = aup[(size_t)k * 1024 + chn]; }
            u32x4 w; w.x = pk2(fw[0], fw[1]); w.y = pk2(fw[2], fw[3]); w.z = pk2(fw[4], fw[5]); w.w = pk2(fw[6], fw[7]); bw[ks] = as_bf16x8(w);
            u32x4 a; a.x = pk2(fa[0], fa[1]); a.y = pk2(fa[2], fa[3]); a.z = pk2(fa[4], fa[5]); a.w = pk2(fa[6], fa[7]); ba[ks] = as_bf16x8(a);
        }
#pragma unroll
        for (int ks = 0; ks < 4; ++ks) {
            float fg[8];
#pragma unroll
            for (int i = 0; i < 8; ++i) { const int k = 32 * ks + quad * 8 + i; fg[i] = gup[(size_t)k * 1024 + chn]; }
            u32x4 g; g.x = pk2(fg[0], fg[1]); g.y = pk2(fg[2], fg[3]); g.z = pk2(fg[4], fg[5]); g.w = pk2(fg[6], fg[7]); bg[ks] = as_bf16x8(g);
        }
    }
    const float w0c = p.in[5][chn], a0c = p.in[7][chn];
    const int cs = tid & 15, ttC = tid >> 4;
    const f32x4 kkc = *(const f32x4*)(p.in[10] + h * 64 + 4 * cs), kac = *(const f32x4*)(p.in[11] + h * 64 + 4 * cs), rkc = *(const f32x4*)(p.in[12] + h * 64 + 4 * cs);
    const f32x4 lng = *(const f32x4*)(p.in[13] + h * 64 + 4 * cs), lnb = *(const f32x4*)(p.in[14] + h * 64 + 4 * cs);
    const int js = tid & 15, rp = tid >> 4;
    f32x2 P[4];
#pragma unroll
    for (int e = 0; e < 4; ++e) P[e] = (f32x2){0.f, 0.f};
    bf16_t* cat = (bf16_t*)(p.ws + OFF_CAT) + (size_t)b * S_ * D_ + 1024 + h * 64;

    int a_off[4];
#pragma unroll
    for (int i = 0; i < 4; ++i) {
        const int idx = tid + 512 * i; const int tt = idx / 56, cv = idx % 56;
        int zc;
        if (cv < 8) zc = ZB + h * 64 + cv * 8;
        else if (cv < 16) zc = ZB + 1024 + h * 64 + (cv - 8) * 8;
        else if (cv < 24) zc = ZB + 2048 + h * 64 + (cv - 16) * 8;
        else zc = ZB + 3072 + (cv - 24) * 8;
        a_off[i] = (idx < 1792) ? (tt * EIN + zc) : zc;
    }
    u32x4 a_cur[4], a_prv[4];
#pragma unroll
    for (int i = 0; i < 4; ++i) {
        const bool act = (i < 3) || (tid < 256);
        a_cur[i] = (u32x4){0u, 0u, 0u, 0u}; a_prv[i] = (u32x4){0u, 0u, 0u, 0u};
        if (act) { a_cur[i] = GLD(u32x4, Z + a_off[i]); if (a_off[i] >= EIN) a_prv[i] = GLD(u32x4, Z + a_off[i] - EIN); }
    }
    for (int t0 = 0; t0 < S_; t0 += 32) {
        __syncthreads();
#pragma unroll
        for (int i = 0; i < 4; ++i) {
            const int idx = tid + 512 * i;
            if ((i < 3) || (tid < 256)) {
            const int tt = idx / 56, cv = idx % 56;
            const int zc = a_off[i] - tt * EIN;
            float cur[8], prv[8];
            unpack8(a_cur[i], cur); unpack8(a_prv[i], prv);
            const f32x4 m0 = GLD(f32x4, mu + (zc - ZB)), m1 = GLD(f32x4, mu + (zc - ZB) + 4);
            float val[8];
#pragma unroll
            for (int e = 0; e < 4; ++e) { val[e] = cur[e] + (prv[e] - cur[e]) * m0[e]; val[4 + e] = cur[4 + e] + (prv[4 + e] - cur[4 + e]) * m1[e]; }
            if (cv < 24) {
                float* dst = (cv < 8 ? R : (cv < 16 ? KP : V)) + tt * 64 + (cv & 7) * 8;
                *(f32x4*)dst = (f32x4){val[0], val[1], val[2], val[3]}; *(f32x4*)(dst + 4) = (f32x4){val[4], val[5], val[6], val[7]};
            } else {
                if (cv < 32) {
#pragma unroll
                    for (int e = 0; e < 8; ++e) { const float ex = fexp(2.f * val[e]); val[e] = 1.f - 2.f * frcp(ex + 1.f); } }
                else if (cv >= 40) {
#pragma unroll
                    for (int e = 0; e < 8; ++e) val[e] = sigmoidf_(val[e]); }
                u32x4 w; w.x = pk2(val[0], val[1]); w.y = pk2(val[2], val[3]); w.z = pk2(val[4], val[5]); w.w = pk2(val[6], val[7]);
                bf16_t* dst = (cv < 32) ? (TW + tt * 72 + (cv - 24) * 8) : ((cv < 40) ? (AL + tt * 72 + (cv - 32) * 8) : (GL + tt * 136 + (cv - 40) * 8));
                *(u32x4*)dst = w;
            }
            }
        }
        __syncthreads();
        if (t0 + 32 < S_) {
#pragma unroll
            for (int i = 0; i < 4; ++i) {
                if ((i < 3) || (tid < 256)) { const size_t o = (size_t)(t0 + 32) * EIN + a_off[i]; a_cur[i] = GLD(u32x4, Z + o); a_prv[i] = GLD(u32x4, Z + o - EIN); }
            }
        }
        {
            f32x4 cw = (f32x4){0.f, 0.f, 0.f, 0.f}, ca = cw, cg_ = cw;
#pragma unroll
            for (int ks = 0; ks < 2; ++ks) {
                const bf16x8 a1 = as_bf16x8(*(const u32x4*)(TW + (16 * mt + lq) * 72 + quad * 8 + 32 * ks));
                const bf16x8 a2 = as_bf16x8(*(const u32x4*)(AL + (16 * mt + lq) * 72 + quad * 8 + 32 * ks));
                cw = mfma16(a1, bw[ks], cw); ca = mfma16(a2, ba[ks], ca);
            }
#pragma unroll
            for (int ks = 0; ks < 4; ++ks) { const bf16x8 a3 = as_bf16x8(*(const u32x4*)(GL + (16 * mt + lq) * 136 + quad * 8 + 32 * ks)); cg_ = mfma16(a3, bg[ks], cg_); }
#pragma unroll
            for (int j = 0; j < 4; ++j) {
                const int tt = 16 * mt + 4 * quad + j, ch = 16 * nt + lq;
                const float wf = cw[j] + w0c;
                const float sp = (wf < -15.f) ? -wf : __logf(1.f + fexp(-wf));
                const float wv = -sp - 0.5f;
                DEC[tt * 64 + ch] = fexp(-fexp(wv));
                AA[tt * 64 + ch] = sigmoidf_(ca[j] + a0c);
                GG[tt * 64 + ch] = cg_[j];
            }
        }
        __syncthreads();
        {
            const f32x4 k4 = *(const f32x4*)(KP + ttC * 64 + 4 * cs), a4 = *(const f32x4*)(AA + ttC * 64 + 4 * cs), r4 = *(const f32x4*)(R + ttC * 64 + 4 * cs);
            f32x4 kkv; float ss = 0.f;
#pragma unroll
            for (int e = 0; e < 4; ++e) { kkv[e] = k4[e] * kkc[e]; ss += kkv[e] * kkv[e]; }
            ss = rowsum16(ss);
            const float inv = fminf(__builtin_amdgcn_rsqf(ss), 1e12f);
            f32x4 nk, ka, kp; float bc = 0.f;
#pragma unroll
            for (int e = 0; e < 4; ++e) { const float kk = kkv[e] * inv; nk[e] = -kk; ka[e] = kk * a4[e]; kp[e] = k4[e] * (1.f + (a4[e] - 1.f) * kac[e]); bc += r4[e] * kp[e] * rkc[e]; }
            bc = rowsum16(bc);
            *(f32x4*)(NKK + ttC * 64 + 4 * cs) = nk; *(f32x4*)(KKA + ttC * 64 + 4 * cs) = ka; *(f32x4*)(KP + ttC * 64 + 4 * cs) = kp;
            if (cs == 0) BC[ttC] = bc;
        }
        __syncthreads();
        {
            f32x4 nk = *(const f32x4*)(NKK + 4 * js), wd = *(const f32x4*)(DEC + 4 * js), ka = *(const f32x4*)(KKA + 4 * js);
            f32x4 kp = *(const f32x4*)(KP + 4 * js), rr = *(const f32x4*)(R + 4 * js);
            f32x2 vv = *(const f32x2*)(V + 2 * rp);
            float yq0 = 0.f, yq1 = 0.f;
#pragma unroll 8
            for (int tt = 0; tt < 32; ++tt) {
                const int tn = (tt < 31) ? tt + 1 : 31;
                const f32x4 nk2 = *(const f32x4*)(NKK + tn * 64 + 4 * js), wd2 = *(const f32x4*)(DEC + tn * 64 + 4 * js), ka2 = *(const f32x4*)(KKA + tn * 64 + 4 * js);
                const f32x4 kp2 = *(const f32x4*)(KP + tn * 64 + 4 * js), rr2 = *(const f32x4*)(R + tn * 64 + 4 * js);
                const f32x2 vv2 = *(const f32x2*)(V + tn * 64 + 2 * rp);
                f32x2 sa = (P[0] * nk[0] + P[1] * nk[1]) + (P[2] * nk[2] + P[3] * nk[3]);
                float sa0 = sa[0], sa1 = sa[1];
                rowsum16x4(sa0, sa1, yq0, yq1);
                if (tt > 0 && js == 0) { f32x2 yy; yy[0] = yq0; yy[1] = yq1; *(f32x2*)(Y + (tt - 1) * 64 + 2 * rp) = yy; }
                f32x2 sav; sav[0] = sa0; sav[1] = sa1;
#pragma unroll
                for (int e = 0; e < 4; ++e) P[e] = P[e] * wd[e] + (sav * ka[e] + vv * kp[e]);
                const f32x2 yv = (P[0] * rr[0] + P[1] * rr[1]) + (P[2] * rr[2] + P[3] * rr[3]);
                yq0 = yv[0]; yq1 = yv[1];
                nk = nk2; wd = wd2; ka = ka2; kp = kp2; rr = rr2; vv = vv2;
            }
            yq0 = rowsum16(yq0); yq1 = rowsum16(yq1);
            if (js == 0) { f32x2 yy; yy[0] = yq0; yy[1] = yq1; *(f32x2*)(Y + 31 * 64 + 2 * rp) = yy; }
        }
        __syncthreads();
        {
            const f32x4 y4 = *(const f32x4*)(Y + ttC * 64 + 4 * cs), v4 = *(const f32x4*)(V + ttC * 64 + 4 * cs), g4 = *(const f32x4*)(GG + ttC * 64 + 4 * cs);
            float sm = (y4[0] + y4[1]) + (y4[2] + y4[3]);
            sm = rowsum16(sm);
            const float mean = sm * (1.f / 64.f);
            float dv[4], sq = 0.f;
#pragma unroll
            for (int e = 0; e < 4; ++e) { dv[e] = y4[e] - mean; sq += dv[e] * dv[e]; }
            sq = rowsum16(sq);
            const float rstd = rsqrtf(sq * (1.f / 64.f) + 6.4e-4f);
            const float bc = BC[ttC];
            float ov[4];
#pragma unroll
            for (int e = 0; e < 4; ++e) ov[e] = (dv[e] * rstd * lng[e] + lnb[e] + bc * v4[e]) * g4[e];
            u32x2 w; w.x = pk2(ov[0], ov[1]); w.y = pk2(ov[2], ov[3]);
            GST(u32x2, cat + (size_t)(t0 + ttC) * D_ + 4 * cs) = w;
        }
    }
}

__device__ __forceinline__ void even_mixer_phase(const Params& p, unsigned char* smem, int tid, int bid, int nblk) {
    for (int rep = 0; rep < REP_RWKV; ++rep)
    for (int it = bid; it < 256; it += nblk) rwkv_item(p, smem, it >> 4, it & 15, tid);
    for (int rep = 0; rep < REP_MOBA; ++rep)
    for (int it = bid; it < 4096; it += nblk) {
        const int qt = 15 - (it >> 8), bh = it & 255;
        moba_item(p, smem, bh >> 4, bh & 15, qt, tid);
    }
}

__device__ __forceinline__ void gelu_tanh4(f32x4& v) {
#pragma unroll
    for (int j = 0; j < 4; ++j) { const float x = v[j]; const float u = 0.7978845608028654f * (x + 0.044715f * x * x * x); const float ex = fexp(2.f * u); const float th = 1.f - 2.f * frcp(ex + 1.f); v[j] = 0.5f * x * (1.f + th); }
}

__device__ __forceinline__ void odd_prep_phase(const Params& p, unsigned char* smem, int tid, int bid, int nblk) {
    const int lane = tid & 63, wave = tid >> 6, lq = lane & 15, quad = lane >> 4;
    bf16_t* Z = (bf16_t*)(p.ws + OFF_Z);
    {
        const f32x2* rope = (const f32x2*)(p.ws + OFF_ROPE);
        const int half = nblk >> 1, nthreads = (nblk - half) * 512;
        for (int it = (bid >= half) ? (bid - half) * 512 + tid : T_ * 64; it < T_ * 64; it += nthreads) {
            const int row = it >> 6, wh = (it >> 2) & 15, cidx = it & 3;
            const int pos = row & (S_ - 1);
            bf16_t* base = Z + (size_t)row * OLD + wh * 64 + cidx * 8;
            float z1[8], z2[8];
            unpack8(GLD(u32x4, base), z1); unpack8(GLD(u32x4, base + 32), z2);
            float o1[8], o2[8];
#pragma unroll
            for (int e = 0; e < 8; ++e) { const f32x2 cs = GLD(f32x2, rope + pos * 32 + cidx * 8 + e); o1[e] = z1[e] * cs[0] - z2[e] * cs[1]; o2[e] = z1[e] * cs[1] + z2[e] * cs[0]; }
            u32x4 w1; w1.x = pk2(o1[0], o1[1]); w1.y = pk2(o1[2], o1[3]); w1.z = pk2(o1[4], o1[5]); w1.w = pk2(o1[6], o1[7]);
            u32x4 w2; w2.x = pk2(o2[0], o2[1]); w2.y = pk2(o2[2], o2[3]); w2.z = pk2(o2[4], o2[5]); w2.w = pk2(o2[6], o2[7]);
            GST(u32x4, base) = w1; GST(u32x4, base + 32) = w2;
        }
    }
    {
        const int gw = bid * 8 + wave, ngw = nblk * 8;
        bf16_t* hid = (bf16_t*)(smem + wave * (16 * 136 * 2));
        for (int task = gw; task < 1024; task += ngw) {
            const int kv = task >> 9, b = (task >> 5) & 15, g = (task >> 3) & 3, ct = task & 7;
            const bf16_t* Zs = Z + (size_t)b * S_ * OLD + (kv ? 4352 : 4096) + g * 64;
            const bf16_t* w1t = (const bf16_t*)(p.ws + (kv ? OFF_W1T_V : OFF_W1T_K));
            const bf16_t* w2t = (const bf16_t*)(p.ws + (kv ? OFF_W2T_V : OFF_W2T_K));
            const float* bias1 = (const float*)(p.ws + OFF_BIAS1) + kv * 128;
            f32x4 acc[8];
#pragma unroll
            for (int n = 0; n < 8; ++n) acc[n] = (f32x4){0.f, 0.f, 0.f, 0.f};
            const int c = ct * 16 + lq;
            bf16x8 a_c, b_c[8], a_n, b_n[8];
            auto cload = [&](int ks, bf16x8& a, bf16x8 (&bb)[8]) {
                const int l = ks >> 1, d0 = (ks & 1) * 32 + quad * 8;
                int row = 16 * c + l; row = row > 2047 ? 2047 : row;
                a = as_bf16x8(GLD(u32x4, Zs + (size_t)row * OLD + d0));
#pragma unroll
                for (int n = 0; n < 8; ++n) bb[n] = as_bf16x8(GLD(u32x4, w1t + (size_t)(16 * n + lq) * 2048 + ks * 32 + quad * 8));
            };
            cload(0, a_c, b_c);
            for (int ks = 0; ks < 64; ++ks) {
                if (ks + 1 < 64) cload(ks + 1, a_n, b_n);
#pragma unroll
                for (int n = 0; n < 8; ++n) acc[n] = mfma16(a_c, b_c[n], acc[n]);
                a_c = a_n;
#pragma unroll
                for (int n = 0; n < 8; ++n) b_c[n] = b_n[n];
            }
#pragma unroll
            for (int n = 0; n < 8; ++n) {
                const float bv = GLD(float, bias1 + 16 * n + lq);
                f32x4 hv = acc[n]; hv[0] += bv; hv[1] += bv; hv[2] += bv; hv[3] += bv;
                gelu_tanh4(hv);
#pragma unroll
                for (int j = 0; j < 4; ++j) { const unsigned pk = pk2(hv[j], 0.f); hid[(4 * quad + j) * 136 + 16 * n + lq] = (bf16_t)(pk & 0xffffu); }
            }
            lds_wait();
            f32x4 acc2[4];
#pragma unroll
            for (int n = 0; n < 4; ++n) acc2[n] = (f32x4){0.f, 0.f, 0.f, 0.f};
#pragma unroll
            for (int ks = 0; ks < 4; ++ks) {
                const bf16x8 a = as_bf16x8(*(const u32x4*)(hid + lq * 136 + quad * 8 + 32 * ks));
#pragma unroll
                for (int n = 0; n < 4; ++n) { const bf16x8 bb = as_bf16x8(GLD(u32x4, w2t + (size_t)(16 * n + lq) * 128 + ks * 32 + quad * 8)); acc2[n] = mfma16(a, bb, acc2[n]); }
            }
            lds_wait();
            bf16_t* dst = (bf16_t*)(p.ws + (kv ? OFF_VC : OFF_KC)) + (size_t)((b * 4 + g) * 128) * 64;
#pragma unroll
            for (int n = 0; n < 4; ++n)
#pragma unroll
                for (int j = 0; j < 4; ++j) {
                    const int cc = ct * 16 + 4 * quad + j;
                    const float v = (cc < 127) ? acc2[n][j] : 0.f;
                    GST(bf16_t, dst + (size_t)cc * 64 + 16 * n + lq) = (bf16_t)(pk2(v, 0.f) & 0xffffu);
                }
        }
    }
}

__device__ __forceinline__ void select_phase(const Params& p, unsigned char* smem, int tid, int bid, int nblk) {
    const int lane = tid & 63, wave = tid >> 6, lq = lane & 15, quad = lane >> 4;
    const bf16_t* Z = (const bf16_t*)(p.ws + OFF_Z);
    const int gw = bid * 8 + wave, ngw = nblk * 8;
    float* PS = (float*)(smem + wave * 2048);
    constexpr float SC = 0.125f * 1.4426950408889634f;
    for (int task = gw; task < 8192; task += ngw) {
        const int b = task >> 9, g = (task >> 7) & 3, qt = task & 127;
        const int t = qt * 16 + lq;
        const bf16_t* kc = (const bf16_t*)(p.ws + OFF_KC) + (size_t)((b * 4 + g) * 128) * 64;
        const int cmax = (t - 31) >> 4;
        f32x4 psum[8];
#pragma unroll
        for (int sub = 0; sub < 8; ++sub) psum[sub] = (f32x4){0.f, 0.f, 0.f, 0.f};
        bf16x8 kfr[8][2], qfr[4][2];
#pragma unroll
        for (int sub = 0; sub < 8; ++sub)
#pragma unroll
            for (int ks = 0; ks < 2; ++ks) kfr[sub][ks] = as_bf16x8(GLD(u32x4, kc + (size_t)(16 * sub + lq) * 64 + quad * 8 + 32 * ks));
#pragma unroll
        for (int r = 0; r < 4; ++r)
#pragma unroll
            for (int ks = 0; ks < 2; ++ks) qfr[r][ks] = as_bf16x8(GLD(u32x4, Z + (size_t)(b * S_ + t) * OLD + 3072 + (g * 4 + r) * 64 + quad * 8 + 32 * ks));
#pragma unroll
        for (int r = 0; r < 4; ++r) {
            f32x4 s[8]; float mx = -INFINITY;
#pragma unroll
            for (int sub = 0; sub < 8; ++sub) {
                s[sub] = (f32x4){0.f, 0.f, 0.f, 0.f};
#pragma unroll
                for (int ks = 0; ks < 2; ++ks) s[sub] = mfma16(kfr[sub][ks], qfr[r][ks], s[sub]);
#pragma unroll
                for (int j = 0; j < 4; ++j) { const int key = 16 * sub + 4 * quad + j; const float sv = (key <= cmax) ? s[sub][j] * SC : -INFINITY; s[sub][j] = sv; mx = fmaxf(mx, sv); }
            }
            mx = fmaxf(mx, __shfl_xor(mx, 16)); mx = fmaxf(mx, __shfl_xor(mx, 32));
            const float m_use = (mx == -INFINITY) ? 0.f : mx;
            float rs = 0.f;
#pragma unroll
            for (int sub = 0; sub < 8; ++sub)
#pragma unroll
                for (int j = 0; j < 4; ++j) { const float e = fexp2(s[sub][j] - m_use); s[sub][j] = e; rs += e; }
            rs += __shfl_xor(rs, 16); rs += __shfl_xor(rs, 32);
            const float inv = (rs > 0.f) ? 1.f / rs : 0.f;
#pragma unroll
            for (int sub = 0; sub < 8; ++sub)
#pragma unroll
                for (int j = 0; j < 4; ++j) psum[sub][j] += s[sub][j] * inv;
        }
        float pslc[8], tprev[8];
#pragma unroll
        for (int sub = 0; sub < 8; ++sub) tprev[sub] = __shfl(psum[sub][3], (lane + 48) & 63);
#pragma unroll
        for (int sub = 0; sub < 8; ++sub) {
            float extra;
            if (quad >= 1) extra = tprev[sub]; else extra = (sub >= 1) ? tprev[sub >= 1 ? sub - 1 : 0] : 0.f;
            pslc[sub] = ((psum[sub][0] + psum[sub][1]) + (psum[sub][2] + psum[sub][3])) + extra;
            PS[lq * 32 + 4 * sub + quad] = pslc[sub];
        }
        lds_wait();
        float pvv[32];
#pragma unroll
        for (int q = 0; q < 8; ++q) { const f32x4 v = *(const f32x4*)(PS + lq * 32 + 4 * q); pvv[4 * q] = v[0]; pvv[4 * q + 1] = v[1]; pvv[4 * q + 2] = v[2]; pvv[4 * q + 3] = v[3]; }
        lds_wait();
        const int own = t >> 6;
        unsigned bits = 0;
#pragma unroll
        for (int sub = 0; sub < 8; ++sub) {
            const int j = 4 * sub + quad; const float mv = pslc[sub];
            int cnt = 0;
#pragma unroll
            for (int j2 = 1; j2 < 32; ++j2) { const bool beats = (pvv[j2] > mv) || (pvv[j2] == mv && j2 < j); cnt += (j2 < own && j2 != j && beats) ? 1 : 0; }
            const bool sel = (j == 0) || (j == own) || (j >= 1 && j < own && cnt < 14);
            if (sel) bits |= (1u << j);
        }
        bits |= (unsigned)__shfl_xor((int)bits, 16); bits |= (unsigned)__shfl_xor((int)bits, 32);
        if (quad == 0) GST(unsigned, (unsigned*)(p.ws + OFF_SEL) + (size_t)(b * 4 + g) * S_ + t) = bits;
    }
}

__device__ __forceinline__ void nsa_item(const Params& p, unsigned char* smem, int b, int head, int qt, int tid) {
    const int lane = tid & 63, wave = tid >> 6, lq = lane & 15, quad = lane >> 4;
    const int g = head >> 2, q0 = qt * 128, t = q0 + wave * 16 + lq;
    const bf16_t* Z = (const bf16_t*)(p.ws + OFF_Z) + (size_t)b * S_ * OLD;
    const unsigned rowmask = GLD(unsigned, (const unsigned*)(p.ws + OFF_SEL) + (size_t)(b * 4 + g) * S_ + t);
    float gate[3];
#pragma unroll
    for (int i = 0; i < 3; ++i) gate[i] = sigmoidf_(bf2f(GLD(bf16_t, Z + (size_t)t * OLD + 5632 + head * 3 + i)));
    f32x4 o[4], tot[4];
    const bf16_t* kc = (const bf16_t*)(p.ws + OFF_KC) + (size_t)((b * 4 + g) * 128) * 64;
    const bf16_t* vc = (const bf16_t*)(p.ws + OFF_VC) + (size_t)((b * 4 + g) * 128) * 64;
#ifndef NSA_PASSES
#define NSA_PASSES 7
#endif
    if (NSA_PASSES & 1) attn_pass<M_CMP, 64>(smem, Z + 3072 + head * 64, OLD, kc, 64, vc, 64, q0, 0u, 0.f, o, tid);
    else { o[0] = o[1] = o[2] = o[3] = (f32x4){0.f, 0.f, 0.f, 0.f}; }
#pragma unroll
    for (int c = 0; c < 4; ++c) { tot[c][0] = gate[0] * o[c][0]; tot[c][1] = gate[0] * o[c][1]; tot[c][2] = gate[0] * o[c][2]; tot[c][3] = gate[0] * o[c][3]; }
    if (NSA_PASSES & 2) attn_pass<M_SLC, 64>(smem, Z + 3072 + head * 64, OLD, Z + 4608 + g * 64, OLD, Z + 4864 + g * 64, OLD, q0, rowmask, 0.f, o, tid);
#pragma unroll
    for (int c = 0; c < 4; ++c) { tot[c][0] += gate[1] * o[c][0]; tot[c][1] += gate[1] * o[c][1]; tot[c][2] += gate[1] * o[c][2]; tot[c][3] += gate[1] * o[c][3]; }
    if (NSA_PASSES & 4) attn_pass<M_WIN, 64>(smem, Z + 3072 + head * 64, OLD, Z + 5120 + g * 64, OLD, Z + 5376 + g * 64, OLD, q0, 0u, 0.f, o, tid);
#pragma unroll
    for (int c = 0; c < 4; ++c) { tot[c][0] += gate[2] * o[c][0]; tot[c][1] += gate[2] * o[c][1]; tot[c][2] += gate[2] * o[c][2]; tot[c][3] += gate[2] * o[c][3]; }
    bf16_t* cat = (bf16_t*)(p.ws + OFF_CAT) + (size_t)(b * S_ + t) * D_ + 1024 + head * 64;
#pragma unroll
    for (int c = 0; c < 4; ++c) { u32x2 w; w.x = pk2(tot[c][0], tot[c][1]); w.y = pk2(tot[c][2], tot[c][3]); GST(u32x2, cat + 16 * c + 4 * quad) = w; }
}

__device__ __forceinline__ void ret_item(const Params& p, unsigned char* smem, int b, int h, int qt, int tid) {
    const int lane = tid & 63, wave = tid >> 6, lq = lane & 15, quad = lane >> 4;
    const int q0 = qt * 128, t = q0 + wave * 16 + lq;
    const bf16_t* Z = (const bf16_t*)(p.ws + OFF_Z) + (size_t)b * S_ * OLD;
    const float log2g = log2f(1.f - exp2f(-5.f - (float)h));
    f32x4 o[8];
    attn_pass<M_RET, 128>(smem, Z + h * 64, OLD, Z + 512 + h * 64, OLD, Z + 1024 + h * 128, OLD, q0, 0u, log2g, o, tid);
    float sm = 0.f;
#pragma unroll
    for (int c = 0; c < 8; ++c) sm += (o[c][0] + o[c][1]) + (o[c][2] + o[c][3]);
    sm += __shfl_xor(sm, 16); sm += __shfl_xor(sm, 32);
    const float mean = sm * (1.f / 128.f);
    float sq = 0.f;
#pragma unroll
    for (int c = 0; c < 8; ++c)
#pragma unroll
        for (int j = 0; j < 4; ++j) { o[c][j] -= mean; sq += o[c][j] * o[c][j]; }
    sq += __shfl_xor(sq, 16); sq += __shfl_xor(sq, 32);
    const float rstd = rsqrtf(sq * (1.f / 128.f) + 1e-6f);
    const bf16_t* rg = Z + (size_t)t * OLD + 2048 + h * 128;
    bf16_t* cat = (bf16_t*)(p.ws + OFF_CAT) + (size_t)(b * S_ + t) * D_ + h * 128;
#pragma unroll
    for (int c = 0; c < 8; ++c) {
        const u32x2 gv = GLD(u32x2, rg + 16 * c + 4 * quad);
        const float g0 = __uint_as_float(gv.x << 16), g1 = __uint_as_float(gv.x & 0xffff0000u), g2 = __uint_as_float(gv.y << 16), g3 = __uint_as_float(gv.y & 0xffff0000u);
        const float r0 = g0 * sigmoidf_(g0) * o[c][0] * rstd, r1 = g1 * sigmoidf_(g1) * o[c][1] * rstd, r2 = g2 * sigmoidf_(g2) * o[c][2] * rstd, r3 = g3 * sigmoidf_(g3) * o[c][3] * rstd;
        u32x2 w; w.x = pk2(r0, r1); w.y = pk2(r2, r3);
        GST(u32x2, cat + 16 * c + 4 * quad) = w;
    }
}

__device__ __forceinline__ void odd_mixer_phase(const Params& p, unsigned char* smem, int tid, int bid, int nblk) {
    for (int it = bid; it < 6144; it += nblk) {
        const int lvl = it / 384, r = it % 384, qt = 15 - lvl;
        if (r < 128) { for (int rep = 0; rep < REP_RET; ++rep) ret_item(p, smem, r >> 3, r & 7, qt, tid); }
        else { const int bh = r - 128; for (int rep = 0; rep < REP_NSA; ++rep) nsa_item(p, smem, bh >> 4, bh & 15, qt, tid); }
    }
}

#define XB_TMO      128
#define XB_XCNT(j)  (256  + 64 * (j))
#define XB_XSUB(j)  (1280 + 64 * (j))
#define XB_XGEN(j)  (2304 + 64 * (j))
#define XB_TOP      3328
#define XB_TOPGEN   3392
#define XCD_BAR_WORDS 3456
#define XB_SPIN_CAP (1u << 18)

__device__ __forceinline__ unsigned xb_ld(unsigned* p)              { return __hip_atomic_load(p, __ATOMIC_RELAXED, __HIP_MEMORY_SCOPE_AGENT); }
__device__ __forceinline__ unsigned xb_add(unsigned* p, unsigned v) { return __hip_atomic_fetch_add(p, v, __ATOMIC_RELAXED, __HIP_MEMORY_SCOPE_AGENT); }
__device__ __forceinline__ unsigned xb_xcc_id() { return (unsigned)__builtin_amdgcn_s_getreg((3 << 11) | 20) & 0xFu; }
#define XB_SPIN(cond, bar) do { unsigned _sp = 0; while (cond) { __builtin_amdgcn_s_sleep(1); \
    if ((++_sp & 255u) == 0u) { if (xb_ld(&(bar)[XB_TMO])) break; if (_sp > XB_SPIN_CAP) { atomicAdd(&(bar)[XB_TMO], 1u); break; } } } } while (0)

struct XcdBarrier {
    unsigned* bar; unsigned x;
    volatile LAS unsigned* st;
};

__device__ __forceinline__ XcdBarrier xcd_barrier_post(unsigned* bar, volatile LAS unsigned* st) {
    XcdBarrier b; b.bar = bar; b.x = xb_xcc_id(); b.st = st;
    if (threadIdx.x == 0) (void)xb_add(&bar[XB_XCNT(b.x)], 1u);
    return b;
}
__device__ __forceinline__ void xcd_barrier_complete(unsigned* bar, unsigned x, unsigned& nloc, unsigned& nx) {
    const unsigned G = gridDim.x * gridDim.y * gridDim.z;
    unsigned sum, cnt, mine, sp = 0u;
    for (;;) {
        sum = 0u; cnt = 0u; mine = 0u;
#pragma unroll
        for (unsigned j = 0; j < 16; ++j) { const unsigned c = xb_ld(&bar[XB_XCNT(j)]); sum += c; cnt += (c > 0u) ? 1u : 0u; mine = (j == x) ? c : mine; }
        if (sum == G) break;
        __builtin_amdgcn_s_sleep(1);
        if ((++sp & 255u) == 0u) { if (xb_ld(&bar[XB_TMO])) break; if (sp > XB_SPIN_CAP) { atomicAdd(&bar[XB_TMO], 1u); break; } }
    }
    nloc = mine > 0u ? mine : 1u; nx = cnt > 0u ? cnt : 1u;
}

__device__ __forceinline__ void xcd_barrier(const XcdBarrier& b) {
    asm volatile("s_waitcnt vmcnt(0)" ::: "memory");
    __syncthreads();
    if (threadIdx.x == 0) {
        unsigned* bar = b.bar;
        __builtin_amdgcn_s_waitcnt(0);
        unsigned nloc = b.st[0], nx = b.st[1];
        if (nloc == 0u) { xcd_barrier_complete(bar, b.x, nloc, nx); b.st[0] = nloc; b.st[1] = nx; }
        const unsigned old = xb_add(&bar[XB_XSUB(b.x)], 1u);
        const unsigned gen = old / nloc;
        if (old + 1u == (gen + 1u) * nloc) {
            __builtin_amdgcn_fence(__ATOMIC_RELEASE, "agent");
            asm volatile("s_waitcnt vmcnt(0)" ::: "memory");
            const unsigned og = xb_add(&bar[XB_TOP], 1u);
            const unsigned tg = og / nx;
            if (og + 1u == (tg + 1u) * nx) xb_add(&bar[XB_TOPGEN], 1u);
            else XB_SPIN(xb_ld(&bar[XB_TOPGEN]) == tg, bar);
            __builtin_amdgcn_fence(__ATOMIC_ACQUIRE, "agent");
            xb_add(&bar[XB_XGEN(b.x)], 1u);
            asm volatile("s_waitcnt vmcnt(0)" ::: "memory");
        } else {
            XB_SPIN(xb_ld(&bar[XB_XGEN(b.x)]) == gen, bar);
            __builtin_amdgcn_fence(__ATOMIC_ACQUIRE, "agent");
            asm volatile("s_waitcnt vmcnt(0)" ::: "memory");
        }
    }
    __syncthreads();
}

#ifndef ONLYMASK
#define ONLYMASK 0xFFFFFFu
#endif
#define PH_ON(n) ((ONLYMASK >> (n)) & 1u)
__device__ __forceinline__ const Params& opaque_params() {
    const Params* pp = (const Params*)__builtin_amdgcn_kernarg_segment_ptr(); asm volatile("" : "+s"(pp)); return *pp;
}
__device__ __forceinline__ void run_gemm(unsigned char* smem, int ph, int bid, int nblk) {
    const Params& p = opaque_params();
    unsigned char* ws = p.ws;
    pg8::Gemm g; EpiAll E; g.M = T_;
    E.O = (bf16_t*)(ws + OFF_Z); E.ldc = EIN; E.Xin = p.out; E.Xout = p.out; E.mode = 0;
    if (ph == 1) { g.A = (const bf16_t*)(ws + OFF_H); g.Bt = (const bf16_t*)(ws + OFF_WT_EIN); g.N = EIN; g.K = D_; E.mode = 0; E.ldc = EIN; }
    else if (ph == 9) { g.A = (const bf16_t*)(ws + OFF_H); g.Bt = (const bf16_t*)(ws + OFF_WT_OIN); g.N = OLD; g.K = D_; E.mode = 0; E.ldc = OLD; }
    else if (ph == 4) { g.A = (const bf16_t*)(ws + OFF_CAT); g.Bt = (const bf16_t*)(ws + OFF_WT_EOUT); g.N = D_; g.K = D_; E.mode = 1; E.Xin = p.in[0]; }
    else if (ph == 13) { g.A = (const bf16_t*)(ws + OFF_CAT); g.Bt = (const bf16_t*)(ws + OFF_WT_OOUT); g.N = D_; g.K = D_; E.mode = 1; }
    else if (ph == 7) { g.A = (const bf16_t*)(ws + OFF_Z); g.Bt = (const bf16_t*)(ws + OFF_WT2_0); g.N = D_; g.K = FF_; E.mode = 1; }
    else if (ph == 16) { g.A = (const bf16_t*)(ws + OFF_Z); g.Bt = (const bf16_t*)(ws + OFF_WT2_1); g.N = D_; g.K = FF_; E.mode = 1; }
    else if (ph == 6) { g.A = (const bf16_t*)(ws + OFF_H); g.Bt = (const bf16_t*)(ws + OFF_WT13_0); g.N = 2 * FF_; g.K = D_; E.mode = 2; }
    else { g.A = (const bf16_t*)(ws + OFF_H); g.Bt = (const bf16_t*)(ws + OFF_WT13_1); g.N = 2 * FF_; g.K = D_; E.mode = 2; }
    pg8::StaticOrder So; So.init(g.M, g.N, (int)nblk, (int)bid);
    pg8::gemm_phase<EpiAll, pg8::StaticOrder, false>((PG8_LAS unsigned char*)smem, g, So, E, nullptr);
}
__device__ __forceinline__ void run_norm(int ph, int tid, int bid, int nblk) {
    const Params& p = opaque_params();
    const int lane = tid & 63, wave = tid >> 6;
    const int gw = bid * 8 + wave, ngw = nblk * 8;
    bf16_t* H = (bf16_t*)(p.ws + OFF_H);
#ifdef SKEL
    if (ph == 17) rmsnorm_rows(p.in[0], p.in[27], nullptr, p.out, gw, ngw, lane);
    else if (ph == 5) {}
#else
    if (ph == 17) rmsnorm_rows(p.out, p.in[27], nullptr, p.out, gw, ngw, lane);
#endif
    else rmsnorm_rows(p.out, (ph == 8 ? p.in[1] + D_ : p.in[2] + (ph == 14 ? D_ : 0)), H, nullptr, gw, ngw, lane);
}
__global__ void __launch_bounds__(512, 2) mega(Params pk) {
    extern __shared__ __attribute__((aligned(16))) unsigned char smem[];
    cg::grid_group grid = cg::this_grid();
    {
        volatile LAS unsigned* st0 = (volatile LAS unsigned*)(smem + 131072);
        if (threadIdx.x == 0) { st0[0] = 0u; st0[1] = 0u; }
        __syncthreads();
        (void)xcd_barrier_post((unsigned*)(opaque_params().ws + OFF_BAR), st0);
    }
    const int ph_lo = ((const Params*)__builtin_amdgcn_kernarg_segment_ptr())->ph_lo, ph_hi = ((const Params*)__builtin_amdgcn_kernarg_segment_ptr())->ph_hi;
#pragma nounroll
    for (int ph = ph_lo; ph < ph_hi; ++ph) {
        int tid = threadIdx.x; asm volatile("" : "+v"(tid));
        int bid = __builtin_amdgcn_workgroup_id_x(); asm volatile("" : "+s"(bid));
        int nblk = (int)__builtin_amdgcn_grid_size_x() / 512; asm volatile("" : "+s"(nblk));
        if (ph == 0) { for (int rep = 0; rep < REP_P0; ++rep) { phase0(opaque_params(), smem, tid, bid, nblk); __syncthreads(); } }
        else if (ph == 2) { if (PH_ON(2)) kmean_phase(opaque_params(), tid, bid, nblk); }
        else if (ph == 3) { if (PH_ON(3)) even_mixer_phase(opaque_params(), smem, tid, bid, nblk); }
        else if (ph == 10) { if (PH_ON(10)) odd_prep_phase(opaque_params(), smem, tid, bid, nblk); }
        else if (ph == 11) { for (int rep = 0; rep < REP_SEL; ++rep) select_phase(opaque_params(), smem, tid, bid, nblk); }
        else if (ph == 12) { if (PH_ON(12)) odd_mixer_phase(opaque_params(), smem, tid, bid, nblk); }
#ifdef SKEL
        else if (ph == 17) { run_norm(ph, tid, bid, nblk); }
        else if (ph == 5 || ph == 8 || ph == 14) { }
#else
        else if (ph == 5 || ph == 8 || ph == 14 || ph == 17) { const int nrep = (ph == 5) ? REP_NORM : 1; for (int rep = 0; rep < nrep; ++rep) run_norm(ph, tid, bid, nblk); }
#endif
        else { const int nrep = (ph == 1 || ph == 6 || ph == 9 || ph == 15) ? REP_GEMM : 1; for (int rep = 0; rep < nrep; ++rep) { run_gemm(smem, ph, bid, nblk); __syncthreads(); } }
        if (ph + 1 < ph_hi) {
            if (ph == 0) grid.sync();
            else { XcdBarrier xb; xb.bar = (unsigned*)(opaque_params().ws + OFF_BAR); xb.x = xb_xcc_id(); xb.st = (volatile LAS unsigned*)(smem + 131072); xcd_barrier(xb); }
        }
    }
}

extern "C" void kernel_launch(void* const* d_in, const int* in_sizes, int n_in, void* d_out, int out_size, void* d_ws, size_t ws_size, hipStream_t stream) {
    static int grid = 0;
    if (grid == 0) {
        if (n_in != 28 || out_size != T_ * D_ || ws_size < WS_END) { fprintf(stderr, "kernel_launch: unexpected shapes (n_in %d out %d ws %zu need %zu)\n", n_in, out_size, ws_size, (size_t)WS_END); grid = -1; return; }
        int dev = 0, cus = 0, per_cu = 0;
        hipGetDevice(&dev);
        hipDeviceGetAttribute(&cus, hipDeviceAttributeMultiprocessorCount, dev);
        if (hipFuncSetAttribute((const void*)mega, hipFuncAttributeMaxDynamicSharedMemorySize, LDS_BYTES) != hipSuccess) { fprintf(stderr, "kernel_launch: hipFuncSetAttribute failed\n"); grid = -1; return; }
        hipOccupancyMaxActiveBlocksPerMultiprocessor(&per_cu, (const void*)mega, 512, LDS_BYTES);
        if (per_cu < 1) { fprintf(stderr, "kernel_launch: occupancy query says %d blocks per CU\n", per_cu); per_cu = 1; }
        (void)hipGetLastError();
        grid = cus;
    }
    if (grid < 0) return;
    Params p{};
    for (int i = 0; i < 28; ++i) p.in[i] = (const float*)d_in[i];
    p.out = (float*)d_out; p.ws = (unsigned char*)d_ws;
    for (int i = 0; i < 32; ++i) p.inv_freq[i] = pow(10000.0, -(double)i / 32.0);
    p.ph_lo = 0; p.ph_hi = NPHASE;
#ifdef ZEROCAT
    (void)hipMemsetAsync((char*)d_ws + OFF_CAT, 0, (size_t)T_ * D_ * 2, stream);
#endif
    if (hipMemsetAsync((char*)d_ws + OFF_BAR, 0, XCD_BAR_WORDS * sizeof(unsigned), stream) != hipSuccess) { fprintf(stderr, "kernel_launch: memset of barrier words failed\n"); return; }
    void* args[] = {&p};
    hipError_t e = hipLaunchCooperativeKernel((const void*)mega, dim3(grid), dim3(512), args, LDS_BYTES, stream);
    if (e != hipSuccess) fprintf(stderr, "kernel_launch: cooperative launch failed: %s (grid %d)\n", hipGetErrorString(e), grid);
}
```

```cpp
#include <hip/hip_runtime.h>
#include <hip/hip_cooperative_groups.h>
#include <cstdio>
#include <cmath>
namespace cg = cooperative_groups;
namespace pg8 {
#define PG8_LAS __attribute__((address_space(3)))
typedef unsigned short bf16_t;
typedef short bf16x8 __attribute__((ext_vector_type(8)));
typedef float f32x4 __attribute__((ext_vector_type(4)));
typedef unsigned u32x4 __attribute__((ext_vector_type(4)));
constexpr int BM = 256, BK = 64, HALF = 128, HTB = HALF * BK * 2  , STAGE_BYTES = 8 * HTB, NXCD = 8, WGM = 8;

__host__ __device__ __forceinline__ int lds_byte(int r, int c) { const int st = (r >> 4) * 2 + (c >> 5), rr = r & 15, cc = c & 31, ob = rr * 64 + cc * 2; return st * 1024 + (ob ^ (((ob >> 9) & 1) << 5)); }
__host__ __device__ __forceinline__ void stage_rc(int b, int& R, int& C) { const int st = b / 1024, sb = b % 1024, swz = sb ^ (((sb >> 9) & 1) << 5); R = (st >> 1) * 16 + swz / 64; C = (st & 1) * 32 + (swz % 64) / 2; }
__host__ __device__ __forceinline__ int perm32(int rho) { const int n = rho >> 4, i = rho & 15; return 8 * (i >> 2) + 4 * n + (i & 3); }

struct Unit { int pm, pn; };
struct Gemm { const bf16_t* A; const bf16_t* Bt; int M, N, K; };

struct StaticOrder {
    int nM, nN, nwg, G, c;
    __host__ __device__ void init(int M, int N, int G_, int c_) { nM = M / BM; nN = N / BM; nwg = nM * nN; G = G_; c = c_; }
    __host__ __device__ bool next(int i, Unit& u) const {
        const long L = (long)i * G + c; if (L >= nwg) return false;
        int wgid = (int)L; { const int q = nwg / NXCD, r = nwg % NXCD, xcd = wgid % NXCD, off = wgid / NXCD; wgid = (xcd < r ? xcd * (q + 1) : r * (q + 1) + (xcd - r) * q) + off; }
        const int nig = WGM * nN, gid = wgid / nig, fm = gid * WGM, gsz = (nM - fm) < WGM ? (nM - fm) : WGM;
        u.pm = fm + ((wgid % nig) % gsz); u.pn = (wgid % nig) / gsz; return true;
    }
    __device__ __forceinline__ void a_ready(const Unit&) const {}
    __device__ __forceinline__ void done(const Unit&) const {}
};
__device__ __forceinline__ unsigned cvt_pk_bf16(float lo, float hi) { unsigned r; asm volatile("v_cvt_pk_bf16_f32 %0, %1, %2" : "=v"(r) : "v"(lo), "v"(hi)); return r; }
template <class Epi, class Sched, bool STAMP = false>
__device__ __forceinline__ void gemm_phase(PG8_LAS unsigned char* lds, const Gemm g, const Sched& S, const Epi& E, unsigned long long* stamps) {
    int tid = threadIdx.x; asm volatile("" : "+v"(tid)); const int wid = __builtin_amdgcn_readfirstlane(tid >> 6), lane = tid & 63, wr = wid >> 2, wc = wid & 3, fr = lane & 15, fq = lane >> 4;
    const int K = g.K, nt = K / BK;
    int ts_lo = 0, ts_hi = 0, nts = 0; const unsigned long long rt_entry = STAMP ? (unsigned long long)wall_clock64() : 0ull;
#define PG8_STAMP() do { if (STAMP && wid == 0 && nts < 64) { const unsigned long long _c = (unsigned long long)clock64(); \
        ts_lo = (lane == nts) ? (int)(unsigned)_c : ts_lo; ts_hi = (lane == nts) ? (int)(unsigned)(_c >> 32) : ts_hi; ++nts; } } while (0)
    PG8_STAMP();
    unsigned voffA[2], voffB[2];
#pragma unroll
    for (int i = 0; i < 2; ++i) { int R, C; stage_rc(tid * 16 + i * 8192, R, C); const int Rb = Epi::PERM ? ((R & ~31) + perm32(R & 31)) : R;
        voffA[i] = (unsigned)(R * K + C) * 2u; voffB[i] = (unsigned)(Rb * K + C) * 2u; }
    const size_t kstep = (size_t)(BK * 2);
    const size_t hstep = (size_t)HALF * K * 2;
    const size_t tstep = 2 * hstep;
    const unsigned ldsw = (unsigned)wid * 1024u;
    const int aoff = lds_byte(wr * 64 + fr, fq * 8), boff = lds_byte(wc * 32 + fr, fq * 8);
#define PG8_SA(b, h) (((b) * 2 + (h)) * HTB)
#define PG8_SB(b, h) ((4 + (b) * 2 + (h)) * HTB)
#define PG8_STAGE(bufoff, gbase, voff) do { _Pragma("unroll") for (int _i = 0; _i < 2; ++_i) \
        __builtin_amdgcn_global_load_lds((const unsigned*)((const char*)(gbase) + (voff)[_i]), (PG8_LAS unsigned*)(lds + (bufoff) + ldsw + _i * 8192), 16, 0, 0); } while (0)
#define PG8_LDA(dst, b, h) do { _Pragma("unroll") for (int m = 0; m < 4; ++m) _Pragma("unroll") for (int k = 0; k < 2; ++k) dst[m][k] = *(const PG8_LAS bf16x8*)(lds + PG8_SA(b, h) + aoff + m * 2048 + k * 1024); } while (0)
#define PG8_LDB(dst, b, h) do { _Pragma("unroll") for (int n = 0; n < 2; ++n) _Pragma("unroll") for (int k = 0; k < 2; ++k) dst[n][k] = *(const PG8_LAS bf16x8*)(lds + PG8_SB(b, h) + boff + n * 2048 + k * 1024); } while (0)
#define PG8_MMA(ai, bj, At, Bt) do { __builtin_amdgcn_s_setprio(1); _Pragma("unroll") for (int m = 0; m < 4; ++m) _Pragma("unroll") for (int n = 0; n < 2; ++n) _Pragma("unroll") for (int k = 0; k < 2; ++k) \
        acc[ai][bj][m][n] = __builtin_amdgcn_mfma_f32_16x16x32_bf16(Bt[n][k], At[m][k], acc[ai][bj][m][n], 0, 0, 0); __builtin_amdgcn_s_setprio(0); } while (0)
#define PG8_WAIT_V(n) asm volatile("s_waitcnt vmcnt(" #n ")" ::: "memory")
#define PG8_WAIT_L(n) asm volatile("s_waitcnt lgkmcnt(" #n ")" ::: "memory")
#define PG8_BAR __builtin_amdgcn_s_barrier()
#define PG8_SCHED __builtin_amdgcn_sched_barrier(0)
    Unit cur, nxt; int ui = 0;
    if (!S.next(0, cur)) return;
    f32x4 acc[2][2][4][2];
#pragma unroll
    for (int a = 0; a < 2; ++a)
#pragma unroll
        for (int b = 0; b < 2; ++b)
#pragma unroll
            for (int m = 0; m < 4; ++m)
#pragma unroll
                for (int n = 0; n < 2; ++n) acc[a][b][m][n] = (f32x4){0.f, 0.f, 0.f, 0.f};
    bf16x8 At[4][2], B0[2][2], B1[2][2];
    const char* cA = (const char*)g.A + (size_t)cur.pm * tstep; const char* cB = (const char*)g.Bt + (size_t)cur.pn * tstep;
    S.a_ready(cur);
    PG8_STAGE(PG8_SB(0, 0), cB, voffB); PG8_STAGE(PG8_SA(0, 0), cA, voffA); PG8_STAGE(PG8_SB(0, 1), cB + hstep, voffB); PG8_STAGE(PG8_SA(0, 1), cA + hstep, voffA);
    if (wr == 1) PG8_BAR;
    PG8_WAIT_V(4); PG8_BAR;
    PG8_STAGE(PG8_SB(1, 0), cB + kstep, voffB); PG8_STAGE(PG8_SA(1, 0), cA + kstep, voffA); PG8_STAGE(PG8_SB(1, 1), cB + hstep + kstep, voffB);
    PG8_WAIT_V(6); PG8_BAR;
    PG8_STAMP();
    for (;;) {
        const bool has_next = S.next(ui + 1, nxt);
        const char* nA = has_next ? (const char*)g.A + (size_t)nxt.pm * tstep : cA; const char* nB = has_next ? (const char*)g.Bt + (size_t)nxt.pn * tstep : cB;
        for (int t = 0; t < nt; t += 2) {
            const bool last = (t == nt - 2);
            const char* a1 = cA + (size_t)(t + 1) * kstep;
            const char* a2 = last ? nA : cA + (size_t)(t + 2) * kstep; const char* b2 = last ? nB : cB + (size_t)(t + 2) * kstep;
            const char* a3 = a2 + kstep; const char* b3 = b2 + kstep;
            if (last && has_next) S.a_ready(nxt);
            PG8_LDB(B0, 0, 0); PG8_SCHED; PG8_LDA(At, 0, 0); PG8_STAGE(PG8_SA(1, 1), a1 + hstep, voffA);
            PG8_WAIT_L(8); PG8_BAR; PG8_WAIT_L(0); PG8_MMA(0, 0, At, B0); PG8_BAR; PG8_SCHED;
            PG8_LDB(B1, 0, 1); PG8_STAGE(PG8_SB(0, 0), b2, voffB);
            PG8_BAR; PG8_WAIT_L(0); PG8_MMA(0, 1, At, B1); PG8_BAR;
            PG8_LDA(At, 0, 1); PG8_STAGE(PG8_SA(0, 0), a2, voffA);
            PG8_BAR; PG8_WAIT_L(0); PG8_MMA(1, 0, At, B0); PG8_BAR; PG8_SCHED;
            PG8_STAGE(PG8_SB(0, 1), b2 + hstep, voffB);
            PG8_WAIT_V(6); PG8_BAR; PG8_MMA(1, 1, At, B1); PG8_BAR;
            PG8_LDB(B0, 1, 0); PG8_SCHED; PG8_LDA(At, 1, 0); PG8_STAGE(PG8_SA(0, 1), a2 + hstep, voffA);
            PG8_WAIT_L(8); PG8_BAR; PG8_WAIT_L(0); PG8_MMA(0, 0, At, B0); PG8_BAR; PG8_SCHED;
            PG8_LDB(B1, 1, 1); PG8_STAGE(PG8_SB(1, 0), b3, voffB);
            PG8_BAR; PG8_WAIT_L(0); PG8_MMA(0, 1, At, B1); PG8_BAR;
            PG8_LDA(At, 1, 1); PG8_STAGE(PG8_SA(1, 0), a3, voffA);
            PG8_BAR; PG8_WAIT_L(0); PG8_MMA(1, 0, At, B0); PG8_BAR; PG8_SCHED;
            PG8_STAGE(PG8_SB(1, 1), b3 + hstep, voffB);
            PG8_WAIT_V(6); PG8_BAR; PG8_MMA(1, 1, At, B1); PG8_BAR;
        }
        PG8_STAMP();
        if constexpr (!Epi::AFTER_DRAIN) { E(acc, cur, wr, wc, fr, fq); S.done(cur); }
        PG8_STAMP();
        if (!has_next) break;
#pragma unroll
        for (int a = 0; a < 2; ++a)
#pragma unroll
            for (int b = 0; b < 2; ++b)
#pragma unroll
                for (int m = 0; m < 4; ++m)
#pragma unroll
                    for (int n = 0; n < 2; ++n) acc[a][b][m][n] = (f32x4){0.f, 0.f, 0.f, 0.f};
        cur = nxt; cA = nA; cB = nB; ++ui;
    }
    PG8_WAIT_V(0);
    if (wr == 0) PG8_BAR;
    PG8_BAR;
    if constexpr (Epi::AFTER_DRAIN) { E.fused(acc, cur, wr, wc, fr, fq, lds, wid, lane); S.done(cur); }
    PG8_STAMP();
    if (STAMP && wid == 0) { stamps[lane] = lane < nts ? (((unsigned long long)(unsigned)ts_hi << 32) | (unsigned)ts_lo) : 0ull;
        if (lane == 62) stamps[62] = rt_entry; if (lane == 63) stamps[63] = (unsigned long long)wall_clock64(); }
#undef PG8_STAMP
#undef PG8_SA
#undef PG8_SB
#undef PG8_STAGE
#undef PG8_LDA
#undef PG8_LDB
#undef PG8_MMA
#undef PG8_WAIT_V
#undef PG8_WAIT_L
#undef PG8_BAR
#undef PG8_SCHED
}
}

typedef unsigned short bf16_t;
typedef short bf16x8 __attribute__((ext_vector_type(8)));
typedef short s16x4 __attribute__((ext_vector_type(4)));
typedef float f32x4 __attribute__((ext_vector_type(4)));
typedef float f32x2 __attribute__((ext_vector_type(2)));
typedef unsigned u32x4 __attribute__((ext_vector_type(4)));
typedef unsigned u32x2 __attribute__((ext_vector_type(2)));
#define LAS __attribute__((address_space(3)))
#define GAS __attribute__((address_space(1)))
#define GLD(T, ptr) (*(const GAS T*)(ptr))
#define GST(T, ptr) (*(GAS T*)(ptr))

constexpr int T_ = 32768, D_ = 2048, S_ = 2048, B_ = 16, FF_ = 5632;
constexpr int EIN = 6400, OIN = 5680, OLD = 5888;
constexpr float EPS_ = 1e-6f;

constexpr size_t AL256(size_t x) { return (x + 255) & ~(size_t)255; }
constexpr size_t OFF_CTRL = 0;
constexpr size_t OFF_WT_EIN = 4096;
constexpr size_t OFF_WT_EOUT = OFF_WT_EIN + (size_t)EIN * D_ * 2;
constexpr size_t OFF_WT_OIN = OFF_WT_EOUT + (size_t)D_ * D_ * 2;
constexpr size_t OFF_WT_OOUT = OFF_WT_OIN + (size_t)OLD * D_ * 2;
constexpr size_t OFF_WT13_0 = OFF_WT_OOUT + (size_t)D_ * D_ * 2;
constexpr size_t OFF_WT13_1 = OFF_WT13_0 + (size_t)2 * FF_ * D_ * 2;
constexpr size_t OFF_WT2_0 = OFF_WT13_1 + (size_t)2 * FF_ * D_ * 2;
constexpr size_t OFF_WT2_1 = OFF_WT2_0 + (size_t)D_ * FF_ * 2;
constexpr size_t OFF_W1T_K = OFF_WT2_1 + (size_t)D_ * FF_ * 2;
constexpr size_t OFF_W1T_V = OFF_W1T_K + (size_t)128 * 2048 * 2;
constexpr size_t OFF_W2T_K = OFF_W1T_V + (size_t)128 * 2048 * 2;
constexpr size_t OFF_W2T_V = OFF_W2T_K + (size_t)64 * 128 * 2;
constexpr size_t OFF_BIAS1 = OFF_W2T_V + (size_t)64 * 128 * 2;
constexpr size_t OFF_ROPE = OFF_BIAS1 + 1024;
constexpr size_t OFF_KMEAN = OFF_ROPE + (size_t)2048 * 32 * 8;
constexpr size_t OFF_KC = OFF_KMEAN + (size_t)16 * 16 * 8 * 64 * 4;
constexpr size_t OFF_VC = OFF_KC + (size_t)16 * 4 * 128 * 64 * 2;
constexpr size_t OFF_SEL = OFF_VC + (size_t)16 * 4 * 128 * 64 * 2;
constexpr size_t OFF_H = OFF_SEL + (size_t)16 * 4 * 2048 * 4;
constexpr size_t OFF_Z = OFF_H + (size_t)T_ * D_ * 2;
constexpr size_t OFF_CAT = OFF_Z + (size_t)T_ * EIN * 2;
constexpr size_t OFF_BAR = OFF_CAT + (size_t)T_ * D_ * 2;
constexpr size_t WS_END = OFF_BAR + 16384;

constexpr int LDS_BYTES = 131072 + 16;
constexpr int NPHASE = 18;
#ifndef REP_P0
#define REP_P0 1
#endif
#ifndef REP_RWKV
#define REP_RWKV 1
#endif
#ifndef REP_MOBA
#define REP_MOBA 1
#endif
#ifndef REP_RET
#define REP_RET 1
#endif
#ifndef REP_NSA
#define REP_NSA 1
#endif
#ifndef REP_GEMM
#define REP_GEMM 1
#endif
#ifndef REP_NORM
#define REP_NORM 1
#endif
#ifndef REP_SEL
#define REP_SEL 1
#endif

struct Params {
    const float* in[28];
    float* out;
    unsigned char* ws;
    double inv_freq[32];
    int ph_lo, ph_hi;
};

__device__ __forceinline__ float bf2f(unsigned short b) { return __uint_as_float(((unsigned)b) << 16); }
typedef __bf16 bf16x2_t __attribute__((ext_vector_type(2)));
__device__ __forceinline__ unsigned pk2(float lo, float hi) { f32x2 v; v[0] = lo; v[1] = hi; const bf16x2_t r = __builtin_convertvector(v, bf16x2_t); return __builtin_bit_cast(unsigned, r); }
__device__ __forceinline__ float wave_sum(float v) {
#pragma unroll
    for (int o = 1; o < 64; o <<= 1) v += __shfl_xor(v, o);
    return v;
}
template <int CTRL> __device__ __forceinline__ float dppf(float x) {
    return __int_as_float(__builtin_amdgcn_update_dpp(0, __float_as_int(x), CTRL, 0xf, 0xf, false));
}
__device__ __forceinline__ float rowsum16(float x) {
    x += dppf<0x128>(x);
    x += dppf<0x124>(x);
    x += dppf<0x4E>(x);
    x += dppf<0xB1>(x);
    return x;
}
__device__ __forceinline__ void rowsum16x4(float& a, float& b, float& c, float& d) {
    asm volatile("" : "+v"(a), "+v"(b), "+v"(c), "+v"(d));
    a += dppf<0x128>(a); b += dppf<0x128>(b); c += dppf<0x128>(c); d += dppf<0x128>(d); asm volatile("" : "+v"(a), "+v"(b), "+v"(c), "+v"(d));
    a += dppf<0x124>(a); b += dppf<0x124>(b); c += dppf<0x124>(c); d += dppf<0x124>(d); asm volatile("" : "+v"(a), "+v"(b), "+v"(c), "+v"(d));
    a += dppf<0x4E>(a); b += dppf<0x4E>(b); c += dppf<0x4E>(c); d += dppf<0x4E>(d); asm volatile("" : "+v"(a), "+v"(b), "+v"(c), "+v"(d));
    a += dppf<0xB1>(a); b += dppf<0xB1>(b); c += dppf<0xB1>(c); d += dppf<0xB1>(d); asm volatile("" : "+v"(a), "+v"(b), "+v"(c), "+v"(d));
}
__device__ __forceinline__ float fexp2(float x) { return __builtin_amdgcn_exp2f(x); }
__device__ __forceinline__ float fexp(float x) { return __builtin_amdgcn_exp2f(x * 1.4426950408889634f); }
__device__ __forceinline__ float frcp(float x) { return __builtin_amdgcn_rcpf(x); }
__device__ __forceinline__ float sigmoidf_(float x) { return frcp(1.f + fexp(-x)); }
__device__ __forceinline__ void lds_wait() { asm volatile("s_waitcnt lgkmcnt(0)" ::: "memory"); }
__device__ __forceinline__ void unpack8(u32x4 v, float (&f)[8]) {
    f[0] = __uint_as_float(v.x << 16); f[1] = __uint_as_float(v.x & 0xffff0000u);
    f[2] = __uint_as_float(v.y << 16); f[3] = __uint_as_float(v.y & 0xffff0000u);
    f[4] = __uint_as_float(v.z << 16); f[5] = __uint_as_float(v.z & 0xffff0000u);
    f[6] = __uint_as_float(v.w << 16); f[7] = __uint_as_float(v.w & 0xffff0000u);
}
__device__ __forceinline__ bf16x8 as_bf16x8(u32x4 v) { return __builtin_bit_cast(bf16x8, v); }
__device__ __forceinline__ f32x4 mfma16(bf16x8 a, bf16x8 b, f32x4 c) { return __builtin_amdgcn_mfma_f32_16x16x32_bf16(a, b, c, 0, 0, 0); }

struct EpiAll {
    static constexpr bool PERM = true, AFTER_DRAIN = false;
    int mode; bf16_t* O; int ldc; const float* Xin; float* Xout;
    __device__ __forceinline__ void operator()(const pg8::f32x4 (&acc)[2][2][4][2], const pg8::Unit& u, int wr, int wc, int fr, int fq) const {
        const int row0 = u.pm * 256 + wr * 64 + fr;
        if (mode == 0) {
            const int col0 = u.pn * 256 + wc * 32 + 8 * fq;
#pragma unroll
            for (int ai = 0; ai < 2; ++ai)
#pragma unroll
                for (int m = 0; m < 4; ++m) {
                    bf16_t* rowp = O + (size_t)(row0 + ai * 128 + m * 16) * ldc + col0;
#pragma unroll
                    for (int bj = 0; bj < 2; ++bj) {
                        const pg8::f32x4 v0 = acc[ai][bj][m][0], v1 = acc[ai][bj][m][1];
                        u32x4 w; w.x = pk2(v0[0], v0[1]); w.y = pk2(v0[2], v0[3]); w.z = pk2(v1[0], v1[1]); w.w = pk2(v1[2], v1[3]);
                        GST(u32x4, rowp + bj * 128) = w;
                    }
                }
        } else if (mode == 1) {
            const int col0 = u.pn * 256 + wc * 32 + 8 * fq;
#pragma unroll
            for (int ai = 0; ai < 2; ++ai)
#pragma unroll
                for (int m = 0; m < 4; ++m) {
                    const size_t off = (size_t)(row0 + ai * 128 + m * 16) * D_ + col0;
#pragma unroll
                    for (int bj = 0; bj < 2; ++bj)
#pragma unroll
                        for (int n = 0; n < 2; ++n) {
                            const size_t idx = off + bj * 128 + n * 4;
                            const f32x4 x = GLD(f32x4, Xin + idx);
                            f32x4 r; r[0] = x[0] + acc[ai][bj][m][n][0]; r[1] = x[1] + acc[ai][bj][m][n][1]; r[2] = x[2] + acc[ai][bj][m][n][2]; r[3] = x[3] + acc[ai][bj][m][n][3];
                            GST(f32x4, Xout + idx) = r;
                        }
                }
        } else {
            const int col0 = u.pn * 128 + wc * 32 + 8 * fq;
#pragma unroll
            for (int ai = 0; ai < 2; ++ai)
#pragma unroll
                for (int m = 0; m < 4; ++m) {
                    bf16_t* rowp = O + (size_t)(row0 + ai * 128 + m * 16) * FF_ + col0;
                    float hv[8];
#pragma unroll
                    for (int n = 0; n < 2; ++n)
#pragma unroll
                        for (int j = 0; j < 4; ++j) { const float g = acc[ai][0][m][n][j], up = acc[ai][1][m][n][j]; hv[n * 4 + j] = g * sigmoidf_(g) * up; }
                    u32x4 w; w.x = pk2(hv[0], hv[1]); w.y = pk2(hv[2], hv[3]); w.z = pk2(hv[4], hv[5]); w.w = pk2(hv[6], hv[7]);
                    GST(u32x4, rowp) = w;
                }
        }
    }
};

template <int MODE>
__device__ __forceinline__ void prep_w(const float* Wa, const float* Wb, int K, int Nsrc, bf16_t* WT, int nOutBlocks, float* scr, int gw, int ngw, int lane, const float* gain) {
    const int nkb = K / 64, nitems = nkb * nOutBlocks;
    const int lr = lane >> 3, lc = (lane & 7) * 4;
    f32x4 cur[8], nxt[8];
    auto locate = [&](int it, const float*& src, int& c0, int& k0, int& ob) {
        ob = it % nOutBlocks; k0 = (it / nOutBlocks) * 64;
        if (MODE == 0) { src = Wa; c0 = ob * 32; }
        else { const int pn = ob >> 3, sb = ob & 7; src = (sb < 4) ? Wa : Wb; c0 = (pn * 4 + (sb & 3)) * 32; }
    };
    auto load = [&](int it, f32x4 (&v)[8]) {
        const float* src; int c0, k0, ob; locate(it, src, c0, k0, ob);
        const int col = c0 + lc;
#pragma unroll
        for (int i = 0; i < 8; ++i) v[i] = (col < Nsrc) ? GLD(f32x4, src + (size_t)(k0 + 8 * i + lr) * Nsrc + col) : (f32x4){0.f, 0.f, 0.f, 0.f};
    };
    int it = gw;
    if (it < nitems) load(it, cur);
    for (; it < nitems; it += ngw) {
        const int itn = it + ngw;
        if (itn < nitems) load(itn, nxt);
        const float* src; int c0, k0, ob; locate(it, src, c0, k0, ob);
#pragma unroll
        for (int i = 0; i < 8; ++i) {
            const int kk = 8 * i + lr; const float gk = gain ? gain[k0 + kk] : 1.f;
            float* d = scr + kk * 33 + lc;
            d[0] = cur[i][0] * gk; d[1] = cur[i][1] * gk; d[2] = cur[i][2] * gk; d[3] = cur[i][3] * gk;
        }
        lds_wait();
        const int c = lane & 7;
#pragma unroll
        for (int j = 0; j < 4; ++j) {
            const int n = (lane >> 3) + 8 * j; const float* sp = scr + (8 * c) * 33 + n;
            u32x4 o; o.x = pk2(sp[0 * 33], sp[1 * 33]); o.y = pk2(sp[2 * 33], sp[3 * 33]); o.z = pk2(sp[4 * 33], sp[5 * 33]); o.w = pk2(sp[6 * 33], sp[7 * 33]);
            GST(u32x4, WT + (size_t)(ob * 32 + n) * K + k0 + 8 * c) = o;
        }
        lds_wait();
#pragma unroll
        for (int i = 0; i < 8; ++i) cur[i] = nxt[i];
    }
}

__device__ __forceinline__ void rmsnorm_rows(const float* X, const float* g, bf16_t* H, float* OutF, int gw, int ngw, int lane) {
    f32x4 gv[8];
#pragma unroll
    for (int j = 0; j < 8; ++j) gv[j] = GLD(f32x4, (const f32x4*)g + lane + 64 * j);
    f32x4 v[8], vn[8];
    int m = gw;
    if (m < T_) {
#pragma unroll
        for (int j = 0; j < 8; ++j) v[j] = GLD(f32x4, (const f32x4*)(X + (size_t)m * D_) + lane + 64 * j);
    }
    for (; m < T_; m += ngw) {
        const int mn = m + ngw;
        if (mn < T_) {
#pragma unroll
            for (int j = 0; j < 8; ++j) vn[j] = GLD(f32x4, (const f32x4*)(X + (size_t)mn * D_) + lane + 64 * j);
        }
        float ss = 0.f;
#pragma unroll
        for (int j = 0; j < 8; ++j) ss += (v[j][0] * v[j][0] + v[j][1] * v[j][1]) + (v[j][2] * v[j][2] + v[j][3] * v[j][3]);
        ss = wave_sum(ss);
        const float rstd = rsqrtf(ss * (1.f / D_) + EPS_);
#pragma unroll
        for (int j = 0; j < 8; ++j) {
            const float y0 = v[j][0] * rstd * gv[j][0], y1 = v[j][1] * rstd * gv[j][1], y2 = v[j][2] * rstd * gv[j][2], y3 = v[j][3] * rstd * gv[j][3];
            if (H) { u32x2 o; o.x = pk2(y0, y1); o.y = pk2(y2, y3); GST(u32x2, H + (size_t)m * D_ + (lane + 64 * j) * 4) = o; }
            if (OutF) { f32x4 o; o[0] = y0; o[1] = y1; o[2] = y2; o[3] = y3; GST(f32x4, (f32x4*)(OutF + (size_t)m * D_) + lane + 64 * j) = o; }
        }
#pragma unroll
        for (int j = 0; j < 8; ++j) v[j] = vn[j];
    }
}

__device__ __forceinline__ void phase0(const Params& p, unsigned char* smem, int tid, int bid, int nblk) {
    const int lane = tid & 63, wave = tid >> 6;
    const int gw = bid * 8 + wave, ngw = nblk * 8;
    float* scr = (float*)(smem + wave * 8448);
    unsigned char* ws = p.ws;
    prep_w<0>(p.in[3], nullptr, D_, EIN, (bf16_t*)(ws + OFF_WT_EIN), EIN / 32, scr, gw, ngw, lane, nullptr);
    prep_w<0>(p.in[15], nullptr, D_, D_, (bf16_t*)(ws + OFF_WT_EOUT), D_ / 32, scr, gw, ngw, lane, nullptr);
    prep_w<0>(p.in[16], nullptr, D_, OIN, (bf16_t*)(ws + OFF_WT_OIN), OLD / 32, scr, gw, ngw, lane, nullptr);
    prep_w<0>(p.in[23], nullptr, D_, D_, (bf16_t*)(ws + OFF_WT_OOUT), D_ / 32, scr, gw, ngw, lane, nullptr);
    prep_w<1>(p.in[24], p.in[25], D_, FF_, (bf16_t*)(ws + OFF_WT13_0), 2 * FF_ / 32, scr, gw, ngw, lane, nullptr);
    prep_w<1>(p.in[24] + (size_t)D_ * FF_, p.in[25] + (size_t)D_ * FF_, D_, FF_, (bf16_t*)(ws + OFF_WT13_1), 2 * FF_ / 32, scr, gw, ngw, lane, nullptr);
    prep_w<0>(p.in[26], nullptr, FF_, D_, (bf16_t*)(ws + OFF_WT2_0), D_ / 32, scr, gw, ngw, lane, nullptr);
    prep_w<0>(p.in[26] + (size_t)FF_ * D_, nullptr, FF_, D_, (bf16_t*)(ws + OFF_WT2_1), D_ / 32, scr, gw, ngw, lane, nullptr);
    prep_w<0>(p.in[18], nullptr, 2048, 128, (bf16_t*)(ws + OFF_W1T_K), 4, scr, gw, ngw, lane, nullptr);
    prep_w<0>(p.in[21], nullptr, 2048, 128, (bf16_t*)(ws + OFF_W1T_V), 4, scr, gw, ngw, lane, nullptr);
    prep_w<0>(p.in[19], nullptr, 128, 64, (bf16_t*)(ws + OFF_W2T_K), 2, scr, gw, ngw, lane, nullptr);
    prep_w<0>(p.in[22], nullptr, 128, 64, (bf16_t*)(ws + OFF_W2T_V), 2, scr, gw, ngw, lane, nullptr);
    if (gw < 256) {
        const int kv = gw >> 7, n = gw & 127;
        const float* pe = p.in[kv ? 20 : 17]; const float* w1 = p.in[kv ? 21 : 18];
        float s = 0.f;
        for (int k = lane; k < 2048; k += 64) s += pe[k] * w1[(size_t)k * 128 + n];
        s = wave_sum(s);
        if (lane == 0) ((float*)(ws + OFF_BIAS1))[gw] = s;
    }
    {
        f32x2* rope = (f32x2*)(ws + OFF_ROPE);
        for (int e = bid * 512 + tid; e < 2048 * 32; e += nblk * 512) {
            const int pos = e >> 5, i = e & 31;
            const double ang = (double)pos * p.inv_freq[i];
            const double kq = rint(ang * 0.63661977236758134308);
            double r = fma(-kq, 1.57079632679489655800e+00, ang);
            r = fma(-kq, 6.12323399573676603587e-17, r);
            const float rf = (float)r;
            const float r2 = rf * rf;
            const float sn = rf * (1.f + r2 * (-1.6666667e-1f + r2 * (8.3333333e-3f + r2 * (-1.9841270e-4f + r2 * 2.7557319e-6f))));
            const float cs = 1.f + r2 * (-0.5f + r2 * (4.1666667e-2f + r2 * (-1.3888889e-3f + r2 * (2.4801587e-5f + r2 * -2.7557319e-7f))));
            const int q = ((int)kq) & 3;
            float c, s;
            if (q == 0) { c = cs; s = sn; } else if (q == 1) { c = -sn; s = cs; } else if (q == 2) { c = -cs; s = -sn; } else { c = sn; s = -cs; }
            f32x2 o; o[0] = c; o[1] = s; rope[e] = o;
        }
    }
    rmsnorm_rows(p.in[0], p.in[1], (bf16_t*)(ws + OFF_H), nullptr, gw, ngw, lane);
}

enum { M_MOBA = 0, M_SLC = 1, M_WIN = 2, M_CMP = 3, M_RET = 4 };
template <int MODE, int DV>
__device__ __forceinline__ void attn_pass(unsigned char* smem, const bf16_t* Qb, int ldq, const bf16_t* Kb, int ldk, const bf16_t* Vb, int ldv,
                                          int q0, unsigned rowmask, float log2g, f32x4 (&o)[DV / 16], int tid) {
    constexpr int VST = DV + 8;
    const int lane = tid & 63, wave = tid >> 6, lq = lane & 15, quad = lane >> 4;
    const int t = q0 + wave * 16 + lq;
    constexpr int KSZ = 64 * 72 * 2, BUFSZ = KSZ + 64 * VST * 2;
    bf16x8 qf[2];
#pragma unroll
    for (int ks = 0; ks < 2; ++ks) qf[ks] = as_bf16x8(GLD(u32x4, Qb + (size_t)t * ldq + quad * 8 + 32 * ks));
    float m = -INFINITY, l = 0.f;
#pragma unroll
    for (int c = 0; c < DV / 16; ++c) o[c] = (f32x4){0.f, 0.f, 0.f, 0.f};
    int kt_lo = 0, kt_hi = (q0 + 127) >> 6;
    if (MODE == M_WIN) { const int lo = q0 - 511; kt_lo = (lo > 0 ? lo : 0) >> 6; }
    if (MODE == M_CMP) { kt_hi = 1; }
    constexpr float SC = 0.125f * 1.4426950408889634f;
    const int q4 = lq >> 2, pp = lq & 3;
    float dk[4][4];
#pragma unroll
    for (int sub = 0; sub < 4; ++sub)
#pragma unroll
        for (int j = 0; j < 4; ++j) dk[sub][j] = (MODE == M_RET) ? 0.125f * fexp2(-(float)(16 * sub + 4 * quad + j) * log2g) : 0.f;
    const int rk_ = tid >> 3, chk_ = tid & 7;
    u32x4 kreg, vreg[DV / 64];
    auto gload = [&](int kt) {
        kreg = GLD(u32x4, Kb + (size_t)(kt * 64 + rk_) * ldk + chk_ * 8);
#pragma unroll
        for (int i = 0; i < DV / 64; ++i) { const int idx = tid + i * 512; const int r = idx / (DV / 8), ch = idx % (DV / 8); vreg[i] = GLD(u32x4, Vb + (size_t)(kt * 64 + r) * ldv + ch * 8); }
    };
    auto lstore = [&](int b) {
        bf16_t* Ks_ = (bf16_t*)(smem + b * BUFSZ); bf16_t* Vs_ = (bf16_t*)(smem + b * BUFSZ + KSZ);
        *(u32x4*)(Ks_ + rk_ * 72 + chk_ * 8) = kreg;
#pragma unroll
        for (int i = 0; i < DV / 64; ++i) { const int idx = tid + i * 512; const int r = idx / (DV / 8), ch = idx % (DV / 8); *(u32x4*)(Vs_ + r * VST + ch * 8) = vreg[i]; }
    };
    gload(kt_lo);
    __syncthreads();
    lstore(0);
    if (kt_lo + 1 <= kt_hi) gload(kt_lo + 1);
    __syncthreads();
    int bsel = 0;
    for (int kt = kt_lo; kt <= kt_hi; ++kt, bsel ^= 1) {
        if (kt + 1 <= kt_hi) lstore(bsel ^ 1);
        if (kt + 2 <= kt_hi) gload(kt + 2);
        const bf16_t* Ks = (const bf16_t*)(smem + bsel * BUFSZ); const bf16_t* Vs = (const bf16_t*)(smem + bsel * BUFSZ + KSZ);
        const int kbase = kt * 64;
        bool lane_any;
        if (MODE == M_MOBA) lane_any = (kbase <= t) && ((rowmask >> (kt >> 2)) & 1u);
        else if (MODE == M_SLC) lane_any = (kbase <= t) && ((rowmask >> kt) & 1u);
        else if (MODE == M_WIN) lane_any = (kbase <= t) && (kbase + 63 > t - 512);
        else if (MODE == M_CMP) lane_any = (kbase * 16 + 31 <= t);
        else lane_any = (kbase <= t);
        if (__any(lane_any ? 1 : 0)) {
        f32x4 s[4];
#pragma unroll
        for (int sub = 0; sub < 4; ++sub) {
            s[sub] = (f32x4){0.f, 0.f, 0.f, 0.f};
#pragma unroll
            for (int ks = 0; ks < 2; ++ks) { const bf16x8 a = as_bf16x8(*(const u32x4*)(Ks + (16 * sub + lq) * 72 + quad * 8 + 32 * ks)); s[sub] = mfma16(a, qf[ks], s[sub]); }
        }
        float pv[4][4];
        const int t_min = q0 + wave * 16;
        bool need_mask;
        if (MODE == M_WIN) need_mask = (kbase + 63 > t_min) || (kbase <= t_min + 15 - 512);
        else if (MODE == M_CMP) need_mask = true;
        else need_mask = (kbase + 63 > t_min);
        if (MODE != M_RET) {
            float mx = -INFINITY;
            if (need_mask) {
#pragma unroll
                for (int sub = 0; sub < 4; ++sub)
#pragma unroll
                    for (int j = 0; j < 4; ++j) {
                        const int key = kbase + 16 * sub + 4 * quad + j;
                        bool valid;
                        if (MODE == M_MOBA || MODE == M_SLC) valid = lane_any && (key <= t);
                        else if (MODE == M_WIN) valid = (key <= t) && (key > t - 512);
                        else valid = (key * 16 + 31 <= t);
                        const float sv = valid ? s[sub][j] : -INFINITY;
                        pv[sub][j] = sv; mx = fmaxf(mx, sv);
                    }
            } else if (MODE == M_MOBA || MODE == M_SLC) {
#pragma unroll
                for (int sub = 0; sub < 4; ++sub)
#pragma unroll
                    for (int j = 0; j < 4; ++j) { const float sv = lane_any ? s[sub][j] : -INFINITY; pv[sub][j] = sv; mx = fmaxf(mx, sv); }
            } else {
#pragma unroll
                for (int sub = 0; sub < 4; ++sub)
#pragma unroll
                    for (int j = 0; j < 4; ++j) { pv[sub][j] = s[sub][j]; mx = fmaxf(mx, s[sub][j]); }
            }
            mx = fmaxf(mx, __shfl_xor(mx, 16)); mx = fmaxf(mx, __shfl_xor(mx, 32));
            const float m_new = fmaxf(m, mx * SC);
            const float m_use = (m_new == -INFINITY) ? 0.f : m_new;
            const float alpha = fexp2(m - m_use);
            float rs = 0.f;
#pragma unroll
            for (int sub = 0; sub < 4; ++sub)
#pragma unroll
                for (int j = 0; j < 4; ++j) { const float e = fexp2(__builtin_fmaf(pv[sub][j], SC, -m_use)); pv[sub][j] = e; rs += e; }
            l = l * alpha + rs; m = m_new;
#pragma unroll
            for (int c = 0; c < DV / 16; ++c) { o[c][0] *= alpha; o[c][1] *= alpha; o[c][2] *= alpha; o[c][3] *= alpha; }
        } else {
            const float rowfac = fexp2((float)(t - kbase) * log2g);
            if (need_mask) {
#pragma unroll
                for (int sub = 0; sub < 4; ++sub)
#pragma unroll
                    for (int j = 0; j < 4; ++j) { const int key = kbase + 16 * sub + 4 * quad + j; pv[sub][j] = (key <= t) ? (s[sub][j] * dk[sub][j]) * rowfac : 0.f; }
            } else {
#pragma unroll
                for (int sub = 0; sub < 4; ++sub)
#pragma unroll
                    for (int j = 0; j < 4; ++j) pv[sub][j] = (s[sub][j] * dk[sub][j]) * rowfac;
            }
        }
        bf16x8 pb[2];
#pragma unroll
        for (int s2 = 0; s2 < 2; ++s2) {
            u32x4 w; w.x = pk2(pv[2 * s2][0], pv[2 * s2][1]); w.y = pk2(pv[2 * s2][2], pv[2 * s2][3]); w.z = pk2(pv[2 * s2 + 1][0], pv[2 * s2 + 1][1]); w.w = pk2(pv[2 * s2 + 1][2], pv[2 * s2 + 1][3]);
            pb[s2] = as_bf16x8(w);
        }
#pragma unroll
        for (int c = 0; c < DV / 16; ++c)
#pragma unroll
            for (int s2 = 0; s2 < 2; ++s2) {
                const s16x4 t1 = __builtin_amdgcn_ds_read_tr16_b64_v4i16((LAS s16x4*)(Vs + (32 * s2 + 4 * quad + q4) * VST + 16 * c + 4 * pp));
                const s16x4 t2 = __builtin_amdgcn_ds_read_tr16_b64_v4i16((LAS s16x4*)(Vs + (32 * s2 + 16 + 4 * quad + q4) * VST + 16 * c + 4 * pp));
                bf16x8 a; a[0] = t1[0]; a[1] = t1[1]; a[2] = t1[2]; a[3] = t1[3]; a[4] = t2[0]; a[5] = t2[1]; a[6] = t2[2]; a[7] = t2[3];
                o[c] = mfma16(a, pb[s2], o[c]);
            }
            }
        __syncthreads();
    }
    if (MODE != M_RET) {
        l += __shfl_xor(l, 16); l += __shfl_xor(l, 32);
        const float inv = (l > 0.f) ? 1.f / l : 1.f;
#pragma unroll
        for (int c = 0; c < DV / 16; ++c) { o[c][0] *= inv; o[c][1] *= inv; o[c][2] *= inv; o[c][3] *= inv; }
    }
}


template <int MODE>
__device__ __forceinline__ void attn_pass2(unsigned char* smem, const bf16_t* Qb, int ldq, const bf16_t* Kb, int ldk, const bf16_t* Vb, int ldv,
                                           int q0, const unsigned (&rowmask)[2], f32x4 (&o)[2][4], int tid) {
    constexpr int VST = 72;
    const int lane = tid & 63, wave = tid >> 6, lq = lane & 15, quad = lane >> 4;
    const int t_min = q0 + wave * 32;
    int t[2]; t[0] = t_min + lq; t[1] = t_min + 16 + lq;
    constexpr int KSZ = 64 * 72 * 2, BUFSZ = KSZ + 64 * VST * 2;
    bf16x8 qf[2][2];
#pragma unroll
    for (int qs = 0; qs < 2; ++qs)
#pragma unroll
        for (int ks = 0; ks < 2; ++ks) qf[qs][ks] = as_bf16x8(GLD(u32x4, Qb + (size_t)t[qs] * ldq + quad * 8 + 32 * ks));
    float m[2], l[2];
#pragma unroll
    for (int qs = 0; qs < 2; ++qs) { m[qs] = -INFINITY; l[qs] = 0.f;
#pragma unroll
        for (int c = 0; c < 4; ++c) o[qs][c] = (f32x4){0.f, 0.f, 0.f, 0.f}; }
    int kt_lo = 0, kt_hi = (q0 + 255) >> 6;
    if (MODE == M_WIN) { const int lo = q0 - 511; kt_lo = (lo > 0 ? lo : 0) >> 6; }
    if (MODE == M_CMP) { kt_hi = (q0 + 255 >= 64 * 16 + 31) ? 1 : 0; }
    constexpr float SC = 0.125f * 1.4426950408889634f;
    const int q4 = lq >> 2, pp = lq & 3;
    const int rk_ = tid >> 3, chk_ = tid & 7;
    u32x4 kreg, vreg;
    auto gload = [&](int kt) {
        kreg = GLD(u32x4, Kb + (size_t)(kt * 64 + rk_) * ldk + chk_ * 8);
        vreg = GLD(u32x4, Vb + (size_t)(kt * 64 + rk_) * ldv + chk_ * 8);
    };
    auto lstore = [&](int b) {
        bf16_t* Ks_ = (bf16_t*)(smem + b * BUFSZ); bf16_t* Vs_ = (bf16_t*)(smem + b * BUFSZ + KSZ);
        *(u32x4*)(Ks_ + rk_ * 72 + chk_ * 8) = kreg;
        *(u32x4*)(Vs_ + rk_ * VST + chk_ * 8) = vreg;
    };
    gload(kt_lo);
    __syncthreads();
    lstore(0);
    if (kt_lo + 1 <= kt_hi) gload(kt_lo + 1);
    __syncthreads();
    int bsel = 0;
    for (int kt = kt_lo; kt <= kt_hi; ++kt, bsel ^= 1) {
        if (kt + 1 <= kt_hi) lstore(bsel ^ 1);
        if (kt + 2 <= kt_hi) gload(kt + 2);
        const bf16_t* Ks = (const bf16_t*)(smem + bsel * BUFSZ); const bf16_t* Vs = (const bf16_t*)(smem + bsel * BUFSZ + KSZ);
        const int kbase = kt * 64;
        bool la[2];
#pragma unroll
        for (int qs = 0; qs < 2; ++qs) {
            if (MODE == M_MOBA) la[qs] = (kbase <= t[qs]) && ((rowmask[qs] >> (kt >> 2)) & 1u);
            else if (MODE == M_SLC) la[qs] = (kbase <= t[qs]) && ((rowmask[qs] >> kt) & 1u);
            else if (MODE == M_WIN) la[qs] = (kbase <= t[qs]) && (kbase + 63 > t[qs] - 512);
            else la[qs] = (kbase * 16 + 31 <= t[qs]);
        }
        if (__any((la[0] || la[1]) ? 1 : 0)) {
            f32x4 s[2][4];
#pragma unroll
            for (int sub = 0; sub < 4; ++sub) {
                s[0][sub] = (f32x4){0.f, 0.f, 0.f, 0.f}; s[1][sub] = (f32x4){0.f, 0.f, 0.f, 0.f};
#pragma unroll
                for (int ks = 0; ks < 2; ++ks) {
                    const bf16x8 a = as_bf16x8(*(const u32x4*)(Ks + (16 * sub + lq) * 72 + quad * 8 + 32 * ks));
                    s[0][sub] = mfma16(a, qf[0][ks], s[0][sub]); s[1][sub] = mfma16(a, qf[1][ks], s[1][sub]);
                }
            }
            bool need_mask;
            if (MODE == M_WIN) need_mask = (kbase + 63 > t_min) || (kbase <= t_min + 31 - 512);
            else if (MODE == M_CMP) need_mask = true;
            else need_mask = (kbase + 63 > t_min);
            bf16x8 pb[2][2];
#pragma unroll
            for (int qs = 0; qs < 2; ++qs) {
                float mx = -INFINITY;
                if (need_mask) {
#pragma unroll
                    for (int sub = 0; sub < 4; ++sub)
#pragma unroll
                        for (int j = 0; j < 4; ++j) {
                            const int key = kbase + 16 * sub + 4 * quad + j;
                            bool valid;
                            if (MODE == M_MOBA || MODE == M_SLC) valid = la[qs] && (key <= t[qs]);
                            else if (MODE == M_WIN) valid = (key <= t[qs]) && (key > t[qs] - 512);
                            else valid = (key * 16 + 31 <= t[qs]);
                            const float sv = valid ? s[qs][sub][j] : -INFINITY;
                            s[qs][sub][j] = sv; mx = fmaxf(mx, sv);
                        }
                } else if (MODE == M_MOBA || MODE == M_SLC) {
#pragma unroll
                    for (int sub = 0; sub < 4; ++sub)
#pragma unroll
                        for (int j = 0; j < 4; ++j) { const float sv = la[qs] ? s[qs][sub][j] : -INFINITY; s[qs][sub][j] = sv; mx = fmaxf(mx, sv); }
                } else {
#pragma unroll
                    for (int sub = 0; sub < 4; ++sub)
#pragma unroll
                        for (int j = 0; j < 4; ++j) mx = fmaxf(mx, s[qs][sub][j]);
                }
                mx = fmaxf(mx, __shfl_xor(mx, 16)); mx = fmaxf(mx, __shfl_xor(mx, 32));
                const float m_new = fmaxf(m[qs], mx * SC);
                const float m_use = (m_new == -INFINITY) ? 0.f : m_new;
                const float alpha = fexp2(m[qs] - m_use);
                float rs = 0.f;
#pragma unroll
                for (int sub = 0; sub < 4; ++sub)
#pragma unroll
                    for (int j = 0; j < 4; ++j) { const float e = fexp2(__builtin_fmaf(s[qs][sub][j], SC, -m_use)); s[qs][sub][j] = e; rs += e; }
                l[qs] = l[qs] * alpha + rs; m[qs] = m_new;
#pragma unroll
                for (int c = 0; c < 4; ++c) { o[qs][c][0] *= alpha; o[qs][c][1] *= alpha; o[qs][c][2] *= alpha; o[qs][c][3] *= alpha; }
#pragma unroll
                for (int s2 = 0; s2 < 2; ++s2) {
                    u32x4 w; w.x = pk2(s[qs][2 * s2][0], s[qs][2 * s2][1]); w.y = pk2(s[qs][2 * s2][2], s[qs][2 * s2][3]);
                    w.z = pk2(s[qs][2 * s2 + 1][0], s[qs][2 * s2 + 1][1]); w.w = pk2(s[qs][2 * s2 + 1][2], s[qs][2 * s2 + 1][3]);
                    pb[qs][s2] = as_bf16x8(w);
                }
            }
#pragma unroll
            for (int c = 0; c < 4; ++c)
#pragma unroll
                for (int s2 = 0; s2 < 2; ++s2) {
                    const s16x4 t1 = __builtin_amdgcn_ds_read_tr16_b64_v4i16((LAS s16x4*)(Vs + (32 * s2 + 4 * quad + q4) * VST + 16 * c + 4 * pp));
                    const s16x4 t2 = __builtin_amdgcn_ds_read_tr16_b64_v4i16((LAS s16x4*)(Vs + (32 * s2 + 16 + 4 * quad + q4) * VST + 16 * c + 4 * pp));
                    bf16x8 a; a[0] = t1[0]; a[1] = t1[1]; a[2] = t1[2]; a[3] = t1[3]; a[4] = t2[0]; a[5] = t2[1]; a[6] = t2[2]; a[7] = t2[3];
                    o[0][c] = mfma16(a, pb[0][s2], o[0][c]); o[1][c] = mfma16(a, pb[1][s2], o[1][c]);
                }
        }
        __syncthreads();
    }
#pragma unroll
    for (int qs = 0; qs < 2; ++qs) {
        float lt = l[qs];
        lt += __shfl_xor(lt, 16); lt += __shfl_xor(lt, 32);
        const float inv = (lt > 0.f) ? 1.f / lt : 1.f;
#pragma unroll
        for (int c = 0; c < 4; ++c) { o[qs][c][0] *= inv; o[qs][c][1] *= inv; o[qs][c][2] *= inv; o[qs][c][3] *= inv; }
    }
}

__device__ __forceinline__ void kmean_phase(const Params& p, int tid, int bid, int nblk) {
    const bf16_t* Z = (const bf16_t*)(p.ws + OFF_Z);
    float* km = (float*)(p.ws + OFF_KMEAN);
    for (int it = bid; it < 256; it += nblk) {
        const int b = it >> 4, n = (it >> 1) & 7, half = it & 1;
        const int ch = half * 512 + tid;
        const bf16_t* src = Z + ((size_t)(b * S_ + n * 256)) * EIN + 1024 + ch;
        float s = 0.f;
#pragma unroll 8
        for (int tt = 0; tt < 256; ++tt) s += bf2f(GLD(bf16_t, src + (size_t)tt * EIN));
        const int h = ch >> 6, d = ch & 63;
        GST(float, km + ((size_t)(b * 16 + h) * 8 + n) * 64 + d) = s * (1.f / 256.f);
    }
}

__device__ __forceinline__ void moba_item(const Params& p, unsigned char* smem, int b, int h, int qt, int tid) {
    const int lane = tid & 63, wave = tid >> 6, lq = lane & 15, quad = lane >> 4;
    const bf16_t* Z = (const bf16_t*)(p.ws + OFF_Z) + (size_t)b * S_ * EIN;
    const int q0 = qt * 128, t = q0 + wave * 16 + lq, own = q0 >> 8;
    unsigned rowmask = 1u << own;
    if (own > 0) {
        const float* km = (const float*)(p.ws + OFF_KMEAN) + (size_t)(b * 16 + h) * 8 * 64;
        u32x4 zq[8];
#pragma unroll
        for (int c8 = 0; c8 < 8; ++c8) zq[c8] = GLD(u32x4, Z + (size_t)t * EIN + h * 64 + c8 * 8);
        float g2[2] = {0.f, 0.f};
#pragma unroll
        for (int i = 0; i < 2; ++i) {
            const int n = quad + 4 * i;
            if (n < own) {
                f32x4 kv[16];
#pragma unroll
                for (int d4 = 0; d4 < 16; ++d4) kv[d4] = GLD(f32x4, km + n * 64 + d4 * 4);
                float acc = 0.f;
#pragma unroll
                for (int c8 = 0; c8 < 8; ++c8) {
                    float f[8]; unpack8(zq[c8], f);
                    acc += (f[0] * kv[2 * c8][0] + f[1] * kv[2 * c8][1]) + (f[2] * kv[2 * c8][2] + f[3] * kv[2 * c8][3])
                         + (f[4] * kv[2 * c8 + 1][0] + f[5] * kv[2 * c8 + 1][1]) + (f[6] * kv[2 * c8 + 1][2] + f[7] * kv[2 * c8 + 1][3]);
                }
                g2[i] = acc;
            }
        }
        float gsc[7];
#pragma unroll
        for (int n = 0; n < 7; ++n) gsc[n] = __shfl((n >> 2) ? g2[1] : g2[0], lq + 16 * (n & 3));
#pragma unroll
        for (int n = 0; n < 7; ++n) {
            int cnt = 0;
#pragma unroll
            for (int n2 = 0; n2 < 7; ++n2) { if (n2 != n) { const bool beats = (gsc[n2] > gsc[n]) || (gsc[n2] == gsc[n] && n2 < n); cnt += (n2 < own && beats) ? 1 : 0; } }
            if (n < own && cnt < 3) rowmask |= (1u << n);
        }
    }
    f32x4 o[4];
    attn_pass<M_MOBA, 64>(smem, Z + h * 64, EIN, Z + 1024 + h * 64, EIN, Z + 2048 + h * 64, EIN, q0, rowmask, 0.f, o, tid);
    bf16_t* cat = (bf16_t*)(p.ws + OFF_CAT) + (size_t)(b * S_ + t) * D_ + h * 64;
#pragma unroll
    for (int c = 0; c < 4; ++c) { u32x2 w; w.x = pk2(o[c][0], o[c][1]); w.y = pk2(o[c][2], o[c][3]); GST(u32x2, cat + 16 * c + 4 * quad) = w; }
}


__device__ __forceinline__ void moba_item2(const Params& p, unsigned char* smem, int b, int h, int qt, int tid) {
    const int lane = tid & 63, wave = tid >> 6, lq = lane & 15, quad = lane >> 4;
    const bf16_t* Z = (const bf16_t*)(p.ws + OFF_Z) + (size_t)b * S_ * EIN;
    const int q0 = qt * 256, own = qt;
    int t[2]; t[0] = q0 + wave * 32 + lq; t[1] = t[0] + 16;
    unsigned rowmask[2]; rowmask[0] = 1u << own; rowmask[1] = 1u << own;
    if (own > 0) {
        const float* km = (const float*)(p.ws + OFF_KMEAN) + (size_t)(b * 16 + h) * 8 * 64;
        u32x4 zq[2][8];
#pragma unroll
        for (int qs = 0; qs < 2; ++qs)
#pragma unroll
            for (int c8 = 0; c8 < 8; ++c8) zq[qs][c8] = GLD(u32x4, Z + (size_t)t[qs] * EIN + h * 64 + c8 * 8);
        float g2[2][2] = {{0.f, 0.f}, {0.f, 0.f}};
#pragma unroll
        for (int i = 0; i < 2; ++i) {
            const int n = quad + 4 * i;
            if (n < own) {
                f32x4 kv[16];
#pragma unroll
                for (int d4 = 0; d4 < 16; ++d4) kv[d4] = GLD(f32x4, km + n * 64 + d4 * 4);
#pragma unroll
                for (int qs = 0; qs < 2; ++qs) {
                    float acc = 0.f;
#pragma unroll
                    for (int c8 = 0; c8 < 8; ++c8) {
                        float f[8]; unpack8(zq[qs][c8], f);
                        acc += (f[0] * kv[2 * c8][0] + f[1] * kv[2 * c8][1]) + (f[2] * kv[2 * c8][2] + f[3] * kv[2 * c8][3])
                             + (f[4] * kv[2 * c8 + 1][0] + f[5] * kv[2 * c8 + 1][1]) + (f[6] * kv[2 * c8 + 1][2] + f[7] * kv[2 * c8 + 1][3]);
                    }
                    g2[qs][i] = acc;
                }
            }
        }
#pragma unroll
        for (int qs = 0; qs < 2; ++qs) {
            float gsc[7];
#pragma unroll
            for (int n = 0; n < 7; ++n) gsc[n] = __shfl((n >> 2) ? g2[qs][1] : g2[qs][0], lq + 16 * (n & 3));
#pragma unroll
            for (int n = 0; n < 7; ++n) {
                int cnt = 0;
#pragma unroll
                for (int n2 = 0; n2 < 7; ++n2) { if (n2 != n) { const bool beats = (gsc[n2] > gsc[n]) || (gsc[n2] == gsc[n] && n2 < n); cnt += (n2 < own && beats) ? 1 : 0; } }
                if (n < own && cnt < 3) rowmask[qs] |= (1u << n);
            }
        }
    }
    f32x4 o[2][4];
    attn_pass2<M_MOBA>(smem, Z + h * 64, EIN, Z + 1024 + h * 64, EIN, Z + 2048 + h * 64, EIN, q0, rowmask, o, tid);
#pragma unroll
    for (int qs = 0; qs < 2; ++qs) {
        bf16_t* cat = (bf16_t*)(p.ws + OFF_CAT) + (size_t)(b * S_ + t[qs]) * D_ + h * 64;
#pragma unroll
        for (int c = 0; c < 4; ++c) { u32x2 w; w.x = pk2(o[qs][c][0], o[qs][c][1]); w.y = pk2(o[qs][c][2], o[qs][c][3]); GST(u32x2, cat + 16 * c + 4 * quad) = w; }
    }
}

__device__ __forceinline__ void rwkv_item(const Params& p, unsigned char* smem, int b, int h, int tid) {
    const int lane = tid & 63, wave = tid >> 6, lq = lane & 15, quad = lane >> 4;
    constexpr int ZB = 3072;
    const bf16_t* Z = (const bf16_t*)(p.ws + OFF_Z) + (size_t)b * S_ * EIN;
    const float* mu = p.in[4];
    float* R = (float*)smem;
    float* KP = R + 2048; float* V = KP + 2048; float* DEC = V + 2048; float* NKK = DEC + 2048; float* KKA = NKK + 2048;
    float* GG = KKA + 2048; float* Y = GG + 2048; float* AA = Y + 2048; float* BC = AA + 2048;
    bf16_t* TW = (bf16_t*)(BC + 64);
    bf16_t* AL = TW + 32 * 72;
    bf16_t* GL = AL + 32 * 72;
    const int mt = wave >> 2, nt = wave & 3;
    const int chn = h * 64 + 16 * nt + lq;
    bf16x8 bw[2], ba[2], bg[4];
    {
        const float* wup = p.in[6]; const float* aup = p.in[8]; const float* gup = p.in[9];
#pragma unroll
        for (int ks = 0; ks < 2; ++ks) {
            float fw[8], fa[8];
#pragma unroll
            for (int i = 0; i < 8; ++i) { const int k = 32 * ks + quad * 8 + i; fw[i] = wup[(size_t)k * 1024 + chn]; fa[i] = aup[(size_t)k * 1024 + chn]; }
            u32x4 w; w.x = pk2(fw[0], fw[1]); w.y = pk2(fw[2], fw[3]); w.z = pk2(fw[4], fw[5]); w.w = pk2(fw[6], fw[7]); bw[ks] = as_bf16x8(w);
            u32x4 a; a.x = pk2(fa[0], fa[1]); a.y = pk2(fa[2], fa[3]); a.z = pk2(fa[4], fa[5]); a.w = pk2(fa[6], fa[7]); ba[ks] = as_bf16x8(a);
        }
#pragma unroll
        for (int ks = 0; ks < 4; ++ks) {
            float fg[8];
#pragma unroll
            for (int i = 0; i < 8; ++i) { const int k = 32 * ks + quad * 8 + i; fg[i] = gup[(size_t)k * 1024 + chn]; }
            u32x4 g; g.x = pk2(fg[0], fg[1]); g.y = pk2(fg[2], fg[3]); g.z = pk2(fg[4], fg[5]); g.w = pk2(fg[6], fg[7]); bg[ks] = as_bf16x8(g);
        }
    }
    const float w0c = p.in[5][chn], a0c = p.in[7][chn];
    const int cs = tid & 15, ttC = tid >> 4;
    const f32x4 kkc = *(const f32x4*)(p.in[10] + h * 64 + 4 * cs), kac = *(const f32x4*)(p.in[11] + h * 64 + 4 * cs), rkc = *(const f32x4*)(p.in[12] + h * 64 + 4 * cs);
    const f32x4 lng = *(const f32x4*)(p.in[13] + h * 64 + 4 * cs), lnb = *(const f32x4*)(p.in[14] + h * 64 + 4 * cs);
    const int js = tid & 15, rp = tid >> 4;
    f32x2 P[4];
#pragma unroll
    for (int e = 0; e < 4; ++e) P[e] = (f32x2){0.f, 0.f};
    bf16_t* cat = (bf16_t*)(p.ws + OFF_CAT) + (size_t)b * S_ * D_ + 1024 + h * 64;

    int a_off[4];
#pragma unroll
    for (int i = 0; i < 4; ++i) {
        const int idx = tid + 512 * i; const int tt = idx / 56, cv = idx % 56;
        int zc;
        if (cv < 8) zc = ZB + h * 64 + cv * 8;
        else if (cv < 16) zc = ZB + 1024 + h * 64 + (cv - 8) * 8;
        else if (cv < 24) zc = ZB + 2048 + h * 64 + (cv - 16) * 8;
        else zc = ZB + 3072 + (cv - 24) * 8;
        a_off[i] = (idx < 1792) ? (tt * EIN + zc) : zc;
    }
    u32x4 a_cur[4], a_prv[4];
#pragma unroll
    for (int i = 0; i < 4; ++i) {
        const bool act = (i < 3) || (tid < 256);
        a_cur[i] = (u32x4){0u, 0u, 0u, 0u}; a_prv[i] = (u32x4){0u, 0u, 0u, 0u};
        if (act) { a_cur[i] = GLD(u32x4, Z + a_off[i]); if (a_off[i] >= EIN) a_prv[i] = GLD(u32x4, Z + a_off[i] - EIN); }
    }
    for (int t0 = 0; t0 < S_; t0 += 32) {
        __syncthreads();
#pragma unroll
        for (int i = 0; i < 4; ++i) {
            const int idx = tid + 512 * i;
            if ((i < 3) || (tid < 256)) {
            const int tt = idx / 56, cv = idx % 56;
            const int zc = a_off[i] - tt * EIN;
            float cur[8], prv[8];
            unpack8(a_cur[i], cur); unpack8(a_prv[i], prv);
            const f32x4 m0 = GLD(f32x4, mu + (zc - ZB)), m1 = GLD(f32x4, mu + (zc - ZB) + 4);
            float val[8];
#pragma unroll
            for (int e = 0; e < 4; ++e) { val[e] = cur[e] + (prv[e] - cur[e]) * m0[e]; val[4 + e] = cur[4 + e] + (prv[4 + e] - cur[4 + e]) * m1[e]; }
            if (cv < 24) {
                float* dst = (cv < 8 ? R : (cv < 16 ? KP : V)) + tt * 64 + (cv & 7) * 8;
                *(f32x4*)dst = (f32x4){val[0], val[1], val[2], val[3]}; *(f32x4*)(dst + 4) = (f32x4){val[4], val[5], val[6], val[7]};
            } else {
                if (cv < 32) {
#pragma unroll
                    for (int e = 0; e < 8; ++e) { const float ex = fexp(2.f * val[e]); val[e] = 1.f - 2.f * frcp(ex + 1.f); } }
                else if (cv >= 40) {
#pragma unroll
                    for (int e = 0; e < 8; ++e) val[e] = sigmoidf_(val[e]); }
                u32x4 w; w.x = pk2(val[0], val[1]); w.y = pk2(val[2], val[3]); w.z = pk2(val[4], val[5]); w.w = pk2(val[6], val[7]);
                bf16_t* dst = (cv < 32) ? (TW + tt * 72 + (cv - 24) * 8) : ((cv < 40) ? (AL + tt * 72 + (cv - 32) * 8) : (GL + tt * 136 + (cv - 40) * 8));
                *(u32x4*)dst = w;
            }
            }
        }
        __syncthreads();
        if (t0 + 32 < S_) {
#pragma unroll
            for (int i = 0; i < 4; ++i) {
                if ((i < 3) || (tid < 256)) { const size_t o = (size_t)(t0 + 32) * EIN + a_off[i]; a_cur[i] = GLD(u32x4, Z + o); a_prv[i] = GLD(u32x4, Z + o - EIN); }
            }
        }
        {
            f32x4 cw = (f32x4){0.f, 0.f, 0.f, 0.f}, ca = cw, cg_ = cw;
#pragma unroll
            for (int ks = 0; ks < 2; ++ks) {
                const bf16x8 a1 = as_bf16x8(*(const u32x4*)(TW + (16 * mt + lq) * 72 + quad * 8 + 32 * ks));
                const bf16x8 a2 = as_bf16x8(*(const u32x4*)(AL + (16 * mt + lq) * 72 + quad * 8 + 32 * ks));
                cw = mfma16(a1, bw[ks], cw); ca = mfma16(a2, ba[ks], ca);
            }
#pragma unroll
            for (int ks = 0; ks < 4; ++ks) { const bf16x8 a3 = as_bf16x8(*(const u32x4*)(GL + (16 * mt + lq) * 136 + quad * 8 + 32 * ks)); cg_ = mfma16(a3, bg[ks], cg_); }
#pragma unroll
            for (int j = 0; j < 4; ++j) {
                const int tt = 16 * mt + 4 * quad + j, ch = 16 * nt + lq;
                const float wf = cw[j] + w0c;
                const float sp = (wf < -15.f) ? -wf : __logf(1.f + fexp(-wf));
                const float wv = -sp - 0.5f;
                DEC[tt * 64 + ch] = fexp(-fexp(wv));
                AA[tt * 64 + ch] = sigmoidf_(ca[j] + a0c);
                GG[tt * 64 + ch] = cg_[j];
            }
        }
        __syncthreads();
        {
            const f32x4 k4 = *(const f32x4*)(KP + ttC * 64 + 4 * cs), a4 = *(const f32x4*)(AA + ttC * 64 + 4 * cs), r4 = *(const f32x4*)(R + ttC * 64 + 4 * cs);
            f32x4 kkv; float ss = 0.f;
#pragma unroll
            for (int e = 0; e < 4; ++e) { kkv[e] = k4[e] * kkc[e]; ss += kkv[e] * kkv[e]; }
            ss = rowsum16(ss);
            const float inv = fminf(__builtin_amdgcn_rsqf(ss), 1e12f);
            f32x4 nk, ka, kp; float bc = 0.f;
#pragma unroll
            for (int e = 0; e < 4; ++e) { const float kk = kkv[e] * inv; nk[e] = -kk; ka[e] = kk * a4[e]; kp[e] = k4[e] * (1.f + (a4[e] - 1.f) * kac[e]); bc += r4[e] * kp[e] * rkc[e]; }
            bc = rowsum16(bc);
            *(f32x4*)(NKK + ttC * 64 + 4 * cs) = nk; *(f32x4*)(KKA + ttC * 64 + 4 * cs) = ka; *(f32x4*)(KP + ttC * 64 + 4 * cs) = kp;
            if (cs == 0) BC[ttC] = bc;
        }
        __syncthreads();
        {
            f32x4 nk = *(const f32x4*)(NKK + 4 * js), wd = *(const f32x4*)(DEC + 4 * js), ka = *(const f32x4*)(KKA + 4 * js);
            f32x4 kp = *(const f32x4*)(KP + 4 * js), rr = *(const f32x4*)(R + 4 * js);
            f32x2 vv = *(const f32x2*)(V + 2 * rp);
            float yq0 = 0.f, yq1 = 0.f;
#pragma unroll 8
            for (int tt = 0; tt < 32; ++tt) {
                const int tn = (tt < 31) ? tt + 1 : 31;
                const f32x4 nk2 = *(const f32x4*)(NKK + tn * 64 + 4 * js), wd2 = *(const f32x4*)(DEC + tn * 64 + 4 * js), ka2 = *(const f32x4*)(KKA + tn * 64 + 4 * js);
                const f32x4 kp2 = *(const f32x4*)(KP + tn * 64 + 4 * js), rr2 = *(const f32x4*)(R + tn * 64 + 4 * js);
                const f32x2 vv2 = *(const f32x2*)(V + tn * 64 + 2 * rp);
                f32x2 sa = (P[0] * nk[0] + P[1] * nk[1]) + (P[2] * nk[2] + P[3] * nk[3]);
                float sa0 = sa[0], sa1 = sa[1];
                rowsum16x4(sa0, sa1, yq0, yq1);
                if (tt > 0 && js == 0) { f32x2 yy; yy[0] = yq0; yy[1] = yq1; *(f32x2*)(Y + (tt - 1) * 64 + 2 * rp) = yy; }
                f32x2 sav; sav[0] = sa0; sav[1] = sa1;
#pragma unroll
                for (int e = 0; e < 4; ++e) P[e] = P[e] * wd[e] + (sav * ka[e] + vv * kp[e]);
                const f32x2 yv = (P[0] * rr[0] + P[1] * rr[1]) + (P[2] * rr[2] + P[3] * rr[3]);
                yq0 = yv[0]; yq1 = yv[1];
                nk = nk2; wd = wd2; ka = ka2; kp = kp2; rr = rr2; vv = vv2;
            }
            yq0 = rowsum16(yq0); yq1 = rowsum16(yq1);
            if (js == 0) { f32x2 yy; yy[0] = yq0; yy[1] = yq1; *(f32x2*)(Y + 31 * 64 + 2 * rp) = yy; }
        }
        __syncthreads();
        {
            const f32x4 y4 = *(const f32x4*)(Y + ttC * 64 + 4 * cs), v4 = *(const f32x4*)(V + ttC * 64 + 4 * cs), g4 = *(const f32x4*)(GG + ttC * 64 + 4 * cs);
            float sm = (y4[0] + y4[1]) + (y4[2] + y4[3]);
            sm = rowsum16(sm);
            const float mean = sm * (1.f / 64.f);
            float dv[4], sq = 0.f;
#pragma unroll
            for (int e = 0; e < 4; ++e) { dv[e] = y4[e] - mean; sq += dv[e] * dv[e]; }
            sq = rowsum16(sq);
            const float rstd = rsqrtf(sq * (1.f / 64.f) + 6.4e-4f);
            const float bc = BC[ttC];
            float ov[4];
#pragma unroll
            for (int e = 0; e < 4; ++e) ov[e] = (dv[e] * rstd * lng[e] + lnb[e] + bc * v4[e]) * g4[e];
            u32x2 w; w.x = pk2(ov[0], ov[1]); w.y = pk2(ov[2], ov[3]);
            GST(u32x2, cat + (size_t)(t0 + ttC) * D_ + 4 * cs) = w;
        }
    }
}

__device__ __forceinline__ void even_mixer_phase(const Params& p, unsigned char* smem, int tid, int bid, int nblk) {
    for (int rep = 0; rep < REP_RWKV; ++rep)
    for (int it = bid; it < 256; it += nblk) rwkv_item(p, smem, it >> 4, it & 15, tid);
    for (int rep = 0; rep < REP_MOBA; ++rep)
    for (int it = bid; it < 2048; it += nblk) {
        const int qt = 7 - (it >> 8), bh = it & 255;
        moba_item2(p, smem, bh >> 4, bh & 15, qt, tid);
    }
}

__device__ __forceinline__ void gelu_tanh4(f32x4& v) {
#pragma unroll
    for (int j = 0; j < 4; ++j) { const float x = v[j]; const float u = 0.7978845608028654f * (x + 0.044715f * x * x * x); const float ex = fexp(2.f * u); const float th = 1.f - 2.f * frcp(ex + 1.f); v[j] = 0.5f * x * (1.f + th); }
}

__device__ __forceinline__ void odd_prep_phase(const Params& p, unsigned char* smem, int tid, int bid, int nblk) {
    const int lane = tid & 63, wave = tid >> 6, lq = lane & 15, quad = lane >> 4;
    bf16_t* Z = (bf16_t*)(p.ws + OFF_Z);
    {
        const f32x2* rope = (const f32x2*)(p.ws + OFF_ROPE);
        const int half = nblk >> 1, nthreads = (nblk - half) * 512;
        for (int it = (bid >= half) ? (bid - half) * 512 + tid : T_ * 64; it < T_ * 64; it += nthreads) {
            const int row = it >> 6, wh = (it >> 2) & 15, cidx = it & 3;
            const int pos = row & (S_ - 1);
            bf16_t* base = Z + (size_t)row * OLD + wh * 64 + cidx * 8;
            float z1[8], z2[8];
            unpack8(GLD(u32x4, base), z1); unpack8(GLD(u32x4, base + 32), z2);
            float o1[8], o2[8];
#pragma unroll
            for (int e = 0; e < 8; ++e) { const f32x2 cs = GLD(f32x2, rope + pos * 32 + cidx * 8 + e); o1[e] = z1[e] * cs[0] - z2[e] * cs[1]; o2[e] = z1[e] * cs[1] + z2[e] * cs[0]; }
            u32x4 w1; w1.x = pk2(o1[0], o1[1]); w1.y = pk2(o1[2], o1[3]); w1.z = pk2(o1[4], o1[5]); w1.w = pk2(o1[6], o1[7]);
            u32x4 w2; w2.x = pk2(o2[0], o2[1]); w2.y = pk2(o2[2], o2[3]); w2.z = pk2(o2[4], o2[5]); w2.w = pk2(o2[6], o2[7]);
            GST(u32x4, base) = w1; GST(u32x4, base + 32) = w2;
        }
    }
    {
        const int gw = bid * 8 + wave, ngw = nblk * 8;
        bf16_t* hid = (bf16_t*)(smem + wave * (16 * 136 * 2));
        for (int task = gw; task < 1024; task += ngw) {
            const int kv = task >> 9, b = (task >> 5) & 15, g = (task >> 3) & 3, ct = task & 7;
            const bf16_t* Zs = Z + (size_t)b * S_ * OLD + (kv ? 4352 : 4096) + g * 64;
            const bf16_t* w1t = (const bf16_t*)(p.ws + (kv ? OFF_W1T_V : OFF_W1T_K));
            const bf16_t* w2t = (const bf16_t*)(p.ws + (kv ? OFF_W2T_V : OFF_W2T_K));
            const float* bias1 = (const float*)(p.ws + OFF_BIAS1) + kv * 128;
            f32x4 acc[8];
#pragma unroll
            for (int n = 0; n < 8; ++n) acc[n] = (f32x4){0.f, 0.f, 0.f, 0.f};
            const int c = ct * 16 + lq;
            bf16x8 a_c, b_c[8], a_n, b_n[8];
            auto cload = [&](int ks, bf16x8& a, bf16x8 (&bb)[8]) {
                const int l = ks >> 1, d0 = (ks & 1) * 32 + quad * 8;
                int row = 16 * c + l; row = row > 2047 ? 2047 : row;
                a = as_bf16x8(GLD(u32x4, Zs + (size_t)row * OLD + d0));
#pragma unroll
                for (int n = 0; n < 8; ++n) bb[n] = as_bf16x8(GLD(u32x4, w1t + (size_t)(16 * n + lq) * 2048 + ks * 32 + quad * 8));
            };
            cload(0, a_c, b_c);
            for (int ks = 0; ks < 64; ++ks) {
                if (ks + 1 < 64) cload(ks + 1, a_n, b_n);
#pragma unroll
                for (int n = 0; n < 8; ++n) acc[n] = mfma16(a_c, b_c[n], acc[n]);
                a_c = a_n;
#pragma unroll
                for (int n = 0; n < 8; ++n) b_c[n] = b_n[n];
            }
#pragma unroll
            for (int n = 0; n < 8; ++n) {
                const float bv = GLD(float, bias1 + 16 * n + lq);
                f32x4 hv = acc[n]; hv[0] += bv; hv[1] += bv; hv[2] += bv; hv[3] += bv;
                gelu_tanh4(hv);
#pragma unroll
                for (int j = 0; j < 4; ++j) { const unsigned pk = pk2(hv[j], 0.f); hid[(4 * quad + j) * 136 + 16 * n + lq] = (bf16_t)(pk & 0xffffu); }
            }
            lds_wait();
            f32x4 acc2[4];
#pragma unroll
            for (int n = 0; n < 4; ++n) acc2[n] = (f32x4){0.f, 0.f, 0.f, 0.f};
#pragma unroll
            for (int ks = 0; ks < 4; ++ks) {
                const bf16x8 a = as_bf16x8(*(const u32x4*)(hid + lq * 136 + quad * 8 + 32 * ks));
#pragma unroll
                for (int n = 0; n < 4; ++n) { const bf16x8 bb = as_bf16x8(GLD(u32x4, w2t + (size_t)(16 * n + lq) * 128 + ks * 32 + quad * 8)); acc2[n] = mfma16(a, bb, acc2[n]); }
            }
            lds_wait();
            bf16_t* dst = (bf16_t*)(p.ws + (kv ? OFF_VC : OFF_KC)) + (size_t)((b * 4 + g) * 128) * 64;
#pragma unroll
            for (int n = 0; n < 4; ++n)
#pragma unroll
                for (int j = 0; j < 4; ++j) {
                    const int cc = ct * 16 + 4 * quad + j;
                    const float v = (cc < 127) ? acc2[n][j] : 0.f;
                    GST(bf16_t, dst + (size_t)cc * 64 + 16 * n + lq) = (bf16_t)(pk2(v, 0.f) & 0xffffu);
                }
        }
    }
}

__device__ __forceinline__ void select_phase(const Params& p, unsigned char* smem, int tid, int bid, int nblk) {
    const int lane = tid & 63, wave = tid >> 6, lq = lane & 15, quad = lane >> 4;
    const bf16_t* Z = (const bf16_t*)(p.ws + OFF_Z);
    const int gw = bid * 8 + wave, ngw = nblk * 8;
    float* PS = (float*)(smem + wave * 2048);
    constexpr float SC = 0.125f * 1.4426950408889634f;
    for (int task = gw; task < 8192; task += ngw) {
        const int b = task >> 9, g = (task >> 7) & 3, qt = task & 127;
        const int t = qt * 16 + lq;
        const bf16_t* kc = (const bf16_t*)(p.ws + OFF_KC) + (size_t)((b * 4 + g) * 128) * 64;
        const int cmax = (t - 31) >> 4;
        f32x4 psum[8];
#pragma unroll
        for (int sub = 0; sub < 8; ++sub) psum[sub] = (f32x4){0.f, 0.f, 0.f, 0.f};
        bf16x8 kfr[8][2], qfr[4][2];
#pragma unroll
        for (int sub = 0; sub < 8; ++sub)
#pragma unroll
            for (int ks = 0; ks < 2; ++ks) kfr[sub][ks] = as_bf16x8(GLD(u32x4, kc + (size_t)(16 * sub + lq) * 64 + quad * 8 + 32 * ks));
#pragma unroll
        for (int r = 0; r < 4; ++r)
#pragma unroll
            for (int ks = 0; ks < 2; ++ks) qfr[r][ks] = as_bf16x8(GLD(u32x4, Z + (size_t)(b * S_ + t) * OLD + 3072 + (g * 4 + r) * 64 + quad * 8 + 32 * ks));
#pragma unroll
        for (int r = 0; r < 4; ++r) {
            f32x4 s[8]; float mx = -INFINITY;
#pragma unroll
            for (int sub = 0; sub < 8; ++sub) {
                s[sub] = (f32x4){0.f, 0.f, 0.f, 0.f};
#pragma unroll
                for (int ks = 0; ks < 2; ++ks) s[sub] = mfma16(kfr[sub][ks], qfr[r][ks], s[sub]);
#pragma unroll
                for (int j = 0; j < 4; ++j) { const int key = 16 * sub + 4 * quad + j; const float sv = (key <= cmax) ? s[sub][j] * SC : -INFINITY; s[sub][j] = sv; mx = fmaxf(mx, sv); }
            }
            mx = fmaxf(mx, __shfl_xor(mx, 16)); mx = fmaxf(mx, __shfl_xor(mx, 32));
            const float m_use = (mx == -INFINITY) ? 0.f : mx;
            float rs = 0.f;
#pragma unroll
            for (int sub = 0; sub < 8; ++sub)
#pragma unroll
                for (int j = 0; j < 4; ++j) { const float e = fexp2(s[sub][j] - m_use); s[sub][j] = e; rs += e; }
            rs += __shfl_xor(rs, 16); rs += __shfl_xor(rs, 32);
            const float inv = (rs > 0.f) ? 1.f / rs : 0.f;
#pragma unroll
            for (int sub = 0; sub < 8; ++sub)
#pragma unroll
                for (int j = 0; j < 4; ++j) psum[sub][j] += s[sub][j] * inv;
        }
        float pslc[8], tprev[8];
#pragma unroll
        for (int sub = 0; sub < 8; ++sub) tprev[sub] = __shfl(psum[sub][3], (lane + 48) & 63);
#pragma unroll
        for (int sub = 0; sub < 8; ++sub) {
            float extra;
            if (quad >= 1) extra = tprev[sub]; else extra = (sub >= 1) ? tprev[sub >= 1 ? sub - 1 : 0] : 0.f;
            pslc[sub] = ((psum[sub][0] + psum[sub][1]) + (psum[sub][2] + psum[sub][3])) + extra;
            PS[lq * 32 + 4 * sub + quad] = pslc[sub];
        }
        lds_wait();
        float pvv[32];
#pragma unroll
        for (int q = 0; q < 8; ++q) { const f32x4 v = *(const f32x4*)(PS + lq * 32 + 4 * q); pvv[4 * q] = v[0]; pvv[4 * q + 1] = v[1]; pvv[4 * q + 2] = v[2]; pvv[4 * q + 3] = v[3]; }
        lds_wait();
        const int own = t >> 6;
        unsigned bits = 0;
#pragma unroll
        for (int sub = 0; sub < 8; ++sub) {
            const int j = 4 * sub + quad; const float mv = pslc[sub];
            int cnt = 0;
#pragma unroll
            for (int j2 = 1; j2 < 32; ++j2) { const bool beats = (pvv[j2] > mv) || (pvv[j2] == mv && j2 < j); cnt += (j2 < own && j2 != j && beats) ? 1 : 0; }
            const bool sel = (j == 0) || (j == own) || (j >= 1 && j < own && cnt < 14);
            if (sel) bits |= (1u << j);
        }
        bits |= (unsigned)__shfl_xor((int)bits, 16); bits |= (unsigned)__shfl_xor((int)bits, 32);
        if (quad == 0) GST(unsigned, (unsigned*)(p.ws + OFF_SEL) + (size_t)(b * 4 + g) * S_ + t) = bits;
    }
}

__device__ __forceinline__ void nsa_item(const Params& p, unsigned char* smem, int b, int head, int qt, int tid) {
    const int lane = tid & 63, wave = tid >> 6, lq = lane & 15, quad = lane >> 4;
    const int g = head >> 2, q0 = qt * 128, t = q0 + wave * 16 + lq;
    const bf16_t* Z = (const bf16_t*)(p.ws + OFF_Z) + (size_t)b * S_ * OLD;
    const unsigned rowmask = GLD(unsigned, (const unsigned*)(p.ws + OFF_SEL) + (size_t)(b * 4 + g) * S_ + t);
    float gate[3];
#pragma unroll
    for (int i = 0; i < 3; ++i) gate[i] = sigmoidf_(bf2f(GLD(bf16_t, Z + (size_t)t * OLD + 5632 + head * 3 + i)));
    f32x4 o[4], tot[4];
    const bf16_t* kc = (const bf16_t*)(p.ws + OFF_KC) + (size_t)((b * 4 + g) * 128) * 64;
    const bf16_t* vc = (const bf16_t*)(p.ws + OFF_VC) + (size_t)((b * 4 + g) * 128) * 64;
#ifndef NSA_PASSES
#define NSA_PASSES 7
#endif
    if (NSA_PASSES & 1) attn_pass<M_CMP, 64>(smem, Z + 3072 + head * 64, OLD, kc, 64, vc, 64, q0, 0u, 0.f, o, tid);
    else { o[0] = o[1] = o[2] = o[3] = (f32x4){0.f, 0.f, 0.f, 0.f}; }
#pragma unroll
    for (int c = 0; c < 4; ++c) { tot[c][0] = gate[0] * o[c][0]; tot[c][1] = gate[0] * o[c][1]; tot[c][2] = gate[0] * o[c][2]; tot[c][3] = gate[0] * o[c][3]; }
    if (NSA_PASSES & 2) attn_pass<M_SLC, 64>(smem, Z + 3072 + head * 64, OLD, Z + 4608 + g * 64, OLD, Z + 4864 + g * 64, OLD, q0, rowmask, 0.f, o, tid);
#pragma unroll
    for (int c = 0; c < 4; ++c) { tot[c][0] += gate[1] * o[c][0]; tot[c][1] += gate[1] * o[c][1]; tot[c][2] += gate[1] * o[c][2]; tot[c][3] += gate[1] * o[c][3]; }
    if (NSA_PASSES & 4) attn_pass<M_WIN, 64>(smem, Z + 3072 + head * 64, OLD, Z + 5120 + g * 64, OLD, Z + 5376 + g * 64, OLD, q0, 0u, 0.f, o, tid);
#pragma unroll
    for (int c = 0; c < 4; ++c) { tot[c][0] += gate[2] * o[c][0]; tot[c][1] += gate[2] * o[c][1]; tot[c][2] += gate[2] * o[c][2]; tot[c][3] += gate[2] * o[c][3]; }
    bf16_t* cat = (bf16_t*)(p.ws + OFF_CAT) + (size_t)(b * S_ + t) * D_ + 1024 + head * 64;
#pragma unroll
    for (int c = 0; c < 4; ++c) { u32x2 w; w.x = pk2(tot[c][0], tot[c][1]); w.y = pk2(tot[c][2], tot[c][3]); GST(u32x2, cat + 16 * c + 4 * quad) = w; }
}


__device__ __forceinline__ void nsa_item2(const Params& p, unsigned char* smem, int b, int head, int qt, int tid) {
    const int lane = tid & 63, wave = tid >> 6, lq = lane & 15, quad = lane >> 4;
    const int g = head >> 2, q0 = qt * 256;
    int t[2]; t[0] = q0 + wave * 32 + lq; t[1] = t[0] + 16;
    const bf16_t* Z = (const bf16_t*)(p.ws + OFF_Z) + (size_t)b * S_ * OLD;
    unsigned rowmask[2], nomask[2] = {0u, 0u}; float gate[2][3];
#pragma unroll
    for (int qs = 0; qs < 2; ++qs) {
        rowmask[qs] = GLD(unsigned, (const unsigned*)(p.ws + OFF_SEL) + (size_t)(b * 4 + g) * S_ + t[qs]);
#pragma unroll
        for (int i = 0; i < 3; ++i) gate[qs][i] = sigmoidf_(bf2f(GLD(bf16_t, Z + (size_t)t[qs] * OLD + 5632 + head * 3 + i)));
    }
    f32x4 o[2][4];
    f32x4* tl = (f32x4*)(smem + 40960) + tid;
    const bf16_t* kc = (const bf16_t*)(p.ws + OFF_KC) + (size_t)((b * 4 + g) * 128) * 64;
    const bf16_t* vc = (const bf16_t*)(p.ws + OFF_VC) + (size_t)((b * 4 + g) * 128) * 64;
    attn_pass2<M_CMP>(smem, Z + 3072 + head * 64, OLD, kc, 64, vc, 64, q0, nomask, o, tid);
#pragma unroll
    for (int qs = 0; qs < 2; ++qs)
#pragma unroll
        for (int c = 0; c < 4; ++c) { f32x4 v; v[0] = gate[qs][0] * o[qs][c][0]; v[1] = gate[qs][0] * o[qs][c][1]; v[2] = gate[qs][0] * o[qs][c][2]; v[3] = gate[qs][0] * o[qs][c][3]; tl[(qs * 4 + c) * 512] = v; }
    attn_pass2<M_SLC>(smem, Z + 3072 + head * 64, OLD, Z + 4608 + g * 64, OLD, Z + 4864 + g * 64, OLD, q0, rowmask, o, tid);
#pragma unroll
    for (int qs = 0; qs < 2; ++qs)
#pragma unroll
        for (int c = 0; c < 4; ++c) { f32x4 v = tl[(qs * 4 + c) * 512]; v[0] += gate[qs][1] * o[qs][c][0]; v[1] += gate[qs][1] * o[qs][c][1]; v[2] += gate[qs][1] * o[qs][c][2]; v[3] += gate[qs][1] * o[qs][c][3]; tl[(qs * 4 + c) * 512] = v; }
    attn_pass2<M_WIN>(smem, Z + 3072 + head * 64, OLD, Z + 5120 + g * 64, OLD, Z + 5376 + g * 64, OLD, q0, nomask, o, tid);
#pragma unroll
    for (int qs = 0; qs < 2; ++qs) {
        bf16_t* cat = (bf16_t*)(p.ws + OFF_CAT) + (size_t)(b * S_ + t[qs]) * D_ + 1024 + head * 64;
#pragma unroll
        for (int c = 0; c < 4; ++c) {
            const f32x4 v = tl[(qs * 4 + c) * 512];
            const float r0 = v[0] + gate[qs][2] * o[qs][c][0], r1 = v[1] + gate[qs][2] * o[qs][c][1], r2 = v[2] + gate[qs][2] * o[qs][c][2], r3 = v[3] + gate[qs][2] * o[qs][c][3];
            u32x2 w; w.x = pk2(r0, r1); w.y = pk2(r2, r3); GST(u32x2, cat + 16 * c + 4 * quad) = w;
        }
    }
}

__device__ __forceinline__ void ret_item(const Params& p, unsigned char* smem, int b, int h, int qt, int tid) {
    const int lane = tid & 63, wave = tid >> 6, lq = lane & 15, quad = lane >> 4;
    const int q0 = qt * 128, t = q0 + wave * 16 + lq;
    const bf16_t* Z = (const bf16_t*)(p.ws + OFF_Z) + (size_t)b * S_ * OLD;
    const float log2g = log2f(1.f - exp2f(-5.f - (float)h));
    f32x4 o[8];
    attn_pass<M_RET, 128>(smem, Z + h * 64, OLD, Z + 512 + h * 64, OLD, Z + 1024 + h * 128, OLD, q0, 0u, log2g, o, tid);
    float sm = 0.f;
#pragma unroll
    for (int c = 0; c < 8; ++c) sm += (o[c][0] + o[c][1]) + (o[c][2] + o[c][3]);
    sm += __shfl_xor(sm, 16); sm += __shfl_xor(sm, 32);
    const float mean = sm * (1.f / 128.f);
    float sq = 0.f;
#pragma unroll
    for (int c = 0; c < 8; ++c)
#pragma unroll
        for (int j = 0; j < 4; ++j) { o[c][j] -= mean; sq += o[c][j] * o[c][j]; }
    sq += __shfl_xor(sq, 16); sq += __shfl_xor(sq, 32);
    const float rstd = rsqrtf(sq * (1.f / 128.f) + 1e-6f);
    const bf16_t* rg = Z + (size_t)t * OLD + 2048 + h * 128;
    bf16_t* cat = (bf16_t*)(p.ws + OFF_CAT) + (size_t)(b * S_ + t) * D_ + h * 128;
#pragma unroll
    for (int c = 0; c < 8; ++c) {
        const u32x2 gv = GLD(u32x2, rg + 16 * c + 4 * quad);
        const float g0 = __uint_as_float(gv.x << 16), g1 = __uint_as_float(gv.x & 0xffff0000u), g2 = __uint_as_float(gv.y << 16), g3 = __uint_as_float(gv.y & 0xffff0000u);
        const float r0 = g0 * sigmoidf_(g0) * o[c][0] * rstd, r1 = g1 * sigmoidf_(g1) * o[c][1] * rstd, r2 = g2 * sigmoidf_(g2) * o[c][2] * rstd, r3 = g3 * sigmoidf_(g3) * o[c][3] * rstd;
        u32x2 w; w.x = pk2(r0, r1); w.y = pk2(r2, r3);
        GST(u32x2, cat + 16 * c + 4 * quad) = w;
    }
}

__device__ __forceinline__ void odd_mixer_phase(const Params& p, unsigned char* smem, int tid, int bid, int nblk) {
    for (int it = bid; it < 4096; it += nblk) {
        const int sl = it >> 9, r = it & 511;
        if (r < 256) { const int rr_ = r & 127; ret_item(p, smem, rr_ >> 3, rr_ & 7, 15 - 2 * sl - (r >> 7), tid); }
        else { const int bh = r - 256; nsa_item2(p, smem, bh >> 4, bh & 15, 7 - sl, tid); }
    }
}

#define XB_TMO      128
#define XB_XCNT(j)  (256  + 64 * (j))
#define XB_XSUB(j)  (1280 + 64 * (j))
#define XB_XGEN(j)  (2304 + 64 * (j))
#define XB_TOP      3328
#define XB_TOPGEN   3392
#define XCD_BAR_WORDS 3456
#define XB_SPIN_CAP (1u << 18)

__device__ __forceinline__ unsigned xb_ld(unsigned* p)              { return __hip_atomic_load(p, __ATOMIC_RELAXED, __HIP_MEMORY_SCOPE_AGENT); }
__device__ __forceinline__ unsigned xb_add(unsigned* p, unsigned v) { return __hip_atomic_fetch_add(p, v, __ATOMIC_RELAXED, __HIP_MEMORY_SCOPE_AGENT); }
__device__ __forceinline__ unsigned xb_xcc_id() { return (unsigned)__builtin_amdgcn_s_getreg((3 << 11) | 20) & 0xFu; }
#define XB_SPIN(cond, bar) do { unsigned _sp = 0; while (cond) { __builtin_amdgcn_s_sleep(1); \
    if ((++_sp & 255u) == 0u) { if (xb_ld(&(bar)[XB_TMO])) break; if (_sp > XB_SPIN_CAP) { atomicAdd(&(bar)[XB_TMO], 1u); break; } } } } while (0)

struct XcdBarrier {
    unsigned* bar; unsigned x;
    volatile LAS unsigned* st;
};

__device__ __forceinline__ XcdBarrier xcd_barrier_post(unsigned* bar, volatile LAS unsigned* st) {
    XcdBarrier b; b.bar = bar; b.x = xb_xcc_id(); b.st = st;
    if (threadIdx.x == 0) (void)xb_add(&bar[XB_XCNT(b.x)], 1u);
    return b;
}
__device__ __forceinline__ void xcd_barrier_complete(unsigned* bar, unsigned x, unsigned& nloc, unsigned& nx) {
    const unsigned G = gridDim.x * gridDim.y * gridDim.z;
    unsigned sum, cnt, mine, sp = 0u;
    for (;;) {
        sum = 0u; cnt = 0u; mine = 0u;
#pragma unroll
        for (unsigned j = 0; j < 16; ++j) { const unsigned c = xb_ld(&bar[XB_XCNT(j)]); sum += c; cnt += (c > 0u) ? 1u : 0u; mine = (j == x) ? c : mine; }
        if (sum == G) break;
        __builtin_amdgcn_s_sleep(1);
        if ((++sp & 255u) == 0u) { if (xb_ld(&bar[XB_TMO])) break; if (sp > XB_SPIN_CAP) { atomicAdd(&bar[XB_TMO], 1u); break; } }
    }
    nloc = mine > 0u ? mine : 1u; nx = cnt > 0u ? cnt : 1u;
}

__device__ __forceinline__ void xcd_barrier(const XcdBarrier& b) {
    asm volatile("s_waitcnt vmcnt(0)" ::: "memory");
    __syncthreads();
    if (threadIdx.x == 0) {
        unsigned* bar = b.bar;
        __builtin_amdgcn_s_waitcnt(0);
        unsigned nloc = b.st[0], nx = b.st[1];
        if (nloc == 0u) { xcd_barrier_complete(bar, b.x, nloc, nx); b.st[0] = nloc; b.st[1] = nx; }
        const unsigned old = xb_add(&bar[XB_XSUB(b.x)], 1u);
        const unsigned gen = old / nloc;
        if (old + 1u == (gen + 1u) * nloc) {
            __builtin_amdgcn_fence(__ATOMIC_RELEASE, "agent");
            asm volatile("s_waitcnt vmcnt(0)" ::: "memory");
            const unsigned og = xb_add(&bar[XB_TOP], 1u);
            const unsigned tg = og / nx;
            if (og + 1u == (tg + 1u) * nx) xb_add(&bar[XB_TOPGEN], 1u);
            else XB_SPIN(xb_ld(&bar[XB_TOPGEN]) == tg, bar);
            __builtin_amdgcn_fence(__ATOMIC_ACQUIRE, "agent");
            xb_add(&bar[XB_XGEN(b.x)], 1u);
            asm volatile("s_waitcnt vmcnt(0)" ::: "memory");
        } else {
            XB_SPIN(xb_ld(&bar[XB_XGEN(b.x)]) == gen, bar);
            __builtin_amdgcn_fence(__ATOMIC_ACQUIRE, "agent");
            asm volatile("s_waitcnt vmcnt(0)" ::: "memory");
        }
    }
    __syncthreads();
}

#ifndef ONLYMASK
#define ONLYMASK 0xFFFFFFu
#endif
#define PH_ON(n) ((ONLYMASK >> (n)) & 1u)
__device__ __forceinline__ const Params& opaque_params() {
    const Params* pp = (const Params*)__builtin_amdgcn_kernarg_segment_ptr(); asm volatile("" : "+s"(pp)); return *pp;
}
__device__ __forceinline__ void run_gemm(unsigned char* smem, int ph, int bid, int nblk) {
    const Params& p = opaque_params();
    unsigned char* ws = p.ws;
    pg8::Gemm g; EpiAll E; g.M = T_;
    E.O = (bf16_t*)(ws + OFF_Z); E.ldc = EIN; E.Xin = p.out; E.Xout = p.out; E.mode = 0;
    if (ph == 1) { g.A = (const bf16_t*)(ws + OFF_H); g.Bt = (const bf16_t*)(ws + OFF_WT_EIN); g.N = EIN; g.K = D_; E.mode = 0; E.ldc = EIN; }
    else if (ph == 9) { g.A = (const bf16_t*)(ws + OFF_H); g.Bt = (const bf16_t*)(ws + OFF_WT_OIN); g.N = OLD; g.K = D_; E.mode = 0; E.ldc = OLD; }
    else if (ph == 4) { g.A = (const bf16_t*)(ws + OFF_CAT); g.Bt = (const bf16_t*)(ws + OFF_WT_EOUT); g.N = D_; g.K = D_; E.mode = 1; E.Xin = p.in[0]; }
    else if (ph == 13) { g.A = (const bf16_t*)(ws + OFF_CAT); g.Bt = (const bf16_t*)(ws + OFF_WT_OOUT); g.N = D_; g.K = D_; E.mode = 1; }
    else if (ph == 7) { g.A = (const bf16_t*)(ws + OFF_Z); g.Bt = (const bf16_t*)(ws + OFF_WT2_0); g.N = D_; g.K = FF_; E.mode = 1; }
    else if (ph == 16) { g.A = (const bf16_t*)(ws + OFF_Z); g.Bt = (const bf16_t*)(ws + OFF_WT2_1); g.N = D_; g.K = FF_; E.mode = 1; }
    else if (ph == 6) { g.A = (const bf16_t*)(ws + OFF_H); g.Bt = (const bf16_t*)(ws + OFF_WT13_0); g.N = 2 * FF_; g.K = D_; E.mode = 2; }
    else { g.A = (const bf16_t*)(ws + OFF_H); g.Bt = (const bf16_t*)(ws + OFF_WT13_1); g.N = 2 * FF_; g.K = D_; E.mode = 2; }
    pg8::StaticOrder So; So.init(g.M, g.N, (int)nblk, (int)bid);
    pg8::gemm_phase<EpiAll, pg8::StaticOrder, false>((PG8_LAS unsigned char*)smem, g, So, E, nullptr);
}
__device__ __forceinline__ void run_norm(int ph, int tid, int bid, int nblk) {
    const Params& p = opaque_params();
    const int lane = tid & 63, wave = tid >> 6;
    const int gw = bid * 8 + wave, ngw = nblk * 8;
    bf16_t* H = (bf16_t*)(p.ws + OFF_H);
#ifdef SKEL
    if (ph == 17) rmsnorm_rows(p.in[0], p.in[27], nullptr, p.out, gw, ngw, lane);
    else if (ph == 5) {}
#else
    if (ph == 17) rmsnorm_rows(p.out, p.in[27], nullptr, p.out, gw, ngw, lane);
#endif
    else rmsnorm_rows(p.out, (ph == 8 ? p.in[1] + D_ : p.in[2] + (ph == 14 ? D_ : 0)), H, nullptr, gw, ngw, lane);
}
__global__ void __launch_bounds__(512, 2) mega(Params pk) {
    extern __shared__ __attribute__((aligned(16))) unsigned char smem[];
    cg::grid_group grid = cg::this_grid();
    {
        volatile LAS unsigned* st0 = (volatile LAS unsigned*)(smem + 131072);
        if (threadIdx.x == 0) { st0[0] = 0u; st0[1] = 0u; }
        __syncthreads();
        (void)xcd_barrier_post((unsigned*)(opaque_params().ws + OFF_BAR), st0);
    }
    const int ph_lo = ((const Params*)__builtin_amdgcn_kernarg_segment_ptr())->ph_lo, ph_hi = ((const Params*)__builtin_amdgcn_kernarg_segment_ptr())->ph_hi;
#pragma nounroll
    for (int ph = ph_lo; ph < ph_hi; ++ph) {
        int tid = threadIdx.x; asm volatile("" : "+v"(tid));
        int bid = __builtin_amdgcn_workgroup_id_x(); asm volatile("" : "+s"(bid));
        int nblk = (int)__builtin_amdgcn_grid_size_x() / 512; asm volatile("" : "+s"(nblk));
        if (ph == 0) { for (int rep = 0; rep < REP_P0; ++rep) { phase0(opaque_params(), smem, tid, bid, nblk); __syncthreads(); } }
        else if (ph == 2) { if (PH_ON(2)) kmean_phase(opaque_params(), tid, bid, nblk); }
        else if (ph == 3) { if (PH_ON(3)) even_mixer_phase(opaque_params(), smem, tid, bid, nblk); }
        else if (ph == 10) { if (PH_ON(10)) odd_prep_phase(opaque_params(), smem, tid, bid, nblk); }
        else if (ph == 11) { for (int rep = 0; rep < REP_SEL; ++rep) select_phase(opaque_params(), smem, tid, bid, nblk); }
        else if (ph == 12) { if (PH_ON(12)) odd_mixer_phase(opaque_params(), smem, tid, bid, nblk); }
#ifdef SKEL
        else if (ph == 17) { run_norm(ph, tid, bid, nblk); }
        else if (ph == 5 || ph == 8 || ph == 14) { }
#else
        else if (ph == 5 || ph == 8 || ph == 14 || ph == 17) { const int nrep = (ph == 5) ? REP_NORM : 1; for (int rep = 0; rep < nrep; ++rep) run_norm(ph, tid, bid, nblk); }
#endif
        else { const int nrep = (ph == 1 || ph == 6 || ph == 9 || ph == 15) ? REP_GEMM : 1; for (int rep = 0; rep < nrep; ++rep) { run_gemm(smem, ph, bid, nblk); __syncthreads(); } }
        if (ph + 1 < ph_hi) {
            if (ph == 0) grid.sync();
            else { XcdBarrier xb; xb.bar = (unsigned*)(opaque_params().ws + OFF_BAR); xb.x = xb_xcc_id(); xb.st = (volatile LAS unsigned*)(smem + 131072); xcd_barrier(xb); }
        }
    }
}

extern "C" void kernel_launch(void* const* d_in, const int* in_sizes, int n_in, void* d_out, int out_size, void* d_ws, size_t ws_size, hipStream_t stream) {
    static int grid = 0;
    if (grid == 0) {
        if (n_in != 28 || out_size != T_ * D_ || ws_size < WS_END) { fprintf(stderr, "kernel_launch: unexpected shapes (n_in %d out %d ws %zu need %zu)\n", n_in, out_size, ws_size, (size_t)WS_END); grid = -1; return; }
        int dev = 0, cus = 0, per_cu = 0;
        hipGetDevice(&dev);
        hipDeviceGetAttribute(&cus, hipDeviceAttributeMultiprocessorCount, dev);
        if (hipFuncSetAttribute((const void*)mega, hipFuncAttributeMaxDynamicSharedMemorySize, LDS_BYTES) != hipSuccess) { fprintf(stderr, "kernel_launch: hipFuncSetAttribute failed\n"); grid = -1; return; }
        hipOccupancyMaxActiveBlocksPerMultiprocessor(&per_cu, (const void*)mega, 512, LDS_BYTES);
        if (per_cu < 1) { fprintf(stderr, "kernel_launch: occupancy query says %d blocks per CU\n", per_cu); per_cu = 1; }
        (void)hipGetLastError();
        grid = cus;
    }
    if (grid < 0) return;
    Params p{};
    for (int i = 0; i < 28; ++i) p.in[i] = (const float*)d_in[i];
    p.out = (float*)d_out; p.ws = (unsigned char*)d_ws;
    for (int i = 0; i < 32; ++i) p.inv_freq[i] = pow(10000.0, -(double)i / 32.0);
    p.ph_lo = 0; p.ph_hi = NPHASE;
#ifdef ZEROCAT
    (void)hipMemsetAsync((char*)d_ws + OFF_CAT, 0, (size_t)T_ * D_ * 2, stream);
#endif
    if (hipMemsetAsync((char*)d_ws + OFF_BAR, 0, XCD_BAR_WORDS * sizeof(unsigned), stream) != hipSuccess) { fprintf(stderr, "kernel_launch: memset of barrier words failed\n"); return; }
    void* args[] = {&p};
    hipError_t e = hipLaunchCooperativeKernel((const void*)mega, dim3(grid), dim3(512), args, LDS_BYTES, stream);
    if (e != hipSuccess) fprintf(stderr, "kernel_launch: cooperative launch failed: %s (grid %d)\n", hipGetErrorString(e), grid);
}
```

```cpp
#include <hip/hip_runtime.h>
#include <hip/hip_cooperative_groups.h>
#include <cstdio>
#include <cmath>
namespace cg = cooperative_groups;
namespace pg8 {
#define PG8_LAS __attribute__((address_space(3)))
typedef unsigned short bf16_t;
typedef short bf16x8 __attribute__((ext_vector_type(8)));
typedef float f32x4 __attribute__((ext_vector_type(4)));
typedef unsigned u32x4 __attribute__((ext_vector_type(4)));
constexpr int BM = 256, BK = 64, HALF = 128, HTB = HALF * BK * 2  , STAGE_BYTES = 8 * HTB, NXCD = 8, WGM = 8;

__host__ __device__ __forceinline__ int lds_byte(int r, int c) { const int st = (r >> 4) * 2 + (c >> 5), rr = r & 15, cc = c & 31, ob = rr * 64 + cc * 2; return st * 1024 + (ob ^ (((ob >> 9) & 1) << 5)); }
__host__ __device__ __forceinline__ void stage_rc(int b, int& R, int& C) { const int st = b / 1024, sb = b % 1024, swz = sb ^ (((sb >> 9) & 1) << 5); R = (st >> 1) * 16 + swz / 64; C = (st & 1) * 32 + (swz % 64) / 2; }
__host__ __device__ __forceinline__ int perm32(int rho) { const int n = rho >> 4, i = rho & 15; return 8 * (i >> 2) + 4 * n + (i & 3); }

struct Unit { int pm, pn; };
struct Gemm { const bf16_t* A; const bf16_t* Bt; int M, N, K; };

struct StaticOrder {
    int nM, nN, nwg, G, c;
    __host__ __device__ void init(int M, int N, int G_, int c_) { nM = M / BM; nN = N / BM; nwg = nM * nN; G = G_; c = c_; }
    __host__ __device__ bool next(int i, Unit& u) const {
        const long L = (long)i * G + c; if (L >= nwg) return false;
        int wgid = (int)L; { const int q = nwg / NXCD, r = nwg % NXCD, xcd = wgid % NXCD, off = wgid / NXCD; wgid = (xcd < r ? xcd * (q + 1) : r * (q + 1) + (xcd - r) * q) + off; }
        const int nig = WGM * nN, gid = wgid / nig, fm = gid * WGM, gsz = (nM - fm) < WGM ? (nM - fm) : WGM;
        u.pm = fm + ((wgid % nig) % gsz); u.pn = (wgid % nig) / gsz; return true;
    }
    __device__ __forceinline__ void a_ready(const Unit&) const {}
    __device__ __forceinline__ void done(const Unit&) const {}
};
__device__ __forceinline__ unsigned cvt_pk_bf16(float lo, float hi) { unsigned r; asm volatile("v_cvt_pk_bf16_f32 %0, %1, %2" : "=v"(r) : "v"(lo), "v"(hi)); return r; }
template <class Epi, class Sched, bool STAMP = false>
__device__ __forceinline__ void gemm_phase(PG8_LAS unsigned char* lds, const Gemm g, const Sched& S, const Epi& E, unsigned long long* stamps) {
    int tid = threadIdx.x; asm volatile("" : "+v"(tid)); const int wid = __builtin_amdgcn_readfirstlane(tid >> 6), lane = tid & 63, wr = wid >> 2, wc = wid & 3, fr = lane & 15, fq = lane >> 4;
    const int K = g.K, nt = K / BK;
    int ts_lo = 0, ts_hi = 0, nts = 0; const unsigned long long rt_entry = STAMP ? (unsigned long long)wall_clock64() : 0ull;
#define PG8_STAMP() do { if (STAMP && wid == 0 && nts < 64) { const unsigned long long _c = (unsigned long long)clock64(); \
        ts_lo = (lane == nts) ? (int)(unsigned)_c : ts_lo; ts_hi = (lane == nts) ? (int)(unsigned)(_c >> 32) : ts_hi; ++nts; } } while (0)
    PG8_STAMP();
    unsigned voffA[2], voffB[2];
#pragma unroll
    for (int i = 0; i < 2; ++i) { int R, C; stage_rc(tid * 16 + i * 8192, R, C); const int Rb = Epi::PERM ? ((R & ~31) + perm32(R & 31)) : R;
        voffA[i] = (unsigned)(R * K + C) * 2u; voffB[i] = (unsigned)(Rb * K + C) * 2u; }
    const size_t kstep = (size_t)(BK * 2);
    const size_t hstep = (size_t)HALF * K * 2;
    const size_t tstep = 2 * hstep;
    const unsigned ldsw = (unsigned)wid * 1024u;
    const int aoff = lds_byte(wr * 64 + fr, fq * 8), boff = lds_byte(wc * 32 + fr, fq * 8);
#define PG8_SA(b, h) (((b) * 2 + (h)) * HTB)
#define PG8_SB(b, h) ((4 + (b) * 2 + (h)) * HTB)
#define PG8_STAGE(bufoff, gbase, voff) do { _Pragma("unroll") for (int _i = 0; _i < 2; ++_i) \
        __builtin_amdgcn_global_load_lds((const unsigned*)((const char*)(gbase) + (voff)[_i]), (PG8_LAS unsigned*)(lds + (bufoff) + ldsw + _i * 8192), 16, 0, 0); } while (0)
#define PG8_LDA(dst, b, h) do { _Pragma("unroll") for (int m = 0; m < 4; ++m) _Pragma("unroll") for (int k = 0; k < 2; ++k) dst[m][k] = *(const PG8_LAS bf16x8*)(lds + PG8_SA(b, h) + aoff + m * 2048 + k * 1024); } while (0)
#define PG8_LDB(dst, b, h) do { _Pragma("unroll") for (int n = 0; n < 2; ++n) _Pragma("unroll") for (int k = 0; k < 2; ++k) dst[n][k] = *(const PG8_LAS bf16x8*)(lds + PG8_SB(b, h) + boff + n * 2048 + k * 1024); } while (0)
#define PG8_MMA(ai, bj, At, Bt) do { __builtin_amdgcn_s_setprio(1); _Pragma("unroll") for (int m = 0; m < 4; ++m) _Pragma("unroll") for (int n = 0; n < 2; ++n) _Pragma("unroll") for (int k = 0; k < 2; ++k) \
        acc[ai][bj][m][n] = __builtin_amdgcn_mfma_f32_16x16x32_bf16(Bt[n][k], At[m][k], acc[ai][bj][m][n], 0, 0, 0); __builtin_amdgcn_s_setprio(0); } while (0)
#define PG8_WAIT_V(n) asm volatile("s_waitcnt vmcnt(" #n ")" ::: "memory")
#define PG8_WAIT_L(n) asm volatile("s_waitcnt lgkmcnt(" #n ")" ::: "memory")
#define PG8_BAR __builtin_amdgcn_s_barrier()
#define PG8_SCHED __builtin_amdgcn_sched_barrier(0)
    Unit cur, nxt; int ui = 0;
    if (!S.next(0, cur)) return;
    f32x4 acc[2][2][4][2];
#pragma unroll
    for (int a = 0; a < 2; ++a)
#pragma unroll
        for (int b = 0; b < 2; ++b)
#pragma unroll
            for (int m = 0; m < 4; ++m)
#pragma unroll
                for (int n = 0; n < 2; ++n) acc[a][b][m][n] = (f32x4){0.f, 0.f, 0.f, 0.f};
    bf16x8 At[4][2], B0[2][2], B1[2][2];
    const char* cA = (const char*)g.A + (size_t)cur.pm * tstep; const char* cB = (const char*)g.Bt + (size_t)cur.pn * tstep;
    S.a_ready(cur);
    PG8_STAGE(PG8_SB(0, 0), cB, voffB); PG8_STAGE(PG8_SA(0, 0), cA, voffA); PG8_STAGE(PG8_SB(0, 1), cB + hstep, voffB); PG8_STAGE(PG8_SA(0, 1), cA + hstep, voffA);
    if (wr == 1) PG8_BAR;
    PG8_WAIT_V(4); PG8_BAR;
    PG8_STAGE(PG8_SB(1, 0), cB + kstep, voffB); PG8_STAGE(PG8_SA(1, 0), cA + kstep, voffA); PG8_STAGE(PG8_SB(1, 1), cB + hstep + kstep, voffB);
    PG8_WAIT_V(6); PG8_BAR;
    PG8_STAMP();
    for (;;) {
        const bool has_next = S.next(ui + 1, nxt);
        const char* nA = has_next ? (const char*)g.A + (size_t)nxt.pm * tstep : cA; const char* nB = has_next ? (const char*)g.Bt + (size_t)nxt.pn * tstep : cB;
        for (int t = 0; t < nt; t += 2) {
            const bool last = (t == nt - 2);
            const char* a1 = cA + (size_t)(t + 1) * kstep;
            const char* a2 = last ? nA : cA + (size_t)(t + 2) * kstep; const char* b2 = last ? nB : cB + (size_t)(t + 2) * kstep;
            const char* a3 = a2 + kstep; const char* b3 = b2 + kstep;
            if (last && has_next) S.a_ready(nxt);
            PG8_LDB(B0, 0, 0); PG8_SCHED; PG8_LDA(At, 0, 0); PG8_STAGE(PG8_SA(1, 1), a1 + hstep, voffA);
            PG8_WAIT_L(8); PG8_BAR; PG8_WAIT_L(0); PG8_MMA(0, 0, At, B0); PG8_BAR; PG8_SCHED;
            PG8_LDB(B1, 0, 1); PG8_STAGE(PG8_SB(0, 0), b2, voffB);
            PG8_BAR; PG8_WAIT_L(0); PG8_MMA(0, 1, At, B1); PG8_BAR;
            PG8_LDA(At, 0, 1); PG8_STAGE(PG8_SA(0, 0), a2, voffA);
            PG8_BAR; PG8_WAIT_L(0); PG8_MMA(1, 0, At, B0); PG8_BAR; PG8_SCHED;
            PG8_STAGE(PG8_SB(0, 1), b2 + hstep, voffB);
            PG8_WAIT_V(6); PG8_BAR; PG8_MMA(1, 1, At, B1); PG8_BAR;
            PG8_LDB(B0, 1, 0); PG8_SCHED; PG8_LDA(At, 1, 0); PG8_STAGE(PG8_SA(0, 1), a2 + hstep, voffA);
            PG8_WAIT_L(8); PG8_BAR; PG8_WAIT_L(0); PG8_MMA(0, 0, At, B0); PG8_BAR; PG8_SCHED;
            PG8_LDB(B1, 1, 1); PG8_STAGE(PG8_SB(1, 0), b3, voffB);
            PG8_BAR; PG8_WAIT_L(0); PG8_MMA(0, 1, At, B1); PG8_BAR;
            PG8_LDA(At, 1, 1); PG8_STAGE(PG8_SA(1, 0), a3, voffA);
            PG8_BAR; PG8_WAIT_L(0); PG8_MMA(1, 0, At, B0); PG8_BAR; PG8_SCHED;
            PG8_STAGE(PG8_SB(1, 1), b3 + hstep, voffB);
            PG8_WAIT_V(6); PG8_BAR; PG8_MMA(1, 1, At, B1); PG8_BAR;
        }
        PG8_STAMP();
        if constexpr (!Epi::AFTER_DRAIN) { E(acc, cur, wr, wc, fr, fq); S.done(cur); }
        PG8_STAMP();
        if (!has_next) break;
#pragma unroll
        for (int a = 0; a < 2; ++a)
#pragma unroll
            for (int b = 0; b < 2; ++b)
#pragma unroll
                for (int m = 0; m < 4; ++m)
#pragma unroll
                    for (int n = 0; n < 2; ++n) acc[a][b][m][n] = (f32x4){0.f, 0.f, 0.f, 0.f};
        cur = nxt; cA = nA; cB = nB; ++ui;
    }
    PG8_WAIT_V(0);
    if (wr == 0) PG8_BAR;
    PG8_BAR;
    if constexpr (Epi::AFTER_DRAIN) { E.fused(acc, cur, wr, wc, fr, fq, lds, wid, lane); S.done(cur); }
    PG8_STAMP();
    if (STAMP && wid == 0) { stamps[lane] = lane < nts ? (((unsigned long long)(unsigned)ts_hi << 32) | (unsigned)ts_lo) : 0ull;
        if (lane == 62) stamps[62] = rt_entry; if (lane == 63) stamps[63] = (unsigned long long)wall_clock64(); }
#undef PG8_STAMP
#undef PG8_SA
#undef PG8_SB
#undef PG8_STAGE
#undef PG8_LDA
#undef PG8_LDB
#undef PG8_MMA
#undef PG8_WAIT_V
#undef PG8_WAIT_L
#undef PG8_BAR
#undef PG8_SCHED
}
}

typedef unsigned short bf16_t;
typedef short bf16x8 __attribute__((ext_vector_type(8)));
typedef short s16x4 __attribute__((ext_vector_type(4)));
typedef float f32x4 __attribute__((ext_vector_type(4)));
typedef float f32x2 __attribute__((ext_vector_type(2)));
typedef unsigned u32x4 __attribute__((ext_vector_type(4)));
typedef unsigned u32x2 __attribute__((ext_vector_type(2)));
#define LAS __attribute__((address_space(3)))
#define GAS __attribute__((address_space(1)))
#define GLD(T, ptr) (*(const GAS T*)(ptr))
#define GST(T, ptr) (*(GAS T*)(ptr))

constexpr int T_ = 32768, D_ = 2048, S_ = 2048, B_ = 16, FF_ = 5632;
constexpr int EIN = 6400, OIN = 5680, OLD = 5888;
constexpr float EPS_ = 1e-6f;

constexpr size_t AL256(size_t x) { return (x + 255) & ~(size_t)255; }
constexpr size_t OFF_CTRL = 0;
constexpr size_t OFF_WT_EIN = 4096;
constexpr size_t OFF_WT_EOUT = OFF_WT_EIN + (size_t)EIN * D_ * 2;
constexpr size_t OFF_WT_OIN = OFF_WT_EOUT + (size_t)D_ * D_ * 2;
constexpr size_t OFF_WT_OOUT = OFF_WT_OIN + (size_t)OLD * D_ * 2;
constexpr size_t OFF_WT13_0 = OFF_WT_OOUT + (size_t)D_ * D_ * 2;
constexpr size_t OFF_WT13_1 = OFF_WT13_0 + (size_t)2 * FF_ * D_ * 2;
constexpr size_t OFF_WT2_0 = OFF_WT13_1 + (size_t)2 * FF_ * D_ * 2;
constexpr size_t OFF_WT2_1 = OFF_WT2_0 + (size_t)D_ * FF_ * 2;
constexpr size_t OFF_W1T_K = OFF_WT2_1 + (size_t)D_ * FF_ * 2;
constexpr size_t OFF_W1T_V = OFF_W1T_K + (size_t)128 * 2048 * 2;
constexpr size_t OFF_W2T_K = OFF_W1T_V + (size_t)128 * 2048 * 2;
constexpr size_t OFF_W2T_V = OFF_W2T_K + (size_t)64 * 128 * 2;
constexpr size_t OFF_BIAS1 = OFF_W2T_V + (size_t)64 * 128 * 2;
constexpr size_t OFF_ROPE = OFF_BIAS1 + 1024;
constexpr size_t OFF_KMEAN = OFF_ROPE + (size_t)2048 * 32 * 8;
constexpr size_t OFF_KC = OFF_KMEAN + (size_t)16 * 16 * 8 * 64 * 4;
constexpr size_t OFF_VC = OFF_KC + (size_t)16 * 4 * 128 * 64 * 2;
constexpr size_t OFF_SEL = OFF_VC + (size_t)16 * 4 * 128 * 64 * 2;
constexpr size_t OFF_H = OFF_SEL + (size_t)16 * 4 * 2048 * 4;
constexpr size_t OFF_Z = OFF_H + (size_t)T_ * D_ * 2;
constexpr size_t OFF_CAT = OFF_Z + (size_t)T_ * EIN * 2;
constexpr size_t OFF_BAR = OFF_CAT + (size_t)T_ * D_ * 2;
constexpr size_t WS_END = OFF_BAR + 16384;

constexpr int LDS_BYTES = 131072 + 16;
constexpr int NPHASE = 18;
#ifndef REP_P0
#define REP_P0 1
#endif
#ifndef REP_RWKV
#define REP_RWKV 1
#endif
#ifndef REP_MOBA
#define REP_MOBA 1
#endif
#ifndef REP_RET
#define REP_RET 1
#endif
#ifndef REP_NSA
#define REP_NSA 1
#endif
#ifndef REP_GEMM
#define REP_GEMM 1
#endif
#ifndef REP_NORM
#define REP_NORM 1
#endif
#ifndef REP_SEL
#define REP_SEL 1
#endif

struct Params {
    const float* in[28];
    float* out;
    unsigned char* ws;
    double inv_freq[32];
    int ph_lo, ph_hi;
};

__device__ __forceinline__ float bf2f(unsigned short b) { return __uint_as_float(((unsigned)b) << 16); }
typedef __bf16 bf16x2_t __attribute__((ext_vector_type(2)));
__device__ __forceinline__ unsigned pk2(float lo, float hi) { f32x2 v; v[0] = lo; v[1] = hi; const bf16x2_t r = __builtin_convertvector(v, bf16x2_t); return __builtin_bit_cast(unsigned, r); }
__device__ __forceinline__ float wave_sum(float v) {
#pragma unroll
    for (int o = 1; o < 64; o <<= 1) v += __shfl_xor(v, o);
    return v;
}
template <int CTRL> __device__ __forceinline__ float dppf(float x) {
    return __int_as_float(__builtin_amdgcn_update_dpp(0, __float_as_int(x), CTRL, 0xf, 0xf, false));
}
__device__ __forceinline__ float rowsum16(float x) {
    x += dppf<0x128>(x);
    x += dppf<0x124>(x);
    x += dppf<0x4E>(x);
    x += dppf<0xB1>(x);
    return x;
}
__device__ __forceinline__ void rowsum16x4(float& a, float& b, float& c, float& d) {
    asm volatile("" : "+v"(a), "+v"(b), "+v"(c), "+v"(d));
    a += dppf<0x128>(a); b += dppf<0x128>(b); c += dppf<0x128>(c); d += dppf<0x128>(d); asm volatile("" : "+v"(a), "+v"(b), "+v"(c), "+v"(d));
    a += dppf<0x124>(a); b += dppf<0x124>(b); c += dppf<0x124>(c); d += dppf<0x124>(d); asm volatile("" : "+v"(a), "+v"(b), "+v"(c), "+v"(d));
    a += dppf<0x4E>(a); b += dppf<0x4E>(b); c += dppf<0x4E>(c); d += dppf<0x4E>(d); asm volatile("" : "+v"(a), "+v"(b), "+v"(c), "+v"(d));
    a += dppf<0xB1>(a); b += dppf<0xB1>(b); c += dppf<0xB1>(c); d += dppf<0xB1>(d); asm volatile("" : "+v"(a), "+v"(b), "+v"(c), "+v"(d));
}
__device__ __forceinline__ float fexp2(float x) { return __builtin_amdgcn_exp2f(x); }
__device__ __forceinline__ float fexp(float x) { return __builtin_amdgcn_exp2f(x * 1.4426950408889634f); }
__device__ __forceinline__ float frcp(float x) { return __builtin_amdgcn_rcpf(x); }
__device__ __forceinline__ float sigmoidf_(float x) { return frcp(1.f + fexp(-x)); }
__device__ __forceinline__ void lds_wait() { asm volatile("s_waitcnt lgkmcnt(0)" ::: "memory"); }
__device__ __forceinline__ void unpack8(u32x4 v, float (&f)[8]) {
    f[0] = __uint_as_float(v.x << 16); f[1] = __uint_as_float(v.x & 0xffff0000u);
    f[2] = __uint_as_float(v.y << 16); f[3] = __uint_as_float(v.y & 0xffff0000u);
    f[4] = __uint_as_float(v.z << 16); f[5] = __uint_as_float(v.z & 0xffff0000u);
    f[6] = __uint_as_float(v.w << 16); f[7] = __uint_as_float(v.w & 0xffff0000u);
}
__device__ __forceinline__ bf16x8 as_bf16x8(u32x4 v) { return __builtin_bit_cast(bf16x8, v); }
__device__ __forceinline__ f32x4 mfma16(bf16x8 a, bf16x8 b, f32x4 c) { return __builtin_amdgcn_mfma_f32_16x16x32_bf16(a, b, c, 0, 0, 0); }

struct EpiAll {
    static constexpr bool PERM = true, AFTER_DRAIN = false;
    int mode; bf16_t* O; int ldc; const float* Xin; float* Xout;
    __device__ __forceinline__ void operator()(const pg8::f32x4 (&acc)[2][2][4][2], const pg8::Unit& u, int wr, int wc, int fr, int fq) const {
        const int row0 = u.pm * 256 + wr * 64 + fr;
        if (mode == 0) {
            const int col0 = u.pn * 256 + wc * 32 + 8 * fq;
#pragma unroll
            for (int ai = 0; ai < 2; ++ai)
#pragma unroll
                for (int m = 0; m < 4; ++m) {
                    bf16_t* rowp = O + (size_t)(row0 + ai * 128 + m * 16) * ldc + col0;
#pragma unroll
                    for (int bj = 0; bj < 2; ++bj) {
                        const pg8::f32x4 v0 = acc[ai][bj][m][0], v1 = acc[ai][bj][m][1];
                        u32x4 w; w.x = pk2(v0[0], v0[1]); w.y = pk2(v0[2], v0[3]); w.z = pk2(v1[0], v1[1]); w.w = pk2(v1[2], v1[3]);
                        GST(u32x4, rowp + bj * 128) = w;
                    }
                }
        } else if (mode == 1) {
            const int col0 = u.pn * 256 + wc * 32 + 8 * fq;
#pragma unroll
            for (int ai = 0; ai < 2; ++ai)
#pragma unroll
                for (int m = 0; m < 4; ++m) {
                    const size_t off = (size_t)(row0 + ai * 128 + m * 16) * D_ + col0;
#pragma unroll
                    for (int bj = 0; bj < 2; ++bj)
#pragma unroll
                        for (int n = 0; n < 2; ++n) {
                            const size_t idx = off + bj * 128 + n * 4;
                            const f32x4 x = GLD(f32x4, Xin + idx);
                            f32x4 r; r[0] = x[0] + acc[ai][bj][m][n][0]; r[1] = x[1] + acc[ai][bj][m][n][1]; r[2] = x[2] + acc[ai][bj][m][n][2]; r[3] = x[3] + acc[ai][bj][m][n][3];
                            GST(f32x4, Xout + idx) = r;
                        }
                }
        } else {
            const int col0 = u.pn * 128 + wc * 32 + 8 * fq;
#pragma unroll
            for (int ai = 0; ai < 2; ++ai)
#pragma unroll
                for (int m = 0; m < 4; ++m) {
                    bf16_t* rowp = O + (size_t)(row0 + ai * 128 + m * 16) * FF_ + col0;
                    float hv[8];
#pragma unroll
                    for (int n = 0; n < 2; ++n)
#pragma unroll
                        for (int j = 0; j < 4; ++j) { const float g = acc[ai][0][m][n][j], up = acc[ai][1][m][n][j]; hv[n * 4 + j] = g * sigmoidf_(g) * up; }
                    u32x4 w; w.x = pk2(hv[0], hv[1]); w.y = pk2(hv[2], hv[3]); w.z = pk2(hv[4], hv[5]); w.w = pk2(hv[6], hv[7]);
                    GST(u32x4, rowp) = w;
                }
        }
    }
};

template <int MODE>
__device__ __forceinline__ void prep_w(const float* Wa, const float* Wb, int K, int Nsrc, bf16_t* WT, int nOutBlocks, float* scr, int gw, int ngw, int lane, const float* gain) {
    const int nkb = K / 64, nitems = nkb * nOutBlocks;
    const int lr = lane >> 3, lc = (lane & 7) * 4;
    f32x4 cur[8], nxt[8];
    auto locate = [&](int it, const float*& src, int& c0, int& k0, int& ob) {
        ob = it % nOutBlocks; k0 = (it / nOutBlocks) * 64;
        if (MODE == 0) { src = Wa; c0 = ob * 32; }
        else { const int pn = ob >> 3, sb = ob & 7; src = (sb < 4) ? Wa : Wb; c0 = (pn * 4 + (sb & 3)) * 32; }
    };
    auto load = [&](int it, f32x4 (&v)[8]) {
        const float* src; int c0, k0, ob; locate(it, src, c0, k0, ob);
        const int col = c0 + lc;
#pragma unroll
        for (int i = 0; i < 8; ++i) v[i] = (col < Nsrc) ? GLD(f32x4, src + (size_t)(k0 + 8 * i + lr) * Nsrc + col) : (f32x4){0.f, 0.f, 0.f, 0.f};
    };
    int it = gw;
    if (it < nitems) load(it, cur);
    for (; it < nitems; it += ngw) {
        const int itn = it + ngw;
        if (itn < nitems) load(itn, nxt);
        const float* src; int c0, k0, ob; locate(it, src, c0, k0, ob);
#pragma unroll
        for (int i = 0; i < 8; ++i) {
            const int kk = 8 * i + lr; const float gk = gain ? gain[k0 + kk] : 1.f;
            float* d = scr + kk * 33 + lc;
            d[0] = cur[i][0] * gk; d[1] = cur[i][1] * gk; d[2] = cur[i][2] * gk; d[3] = cur[i][3] * gk;
        }
        lds_wait();
        const int c = lane & 7;
#pragma unroll
        for (int j = 0; j < 4; ++j) {
            const int n = (lane >> 3) + 8 * j; const float* sp = scr + (8 * c) * 33 + n;
            u32x4 o; o.x = pk2(sp[0 * 33], sp[1 * 33]); o.y = pk2(sp[2 * 33], sp[3 * 33]); o.z = pk2(sp[4 * 33], sp[5 * 33]); o.w = pk2(sp[6 * 33], sp[7 * 33]);
            GST(u32x4, WT + (size_t)(ob * 32 + n) * K + k0 + 8 * c) = o;
        }
        lds_wait();
#pragma unroll
        for (int i = 0; i < 8; ++i) cur[i] = nxt[i];
    }
}

__device__ __forceinline__ void rmsnorm_rows(const float* X, const float* g, bf16_t* H, float* OutF, int gw, int ngw, int lane) {
    f32x4 gv[8];
#pragma unroll
    for (int j = 0; j < 8; ++j) gv[j] = GLD(f32x4, (const f32x4*)g + lane + 64 * j);
    f32x4 v[8], vn[8];
    int m = gw;
    if (m < T_) {
#pragma unroll
        for (int j = 0; j < 8; ++j) v[j] = GLD(f32x4, (const f32x4*)(X + (size_t)m * D_) + lane + 64 * j);
    }
    for (; m < T_; m += ngw) {
        const int mn = m + ngw;
        if (mn < T_) {
#pragma unroll
            for (int j = 0; j < 8; ++j) vn[j] = GLD(f32x4, (const f32x4*)(X + (size_t)mn * D_) + lane + 64 * j);
        }
        float ss = 0.f;
#pragma unroll
        for (int j = 0; j < 8; ++j) ss += (v[j][0] * v[j][0] + v[j][1] * v[j][1]) + (v[j][2] * v[j][2] + v[j][3] * v[j][3]);
        ss = wave_sum(ss);
        const float rstd = rsqrtf(ss * (1.f / D_) + EPS_);
#pragma unroll
        for (int j = 0; j < 8; ++j) {
            const float y0 = v[j][0] * rstd * gv[j][0], y1 = v[j][1] * rstd * gv[j][1], y2 = v[j][2] * rstd * gv[j][2], y3 = v[j][3] * rstd * gv[j][3];
            if (H) { u32x2 o; o.x = pk2(y0, y1); o.y = pk2(y2, y3); GST(u32x2, H + (size_t)m * D_ + (lane + 64 * j) * 4) = o; }
            if (OutF) { f32x4 o; o[0] = y0; o[1] = y1; o[2] = y2; o[3] = y3; GST(f32x4, (f32x4*)(OutF + (size_t)m * D_) + lane + 64 * j) = o; }
        }
#pragma unroll
        for (int j = 0; j < 8; ++j) v[j] = vn[j];
    }
}

__device__ __forceinline__ void phase0(const Params& p, unsigned char* smem, int tid, int bid, int nblk) {
    const int lane = tid & 63, wave = tid >> 6;
    const int gw = bid * 8 + wave, ngw = nblk * 8;
    float* scr = (float*)(smem + wave * 8448);
    unsigned char* ws = p.ws;
    prep_w<0>(p.in[3], nullptr, D_, EIN, (bf16_t*)(ws + OFF_WT_EIN), EIN / 32, scr, gw, ngw, lane, nullptr);
    prep_w<0>(p.in[15], nullptr, D_, D_, (bf16_t*)(ws + OFF_WT_EOUT), D_ / 32, scr, gw, ngw, lane, nullptr);
    prep_w<0>(p.in[16], nullptr, D_, OIN, (bf16_t*)(ws + OFF_WT_OIN), OLD / 32, scr, gw, ngw, lane, nullptr);
    prep_w<0>(p.in[23], nullptr, D_, D_, (bf16_t*)(ws + OFF_WT_OOUT), D_ / 32, scr, gw, ngw, lane, nullptr);
    prep_w<1>(p.in[24], p.in[25], D_, FF_, (bf16_t*)(ws + OFF_WT13_0), 2 * FF_ / 32, scr, gw, ngw, lane, nullptr);
    prep_w<1>(p.in[24] + (size_t)D_ * FF_, p.in[25] + (size_t)D_ * FF_, D_, FF_, (bf16_t*)(ws + OFF_WT13_1), 2 * FF_ / 32, scr, gw, ngw, lane, nullptr);
    prep_w<0>(p.in[26], nullptr, FF_, D_, (bf16_t*)(ws + OFF_WT2_0), D_ / 32, scr, gw, ngw, lane, nullptr);
    prep_w<0>(p.in[26] + (size_t)FF_ * D_, nullptr, FF_, D_, (bf16_t*)(ws + OFF_WT2_1), D_ / 32, scr, gw, ngw, lane, nullptr);
    prep_w<0>(p.in[18], nullptr, 2048, 128, (bf16_t*)(ws + OFF_W1T_K), 4, scr, gw, ngw, lane, nullptr);
    prep_w<0>(p.in[21], nullptr, 2048, 128, (bf16_t*)(ws + OFF_W1T_V), 4, scr, gw, ngw, lane, nullptr);
    prep_w<0>(p.in[19], nullptr, 128, 64, (bf16_t*)(ws + OFF_W2T_K), 2, scr, gw, ngw, lane, nullptr);
    prep_w<0>(p.in[22], nullptr, 128, 64, (bf16_t*)(ws + OFF_W2T_V), 2, scr, gw, ngw, lane, nullptr);
    if (gw < 256) {
        const int kv = gw >> 7, n = gw & 127;
        const float* pe = p.in[kv ? 20 : 17]; const float* w1 = p.in[kv ? 21 : 18];
        float s = 0.f;
        for (int k = lane; k < 2048; k += 64) s += pe[k] * w1[(size_t)k * 128 + n];
        s = wave_sum(s);
        if (lane == 0) ((float*)(ws + OFF_BIAS1))[gw] = s;
    }
    {
        f32x2* rope = (f32x2*)(ws + OFF_ROPE);
        for (int e = bid * 512 + tid; e < 2048 * 32; e += nblk * 512) {
            const int pos = e >> 5, i = e & 31;
            const double ang = (double)pos * p.inv_freq[i];
            const double kq = rint(ang * 0.63661977236758134308);
            double r = fma(-kq, 1.57079632679489655800e+00, ang);
            r = fma(-kq, 6.12323399573676603587e-17, r);
            const float rf = (float)r;
            const float r2 = rf * rf;
            const float sn = rf * (1.f + r2 * (-1.6666667e-1f + r2 * (8.3333333e-3f + r2 * (-1.9841270e-4f + r2 * 2.7557319e-6f))));
            const float cs = 1.f + r2 * (-0.5f + r2 * (4.1666667e-2f + r2 * (-1.3888889e-3f + r2 * (2.4801587e-5f + r2 * -2.7557319e-7f))));
            const int q = ((int)kq) & 3;
            float c, s;
            if (q == 0) { c = cs; s = sn; } else if (q == 1) { c = -sn; s = cs; } else if (q == 2) { c = -cs; s = -sn; } else { c = sn; s = -cs; }
            f32x2 o; o[0] = c; o[1] = s; rope[e] = o;
        }
    }
    rmsnorm_rows(p.in[0], p.in[1], (bf16_t*)(ws + OFF_H), nullptr, gw, ngw, lane);
}

enum { M_MOBA = 0, M_SLC = 1, M_WIN = 2, M_CMP = 3, M_RET = 4 };
template <int MODE, int DV>
__device__ __forceinline__ void attn_pass(unsigned char* smem, const bf16_t* Qb, int ldq, const bf16_t* Kb, int ldk, const bf16_t* Vb, int ldv,
                                          int q0, unsigned rowmask, float log2g, f32x4 (&o)[DV / 16], int tid) {
    constexpr int VST = DV + 8;
    const int lane = tid & 63, wave = tid >> 6, lq = lane & 15, quad = lane >> 4;
    const int t = q0 + wave * 16 + lq;
    constexpr int KSZ = 64 * 72 * 2, BUFSZ = KSZ + 64 * VST * 2;
    bf16x8 qf[2];
#pragma unroll
    for (int ks = 0; ks < 2; ++ks) qf[ks] = as_bf16x8(GLD(u32x4, Qb + (size_t)t * ldq + quad * 8 + 32 * ks));
    float m = -INFINITY, l = 0.f;
#pragma unroll
    for (int c = 0; c < DV / 16; ++c) o[c] = (f32x4){0.f, 0.f, 0.f, 0.f};
    int kt_lo = 0, kt_hi = (q0 + 127) >> 6;
    if (MODE == M_WIN) { const int lo = q0 - 511; kt_lo = (lo > 0 ? lo : 0) >> 6; }
    if (MODE == M_CMP) { kt_hi = 1; }
    constexpr float SC = 0.125f * 1.4426950408889634f;
    const int q4 = lq >> 2, pp = lq & 3;
    float dk[4][4];
#pragma unroll
    for (int sub = 0; sub < 4; ++sub)
#pragma unroll
        for (int j = 0; j < 4; ++j) dk[sub][j] = (MODE == M_RET) ? 0.125f * fexp2(-(float)(16 * sub + 4 * quad + j) * log2g) : 0.f;
    const int rk_ = tid >> 3, chk_ = tid & 7;
    u32x4 kreg, vreg[DV / 64];
    auto gload = [&](int kt) {
        kreg = GLD(u32x4, Kb + (size_t)(kt * 64 + rk_) * ldk + chk_ * 8);
#pragma unroll
        for (int i = 0; i < DV / 64; ++i) { const int idx = tid + i * 512; const int r = idx / (DV / 8), ch = idx % (DV / 8); vreg[i] = GLD(u32x4, Vb + (size_t)(kt * 64 + r) * ldv + ch * 8); }
    };
    auto lstore = [&](int b) {
        bf16_t* Ks_ = (bf16_t*)(smem + b * BUFSZ); bf16_t* Vs_ = (bf16_t*)(smem + b * BUFSZ + KSZ);
        *(u32x4*)(Ks_ + rk_ * 72 + chk_ * 8) = kreg;
#pragma unroll
        for (int i = 0; i < DV / 64; ++i) { const int idx = tid + i * 512; const int r = idx / (DV / 8), ch = idx % (DV / 8); *(u32x4*)(Vs_ + r * VST + ch * 8) = vreg[i]; }
    };
    gload(kt_lo);
    __syncthreads();
    lstore(0);
    if (kt_lo + 1 <= kt_hi) gload(kt_lo + 1);
    __syncthreads();
    int bsel = 0;
    for (int kt = kt_lo; kt <= kt_hi; ++kt, bsel ^= 1) {
        if (kt + 1 <= kt_hi) lstore(bsel ^ 1);
        if (kt + 2 <= kt_hi) gload(kt + 2);
        const bf16_t* Ks = (const bf16_t*)(smem + bsel * BUFSZ); const bf16_t* Vs = (const bf16_t*)(smem + bsel * BUFSZ + KSZ);
        const int kbase = kt * 64;
        bool lane_any;
        if (MODE == M_MOBA) lane_any = (kbase <= t) && ((rowmask >> (kt >> 2)) & 1u);
        else if (MODE == M_SLC) lane_any = (kbase <= t) && ((rowmask >> kt) & 1u);
        else if (MODE == M_WIN) lane_any = (kbase <= t) && (kbase + 63 > t - 512);
        else if (MODE == M_CMP) lane_any = (kbase * 16 + 31 <= t);
        else lane_any = (kbase <= t);
        if (__any(lane_any ? 1 : 0)) {
        f32x4 s[4];
#pragma unroll
        for (int sub = 0; sub < 4; ++sub) {
            s[sub] = (f32x4){0.f, 0.f, 0.f, 0.f};
#pragma unroll
            for (int ks = 0; ks < 2; ++ks) { const bf16x8 a = as_bf16x8(*(const u32x4*)(Ks + (16 * sub + lq) * 72 + quad * 8 + 32 * ks)); s[sub] = mfma16(a, qf[ks], s[sub]); }
        }
        float pv[4][4];
        const int t_min = q0 + wave * 16;
        bool need_mask;
        if (MODE == M_WIN) need_mask = (kbase + 63 > t_min) || (kbase <= t_min + 15 - 512);
        else if (MODE == M_CMP) need_mask = true;
        else need_mask = (kbase + 63 > t_min);
        if (MODE != M_RET) {
            float mx = -INFINITY;
            if (need_mask) {
#pragma unroll
                for (int sub = 0; sub < 4; ++sub)
#pragma unroll
                    for (int j = 0; j < 4; ++j) {
                        const int key = kbase + 16 * sub + 4 * quad + j;
                        bool valid;
                        if (MODE == M_MOBA || MODE == M_SLC) valid = lane_any && (key <= t);
                        else if (MODE == M_WIN) valid = (key <= t) && (key > t - 512);
                        else valid = (key * 16 + 31 <= t);
                        const float sv = valid ? s[sub][j] : -INFINITY;
                        pv[sub][j] = sv; mx = fmaxf(mx, sv);
                    }
            } else if (MODE == M_MOBA || MODE == M_SLC) {
#pragma unroll
                for (int sub = 0; sub < 4; ++sub)
#pragma unroll
                    for (int j = 0; j < 4; ++j) { const float sv = lane_any ? s[sub][j] : -INFINITY; pv[sub][j] = sv; mx = fmaxf(mx, sv); }
            } else {
#pragma unroll
                for (int sub = 0; sub < 4; ++sub)
#pragma unroll
                    for (int j = 0; j < 4; ++j) { pv[sub][j] = s[sub][j]; mx = fmaxf(mx, s[sub][j]); }
            }
            mx = fmaxf(mx, __shfl_xor(mx, 16)); mx = fmaxf(mx, __shfl_xor(mx, 32));
            const float m_new = fmaxf(m, mx * SC);
            const float m_use = (m_new == -INFINITY) ? 0.f : m_new;
            const float alpha = fexp2(m - m_use);
            float rs = 0.f;
#pragma unroll
            for (int sub = 0; sub < 4; ++sub)
#pragma unroll
                for (int j = 0; j < 4; ++j) { const float e = fexp2(__builtin_fmaf(pv[sub][j], SC, -m_use)); pv[sub][j] = e; rs += e; }
            l = l * alpha + rs; m = m_new;
#pragma unroll
            for (int c = 0; c < DV / 16; ++c) { o[c][0] *= alpha; o[c][1] *= alpha; o[c][2] *= alpha; o[c][3] *= alpha; }
        } else {
            const float rowfac = fexp2((float)(t - kbase) * log2g);
            if (need_mask) {
#pragma unroll
                for (int sub = 0; sub < 4; ++sub)
#pragma unroll
                    for (int j = 0; j < 4; ++j) { const int key = kbase + 16 * sub + 4 * quad + j; pv[sub][j] = (key <= t) ? (s[sub][j] * dk[sub][j]) * rowfac : 0.f; }
            } else {
#pragma unroll
                for (int sub = 0; sub < 4; ++sub)
#pragma unroll
                    for (int j = 0; j < 4; ++j) pv[sub][j] = (s[sub][j] * dk[sub][j]) * rowfac;
            }
        }
        bf16x8 pb[2];
#pragma unroll
        for (int s2 = 0; s2 < 2; ++s2) {
            u32x4 w; w.x = pk2(pv[2 * s2][0], pv[2 * s2][1]); w.y = pk2(pv[2 * s2][2], pv[2 * s2][3]); w.z = pk2(pv[2 * s2 + 1][0], pv[2 * s2 + 1][1]); w.w = pk2(pv[2 * s2 + 1][2], pv[2 * s2 + 1][3]);
            pb[s2] = as_bf16x8(w);
        }
#pragma unroll
        for (int c = 0; c < DV / 16; ++c)
#pragma unroll
            for (int s2 = 0; s2 < 2; ++s2) {
                const s16x4 t1 = __builtin_amdgcn_ds_read_tr16_b64_v4i16((LAS s16x4*)(Vs + (32 * s2 + 4 * quad + q4) * VST + 16 * c + 4 * pp));
                const s16x4 t2 = __builtin_amdgcn_ds_read_tr16_b64_v4i16((LAS s16x4*)(Vs + (32 * s2 + 16 + 4 * quad + q4) * VST + 16 * c + 4 * pp));
                bf16x8 a; a[0] = t1[0]; a[1] = t1[1]; a[2] = t1[2]; a[3] = t1[3]; a[4] = t2[0]; a[5] = t2[1]; a[6] = t2[2]; a[7] = t2[3];
                o[c] = mfma16(a, pb[s2], o[c]);
            }
            }
        __syncthreads();
    }
    if (MODE != M_RET) {
        l += __shfl_xor(l, 16); l += __shfl_xor(l, 32);
        const float inv = (l > 0.f) ? 1.f / l : 1.f;
#pragma unroll
        for (int c = 0; c < DV / 16; ++c) { o[c][0] *= inv; o[c][1] *= inv; o[c][2] *= inv; o[c][3] *= inv; }
    }
}


template <int MODE>
__device__ __forceinline__ void attn_pass2(unsigned char* smem, const bf16_t* Qb, int ldq, const bf16_t* Kb, int ldk, const bf16_t* Vb, int ldv,
                                           int q0, const unsigned (&rowmask)[2], f32x4 (&o)[2][4], int tid) {
    constexpr int VST = 72;
    const int lane = tid & 63, wave = tid >> 6, lq = lane & 15, quad = lane >> 4;
    const int t_min = q0 + wave * 32;
    int t[2]; t[0] = t_min + lq; t[1] = t_min + 16 + lq;
    constexpr int KSZ = 64 * 72 * 2, BUFSZ = KSZ + 64 * VST * 2;
    bf16x8 qf[2][2];
#pragma unroll
    for (int qs = 0; qs < 2; ++qs)
#pragma unroll
        for (int ks = 0; ks < 2; ++ks) qf[qs][ks] = as_bf16x8(GLD(u32x4, Qb + (size_t)t[qs] * ldq + quad * 8 + 32 * ks));
    float m[2], l[2];
#pragma unroll
    for (int qs = 0; qs < 2; ++qs) { m[qs] = -INFINITY; l[qs] = 0.f;
#pragma unroll
        for (int c = 0; c < 4; ++c) o[qs][c] = (f32x4){0.f, 0.f, 0.f, 0.f}; }
    int kt_lo = 0, kt_hi = (q0 + 255) >> 6;
    if (MODE == M_WIN) { const int lo = q0 - 511; kt_lo = (lo > 0 ? lo : 0) >> 6; }
    if (MODE == M_CMP) { kt_hi = (q0 + 255 >= 64 * 16 + 31) ? 1 : 0; }
    constexpr float SC = 0.125f * 1.4426950408889634f;
    const int q4 = lq >> 2, pp = lq & 3;
    const int rk_ = tid >> 3, chk_ = tid & 7;
    u32x4 kreg, vreg;
    auto gload = [&](int kt) {
        kreg = GLD(u32x4, Kb + (size_t)(kt * 64 + rk_) * ldk + chk_ * 8);
        vreg = GLD(u32x4, Vb + (size_t)(kt * 64 + rk_) * ldv + chk_ * 8);
    };
    auto lstore = [&](int b) {
        bf16_t* Ks_ = (bf16_t*)(smem + b * BUFSZ); bf16_t* Vs_ = (bf16_t*)(smem + b * BUFSZ + KSZ);
        *(u32x4*)(Ks_ + rk_ * 72 + chk_ * 8) = kreg;
        *(u32x4*)(Vs_ + rk_ * VST + chk_ * 8) = vreg;
    };
    gload(kt_lo);
    __syncthreads();
    lstore(0);
    if (kt_lo + 1 <= kt_hi) gload(kt_lo + 1);
    __syncthreads();
    int bsel = 0;
    for (int kt = kt_lo; kt <= kt_hi; ++kt, bsel ^= 1) {
        if (kt + 1 <= kt_hi) lstore(bsel ^ 1);
        if (kt + 2 <= kt_hi) gload(kt + 2);
        const bf16_t* Ks = (const bf16_t*)(smem + bsel * BUFSZ); const bf16_t* Vs = (const bf16_t*)(smem + bsel * BUFSZ + KSZ);
        const int kbase = kt * 64;
        bool la[2];
#pragma unroll
        for (int qs = 0; qs < 2; ++qs) {
            if (MODE == M_MOBA) la[qs] = (kbase <= t[qs]) && ((rowmask[qs] >> (kt >> 2)) & 1u);
            else if (MODE == M_SLC) la[qs] = (kbase <= t[qs]) && ((rowmask[qs] >> kt) & 1u);
            else if (MODE == M_WIN) la[qs] = (kbase <= t[qs]) && (kbase + 63 > t[qs] - 512);
            else la[qs] = (kbase * 16 + 31 <= t[qs]);
        }
        if (__any((la[0] || la[1]) ? 1 : 0)) {
            f32x4 s[2][4];
#pragma unroll
            for (int sub = 0; sub < 4; ++sub) {
                s[0][sub] = (f32x4){0.f, 0.f, 0.f, 0.f}; s[1][sub] = (f32x4){0.f, 0.f, 0.f, 0.f};
#pragma unroll
                for (int ks = 0; ks < 2; ++ks) {
                    const bf16x8 a = as_bf16x8(*(const u32x4*)(Ks + (16 * sub + lq) * 72 + quad * 8 + 32 * ks));
                    s[0][sub] = mfma16(a, qf[0][ks], s[0][sub]); s[1][sub] = mfma16(a, qf[1][ks], s[1][sub]);
                }
            }
            bool need_mask;
            if (MODE == M_WIN) need_mask = (kbase + 63 > t_min) || (kbase <= t_min + 31 - 512);
            else if (MODE == M_CMP) need_mask = true;
            else need_mask = (kbase + 63 > t_min);
            bf16x8 pb[2][2];
#pragma unroll
            for (int qs = 0; qs < 2; ++qs) {
                float mx = -INFINITY, kill = 0.f;
                if (need_mask) {
#pragma unroll
                    for (int sub = 0; sub < 4; ++sub)
#pragma unroll
                        for (int j = 0; j < 4; ++j) {
                            const int key = kbase + 16 * sub + 4 * quad + j;
                            bool valid;
                            if (MODE == M_MOBA || MODE == M_SLC) valid = la[qs] && (key <= t[qs]);
                            else if (MODE == M_WIN) valid = (key <= t[qs]) && (key > t[qs] - 512);
                            else valid = (key * 16 + 31 <= t[qs]);
                            const float sv = valid ? s[qs][sub][j] : -INFINITY;
                            s[qs][sub][j] = sv; mx = fmaxf(mx, sv);
                        }
                } else if (MODE == M_MOBA || MODE == M_SLC) {
#pragma unroll
                    for (int sub = 0; sub < 4; ++sub)
#pragma unroll
                        for (int j = 0; j < 4; ++j) mx = fmaxf(mx, s[qs][sub][j]);
                    mx = la[qs] ? mx : -INFINITY;
                    kill = la[qs] ? 0.f : INFINITY;
                } else {
#pragma unroll
                    for (int sub = 0; sub < 4; ++sub)
#pragma unroll
                        for (int j = 0; j < 4; ++j) mx = fmaxf(mx, s[qs][sub][j]);
                }
                mx = fmaxf(mx, __shfl_xor(mx, 16)); mx = fmaxf(mx, __shfl_xor(mx, 32));
                const float m_new = fmaxf(m[qs], mx * SC);
                const float m_use = (m_new == -INFINITY) ? 0.f : m_new;
                const float alpha = fexp2(m[qs] - m_use);
                const float msub = m_use + kill;
                float rs = 0.f;
#pragma unroll
                for (int sub = 0; sub < 4; ++sub)
#pragma unroll
                    for (int j = 0; j < 4; ++j) { const float e = fexp2(__builtin_fmaf(s[qs][sub][j], SC, -msub)); s[qs][sub][j] = e; rs += e; }
                l[qs] = l[qs] * alpha + rs; m[qs] = m_new;
#pragma unroll
                for (int c = 0; c < 4; ++c) { o[qs][c][0] *= alpha; o[qs][c][1] *= alpha; o[qs][c][2] *= alpha; o[qs][c][3] *= alpha; }
#pragma unroll
                for (int s2 = 0; s2 < 2; ++s2) {
                    u32x4 w; w.x = pk2(s[qs][2 * s2][0], s[qs][2 * s2][1]); w.y = pk2(s[qs][2 * s2][2], s[qs][2 * s2][3]);
                    w.z = pk2(s[qs][2 * s2 + 1][0], s[qs][2 * s2 + 1][1]); w.w = pk2(s[qs][2 * s2 + 1][2], s[qs][2 * s2 + 1][3]);
                    pb[qs][s2] = as_bf16x8(w);
                }
            }
#pragma unroll
            for (int c = 0; c < 4; ++c)
#pragma unroll
                for (int s2 = 0; s2 < 2; ++s2) {
                    const s16x4 t1 = __builtin_amdgcn_ds_read_tr16_b64_v4i16((LAS s16x4*)(Vs + (32 * s2 + 4 * quad + q4) * VST + 16 * c + 4 * pp));
                    const s16x4 t2 = __builtin_amdgcn_ds_read_tr16_b64_v4i16((LAS s16x4*)(Vs + (32 * s2 + 16 + 4 * quad + q4) * VST + 16 * c + 4 * pp));
                    bf16x8 a; a[0] = t1[0]; a[1] = t1[1]; a[2] = t1[2]; a[3] = t1[3]; a[4] = t2[0]; a[5] = t2[1]; a[6] = t2[2]; a[7] = t2[3];
                    o[0][c] = mfma16(a, pb[0][s2], o[0][c]); o[1][c] = mfma16(a, pb[1][s2], o[1][c]);
                }
        }
        __syncthreads();
    }
#pragma unroll
    for (int qs = 0; qs < 2; ++qs) {
        float lt = l[qs];
        lt += __shfl_xor(lt, 16); lt += __shfl_xor(lt, 32);
        const float inv = (lt > 0.f) ? 1.f / lt : 1.f;
#pragma unroll
        for (int c = 0; c < 4; ++c) { o[qs][c][0] *= inv; o[qs][c][1] *= inv; o[qs][c][2] *= inv; o[qs][c][3] *= inv; }
    }
}

__device__ __forceinline__ void kmean_phase(const Params& p, int tid, int bid, int nblk) {
    const bf16_t* Z = (const bf16_t*)(p.ws + OFF_Z);
    float* km = (float*)(p.ws + OFF_KMEAN);
    for (int it = bid; it < 256; it += nblk) {
        const int b = it >> 4, n = (it >> 1) & 7, half = it & 1;
        const int ch = half * 512 + tid;
        const bf16_t* src = Z + ((size_t)(b * S_ + n * 256)) * EIN + 1024 + ch;
        float s = 0.f;
#pragma unroll 8
        for (int tt = 0; tt < 256; ++tt) s += bf2f(GLD(bf16_t, src + (size_t)tt * EIN));
        const int h = ch >> 6, d = ch & 63;
        GST(float, km + ((size_t)(b * 16 + h) * 8 + n) * 64 + d) = s * (1.f / 256.f);
    }
}

__device__ __forceinline__ void moba_item(const Params& p, unsigned char* smem, int b, int h, int qt, int tid) {
    const int lane = tid & 63, wave = tid >> 6, lq = lane & 15, quad = lane >> 4;
    const bf16_t* Z = (const bf16_t*)(p.ws + OFF_Z) + (size_t)b * S_ * EIN;
    const int q0 = qt * 128, t = q0 + wave * 16 + lq, own = q0 >> 8;
    unsigned rowmask = 1u << own;
    if (own > 0) {
        const float* km = (const float*)(p.ws + OFF_KMEAN) + (size_t)(b * 16 + h) * 8 * 64;
        u32x4 zq[8];
#pragma unroll
        for (int c8 = 0; c8 < 8; ++c8) zq[c8] = GLD(u32x4, Z + (size_t)t * EIN + h * 64 + c8 * 8);
        float g2[2] = {0.f, 0.f};
#pragma unroll
        for (int i = 0; i < 2; ++i) {
            const int n = quad + 4 * i;
            if (n < own) {
                f32x4 kv[16];
#pragma unroll
                for (int d4 = 0; d4 < 16; ++d4) kv[d4] = GLD(f32x4, km + n * 64 + d4 * 4);
                float acc = 0.f;
#pragma unroll
                for (int c8 = 0; c8 < 8; ++c8) {
                    float f[8]; unpack8(zq[c8], f);
                    acc += (f[0] * kv[2 * c8][0] + f[1] * kv[2 * c8][1]) + (f[2] * kv[2 * c8][2] + f[3] * kv[2 * c8][3])
                         + (f[4] * kv[2 * c8 + 1][0] + f[5] * kv[2 * c8 + 1][1]) + (f[6] * kv[2 * c8 + 1][2] + f[7] * kv[2 * c8 + 1][3]);
                }
                g2[i] = acc;
            }
        }
        float gsc[7];
#pragma unroll
        for (int n = 0; n < 7; ++n) gsc[n] = __shfl((n >> 2) ? g2[1] : g2[0], lq + 16 * (n & 3));
#pragma unroll
        for (int n = 0; n < 7; ++n) {
            int cnt = 0;
#pragma unroll
            for (int n2 = 0; n2 < 7; ++n2) { if (n2 != n) { const bool beats = (gsc[n2] > gsc[n]) || (gsc[n2] == gsc[n] && n2 < n); cnt += (n2 < own && beats) ? 1 : 0; } }
            if (n < own && cnt < 3) rowmask |= (1u << n);
        }
    }
    f32x4 o[4];
    attn_pass<M_MOBA, 64>(smem, Z + h * 64, EIN, Z + 1024 + h * 64, EIN, Z + 2048 + h * 64, EIN, q0, rowmask, 0.f, o, tid);
    bf16_t* cat = (bf16_t*)(p.ws + OFF_CAT) + (size_t)(b * S_ + t) * D_ + h * 64;
#pragma unroll
    for (int c = 0; c < 4; ++c) { u32x2 w; w.x = pk2(o[c][0], o[c][1]); w.y = pk2(o[c][2], o[c][3]); GST(u32x2, cat + 16 * c + 4 * quad) = w; }
}


__device__ __forceinline__ void moba_item2(const Params& p, unsigned char* smem, int b, int h, int qt, int tid) {
    const int lane = tid & 63, wave = tid >> 6, lq = lane & 15, quad = lane >> 4;
    const bf16_t* Z = (const bf16_t*)(p.ws + OFF_Z) + (size_t)b * S_ * EIN;
    const int q0 = qt * 256, own = qt;
    int t[2]; t[0] = q0 + wave * 32 + lq; t[1] = t[0] + 16;
    unsigned rowmask[2]; rowmask[0] = 1u << own; rowmask[1] = 1u << own;
    if (own > 0) {
        const float* km = (const float*)(p.ws + OFF_KMEAN) + (size_t)(b * 16 + h) * 8 * 64;
        u32x4 zq[2][8];
#pragma unroll
        for (int qs = 0; qs < 2; ++qs)
#pragma unroll
            for (int c8 = 0; c8 < 8; ++c8) zq[qs][c8] = GLD(u32x4, Z + (size_t)t[qs] * EIN + h * 64 + c8 * 8);
        float g2[2][2] = {{0.f, 0.f}, {0.f, 0.f}};
#pragma unroll
        for (int i = 0; i < 2; ++i) {
            const int n = quad + 4 * i;
            if (n < own) {
                f32x4 kv[16];
#pragma unroll
                for (int d4 = 0; d4 < 16; ++d4) kv[d4] = GLD(f32x4, km + n * 64 + d4 * 4);
#pragma unroll
                for (int qs = 0; qs < 2; ++qs) {
                    float acc = 0.f;
#pragma unroll
                    for (int c8 = 0; c8 < 8; ++c8) {
                        float f[8]; unpack8(zq[qs][c8], f);
                        acc += (f[0] * kv[2 * c8][0] + f[1] * kv[2 * c8][1]) + (f[2] * kv[2 * c8][2] + f[3] * kv[2 * c8][3])
                             + (f[4] * kv[2 * c8 + 1][0] + f[5] * kv[2 * c8 + 1][1]) + (f[6] * kv[2 * c8 + 1][2] + f[7] * kv[2 * c8 + 1][3]);
                    }
                    g2[qs][i] = acc;
                }
            }
        }
#pragma unroll
        for (int qs = 0; qs < 2; ++qs) {
            float gsc[7];
#pragma unroll
            for (int n = 0; n < 7; ++n) gsc[n] = __shfl((n >> 2) ? g2[qs][1] : g2[qs][0], lq + 16 * (n & 3));
#pragma unroll
            for (int n = 0; n < 7; ++n) {
                int cnt = 0;
#pragma unroll
                for (int n2 = 0; n2 < 7; ++n2) { if (n2 != n) { const bool beats = (gsc[n2] > gsc[n]) || (gsc[n2] == gsc[n] && n2 < n); cnt += (n2 < own && beats) ? 1 : 0; } }
                if (n < own && cnt < 3) rowmask[qs] |= (1u << n);
            }
        }
    }
    f32x4 o[2][4];
    attn_pass2<M_MOBA>(smem, Z + h * 64, EIN, Z + 1024 + h * 64, EIN, Z + 2048 + h * 64, EIN, q0, rowmask, o, tid);
#pragma unroll
    for (int qs = 0; qs < 2; ++qs) {
        bf16_t* cat = (bf16_t*)(p.ws + OFF_CAT) + (size_t)(b * S_ + t[qs]) * D_ + h * 64;
#pragma unroll
        for (int c = 0; c < 4; ++c) { u32x2 w; w.x = pk2(o[qs][c][0], o[qs][c][1]); w.y = pk2(o[qs][c][2], o[qs][c][3]); GST(u32x2, cat + 16 * c + 4 * quad) = w; }
    }
}

__device__ __forceinline__ void rwkv_item(const Params& p, unsigned char* smem, int b, int h, int tid) {
    const int lane = tid & 63, wave = tid >> 6, lq = lane & 15, quad = lane >> 4;
    constexpr int ZB = 3072;
    const bf16_t* Z = (const bf16_t*)(p.ws + OFF_Z) + (size_t)b * S_ * EIN;
    const float* mu = p.in[4];
    float* R = (float*)smem;
    float* KP = R + 2048; float* V = KP + 2048; float* DEC = V + 2048; float* NKK = DEC + 2048; float* KKA = NKK + 2048;
    float* GG = KKA + 2048; float* Y = GG + 2048; float* AA = Y + 2048; float* BC = AA + 2048;
    bf16_t* TW = (bf16_t*)(BC + 64);
    bf16_t* AL = TW + 32 * 72;
    bf16_t* GL = AL + 32 * 72;
    const int mt = wave >> 2, nt = wave & 3;
    const int chn = h * 64 + 16 * nt + lq;
    bf16x8 bw[2], ba[2], bg[4];
    {
        const float* wup = p.in[6]; const float* aup = p.in[8]; const float* gup = p.in[9];
#pragma unroll
        for (int ks = 0; ks < 2; ++ks) {
            float fw[8], fa[8];
#pragma unroll
            for (int i = 0; i < 8; ++i) { const int k = 32 * ks + quad * 8 + i; fw[i] = wup[(size_t)k * 1024 + chn]; fa[i] = aup[(size_t)k * 1024 + chn]; }
            u32x4 w; w.x = pk2(fw[0], fw[1]); w.y = pk2(fw[2], fw[3]); w.z = pk2(fw[4], fw[5]); w.w = pk2(fw[6], fw[7]); bw[ks] = as_bf16x8(w);
            u32x4 a; a.x = pk2(fa[0], fa[1]); a.y = pk2(fa[2], fa[3]); a.z = pk2(fa[4], fa[5]); a.w = pk2(fa[6], fa[7]); ba[ks] = as_bf16x8(a);
        }
#pragma unroll
        for (int ks = 0; ks < 4; ++ks) {
            float fg[8];
#pragma unroll
            for (int i = 0; i < 8; ++i) { const int k = 32 * ks + quad * 8 + i; fg[i] = gup[(size_t)k * 1024 + chn]; }
            u32x4 g; g.x = pk2(fg[0], fg[1]); g.y = pk2(fg[2], fg[3]); g.z = pk2(fg[4], fg[5]); g.w = pk2(fg[6], fg[7]); bg[ks] = as_bf16x8(g);
        }
    }
    const float w0c = p.in[5][chn], a0c = p.in[7][chn];
    const int cs = tid & 15, ttC = tid >> 4;
    const f32x4 kkc = *(const f32x4*)(p.in[10] + h * 64 + 4 * cs), kac = *(const f32x4*)(p.in[11] + h * 64 + 4 * cs), rkc = *(const f32x4*)(p.in[12] + h * 64 + 4 * cs);
    const f32x4 lng = *(const f32x4*)(p.in[13] + h * 64 + 4 * cs), lnb = *(const f32x4*)(p.in[14] + h * 64 + 4 * cs);
    const int js = tid & 15, rp = tid >> 4;
    f32x2 P[4];
#pragma unroll
    for (int e = 0; e < 4; ++e) P[e] = (f32x2){0.f, 0.f};
    bf16_t* cat = (bf16_t*)(p.ws + OFF_CAT) + (size_t)b * S_ * D_ + 1024 + h * 64;

    int a_off[4];
#pragma unroll
    for (int i = 0; i < 4; ++i) {
        const int idx = tid + 512 * i; const int tt = idx / 56, cv = idx % 56;
        int zc;
        if (cv < 8) zc = ZB + h * 64 + cv * 8;
        else if (cv < 16) zc = ZB + 1024 + h * 64 + (cv - 8) * 8;
        else if (cv < 24) zc = ZB + 2048 + h * 64 + (cv - 16) * 8;
        else zc = ZB + 3072 + (cv - 24) * 8;
        a_off[i] = (idx < 1792) ? (tt * EIN + zc) : zc;
    }
    u32x4 a_cur[4], a_prv[4];
#pragma unroll
    for (int i = 0; i < 4; ++i) {
        const bool act = (i < 3) || (tid < 256);
        a_cur[i] = (u32x4){0u, 0u, 0u, 0u}; a_prv[i] = (u32x4){0u, 0u, 0u, 0u};
        if (act) { a_cur[i] = GLD(u32x4, Z + a_off[i]); if (a_off[i] >= EIN) a_prv[i] = GLD(u32x4, Z + a_off[i] - EIN); }
    }
    for (int t0 = 0; t0 < S_; t0 += 32) {
        __syncthreads();
#pragma unroll
        for (int i = 0; i < 4; ++i) {
            const int idx = tid + 512 * i;
            if ((i < 3) || (tid < 256)) {
            const int tt = idx / 56, cv = idx % 56;
            const int zc = a_off[i] - tt * EIN;
            float cur[8], prv[8];
            unpack8(a_cur[i], cur); unpack8(a_prv[i], prv);
            const f32x4 m0 = GLD(f32x4, mu + (zc - ZB)), m1 = GLD(f32x4, mu + (zc - ZB) + 4);
            float val[8];
#pragma unroll
            for (int e = 0; e < 4; ++e) { val[e] = cur[e] + (prv[e] - cur[e]) * m0[e]; val[4 + e] = cur[4 + e] + (prv[4 + e] - cur[4 + e]) * m1[e]; }
            if (cv < 24) {
                float* dst = (cv < 8 ? R : (cv < 16 ? KP : V)) + tt * 64 + (cv & 7) * 8;
                *(f32x4*)dst = (f32x4){val[0], val[1], val[2], val[3]}; *(f32x4*)(dst + 4) = (f32x4){val[4], val[5], val[6], val[7]};
            } else {
                if (cv < 32) {
#pragma unroll
                    for (int e = 0; e < 8; ++e) { const float ex = fexp(2.f * val[e]); val[e] = 1.f - 2.f * frcp(ex + 1.f); } }
                else if (cv >= 40) {
#pragma unroll
                    for (int e = 0; e < 8; ++e) val[e] = sigmoidf_(val[e]); }
                u32x4 w; w.x = pk2(val[0], val[1]); w.y = pk2(val[2], val[3]); w.z = pk2(val[4], val[5]); w.w = pk2(val[6], val[7]);
                bf16_t* dst = (cv < 32) ? (TW + tt * 72 + (cv - 24) * 8) : ((cv < 40) ? (AL + tt * 72 + (cv - 32) * 8) : (GL + tt * 136 + (cv - 40) * 8));
                *(u32x4*)dst = w;
            }
            }
        }
        __syncthreads();
        if (t0 + 32 < S_) {
#pragma unroll
            for (int i = 0; i < 4; ++i) {
                if ((i < 3) || (tid < 256)) { const size_t o = (size_t)(t0 + 32) * EIN + a_off[i]; a_cur[i] = GLD(u32x4, Z + o); a_prv[i] = GLD(u32x4, Z + o - EIN); }
            }
        }
        {
            f32x4 cw = (f32x4){0.f, 0.f, 0.f, 0.f}, ca = cw, cg_ = cw;
#pragma unroll
            for (int ks = 0; ks < 2; ++ks) {
                const bf16x8 a1 = as_bf16x8(*(const u32x4*)(TW + (16 * mt + lq) * 72 + quad * 8 + 32 * ks));
                const bf16x8 a2 = as_bf16x8(*(const u32x4*)(AL + (16 * mt + lq) * 72 + quad * 8 + 32 * ks));
                cw = mfma16(a1, bw[ks], cw); ca = mfma16(a2, ba[ks], ca);
            }
#pragma unroll
            for (int ks = 0; ks < 4; ++ks) { const bf16x8 a3 = as_bf16x8(*(const u32x4*)(GL + (16 * mt + lq) * 136 + quad * 8 + 32 * ks)); cg_ = mfma16(a3, bg[ks], cg_); }
#pragma unroll
            for (int j = 0; j < 4; ++j) {
                const int tt = 16 * mt + 4 * quad + j, ch = 16 * nt + lq;
                const float wf = cw[j] + w0c;
                const float sp = (wf < -15.f) ? -wf : __logf(1.f + fexp(-wf));
                const float wv = -sp - 0.5f;
                DEC[tt * 64 + ch] = fexp(-fexp(wv));
                AA[tt * 64 + ch] = sigmoidf_(ca[j] + a0c);
                GG[tt * 64 + ch] = cg_[j];
            }
        }
        __syncthreads();
        {
            const f32x4 k4 = *(const f32x4*)(KP + ttC * 64 + 4 * cs), a4 = *(const f32x4*)(AA + ttC * 64 + 4 * cs), r4 = *(const f32x4*)(R + ttC * 64 + 4 * cs);
            f32x4 kkv; float ss = 0.f;
#pragma unroll
            for (int e = 0; e < 4; ++e) { kkv[e] = k4[e] * kkc[e]; ss += kkv[e] * kkv[e]; }
            ss = rowsum16(ss);
            const float inv = fminf(__builtin_amdgcn_rsqf(ss), 1e12f);
            f32x4 nk, ka, kp; float bc = 0.f;
#pragma unroll
            for (int e = 0; e < 4; ++e) { const float kk = kkv[e] * inv; nk[e] = -kk; ka[e] = kk * a4[e]; kp[e] = k4[e] * (1.f + (a4[e] - 1.f) * kac[e]); bc += r4[e] * kp[e] * rkc[e]; }
            bc = rowsum16(bc);
            *(f32x4*)(NKK + ttC * 64 + 4 * cs) = nk; *(f32x4*)(KKA + ttC * 64 + 4 * cs) = ka; *(f32x4*)(KP + ttC * 64 + 4 * cs) = kp;
            if (cs == 0) BC[ttC] = bc;
        }
        __syncthreads();
        {
            f32x4 nk = *(const f32x4*)(NKK + 4 * js), wd = *(const f32x4*)(DEC + 4 * js), ka = *(const f32x4*)(KKA + 4 * js);
            f32x4 kp = *(const f32x4*)(KP + 4 * js), rr = *(const f32x4*)(R + 4 * js);
            f32x2 vv = *(const f32x2*)(V + 2 * rp);
            float yq0 = 0.f, yq1 = 0.f;
#pragma unroll 8
            for (int tt = 0; tt < 32; ++tt) {
                const int tn = (tt < 31) ? tt + 1 : 31;
                const f32x4 nk2 = *(const f32x4*)(NKK + tn * 64 + 4 * js), wd2 = *(const f32x4*)(DEC + tn * 64 + 4 * js), ka2 = *(const f32x4*)(KKA + tn * 64 + 4 * js);
                const f32x4 kp2 = *(const f32x4*)(KP + tn * 64 + 4 * js), rr2 = *(const f32x4*)(R + tn * 64 + 4 * js);
                const f32x2 vv2 = *(const f32x2*)(V + tn * 64 + 2 * rp);
                f32x2 sa = (P[0] * nk[0] + P[1] * nk[1]) + (P[2] * nk[2] + P[3] * nk[3]);
                float sa0 = sa[0], sa1 = sa[1];
                rowsum16x4(sa0, sa1, yq0, yq1);
                if (tt > 0 && js == 0) { f32x2 yy; yy[0] = yq0; yy[1] = yq1; *(f32x2*)(Y + (tt - 1) * 64 + 2 * rp) = yy; }
                f32x2 sav; sav[0] = sa0; sav[1] = sa1;
#pragma unroll
                for (int e = 0; e < 4; ++e) P[e] = P[e] * wd[e] + (sav * ka[e] + vv * kp[e]);
                const f32x2 yv = (P[0] * rr[0] + P[1] * rr[1]) + (P[2] * rr[2] + P[3] * rr[3]);
                yq0 = yv[0]; yq1 = yv[1];
                nk = nk2; wd = wd2; ka = ka2; kp = kp2; rr = rr2; vv = vv2;
            }
            yq0 = rowsum16(yq0); yq1 = rowsum16(yq1);
            if (js == 0) { f32x2 yy; yy[0] = yq0; yy[1] = yq1; *(f32x2*)(Y + 31 * 64 + 2 * rp) = yy; }
        }
        __syncthreads();
        {
            const f32x4 y4 = *(const f32x4*)(Y + ttC * 64 + 4 * cs), v4 = *(const f32x4*)(V + ttC * 64 + 4 * cs), g4 = *(const f32x4*)(GG + ttC * 64 + 4 * cs);
            float sm = (y4[0] + y4[1]) + (y4[2] + y4[3]);
            sm = rowsum16(sm);
            const float mean = sm * (1.f / 64.f);
            float dv[4], sq = 0.f;
#pragma unroll
            for (int e = 0; e < 4; ++e) { dv[e] = y4[e] - mean; sq += dv[e] * dv[e]; }
            sq = rowsum16(sq);
            const float rstd = rsqrtf(sq * (1.f / 64.f) + 6.4e-4f);
            const float bc = BC[ttC];
            float ov[4];
#pragma unroll
            for (int e = 0; e < 4; ++e) ov[e] = (dv[e] * rstd * lng[e] + lnb[e] + bc * v4[e]) * g4[e];
            u32x2 w; w.x = pk2(ov[0], ov[1]); w.y = pk2(ov[2], ov[3]);
            GST(u32x2, cat + (size_t)(t0 + ttC) * D_ + 4 * cs) = w;
        }
    }
}

__device__ __forceinline__ void even_mixer_phase(const Params& p, unsigned char* smem, int tid, int bid, int nblk) {
    for (int rep = 0; rep < REP_RWKV; ++rep)
    for (int it = bid; it < 256; it += nblk) rwkv_item(p, smem, it >> 4, it & 15, tid);
    for (int rep = 0; rep < REP_MOBA; ++rep)
    for (int it = bid; it < 2048; it += nblk) {
        const int qt = 7 - (it >> 8), bh = it & 255;
        moba_item2(p, smem, bh >> 4, bh & 15, qt, tid);
    }
}

__device__ __forceinline__ void gelu_tanh4(f32x4& v) {
#pragma unroll
    for (int j = 0; j < 4; ++j) { const float x = v[j]; const float u = 0.7978845608028654f * (x + 0.044715f * x * x * x); const float ex = fexp(2.f * u); const float th = 1.f - 2.f * frcp(ex + 1.f); v[j] = 0.5f * x * (1.f + th); }
}

__device__ __forceinline__ void odd_prep_phase(const Params& p, unsigned char* smem, int tid, int bid, int nblk) {
    const int lane = tid & 63, wave = tid >> 6, lq = lane & 15, quad = lane >> 4;
    bf16_t* Z = (bf16_t*)(p.ws + OFF_Z);
    {
        const f32x2* rope = (const f32x2*)(p.ws + OFF_ROPE);
        const int half = nblk >> 1, nthreads = (nblk - half) * 512;
        for (int it = (bid >= half) ? (bid - half) * 512 + tid : T_ * 64; it < T_ * 64; it += nthreads) {
            const int row = it >> 6, wh = (it >> 2) & 15, cidx = it & 3;
            const int pos = row & (S_ - 1);
            bf16_t* base = Z + (size_t)row * OLD + wh * 64 + cidx * 8;
            float z1[8], z2[8];
            unpack8(GLD(u32x4, base), z1); unpack8(GLD(u32x4, base + 32), z2);
            float o1[8], o2[8];
#pragma unroll
            for (int e = 0; e < 8; ++e) { const f32x2 cs = GLD(f32x2, rope + pos * 32 + cidx * 8 + e); o1[e] = z1[e] * cs[0] - z2[e] * cs[1]; o2[e] = z1[e] * cs[1] + z2[e] * cs[0]; }
            u32x4 w1; w1.x = pk2(o1[0], o1[1]); w1.y = pk2(o1[2], o1[3]); w1.z = pk2(o1[4], o1[5]); w1.w = pk2(o1[6], o1[7]);
            u32x4 w2; w2.x = pk2(o2[0], o2[1]); w2.y = pk2(o2[2], o2[3]); w2.z = pk2(o2[4], o2[5]); w2.w = pk2(o2[6], o2[7]);
            GST(u32x4, base) = w1; GST(u32x4, base + 32) = w2;
        }
    }
    {
        const int gw = bid * 8 + wave, ngw = nblk * 8;
        bf16_t* hid = (bf16_t*)(smem + wave * (16 * 136 * 2));
        for (int task = gw; task < 1024; task += ngw) {
            const int kv = task >> 9, b = (task >> 5) & 15, g = (task >> 3) & 3, ct = task & 7;
            const bf16_t* Zs = Z + (size_t)b * S_ * OLD + (kv ? 4352 : 4096) + g * 64;
            const bf16_t* w1t = (const bf16_t*)(p.ws + (kv ? OFF_W1T_V : OFF_W1T_K));
            const bf16_t* w2t = (const bf16_t*)(p.ws + (kv ? OFF_W2T_V : OFF_W2T_K));
            const float* bias1 = (const float*)(p.ws + OFF_BIAS1) + kv * 128;
            f32x4 acc[8];
#pragma unroll
            for (int n = 0; n < 8; ++n) acc[n] = (f32x4){0.f, 0.f, 0.f, 0.f};
            const int c = ct * 16 + lq;
            bf16x8 a_c, b_c[8], a_n, b_n[8];
            auto cload = [&](int ks, bf16x8& a, bf16x8 (&bb)[8]) {
                const int l = ks >> 1, d0 = (ks & 1) * 32 + quad * 8;
                int row = 16 * c + l; row = row > 2047 ? 2047 : row;
                a = as_bf16x8(GLD(u32x4, Zs + (size_t)row * OLD + d0));
#pragma unroll
                for (int n = 0; n < 8; ++n) bb[n] = as_bf16x8(GLD(u32x4, w1t + (size_t)(16 * n + lq) * 2048 + ks * 32 + quad * 8));
            };
            cload(0, a_c, b_c);
            for (int ks = 0; ks < 64; ++ks) {
                if (ks + 1 < 64) cload(ks + 1, a_n, b_n);
#pragma unroll
                for (int n = 0; n < 8; ++n) acc[n] = mfma16(a_c, b_c[n], acc[n]);
                a_c = a_n;
#pragma unroll
                for (int n = 0; n < 8; ++n) b_c[n] = b_n[n];
            }
#pragma unroll
            for (int n = 0; n < 8; ++n) {
                const float bv = GLD(float, bias1 + 16 * n + lq);
                f32x4 hv = acc[n]; hv[0] += bv; hv[1] += bv; hv[2] += bv; hv[3] += bv;
                gelu_tanh4(hv);
#pragma unroll
                for (int j = 0; j < 4; ++j) { const unsigned pk = pk2(hv[j], 0.f); hid[(4 * quad + j) * 136 + 16 * n + lq] = (bf16_t)(pk & 0xffffu); }
            }
            lds_wait();
            f32x4 acc2[4];
#pragma unroll
            for (int n = 0; n < 4; ++n) acc2[n] = (f32x4){0.f, 0.f, 0.f, 0.f};
#pragma unroll
            for (int ks = 0; ks < 4; ++ks) {
                const bf16x8 a = as_bf16x8(*(const u32x4*)(hid + lq * 136 + quad * 8 + 32 * ks));
#pragma unroll
                for (int n = 0; n < 4; ++n) { const bf16x8 bb = as_bf16x8(GLD(u32x4, w2t + (size_t)(16 * n + lq) * 128 + ks * 32 + quad * 8)); acc2[n] = mfma16(a, bb, acc2[n]); }
            }
            lds_wait();
            bf16_t* dst = (bf16_t*)(p.ws + (kv ? OFF_VC : OFF_KC)) + (size_t)((b * 4 + g) * 128) * 64;
#pragma unroll
            for (int n = 0; n < 4; ++n)
#pragma unroll
                for (int j = 0; j < 4; ++j) {
                    const int cc = ct * 16 + 4 * quad + j;
                    const float v = (cc < 127) ? acc2[n][j] : 0.f;
                    GST(bf16_t, dst + (size_t)cc * 64 + 16 * n + lq) = (bf16_t)(pk2(v, 0.f) & 0xffffu);
                }
        }
    }
}

__device__ __forceinline__ void select_phase(const Params& p, unsigned char* smem, int tid, int bid, int nblk) {
    const int lane = tid & 63, wave = tid >> 6, lq = lane & 15, quad = lane >> 4;
    const bf16_t* Z = (const bf16_t*)(p.ws + OFF_Z);
    const int gw = bid * 8 + wave, ngw = nblk * 8;
    float* PS = (float*)(smem + wave * 2048);
    constexpr float SC = 0.125f * 1.4426950408889634f;
    for (int task = gw; task < 8192; task += ngw) {
        const int b = task >> 9, g = (task >> 7) & 3, qt = task & 127;
        const int t = qt * 16 + lq;
        const bf16_t* kc = (const bf16_t*)(p.ws + OFF_KC) + (size_t)((b * 4 + g) * 128) * 64;
        const int cmax = (t - 31) >> 4;
        f32x4 psum[8];
#pragma unroll
        for (int sub = 0; sub < 8; ++sub) psum[sub] = (f32x4){0.f, 0.f, 0.f, 0.f};
        bf16x8 kfr[8][2], qfr[4][2];
#pragma unroll
        for (int sub = 0; sub < 8; ++sub)
#pragma unroll
            for (int ks = 0; ks < 2; ++ks) kfr[sub][ks] = as_bf16x8(GLD(u32x4, kc + (size_t)(16 * sub + lq) * 64 + quad * 8 + 32 * ks));
#pragma unroll
        for (int r = 0; r < 4; ++r)
#pragma unroll
            for (int ks = 0; ks < 2; ++ks) qfr[r][ks] = as_bf16x8(GLD(u32x4, Z + (size_t)(b * S_ + t) * OLD + 3072 + (g * 4 + r) * 64 + quad * 8 + 32 * ks));
#pragma unroll
        for (int r = 0; r < 4; ++r) {
            f32x4 s[8]; float mx = -INFINITY;
#pragma unroll
            for (int sub = 0; sub < 8; ++sub) {
                s[sub] = (f32x4){0.f, 0.f, 0.f, 0.f};
#pragma unroll
                for (int ks = 0; ks < 2; ++ks) s[sub] = mfma16(kfr[sub][ks], qfr[r][ks], s[sub]);
#pragma unroll
                for (int j = 0; j < 4; ++j) { const int key = 16 * sub + 4 * quad + j; const float sv = (key <= cmax) ? s[sub][j] * SC : -INFINITY; s[sub][j] = sv; mx = fmaxf(mx, sv); }
            }
            mx = fmaxf(mx, __shfl_xor(mx, 16)); mx = fmaxf(mx, __shfl_xor(mx, 32));
            const float m_use = (mx == -INFINITY) ? 0.f : mx;
            float rs = 0.f;
#pragma unroll
            for (int sub = 0; sub < 8; ++sub)
#pragma unroll
                for (int j = 0; j < 4; ++j) { const float e = fexp2(s[sub][j] - m_use); s[sub][j] = e; rs += e; }
            rs += __shfl_xor(rs, 16); rs += __shfl_xor(rs, 32);
            const float inv = (rs > 0.f) ? 1.f / rs : 0.f;
#pragma unroll
            for (int sub = 0; sub < 8; ++sub)
#pragma unroll
                for (int j = 0; j < 4; ++j) psum[sub][j] += s[sub][j] * inv;
        }
        float pslc[8], tprev[8];
#pragma unroll
        for (int sub = 0; sub < 8; ++sub) tprev[sub] = __shfl(psum[sub][3], (lane + 48) & 63);
#pragma unroll
        for (int sub = 0; sub < 8; ++sub) {
            float extra;
            if (quad >= 1) extra = tprev[sub]; else extra = (sub >= 1) ? tprev[sub >= 1 ? sub - 1 : 0] : 0.f;
            pslc[sub] = ((psum[sub][0] + psum[sub][1]) + (psum[sub][2] + psum[sub][3])) + extra;
            PS[lq * 32 + 4 * sub + quad] = pslc[sub];
        }
        lds_wait();
        float pvv[32];
#pragma unroll
        for (int q = 0; q < 8; ++q) { const f32x4 v = *(const f32x4*)(PS + lq * 32 + 4 * q); pvv[4 * q] = v[0]; pvv[4 * q + 1] = v[1]; pvv[4 * q + 2] = v[2]; pvv[4 * q + 3] = v[3]; }
        lds_wait();
        const int own = t >> 6;
        unsigned bits = 0;
#pragma unroll
        for (int sub = 0; sub < 8; ++sub) {
            const int j = 4 * sub + quad; const float mv = pslc[sub];
            int cnt = 0;
#pragma unroll
            for (int j2 = 1; j2 < 32; ++j2) { const bool beats = (pvv[j2] > mv) || (pvv[j2] == mv && j2 < j); cnt += (j2 < own && j2 != j && beats) ? 1 : 0; }
            const bool sel = (j == 0) || (j == own) || (j >= 1 && j < own && cnt < 14);
            if (sel) bits |= (1u << j);
        }
        bits |= (unsigned)__shfl_xor((int)bits, 16); bits |= (unsigned)__shfl_xor((int)bits, 32);
        if (quad == 0) GST(unsigned, (unsigned*)(p.ws + OFF_SEL) + (size_t)(b * 4 + g) * S_ + t) = bits;
    }
}

__device__ __forceinline__ void nsa_item(const Params& p, unsigned char* smem, int b, int head, int qt, int tid) {
    const int lane = tid & 63, wave = tid >> 6, lq = lane & 15, quad = lane >> 4;
    const int g = head >> 2, q0 = qt * 128, t = q0 + wave * 16 + lq;
    const bf16_t* Z = (const bf16_t*)(p.ws + OFF_Z) + (size_t)b * S_ * OLD;
    const unsigned rowmask = GLD(unsigned, (const unsigned*)(p.ws + OFF_SEL) + (size_t)(b * 4 + g) * S_ + t);
    float gate[3];
#pragma unroll
    for (int i = 0; i < 3; ++i) gate[i] = sigmoidf_(bf2f(GLD(bf16_t, Z + (size_t)t * OLD + 5632 + head * 3 + i)));
    f32x4 o[4], tot[4];
    const bf16_t* kc = (const bf16_t*)(p.ws + OFF_KC) + (size_t)((b * 4 + g) * 128) * 64;
    const bf16_t* vc = (const bf16_t*)(p.ws + OFF_VC) + (size_t)((b * 4 + g) * 128) * 64;
#ifndef NSA_PASSES
#define NSA_PASSES 7
#endif
    if (NSA_PASSES & 1) attn_pass<M_CMP, 64>(smem, Z + 3072 + head * 64, OLD, kc, 64, vc, 64, q0, 0u, 0.f, o, tid);
    else { o[0] = o[1] = o[2] = o[3] = (f32x4){0.f, 0.f, 0.f, 0.f}; }
#pragma unroll
    for (int c = 0; c < 4; ++c) { tot[c][0] = gate[0] * o[c][0]; tot[c][1] = gate[0] * o[c][1]; tot[c][2] = gate[0] * o[c][2]; tot[c][3] = gate[0] * o[c][3]; }
    if (NSA_PASSES & 2) attn_pass<M_SLC, 64>(smem, Z + 3072 + head * 64, OLD, Z + 4608 + g * 64, OLD, Z + 4864 + g * 64, OLD, q0, rowmask, 0.f, o, tid);
#pragma unroll
    for (int c = 0; c < 4; ++c) { tot[c][0] += gate[1] * o[c][0]; tot[c][1] += gate[1] * o[c][1]; tot[c][2] += gate[1] * o[c][2]; tot[c][3] += gate[1] * o[c][3]; }
    if (NSA_PASSES & 4) attn_pass<M_WIN, 64>(smem, Z + 3072 + head * 64, OLD, Z + 5120 + g * 64, OLD, Z + 5376 + g * 64, OLD, q0, 0u, 0.f, o, tid);
#pragma unroll
    for (int c = 0; c < 4; ++c) { tot[c][0] += gate[2] * o[c][0]; tot[c][1] += gate[2] * o[c][1]; tot[c][2] += gate[2] * o[c][2]; tot[c][3] += gate[2] * o[c][3]; }
    bf16_t* cat = (bf16_t*)(p.ws + OFF_CAT) + (size_t)(b * S_ + t) * D_ + 1024 + head * 64;
#pragma unroll
    for (int c = 0; c < 4; ++c) { u32x2 w; w.x = pk2(tot[c][0], tot[c][1]); w.y = pk2(tot[c][2], tot[c][3]); GST(u32x2, cat + 16 * c + 4 * quad) = w; }
}


__device__ __forceinline__ void nsa_item2(const Params& p, unsigned char* smem, int b, int head, int qt, int tid) {
    const int lane = tid & 63, wave = tid >> 6, lq = lane & 15, quad = lane >> 4;
    const int g = head >> 2, q0 = qt * 256;
    int t[2]; t[0] = q0 + wave * 32 + lq; t[1] = t[0] + 16;
    const bf16_t* Z = (const bf16_t*)(p.ws + OFF_Z) + (size_t)b * S_ * OLD;
    unsigned rowmask[2], nomask[2] = {0u, 0u}; float gate[2][3];
#pragma unroll
    for (int qs = 0; qs < 2; ++qs) {
        rowmask[qs] = GLD(unsigned, (const unsigned*)(p.ws + OFF_SEL) + (size_t)(b * 4 + g) * S_ + t[qs]);
#pragma unroll
        for (int i = 0; i < 3; ++i) gate[qs][i] = sigmoidf_(bf2f(GLD(bf16_t, Z + (size_t)t[qs] * OLD + 5632 + head * 3 + i)));
    }
    f32x4 o[2][4];
    f32x4* tl = (f32x4*)(smem + 40960) + tid;
    const bf16_t* kc = (const bf16_t*)(p.ws + OFF_KC) + (size_t)((b * 4 + g) * 128) * 64;
    const bf16_t* vc = (const bf16_t*)(p.ws + OFF_VC) + (size_t)((b * 4 + g) * 128) * 64;
    attn_pass2<M_CMP>(smem, Z + 3072 + head * 64, OLD, kc, 64, vc, 64, q0, nomask, o, tid);
#pragma unroll
    for (int qs = 0; qs < 2; ++qs)
#pragma unroll
        for (int c = 0; c < 4; ++c) { f32x4 v; v[0] = gate[qs][0] * o[qs][c][0]; v[1] = gate[qs][0] * o[qs][c][1]; v[2] = gate[qs][0] * o[qs][c][2]; v[3] = gate[qs][0] * o[qs][c][3]; tl[(qs * 4 + c) * 512] = v; }
    attn_pass2<M_SLC>(smem, Z + 3072 + head * 64, OLD, Z + 4608 + g * 64, OLD, Z + 4864 + g * 64, OLD, q0, rowmask, o, tid);
#pragma unroll
    for (int qs = 0; qs < 2; ++qs)
#pragma unroll
        for (int c = 0; c < 4; ++c) { f32x4 v = tl[(qs * 4 + c) * 512]; v[0] += gate[qs][1] * o[qs][c][0]; v[1] += gate[qs][1] * o[qs][c][1]; v[2] += gate[qs][1] * o[qs][c][2]; v[3] += gate[qs][1] * o[qs][c][3]; tl[(qs * 4 + c) * 512] = v; }
    attn_pass2<M_WIN>(smem, Z + 3072 + head * 64, OLD, Z + 5120 + g * 64, OLD, Z + 5376 + g * 64, OLD, q0, nomask, o, tid);
#pragma unroll
    for (int qs = 0; qs < 2; ++qs) {
        bf16_t* cat = (bf16_t*)(p.ws + OFF_CAT) + (size_t)(b * S_ + t[qs]) * D_ + 1024 + head * 64;
#pragma unroll
        for (int c = 0; c < 4; ++c) {
            const f32x4 v = tl[(qs * 4 + c) * 512];
            const float r0 = v[0] + gate[qs][2] * o[qs][c][0], r1 = v[1] + gate[qs][2] * o[qs][c][1], r2 = v[2] + gate[qs][2] * o[qs][c][2], r3 = v[3] + gate[qs][2] * o[qs][c][3];
            u32x2 w; w.x = pk2(r0, r1); w.y = pk2(r2, r3); GST(u32x2, cat + 16 * c + 4 * quad) = w;
        }
    }
}

__device__ __forceinline__ void ret_item(const Params& p, unsigned char* smem, int b, int h, int qt, int tid) {
    const int lane = tid & 63, wave = tid >> 6, lq = lane & 15, quad = lane >> 4;
    const int q0 = qt * 128, t = q0 + wave * 16 + lq;
    const bf16_t* Z = (const bf16_t*)(p.ws + OFF_Z) + (size_t)b * S_ * OLD;
    const float log2g = log2f(1.f - exp2f(-5.f - (float)h));
    f32x4 o[8];
    attn_pass<M_RET, 128>(smem, Z + h * 64, OLD, Z + 512 + h * 64, OLD, Z + 1024 + h * 128, OLD, q0, 0u, log2g, o, tid);
    float sm = 0.f;
#pragma unroll
    for (int c = 0; c < 8; ++c) sm += (o[c][0] + o[c][1]) + (o[c][2] + o[c][3]);
    sm += __shfl_xor(sm, 16); sm += __shfl_xor(sm, 32);
    const float mean = sm * (1.f / 128.f);
    float sq = 0.f;
#pragma unroll
    for (int c = 0; c < 8; ++c)
#pragma unroll
        for (int j = 0; j < 4; ++j) { o[c][j] -= mean; sq += o[c][j] * o[c][j]; }
    sq += __shfl_xor(sq, 16); sq += __shfl_xor(sq, 32);
    const float rstd = rsqrtf(sq * (1.f / 128.f) + 1e-6f);
    const bf16_t* rg = Z + (size_t)t * OLD + 2048 + h * 128;
    bf16_t* cat = (bf16_t*)(p.ws + OFF_CAT) + (size_t)(b * S_ + t) * D_ + h * 128;
#pragma unroll
    for (int c = 0; c < 8; ++c) {
        const u32x2 gv = GLD(u32x2, rg + 16 * c + 4 * quad);
        const float g0 = __uint_as_float(gv.x << 16), g1 = __uint_as_float(gv.x & 0xffff0000u), g2 = __uint_as_float(gv.y << 16), g3 = __uint_as_float(gv.y & 0xffff0000u);
        const float r0 = g0 * sigmoidf_(g0) * o[c][0] * rstd, r1 = g1 * sigmoidf_(g1) * o[c][1] * rstd, r2 = g2 * sigmoidf_(g2) * o[c][2] * rstd, r3 = g3 * sigmoidf_(g3) * o[c][3] * rstd;
        u32x2 w; w.x = pk2(r0, r1); w.y = pk2(r2, r3);
        GST(u32x2, cat + 16 * c + 4 * quad) = w;
    }
}

__device__ __forceinline__ void odd_mixer_phase(const Params& p, unsigned char* smem, int tid, int bid, int nblk) {
    for (int it = bid; it < 4096; it += nblk) {
        const int sl = it >> 9, r = it & 511;
        if (r < 256) { const int rr_ = r & 127; ret_item(p, smem, rr_ >> 3, rr_ & 7, 15 - 2 * sl - ((r >> 7) ^ (sl & 1)), tid); }
        else { const int bh = r - 256; nsa_item2(p, smem, bh >> 4, bh & 15, 7 - sl, tid); }
    }
}

#define XB_TMO      128
#define XB_XCNT(j)  (256  + 64 * (j))
#define XB_XSUB(j)  (1280 + 64 * (j))
#define XB_XGEN(j)  (2304 + 64 * (j))
#define XB_TOP      3328
#define XB_TOPGEN   3392
#define XCD_BAR_WORDS 3456
#define XB_SPIN_CAP (1u << 18)

__device__ __forceinline__ unsigned xb_ld(unsigned* p)              { return __hip_atomic_load(p, __ATOMIC_RELAXED, __HIP_MEMORY_SCOPE_AGENT); }
__device__ __forceinline__ unsigned xb_add(unsigned* p, unsigned v) { return __hip_atomic_fetch_add(p, v, __ATOMIC_RELAXED, __HIP_MEMORY_SCOPE_AGENT); }
__device__ __forceinline__ unsigned xb_xcc_id() { return (unsigned)__builtin_amdgcn_s_getreg((3 << 11) | 20) & 0xFu; }
#define XB_SPIN(cond, bar) do { unsigned _sp = 0; while (cond) { __builtin_amdgcn_s_sleep(1); \
    if ((++_sp & 255u) == 0u) { if (xb_ld(&(bar)[XB_TMO])) break; if (_sp > XB_SPIN_CAP) { atomicAdd(&(bar)[XB_TMO], 1u); break; } } } } while (0)

struct XcdBarrier {
    unsigned* bar; unsigned x;
    volatile LAS unsigned* st;
};

__device__ __forceinline__ XcdBarrier xcd_barrier_post(unsigned* bar, volatile LAS unsigned* st) {
    XcdBarrier b; b.bar = bar; b.x = xb_xcc_id(); b.st = st;
    if (threadIdx.x == 0) (void)xb_add(&bar[XB_XCNT(b.x)], 1u);
    return b;
}
__device__ __forceinline__ void xcd_barrier_complete(unsigned* bar, unsigned x, unsigned& nloc, unsigned& nx) {
    const unsigned G = gridDim.x * gridDim.y * gridDim.z;
    unsigned sum, cnt, mine, sp = 0u;
    for (;;) {
        sum = 0u; cnt = 0u; mine = 0u;
#pragma unroll
        for (unsigned j = 0; j < 16; ++j) { const unsigned c = xb_ld(&bar[XB_XCNT(j)]); sum += c; cnt += (c > 0u) ? 1u : 0u; mine = (j == x) ? c : mine; }
        if (sum == G) break;
        __builtin_amdgcn_s_sleep(1);
        if ((++sp & 255u) == 0u) { if (xb_ld(&bar[XB_TMO])) break; if (sp > XB_SPIN_CAP) { atomicAdd(&bar[XB_TMO], 1u); break; } }
    }
    nloc = mine > 0u ? mine : 1u; nx = cnt > 0u ? cnt : 1u;
}

__device__ __forceinline__ void xcd_barrier(const XcdBarrier& b) {
    asm volatile("s_waitcnt vmcnt(0)" ::: "memory");
    __syncthreads();
    if (threadIdx.x == 0) {
        unsigned* bar = b.bar;
        __builtin_amdgcn_s_waitcnt(0);
        unsigned nloc = b.st[0], nx = b.st[1];
        if (nloc == 0u) { xcd_barrier_complete(bar, b.x, nloc, nx); b.st[0] = nloc; b.st[1] = nx; }
        const unsigned old = xb_add(&bar[XB_XSUB(b.x)], 1u);
        const unsigned gen = old / nloc;
        if (old + 1u == (gen + 1u) * nloc) {
            __builtin_amdgcn_fence(__ATOMIC_RELEASE, "agent");
            asm volatile("s_waitcnt vmcnt(0)" ::: "memory");
            const unsigned og = xb_add(&bar[XB_TOP], 1u);
            const unsigned tg = og / nx;
            if (og + 1u == (tg + 1u) * nx) xb_add(&bar[XB_TOPGEN], 1u);
            else XB_SPIN(xb_ld(&bar[XB_TOPGEN]) == tg, bar);
            __builtin_amdgcn_fence(__ATOMIC_ACQUIRE, "agent");
            xb_add(&bar[XB_XGEN(b.x)], 1u);
            asm volatile("s_waitcnt vmcnt(0)" ::: "memory");
        } else {
            XB_SPIN(xb_ld(&bar[XB_XGEN(b.x)]) == gen, bar);
            __builtin_amdgcn_fence(__ATOMIC_ACQUIRE, "agent");
            asm volatile("s_waitcnt vmcnt(0)" ::: "memory");
        }
    }
    __syncthreads();
}

#ifndef ONLYMASK
#define ONLYMASK 0xFFFFFFu
#endif
#define PH_ON(n) ((ONLYMASK >> (n)) & 1u)
__device__ __forceinline__ const Params& opaque_params() {
    const Params* pp = (const Params*)__builtin_amdgcn_kernarg_segment_ptr(); asm volatile("" : "+s"(pp)); return *pp;
}
__device__ __forceinline__ void run_gemm(unsigned char* smem, int ph, int bid, int nblk) {
    const Params& p = opaque_params();
    unsigned char* ws = p.ws;
    pg8::Gemm g; EpiAll E; g.M = T_;
    E.O = (bf16_t*)(ws + OFF_Z); E.ldc = EIN; E.Xin = p.out; E.Xout = p.out; E.mode = 0;
    if (ph == 1) { g.A = (const bf16_t*)(ws + OFF_H); g.Bt = (const bf16_t*)(ws + OFF_WT_EIN); g.N = EIN; g.K = D_; E.mode = 0; E.ldc = EIN; }
    else if (ph == 9) { g.A = (const bf16_t*)(ws + OFF_H); g.Bt = (const bf16_t*)(ws + OFF_WT_OIN); g.N = OLD; g.K = D_; E.mode = 0; E.ldc = OLD; }
    else if (ph == 4) { g.A = (const bf16_t*)(ws + OFF_CAT); g.Bt = (const bf16_t*)(ws + OFF_WT_EOUT); g.N = D_; g.K = D_; E.mode = 1; E.Xin = p.in[0]; }
    else if (ph == 13) { g.A = (const bf16_t*)(ws + OFF_CAT); g.Bt = (const bf16_t*)(ws + OFF_WT_OOUT); g.N = D_; g.K = D_; E.mode = 1; }
    else if (ph == 7) { g.A = (const bf16_t*)(ws + OFF_Z); g.Bt = (const bf16_t*)(ws + OFF_WT2_0); g.N = D_; g.K = FF_; E.mode = 1; }
    else if (ph == 16) { g.A = (const bf16_t*)(ws + OFF_Z); g.Bt = (const bf16_t*)(ws + OFF_WT2_1); g.N = D_; g.K = FF_; E.mode = 1; }
    else if (ph == 6) { g.A = (const bf16_t*)(ws + OFF_H); g.Bt = (const bf16_t*)(ws + OFF_WT13_0); g.N = 2 * FF_; g.K = D_; E.mode = 2; }
    else { g.A = (const bf16_t*)(ws + OFF_H); g.Bt = (const bf16_t*)(ws + OFF_WT13_1); g.N = 2 * FF_; g.K = D_; E.mode = 2; }
    pg8::StaticOrder So; So.init(g.M, g.N, (int)nblk, (int)bid);
    pg8::gemm_phase<EpiAll, pg8::StaticOrder, false>((PG8_LAS unsigned char*)smem, g, So, E, nullptr);
}
__device__ __forceinline__ void run_norm(int ph, int tid, int bid, int nblk) {
    const Params& p = opaque_params();
    const int lane = tid & 63, wave = tid >> 6;
    const int gw = bid * 8 + wave, ngw = nblk * 8;
    bf16_t* H = (bf16_t*)(p.ws + OFF_H);
#ifdef SKEL
    if (ph == 17) rmsnorm_rows(p.in[0], p.in[27], nullptr, p.out, gw, ngw, lane);
    else if (ph == 5) {}
#else
    if (ph == 17) rmsnorm_rows(p.out, p.in[27], nullptr, p.out, gw, ngw, lane);
#endif
    else rmsnorm_rows(p.out, (ph == 8 ? p.in[1] + D_ : p.in[2] + (ph == 14 ? D_ : 0)), H, nullptr, gw, ngw, lane);
}
__global__ void __launch_bounds__(512, 2) mega(Params pk) {
    extern __shared__ __attribute__((aligned(16))) unsigned char smem[];
    cg::grid_group grid = cg::this_grid();
    {
        volatile LAS unsigned* st0 = (volatile LAS unsigned*)(smem + 131072);
        if (threadIdx.x == 0) { st0[0] = 0u; st0[1] = 0u; }
        __syncthreads();
        (void)xcd_barrier_post((unsigned*)(opaque_params().ws + OFF_BAR), st0);
    }
    const int ph_lo = ((const Params*)__builtin_amdgcn_kernarg_segment_ptr())->ph_lo, ph_hi = ((const Params*)__builtin_amdgcn_kernarg_segment_ptr())->ph_hi;
#pragma nounroll
    for (int ph = ph_lo; ph < ph_hi; ++ph) {
        int tid = threadIdx.x; asm volatile("" : "+v"(tid));
        int bid = __builtin_amdgcn_workgroup_id_x(); asm volatile("" : "+s"(bid));
        int nblk = (int)__builtin_amdgcn_grid_size_x() / 512; asm volatile("" : "+s"(nblk));
        if (ph == 0) { for (int rep = 0; rep < REP_P0; ++rep) { phase0(opaque_params(), smem, tid, bid, nblk); __syncthreads(); } }
        else if (ph == 2) { if (PH_ON(2)) kmean_phase(opaque_params(), tid, bid, nblk); }
        else if (ph == 3) { if (PH_ON(3)) even_mixer_phase(opaque_params(), smem, tid, bid, nblk); }
        else if (ph == 10) { if (PH_ON(10)) odd_prep_phase(opaque_params(), smem, tid, bid, nblk); }
        else if (ph == 11) { for (int rep = 0; rep < REP_SEL; ++rep) select_phase(opaque_params(), smem, tid, bid, nblk); }
        else if (ph == 12) { if (PH_ON(12)) odd_mixer_phase(opaque_params(), smem, tid, bid, nblk); }
#ifdef SKEL
        else if (ph == 17) { run_norm(ph, tid, bid, nblk); }
        else if (ph == 5 || ph == 8 || ph == 14) { }
#else
        else if (ph == 5 || ph == 8 || ph == 14 || ph == 17) { const int nrep = (ph == 5) ? REP_NORM : 1; for (int rep = 0; rep < nrep; ++rep) run_norm(ph, tid, bid, nblk); }
#endif
        else { const int nrep = (ph == 1 || ph == 6 || ph == 9 || ph == 15) ? REP_GEMM : 1; for (int rep = 0; rep < nrep; ++rep) { run_gemm(smem, ph, bid, nblk); __syncthreads(); } }
        if (ph + 1 < ph_hi) {
            if (ph == 0) grid.sync();
            else { XcdBarrier xb; xb.bar = (unsigned*)(opaque_params().ws + OFF_BAR); xb.x = xb_xcc_id(); xb.st = (volatile LAS unsigned*)(smem + 131072); xcd_barrier(xb); }
        }
    }
}

extern "C" void kernel_launch(void* const* d_in, const int* in_sizes, int n_in, void* d_out, int out_size, void* d_ws, size_t ws_size, hipStream_t stream) {
    static int grid = 0;
    if (grid == 0) {
        if (n_in != 28 || out_size != T_ * D_ || ws_size < WS_END) { fprintf(stderr, "kernel_launch: unexpected shapes (n_in %d out %d ws %zu need %zu)\n", n_in, out_size, ws_size, (size_t)WS_END); grid = -1; return; }
        int dev = 0, cus = 0, per_cu = 0;
        hipGetDevice(&dev);
        hipDeviceGetAttribute(&cus, hipDeviceAttributeMultiprocessorCount, dev);
        if (hipFuncSetAttribute((const void*)mega, hipFuncAttributeMaxDynamicSharedMemorySize, LDS_BYTES) != hipSuccess) { fprintf(stderr, "kernel_launch: hipFuncSetAttribute failed\n"); grid = -1; return; }
        hipOccupancyMaxActiveBlocksPerMultiprocessor(&per_cu, (const void*)mega, 512, LDS_BYTES);
        if (per_cu < 1) { fprintf(stderr, "kernel_launch: occupancy query says %d blocks per CU\n", per_cu); per_cu = 1; }
        (void)hipGetLastError();
        grid = cus;
    }
    if (grid < 0) return;
    Params p{};
    for (int i = 0; i < 28; ++i) p.in[i] = (const float*)d_in[i];
    p.out = (float*)d_out; p.ws = (unsigned char*)d_ws;
    for (int i = 0; i < 32; ++i) p.inv_freq[i] = pow(10000.0, -(double)i / 32.0);
    p.ph_lo = 0; p.ph_hi = NPHASE;
#ifdef ZEROCAT
    (void)hipMemsetAsync((char*)d_ws + OFF_CAT, 0, (size_t)T_ * D_ * 2, stream);
#endif
    if (hipMemsetAsync((char*)d_ws + OFF_BAR, 0, XCD_BAR_WORDS * sizeof(unsigned), stream) != hipSuccess) { fprintf(stderr, "kernel_launch: memset of barrier words failed\n"); return; }
    void* args[] = {&p};
    hipError_t e = hipLaunchCooperativeKernel((const void*)mega, dim3(grid), dim3(512), args, LDS_BYTES, stream);
    if (e != hipSuccess) fprintf(stderr, "kernel_launch: cooperative launch failed: %s (grid %d)\n", hipGetErrorString(e), grid);
}
```

```cpp
#include <hip/hip_runtime.h>
#include <hip/hip_cooperative_groups.h>
#include <cstdio>
#include <cmath>
namespace cg = cooperative_groups;
namespace pg8 {
#define PG8_LAS __attribute__((address_space(3)))
typedef unsigned short bf16_t;
typedef short bf16x8 __attribute__((ext_vector_type(8)));
typedef float f32x4 __attribute__((ext_vector_type(4)));
typedef unsigned u32x4 __attribute__((ext_vector_type(4)));
constexpr int BM = 256, BK = 64, HALF = 128, HTB = HALF * BK * 2  , STAGE_BYTES = 8 * HTB, NXCD = 8, WGM = 8;

__host__ __device__ __forceinline__ int lds_byte(int r, int c) { const int st = (r >> 4) * 2 + (c >> 5), rr = r & 15, cc = c & 31, ob = rr * 64 + cc * 2; return st * 1024 + (ob ^ (((ob >> 9) & 1) << 5)); }
__host__ __device__ __forceinline__ void stage_rc(int b, int& R, int& C) { const int st = b / 1024, sb = b % 1024, swz = sb ^ (((sb >> 9) & 1) << 5); R = (st >> 1) * 16 + swz / 64; C = (st & 1) * 32 + (swz % 64) / 2; }
__host__ __device__ __forceinline__ int perm32(int rho) { const int n = rho >> 4, i = rho & 15; return 8 * (i >> 2) + 4 * n + (i & 3); }

struct Unit { int pm, pn; };
struct Gemm { const bf16_t* A; const bf16_t* Bt; int M, N, K; };

struct StaticOrder {
    int nM, nN, nwg, G, c;
    __host__ __device__ void init(int M, int N, int G_, int c_) { nM = M / BM; nN = N / BM; nwg = nM * nN; G = G_; c = c_; }
    __host__ __device__ bool next(int i, Unit& u) const {
        const long L = (long)i * G + c; if (L >= nwg) return false;
        int wgid = (int)L; { const int q = nwg / NXCD, r = nwg % NXCD, xcd = wgid % NXCD, off = wgid / NXCD; wgid = (xcd < r ? xcd * (q + 1) : r * (q + 1) + (xcd - r) * q) + off; }
        const int nig = WGM * nN, gid = wgid / nig, fm = gid * WGM, gsz = (nM - fm) < WGM ? (nM - fm) : WGM;
        u.pm = fm + ((wgid % nig) % gsz); u.pn = (wgid % nig) / gsz; return true;
    }
    __device__ __forceinline__ void a_ready(const Unit&) const {}
    __device__ __forceinline__ void done(const Unit&) const {}
};
__device__ __forceinline__ unsigned cvt_pk_bf16(float lo, float hi) { unsigned r; asm volatile("v_cvt_pk_bf16_f32 %0, %1, %2" : "=v"(r) : "v"(lo), "v"(hi)); return r; }
template <class Epi, class Sched, bool STAMP = false>
__device__ __forceinline__ void gemm_phase(PG8_LAS unsigned char* lds, const Gemm g, const Sched& S, const Epi& E, unsigned long long* stamps) {
    int tid = threadIdx.x; asm volatile("" : "+v"(tid)); const int wid = __builtin_amdgcn_readfirstlane(tid >> 6), lane = tid & 63, wr = wid >> 2, wc = wid & 3, fr = lane & 15, fq = lane >> 4;
    const int K = g.K, nt = K / BK;
    int ts_lo = 0, ts_hi = 0, nts = 0; const unsigned long long rt_entry = STAMP ? (unsigned long long)wall_clock64() : 0ull;
#define PG8_STAMP() do { if (STAMP && wid == 0 && nts < 64) { const unsigned long long _c = (unsigned long long)clock64(); \
        ts_lo = (lane == nts) ? (int)(unsigned)_c : ts_lo; ts_hi = (lane == nts) ? (int)(unsigned)(_c >> 32) : ts_hi; ++nts; } } while (0)
    PG8_STAMP();
    unsigned voffA[2], voffB[2];
#pragma unroll
    for (int i = 0; i < 2; ++i) { int R, C; stage_rc(tid * 16 + i * 8192, R, C); const int Rb = Epi::PERM ? ((R & ~31) + perm32(R & 31)) : R;
        voffA[i] = (unsigned)(R * K + C) * 2u; voffB[i] = (unsigned)(Rb * K + C) * 2u; }
    const size_t kstep = (size_t)(BK * 2);
    const size_t hstep = (size_t)HALF * K * 2;
    const size_t tstep = 2 * hstep;
    const unsigned ldsw = (unsigned)wid * 1024u;
    const int aoff = lds_byte(wr * 64 + fr, fq * 8), boff = lds_byte(wc * 32 + fr, fq * 8);
#define PG8_SA(b, h) (((b) * 2 + (h)) * HTB)
#define PG8_SB(b, h) ((4 + (b) * 2 + (h)) * HTB)
#define PG8_STAGE(bufoff, gbase, voff) do { _Pragma("unroll") for (int _i = 0; _i < 2; ++_i) \
        __builtin_amdgcn_global_load_lds((const unsigned*)((const char*)(gbase) + (voff)[_i]), (PG8_LAS unsigned*)(lds + (bufoff) + ldsw + _i * 8192), 16, 0, 0); } while (0)
#define PG8_LDA(dst, b, h) do { _Pragma("unroll") for (int m = 0; m < 4; ++m) _Pragma("unroll") for (int k = 0; k < 2; ++k) dst[m][k] = *(const PG8_LAS bf16x8*)(lds + PG8_SA(b, h) + aoff + m * 2048 + k * 1024); } while (0)
#define PG8_LDB(dst, b, h) do { _Pragma("unroll") for (int n = 0; n < 2; ++n) _Pragma("unroll") for (int k = 0; k < 2; ++k) dst[n][k] = *(const PG8_LAS bf16x8*)(lds + PG8_SB(b, h) + boff + n * 2048 + k * 1024); } while (0)
#define PG8_MMA(ai, bj, At, Bt) do { __builtin_amdgcn_s_setprio(1); _Pragma("unroll") for (int m = 0; m < 4; ++m) _Pragma("unroll") for (int n = 0; n < 2; ++n) _Pragma("unroll") for (int k = 0; k < 2; ++k) \
        acc[ai][bj][m][n] = __builtin_amdgcn_mfma_f32_16x16x32_bf16(Bt[n][k], At[m][k], acc[ai][bj][m][n], 0, 0, 0); __builtin_amdgcn_s_setprio(0); } while (0)
#define PG8_WAIT_V(n) asm volatile("s_waitcnt vmcnt(" #n ")" ::: "memory")
#define PG8_WAIT_L(n) asm volatile("s_waitcnt lgkmcnt(" #n ")" ::: "memory")
#define PG8_BAR __builtin_amdgcn_s_barrier()
#define PG8_SCHED __builtin_amdgcn_sched_barrier(0)
    Unit cur, nxt; int ui = 0;
    if (!S.next(0, cur)) return;
    f32x4 acc[2][2][4][2];
#pragma unroll
    for (int a = 0; a < 2; ++a)
#pragma unroll
        for (int b = 0; b < 2; ++b)
#pragma unroll
            for (int m = 0; m < 4; ++m)
#pragma unroll
                for (int n = 0; n < 2; ++n) acc[a][b][m][n] = (f32x4){0.f, 0.f, 0.f, 0.f};
    bf16x8 At[4][2], B0[2][2], B1[2][2];
    const char* cA = (const char*)g.A + (size_t)cur.pm * tstep; const char* cB = (const char*)g.Bt + (size_t)cur.pn * tstep;
    S.a_ready(cur);
    PG8_STAGE(PG8_SB(0, 0), cB, voffB); PG8_STAGE(PG8_SA(0, 0), cA, voffA); PG8_STAGE(PG8_SB(0, 1), cB + hstep, voffB); PG8_STAGE(PG8_SA(0, 1), cA + hstep, voffA);
    if (wr == 1) PG8_BAR;
    PG8_WAIT_V(4); PG8_BAR;
    PG8_STAGE(PG8_SB(1, 0), cB + kstep, voffB); PG8_STAGE(PG8_SA(1, 0), cA + kstep, voffA); PG8_STAGE(PG8_SB(1, 1), cB + hstep + kstep, voffB);
    PG8_WAIT_V(6); PG8_BAR;
    PG8_STAMP();
    for (;;) {
        const bool has_next = S.next(ui + 1, nxt);
        const char* nA = has_next ? (const char*)g.A + (size_t)nxt.pm * tstep : cA; const char* nB = has_next ? (const char*)g.Bt + (size_t)nxt.pn * tstep : cB;
        for (int t = 0; t < nt; t += 2) {
            const bool last = (t == nt - 2);
            const char* a1 = cA + (size_t)(t + 1) * kstep;
            const char* a2 = last ? nA : cA + (size_t)(t + 2) * kstep; const char* b2 = last ? nB : cB + (size_t)(t + 2) * kstep;
            const char* a3 = a2 + kstep; const char* b3 = b2 + kstep;
            if (last && has_next) S.a_ready(nxt);
            PG8_LDB(B0, 0, 0); PG8_SCHED; PG8_LDA(At, 0, 0); PG8_STAGE(PG8_SA(1, 1), a1 + hstep, voffA);
            PG8_WAIT_L(8); PG8_BAR; PG8_WAIT_L(0); PG8_MMA(0, 0, At, B0); PG8_BAR; PG8_SCHED;
            PG8_LDB(B1, 0, 1); PG8_STAGE(PG8_SB(0, 0), b2, voffB);
            PG8_BAR; PG8_WAIT_L(0); PG8_MMA(0, 1, At, B1); PG8_BAR;
            PG8_LDA(At, 0, 1); PG8_STAGE(PG8_SA(0, 0), a2, voffA);
            PG8_BAR; PG8_WAIT_L(0); PG8_MMA(1, 0, At, B0); PG8_BAR; PG8_SCHED;
            PG8_STAGE(PG8_SB(0, 1), b2 + hstep, voffB);
            PG8_WAIT_V(6); PG8_BAR; PG8_MMA(1, 1, At, B1); PG8_BAR;
            PG8_LDB(B0, 1, 0); PG8_SCHED; PG8_LDA(At, 1, 0); PG8_STAGE(PG8_SA(0, 1), a2 + hstep, voffA);
            PG8_WAIT_L(8); PG8_BAR; PG8_WAIT_L(0); PG8_MMA(0, 0, At, B0); PG8_BAR; PG8_SCHED;
            PG8_LDB(B1, 1, 1); PG8_STAGE(PG8_SB(1, 0), b3, voffB);
            PG8_BAR; PG8_WAIT_L(0); PG8_MMA(0, 1, At, B1); PG8_BAR;
            PG8_LDA(At, 1, 1); PG8_STAGE(PG8_SA(1, 0), a3, voffA);
            PG8_BAR; PG8_WAIT_L(0); PG8_MMA(1, 0, At, B0); PG8_BAR; PG8_SCHED;
            PG8_STAGE(PG8_SB(1, 1), b3 + hstep, voffB);
            PG8_WAIT_V(6); PG8_BAR; PG8_MMA(1, 1, At, B1); PG8_BAR;
        }
        PG8_STAMP();
        if constexpr (!Epi::AFTER_DRAIN) { E(acc, cur, wr, wc, fr, fq); S.done(cur); }
        PG8_STAMP();
        if (!has_next) break;
#pragma unroll
        for (int a = 0; a < 2; ++a)
#pragma unroll
            for (int b = 0; b < 2; ++b)
#pragma unroll
                for (int m = 0; m < 4; ++m)
#pragma unroll
                    for (int n = 0; n < 2; ++n) acc[a][b][m][n] = (f32x4){0.f, 0.f, 0.f, 0.f};
        cur = nxt; cA = nA; cB = nB; ++ui;
    }
    PG8_WAIT_V(0);
    if (wr == 0) PG8_BAR;
    PG8_BAR;
    if constexpr (Epi::AFTER_DRAIN) { E.fused(acc, cur, wr, wc, fr, fq, lds, wid, lane); S.done(cur); }
    PG8_STAMP();
    if (STAMP && wid == 0) { stamps[lane] = lane < nts ? (((unsigned long long)(unsigned)ts_hi << 32) | (unsigned)ts_lo) : 0ull;
        if (lane == 62) stamps[62] = rt_entry; if (lane == 63) stamps[63] = (unsigned long long)wall_clock64(); }
#undef PG8_STAMP
#undef PG8_SA
#undef PG8_SB
#undef PG8_STAGE
#undef PG8_LDA
#undef PG8_LDB
#undef PG8_MMA
#undef PG8_WAIT_V
#undef PG8_WAIT_L
#undef PG8_BAR
#undef PG8_SCHED
}
}

typedef unsigned short bf16_t;
typedef short bf16x8 __attribute__((ext_vector_type(8)));
typedef short s16x4 __attribute__((ext_vector_type(4)));
typedef float f32x4 __attribute__((ext_vector_type(4)));
typedef float f32x2 __attribute__((ext_vector_type(2)));
typedef unsigned u32x4 __attribute__((ext_vector_type(4)));
typedef unsigned u32x2 __attribute__((ext_vector_type(2)));
#define LAS __attribute__((address_space(3)))
#define GAS __attribute__((address_space(1)))
#define GLD(T, ptr) (*(const GAS T*)(ptr))
#define GST(T, ptr) (*(GAS T*)(ptr))

constexpr int T_ = 32768, D_ = 2048, S_ = 2048, B_ = 16, FF_ = 5632;
constexpr int EIN = 6400, OIN = 5680, OLD = 5888;
constexpr float EPS_ = 1e-6f;

constexpr size_t AL256(size_t x) { return (x + 255) & ~(size_t)255; }
constexpr size_t OFF_CTRL = 0;
constexpr size_t OFF_WT_EIN = 4096;
constexpr size_t OFF_WT_EOUT = OFF_WT_EIN + (size_t)EIN * D_ * 2;
constexpr size_t OFF_WT_OIN = OFF_WT_EOUT + (size_t)D_ * D_ * 2;
constexpr size_t OFF_WT_OOUT = OFF_WT_OIN + (size_t)OLD * D_ * 2;
constexpr size_t OFF_WT13_0 = OFF_WT_OOUT + (size_t)D_ * D_ * 2;
constexpr size_t OFF_WT13_1 = OFF_WT13_0 + (size_t)2 * FF_ * D_ * 2;
constexpr size_t OFF_WT2_0 = OFF_WT13_1 + (size_t)2 * FF_ * D_ * 2;
constexpr size_t OFF_WT2_1 = OFF_WT2_0 + (size_t)D_ * FF_ * 2;
constexpr size_t OFF_W1T_K = OFF_WT2_1 + (size_t)D_ * FF_ * 2;
constexpr size_t OFF_W1T_V = OFF_W1T_K + (size_t)128 * 2048 * 2;
constexpr size_t OFF_W2T_K = OFF_W1T_V + (size_t)128 * 2048 * 2;
constexpr size_t OFF_W2T_V = OFF_W2T_K + (size_t)64 * 128 * 2;
constexpr size_t OFF_BIAS1 = OFF_W2T_V + (size_t)64 * 128 * 2;
constexpr size_t OFF_ROPE = OFF_BIAS1 + 1024;
constexpr size_t OFF_KMEAN = OFF_ROPE + (size_t)2048 * 32 * 8;
constexpr size_t OFF_KC = OFF_KMEAN + (size_t)16 * 16 * 8 * 64 * 4;
constexpr size_t OFF_VC = OFF_KC + (size_t)16 * 4 * 128 * 64 * 2;
constexpr size_t OFF_SEL = OFF_VC + (size_t)16 * 4 * 128 * 64 * 2;
constexpr size_t OFF_H = OFF_SEL + (size_t)16 * 4 * 2048 * 4;
constexpr size_t OFF_Z = OFF_H + (size_t)T_ * D_ * 2;
constexpr size_t OFF_CAT = OFF_Z + (size_t)T_ * EIN * 2;
constexpr size_t OFF_BAR = OFF_CAT + (size_t)T_ * D_ * 2;
constexpr size_t WS_END = OFF_BAR + 16384;

constexpr int LDS_BYTES = 131072 + 16;
constexpr int NPHASE = 18;
#ifndef REP_P0
#define REP_P0 1
#endif
#ifndef REP_RWKV
#define REP_RWKV 1
#endif
#ifndef REP_MOBA
#define REP_MOBA 1
#endif
#ifndef REP_RET
#define REP_RET 1
#endif
#ifndef REP_NSA
#define REP_NSA 1
#endif
#ifndef REP_GEMM
#define REP_GEMM 1
#endif
#ifndef REP_NORM
#define REP_NORM 1
#endif
#ifndef REP_SEL
#define REP_SEL 1
#endif

struct Params {
    const float* in[28];
    float* out;
    unsigned char* ws;
    double inv_freq[32];
    int ph_lo, ph_hi;
};

__device__ __forceinline__ float bf2f(unsigned short b) { return __uint_as_float(((unsigned)b) << 16); }
typedef __bf16 bf16x2_t __attribute__((ext_vector_type(2)));
__device__ __forceinline__ unsigned pk2(float lo, float hi) { f32x2 v; v[0] = lo; v[1] = hi; const bf16x2_t r = __builtin_convertvector(v, bf16x2_t); return __builtin_bit_cast(unsigned, r); }
__device__ __forceinline__ float wave_sum(float v) {
#pragma unroll
    for (int o = 1; o < 64; o <<= 1) v += __shfl_xor(v, o);
    return v;
}
template <int CTRL> __device__ __forceinline__ float dppf(float x) {
    return __int_as_float(__builtin_amdgcn_update_dpp(0, __float_as_int(x), CTRL, 0xf, 0xf, false));
}
__device__ __forceinline__ float rowsum16(float x) {
    x += dppf<0x128>(x);
    x += dppf<0x124>(x);
    x += dppf<0x4E>(x);
    x += dppf<0xB1>(x);
    return x;
}
__device__ __forceinline__ void rowsum16x4(float& a, float& b, float& c, float& d) {
    asm volatile("" : "+v"(a), "+v"(b), "+v"(c), "+v"(d));
    a += dppf<0x128>(a); b += dppf<0x128>(b); c += dppf<0x128>(c); d += dppf<0x128>(d); asm volatile("" : "+v"(a), "+v"(b), "+v"(c), "+v"(d));
    a += dppf<0x124>(a); b += dppf<0x124>(b); c += dppf<0x124>(c); d += dppf<0x124>(d); asm volatile("" : "+v"(a), "+v"(b), "+v"(c), "+v"(d));
    a += dppf<0x4E>(a); b += dppf<0x4E>(b); c += dppf<0x4E>(c); d += dppf<0x4E>(d); asm volatile("" : "+v"(a), "+v"(b), "+v"(c), "+v"(d));
    a += dppf<0xB1>(a); b += dppf<0xB1>(b); c += dppf<0xB1>(c); d += dppf<0xB1>(d); asm volatile("" : "+v"(a), "+v"(b), "+v"(c), "+v"(d));
}
__device__ __forceinline__ float fexp2(float x) { return __builtin_amdgcn_exp2f(x); }
__device__ __forceinline__ float fexp(float x) { return __builtin_amdgcn_exp2f(x * 1.4426950408889634f); }
__device__ __forceinline__ float frcp(float x) { return __builtin_amdgcn_rcpf(x); }
__device__ __forceinline__ float sigmoidf_(float x) { return frcp(1.f + fexp(-x)); }
__device__ __forceinline__ void lds_wait() { asm volatile("s_waitcnt lgkmcnt(0)" ::: "memory"); }
__device__ __forceinline__ void unpack8(u32x4 v, float (&f)[8]) {
    f[0] = __uint_as_float(v.x << 16); f[1] = __uint_as_float(v.x & 0xffff0000u);
    f[2] = __uint_as_float(v.y << 16); f[3] = __uint_as_float(v.y & 0xffff0000u);
    f[4] = __uint_as_float(v.z << 16); f[5] = __uint_as_float(v.z & 0xffff0000u);
    f[6] = __uint_as_float(v.w << 16); f[7] = __uint_as_float(v.w & 0xffff0000u);
}
__device__ __forceinline__ bf16x8 as_bf16x8(u32x4 v) { return __builtin_bit_cast(bf16x8, v); }
__device__ __forceinline__ f32x4 mfma16(bf16x8 a, bf16x8 b, f32x4 c) { return __builtin_amdgcn_mfma_f32_16x16x32_bf16(a, b, c, 0, 0, 0); }

struct EpiAll {
    static constexpr bool PERM = true, AFTER_DRAIN = false;
    int mode; bf16_t* O; int ldc; const float* Xin; float* Xout;
    __device__ __forceinline__ void operator()(const pg8::f32x4 (&acc)[2][2][4][2], const pg8::Unit& u, int wr, int wc, int fr, int fq) const {
        const int row0 = u.pm * 256 + wr * 64 + fr;
        if (mode == 0) {
            const int col0 = u.pn * 256 + wc * 32 + 8 * fq;
#pragma unroll
            for (int ai = 0; ai < 2; ++ai)
#pragma unroll
                for (int m = 0; m < 4; ++m) {
                    bf16_t* rowp = O + (size_t)(row0 + ai * 128 + m * 16) * ldc + col0;
#pragma unroll
                    for (int bj = 0; bj < 2; ++bj) {
                        const pg8::f32x4 v0 = acc[ai][bj][m][0], v1 = acc[ai][bj][m][1];
                        u32x4 w; w.x = pk2(v0[0], v0[1]); w.y = pk2(v0[2], v0[3]); w.z = pk2(v1[0], v1[1]); w.w = pk2(v1[2], v1[3]);
                        GST(u32x4, rowp + bj * 128) = w;
                    }
                }
        } else if (mode == 1) {
            const int col0 = u.pn * 256 + wc * 32 + 8 * fq;
#pragma unroll
            for (int ai = 0; ai < 2; ++ai)
#pragma unroll
                for (int m = 0; m < 4; ++m) {
                    const size_t off = (size_t)(row0 + ai * 128 + m * 16) * D_ + col0;
#pragma unroll
                    for (int bj = 0; bj < 2; ++bj)
#pragma unroll
                        for (int n = 0; n < 2; ++n) {
                            const size_t idx = off + bj * 128 + n * 4;
                            const f32x4 x = GLD(f32x4, Xin + idx);
                            f32x4 r; r[0] = x[0] + acc[ai][bj][m][n][0]; r[1] = x[1] + acc[ai][bj][m][n][1]; r[2] = x[2] + acc[ai][bj][m][n][2]; r[3] = x[3] + acc[ai][bj][m][n][3];
                            GST(f32x4, Xout + idx) = r;
                        }
                }
        } else {
            const int col0 = u.pn * 128 + wc * 32 + 8 * fq;
#pragma unroll
            for (int ai = 0; ai < 2; ++ai)
#pragma unroll
                for (int m = 0; m < 4; ++m) {
                    bf16_t* rowp = O + (size_t)(row0 + ai * 128 + m * 16) * FF_ + col0;
                    float hv[8];
#pragma unroll
                    for (int n = 0; n < 2; ++n)
#pragma unroll
                        for (int j = 0; j < 4; ++j) { const float g = acc[ai][0][m][n][j], up = acc[ai][1][m][n][j]; hv[n * 4 + j] = g * sigmoidf_(g) * up; }
                    u32x4 w; w.x = pk2(hv[0], hv[1]); w.y = pk2(hv[2], hv[3]); w.z = pk2(hv[4], hv[5]); w.w = pk2(hv[6], hv[7]);
                    GST(u32x4, rowp) = w;
                }
        }
    }
};

template <int MODE>
__device__ __forceinline__ void prep_w(const float* Wa, const float* Wb, int K, int Nsrc, bf16_t* WT, int nOutBlocks, float* scr, int gw, int ngw, int lane, const float* gain) {
    const int nkb = K / 64, nitems = nkb * nOutBlocks;
    const int lr = lane >> 3, lc = (lane & 7) * 4;
    f32x4 cur[8], nxt[8];
    auto locate = [&](int it, const float*& src, int& c0, int& k0, int& ob) {
        ob = it % nOutBlocks; k0 = (it / nOutBlocks) * 64;
        if (MODE == 0) { src = Wa; c0 = ob * 32; }
        else { const int pn = ob >> 3, sb = ob & 7; src = (sb < 4) ? Wa : Wb; c0 = (pn * 4 + (sb & 3)) * 32; }
    };
    auto load = [&](int it, f32x4 (&v)[8]) {
        const float* src; int c0, k0, ob; locate(it, src, c0, k0, ob);
        const int col = c0 + lc;
#pragma unroll
        for (int i = 0; i < 8; ++i) v[i] = (col < Nsrc) ? GLD(f32x4, src + (size_t)(k0 + 8 * i + lr) * Nsrc + col) : (f32x4){0.f, 0.f, 0.f, 0.f};
    };
    int it = gw;
    if (it < nitems) load(it, cur);
    for (; it < nitems; it += ngw) {
        const int itn = it + ngw;
        if (itn < nitems) load(itn, nxt);
        const float* src; int c0, k0, ob; locate(it, src, c0, k0, ob);
#pragma unroll
        for (int i = 0; i < 8; ++i) {
            const int kk = 8 * i + lr; const float gk = gain ? gain[k0 + kk] : 1.f;
            float* d = scr + kk * 33 + lc;
            d[0] = cur[i][0] * gk; d[1] = cur[i][1] * gk; d[2] = cur[i][2] * gk; d[3] = cur[i][3] * gk;
        }
        lds_wait();
        const int c = lane & 7;
#pragma unroll
        for (int j = 0; j < 4; ++j) {
            const int n = (lane >> 3) + 8 * j; const float* sp = scr + (8 * c) * 33 + n;
            u32x4 o; o.x = pk2(sp[0 * 33], sp[1 * 33]); o.y = pk2(sp[2 * 33], sp[3 * 33]); o.z = pk2(sp[4 * 33], sp[5 * 33]); o.w = pk2(sp[6 * 33], sp[7 * 33]);
            GST(u32x4, WT + (size_t)(ob * 32 + n) * K + k0 + 8 * c) = o;
        }
        lds_wait();
#pragma unroll
        for (int i = 0; i < 8; ++i) cur[i] = nxt[i];
    }
}

__device__ __forceinline__ void rmsnorm_rows(const float* X, const float* g, bf16_t* H, float* OutF, int gw, int ngw, int lane) {
    f32x4 gv[8];
#pragma unroll
    for (int j = 0; j < 8; ++j) gv[j] = GLD(f32x4, (const f32x4*)g + lane + 64 * j);
    f32x4 v[8], vn[8];
    int m = gw;
    if (m < T_) {
#pragma unroll
        for (int j = 0; j < 8; ++j) v[j] = GLD(f32x4, (const f32x4*)(X + (size_t)m * D_) + lane + 64 * j);
    }
    for (; m < T_; m += ngw) {
        const int mn = m + ngw;
        if (mn < T_) {
#pragma unroll
            for (int j = 0; j < 8; ++j) vn[j] = GLD(f32x4, (const f32x4*)(X + (size_t)mn * D_) + lane + 64 * j);
        }
        float ss = 0.f;
#pragma unroll
        for (int j = 0; j < 8; ++j) ss += (v[j][0] * v[j][0] + v[j][1] * v[j][1]) + (v[j][2] * v[j][2] + v[j][3] * v[j][3]);
        ss = wave_sum(ss);
        const float rstd = rsqrtf(ss * (1.f / D_) + EPS_);
#pragma unroll
        for (int j = 0; j < 8; ++j) {
            const float y0 = v[j][0] * rstd * gv[j][0], y1 = v[j][1] * rstd * gv[j][1], y2 = v[j][2] * rstd * gv[j][2], y3 = v[j][3] * rstd * gv[j][3];
            if (H) { u32x2 o; o.x = pk2(y0, y1); o.y = pk2(y2, y3); GST(u32x2, H + (size_t)m * D_ + (lane + 64 * j) * 4) = o; }
            if (OutF) { f32x4 o; o[0] = y0; o[1] = y1; o[2] = y2; o[3] = y3; GST(f32x4, (f32x4*)(OutF + (size_t)m * D_) + lane + 64 * j) = o; }
        }
#pragma unroll
        for (int j = 0; j < 8; ++j) v[j] = vn[j];
    }
}

__device__ __forceinline__ void phase0(const Params& p, unsigned char* smem, int tid, int bid, int nblk) {
    const int lane = tid & 63, wave = tid >> 6;
    const int gw = bid * 8 + wave, ngw = nblk * 8;
    float* scr = (float*)(smem + wave * 8448);
    unsigned char* ws = p.ws;
    prep_w<0>(p.in[3], nullptr, D_, EIN, (bf16_t*)(ws + OFF_WT_EIN), EIN / 32, scr, gw, ngw, lane, nullptr);
    prep_w<0>(p.in[15], nullptr, D_, D_, (bf16_t*)(ws + OFF_WT_EOUT), D_ / 32, scr, gw, ngw, lane, nullptr);
    prep_w<0>(p.in[16], nullptr, D_, OIN, (bf16_t*)(ws + OFF_WT_OIN), OLD / 32, scr, gw, ngw, lane, nullptr);
    prep_w<0>(p.in[23], nullptr, D_, D_, (bf16_t*)(ws + OFF_WT_OOUT), D_ / 32, scr, gw, ngw, lane, nullptr);
    prep_w<1>(p.in[24], p.in[25], D_, FF_, (bf16_t*)(ws + OFF_WT13_0), 2 * FF_ / 32, scr, gw, ngw, lane, nullptr);
    prep_w<1>(p.in[24] + (size_t)D_ * FF_, p.in[25] + (size_t)D_ * FF_, D_, FF_, (bf16_t*)(ws + OFF_WT13_1), 2 * FF_ / 32, scr, gw, ngw, lane, nullptr);
    prep_w<0>(p.in[26], nullptr, FF_, D_, (bf16_t*)(ws + OFF_WT2_0), D_ / 32, scr, gw, ngw, lane, nullptr);
    prep_w<0>(p.in[26] + (size_t)FF_ * D_, nullptr, FF_, D_, (bf16_t*)(ws + OFF_WT2_1), D_ / 32, scr, gw, ngw, lane, nullptr);
    prep_w<0>(p.in[18], nullptr, 2048, 128, (bf16_t*)(ws + OFF_W1T_K), 4, scr, gw, ngw, lane, nullptr);
    prep_w<0>(p.in[21], nullptr, 2048, 128, (bf16_t*)(ws + OFF_W1T_V), 4, scr, gw, ngw, lane, nullptr);
    prep_w<0>(p.in[19], nullptr, 128, 64, (bf16_t*)(ws + OFF_W2T_K), 2, scr, gw, ngw, lane, nullptr);
    prep_w<0>(p.in[22], nullptr, 128, 64, (bf16_t*)(ws + OFF_W2T_V), 2, scr, gw, ngw, lane, nullptr);
    if (gw < 256) {
        const int kv = gw >> 7, n = gw & 127;
        const float* pe = p.in[kv ? 20 : 17]; const float* w1 = p.in[kv ? 21 : 18];
        float s = 0.f;
        for (int k = lane; k < 2048; k += 64) s += pe[k] * w1[(size_t)k * 128 + n];
        s = wave_sum(s);
        if (lane == 0) ((float*)(ws + OFF_BIAS1))[gw] = s;
    }
    {
        f32x2* rope = (f32x2*)(ws + OFF_ROPE);
        for (int e = bid * 512 + tid; e < 2048 * 32; e += nblk * 512) {
            const int pos = e >> 5, i = e & 31;
            const double ang = (double)pos * p.inv_freq[i];
            const double kq = rint(ang * 0.63661977236758134308);
            double r = fma(-kq, 1.57079632679489655800e+00, ang);
            r = fma(-kq, 6.12323399573676603587e-17, r);
            const float rf = (float)r;
            const float r2 = rf * rf;
            const float sn = rf * (1.f + r2 * (-1.6666667e-1f + r2 * (8.3333333e-3f + r2 * (-1.9841270e-4f + r2 * 2.7557319e-6f))));
            const float cs = 1.f + r2 * (-0.5f + r2 * (4.1666667e-2f + r2 * (-1.3888889e-3f + r2 * (2.4801587e-5f + r2 * -2.7557319e-7f))));
            const int q = ((int)kq) & 3;
            float c, s;
            if (q == 0) { c = cs; s = sn; } else if (q == 1) { c = -sn; s = cs; } else if (q == 2) { c = -cs; s = -sn; } else { c = sn; s = -cs; }
            f32x2 o; o[0] = c; o[1] = s; rope[e] = o;
        }
    }
    rmsnorm_rows(p.in[0], p.in[1], (bf16_t*)(ws + OFF_H), nullptr, gw, ngw, lane);
}

enum { M_MOBA = 0, M_SLC = 1, M_WIN = 2, M_CMP = 3, M_RET = 4 };
template <int MODE, int DV>
__device__ __forceinline__ void attn_pass(unsigned char* smem, const bf16_t* Qb, int ldq, const bf16_t* Kb, int ldk, const bf16_t* Vb, int ldv,
                                          int q0, unsigned rowmask, float log2g, f32x4 (&o)[DV / 16], int tid) {
    constexpr int VST = DV + 8;
    const int lane = tid & 63, wave = tid >> 6, lq = lane & 15, quad = lane >> 4;
    const int t = q0 + wave * 16 + lq;
    constexpr int KSZ = 64 * 72 * 2, BUFSZ = KSZ + 64 * VST * 2;
    bf16x8 qf[2];
#pragma unroll
    for (int ks = 0; ks < 2; ++ks) qf[ks] = as_bf16x8(GLD(u32x4, Qb + (size_t)t * ldq + quad * 8 + 32 * ks));
    float m = -INFINITY, l = 0.f;
#pragma unroll
    for (int c = 0; c < DV / 16; ++c) o[c] = (f32x4){0.f, 0.f, 0.f, 0.f};
    int kt_lo = 0, kt_hi = (q0 + 127) >> 6;
    if (MODE == M_WIN) { const int lo = q0 - 511; kt_lo = (lo > 0 ? lo : 0) >> 6; }
    if (MODE == M_CMP) { kt_hi = 1; }
    constexpr float SC = 0.125f * 1.4426950408889634f;
    const int q4 = lq >> 2, pp = lq & 3;
    float dk[4][4];
#pragma unroll
    for (int sub = 0; sub < 4; ++sub)
#pragma unroll
        for (int j = 0; j < 4; ++j) dk[sub][j] = (MODE == M_RET) ? 0.125f * fexp2(-(float)(16 * sub + 4 * quad + j) * log2g) : 0.f;
    const int rk_ = tid >> 3, chk_ = tid & 7;
    u32x4 kreg, vreg[DV / 64];
    auto gload = [&](int kt) {
        kreg = GLD(u32x4, Kb + (size_t)(kt * 64 + rk_) * ldk + chk_ * 8);
#pragma unroll
        for (int i = 0; i < DV / 64; ++i) { const int idx = tid + i * 512; const int r = idx / (DV / 8), ch = idx % (DV / 8); vreg[i] = GLD(u32x4, Vb + (size_t)(kt * 64 + r) * ldv + ch * 8); }
    };
    auto lstore = [&](int b) {
        bf16_t* Ks_ = (bf16_t*)(smem + b * BUFSZ); bf16_t* Vs_ = (bf16_t*)(smem + b * BUFSZ + KSZ);
        *(u32x4*)(Ks_ + rk_ * 72 + chk_ * 8) = kreg;
#pragma unroll
        for (int i = 0; i < DV / 64; ++i) { const int idx = tid + i * 512; const int r = idx / (DV / 8), ch = idx % (DV / 8); *(u32x4*)(Vs_ + r * VST + ch * 8) = vreg[i]; }
    };
    gload(kt_lo);
    __syncthreads();
    lstore(0);
    if (kt_lo + 1 <= kt_hi) gload(kt_lo + 1);
    __syncthreads();
    int bsel = 0;
    for (int kt = kt_lo; kt <= kt_hi; ++kt, bsel ^= 1) {
        if (kt + 1 <= kt_hi) lstore(bsel ^ 1);
        if (kt + 2 <= kt_hi) gload(kt + 2);
        const bf16_t* Ks = (const bf16_t*)(smem + bsel * BUFSZ); const bf16_t* Vs = (const bf16_t*)(smem + bsel * BUFSZ + KSZ);
        const int kbase = kt * 64;
        bool lane_any;
        if (MODE == M_MOBA) lane_any = (kbase <= t) && ((rowmask >> (kt >> 2)) & 1u);
        else if (MODE == M_SLC) lane_any = (kbase <= t) && ((rowmask >> kt) & 1u);
        else if (MODE == M_WIN) lane_any = (kbase <= t) && (kbase + 63 > t - 512);
        else if (MODE == M_CMP) lane_any = (kbase * 16 + 31 <= t);
        else lane_any = (kbase <= t);
        if (__any(lane_any ? 1 : 0)) {
        f32x4 s[4];
#pragma unroll
        for (int sub = 0; sub < 4; ++sub) {
            s[sub] = (f32x4){0.f, 0.f, 0.f, 0.f};
#pragma unroll
            for (int ks = 0; ks < 2; ++ks) { const bf16x8 a = as_bf16x8(*(const u32x4*)(Ks + (16 * sub + lq) * 72 + quad * 8 + 32 * ks)); s[sub] = mfma16(a, qf[ks], s[sub]); }
        }
        float pv[4][4];
        const int t_min = q0 + wave * 16;
        bool need_mask;
        if (MODE == M_WIN) need_mask = (kbase + 63 > t_min) || (kbase <= t_min + 15 - 512);
        else if (MODE == M_CMP) need_mask = true;
        else need_mask = (kbase + 63 > t_min);
        if (MODE != M_RET) {
            float mx = -INFINITY;
            if (need_mask) {
#pragma unroll
                for (int sub = 0; sub < 4; ++sub)
#pragma unroll
                    for (int j = 0; j < 4; ++j) {
                        const int key = kbase + 16 * sub + 4 * quad + j;
                        bool valid;
                        if (MODE == M_MOBA || MODE == M_SLC) valid = lane_any && (key <= t);
                        else if (MODE == M_WIN) valid = (key <= t) && (key > t - 512);
                        else valid = (key * 16 + 31 <= t);
                        const float sv = valid ? s[sub][j] : -INFINITY;
                        pv[sub][j] = sv; mx = fmaxf(mx, sv);
                    }
            } else if (MODE == M_MOBA || MODE == M_SLC) {
#pragma unroll
                for (int sub = 0; sub < 4; ++sub)
#pragma unroll
                    for (int j = 0; j < 4; ++j) { const float sv = lane_any ? s[sub][j] : -INFINITY; pv[sub][j] = sv; mx = fmaxf(mx, sv); }
            } else {
#pragma unroll
                for (int sub = 0; sub < 4; ++sub)
#pragma unroll
                    for (int j = 0; j < 4; ++j) { pv[sub][j] = s[sub][j]; mx = fmaxf(mx, s[sub][j]); }
            }
            mx = fmaxf(mx, __shfl_xor(mx, 16)); mx = fmaxf(mx, __shfl_xor(mx, 32));
            const float m_new = fmaxf(m, mx * SC);
            const float m_use = (m_new == -INFINITY) ? 0.f : m_new;
            const float alpha = fexp2(m - m_use);
            float rs = 0.f;
#pragma unroll
            for (int sub = 0; sub < 4; ++sub)
#pragma unroll
                for (int j = 0; j < 4; ++j) { const float e = fexp2(__builtin_fmaf(pv[sub][j], SC, -m_use)); pv[sub][j] = e; rs += e; }
            l = l * alpha + rs; m = m_new;
#pragma unroll
            for (int c = 0; c < DV / 16; ++c) { o[c][0] *= alpha; o[c][1] *= alpha; o[c][2] *= alpha; o[c][3] *= alpha; }
        } else {
            const float rowfac = fexp2((float)(t - kbase) * log2g);
            if (need_mask) {
#pragma unroll
                for (int sub = 0; sub < 4; ++sub)
#pragma unroll
                    for (int j = 0; j < 4; ++j) { const int key = kbase + 16 * sub + 4 * quad + j; pv[sub][j] = (key <= t) ? (s[sub][j] * dk[sub][j]) * rowfac : 0.f; }
            } else {
#pragma unroll
                for (int sub = 0; sub < 4; ++sub)
#pragma unroll
                    for (int j = 0; j < 4; ++j) pv[sub][j] = (s[sub][j] * dk[sub][j]) * rowfac;
            }
        }
        bf16x8 pb[2];
#pragma unroll
        for (int s2 = 0; s2 < 2; ++s2) {
            u32x4 w; w.x = pk2(pv[2 * s2][0], pv[2 * s2][1]); w.y = pk2(pv[2 * s2][2], pv[2 * s2][3]); w.z = pk2(pv[2 * s2 + 1][0], pv[2 * s2 + 1][1]); w.w = pk2(pv[2 * s2 + 1][2], pv[2 * s2 + 1][3]);
            pb[s2] = as_bf16x8(w);
        }
#pragma unroll
        for (int c = 0; c < DV / 16; ++c)
#pragma unroll
            for (int s2 = 0; s2 < 2; ++s2) {
                const s16x4 t1 = __builtin_amdgcn_ds_read_tr16_b64_v4i16((LAS s16x4*)(Vs + (32 * s2 + 4 * quad + q4) * VST + 16 * c + 4 * pp));
                const s16x4 t2 = __builtin_amdgcn_ds_read_tr16_b64_v4i16((LAS s16x4*)(Vs + (32 * s2 + 16 + 4 * quad + q4) * VST + 16 * c + 4 * pp));
                bf16x8 a; a[0] = t1[0]; a[1] = t1[1]; a[2] = t1[2]; a[3] = t1[3]; a[4] = t2[0]; a[5] = t2[1]; a[6] = t2[2]; a[7] = t2[3];
                o[c] = mfma16(a, pb[s2], o[c]);
            }
            }
        __syncthreads();
    }
    if (MODE != M_RET) {
        l += __shfl_xor(l, 16); l += __shfl_xor(l, 32);
        const float inv = (l > 0.f) ? 1.f / l : 1.f;
#pragma unroll
        for (int c = 0; c < DV / 16; ++c) { o[c][0] *= inv; o[c][1] *= inv; o[c][2] *= inv; o[c][3] *= inv; }
    }
}


template <int MODE, int DV>
__device__ __forceinline__ void attn_pass2(unsigned char* smem, const bf16_t* Qb, int ldq, const bf16_t* Kb, int ldk, const bf16_t* Vb, int ldv,
                                           int q0, const unsigned (&rowmask)[2], float log2g, f32x4 (&o)[2][DV / 16], int tid) {
    constexpr int VST = DV + 8;
    const int lane = tid & 63, wave = tid >> 6, lq = lane & 15, quad = lane >> 4;
    const int t_min = q0 + wave * 32;
    int t[2]; t[0] = t_min + lq; t[1] = t_min + 16 + lq;
    constexpr int KSZ = 64 * 72 * 2, BUFSZ = KSZ + 64 * VST * 2;
    bf16x8 qf[2][2];
#pragma unroll
    for (int qs = 0; qs < 2; ++qs)
#pragma unroll
        for (int ks = 0; ks < 2; ++ks) qf[qs][ks] = as_bf16x8(GLD(u32x4, Qb + (size_t)t[qs] * ldq + quad * 8 + 32 * ks));
    float m[2], l[2];
#pragma unroll
    for (int qs = 0; qs < 2; ++qs) { m[qs] = -INFINITY; l[qs] = 0.f;
#pragma unroll
        for (int c = 0; c < DV / 16; ++c) o[qs][c] = (f32x4){0.f, 0.f, 0.f, 0.f}; }
    int kt_lo = 0, kt_hi = (q0 + 255) >> 6;
    if (MODE == M_WIN) { const int lo = q0 - 511; kt_lo = (lo > 0 ? lo : 0) >> 6; }
    if (MODE == M_CMP) { kt_hi = (q0 + 255 >= 64 * 16 + 31) ? 1 : 0; }
    constexpr float SC = 0.125f * 1.4426950408889634f;
    const int q4 = lq >> 2, pp = lq & 3;
    const int rk_ = tid >> 3, chk_ = tid & 7;
    float dku[4][4];
#pragma unroll
    for (int sub = 0; sub < 4; ++sub)
#pragma unroll
        for (int j = 0; j < 4; ++j) dku[sub][j] = (MODE == M_RET) ? __int_as_float(__builtin_amdgcn_readfirstlane(__float_as_int(0.125f * fexp2(-(float)(16 * sub + j) * log2g)))) : 0.f;
    u32x4 kreg, vreg[DV / 64];
    auto gload = [&](int kt) {
        kreg = GLD(u32x4, Kb + (size_t)(kt * 64 + rk_) * ldk + chk_ * 8);
#pragma unroll
        for (int i = 0; i < DV / 64; ++i) { const int idx = tid + i * 512; const int r = idx / (DV / 8), ch = idx % (DV / 8); vreg[i] = GLD(u32x4, Vb + (size_t)(kt * 64 + r) * ldv + ch * 8); }
    };
    auto lstore = [&](int b) {
        bf16_t* Ks_ = (bf16_t*)(smem + b * BUFSZ); bf16_t* Vs_ = (bf16_t*)(smem + b * BUFSZ + KSZ);
        *(u32x4*)(Ks_ + rk_ * 72 + chk_ * 8) = kreg;
#pragma unroll
        for (int i = 0; i < DV / 64; ++i) { const int idx = tid + i * 512; const int r = idx / (DV / 8), ch = idx % (DV / 8); *(u32x4*)(Vs_ + r * VST + ch * 8) = vreg[i]; }
    };
    gload(kt_lo);
    __syncthreads();
    lstore(0);
    if (kt_lo + 1 <= kt_hi) gload(kt_lo + 1);
    __syncthreads();
    int bsel = 0;
    for (int kt = kt_lo; kt <= kt_hi; ++kt, bsel ^= 1) {
        if (kt + 1 <= kt_hi) lstore(bsel ^ 1);
        if (kt + 2 <= kt_hi) gload(kt + 2);
        const bf16_t* Ks = (const bf16_t*)(smem + bsel * BUFSZ); const bf16_t* Vs = (const bf16_t*)(smem + bsel * BUFSZ + KSZ);
        const int kbase = kt * 64;
        bool la[2];
#pragma unroll
        for (int qs = 0; qs < 2; ++qs) {
            if (MODE == M_MOBA) la[qs] = (kbase <= t[qs]) && ((rowmask[qs] >> (kt >> 2)) & 1u);
            else if (MODE == M_SLC) la[qs] = (kbase <= t[qs]) && ((rowmask[qs] >> kt) & 1u);
            else if (MODE == M_WIN) la[qs] = (kbase <= t[qs]) && (kbase + 63 > t[qs] - 512);
            else if (MODE == M_CMP) la[qs] = (kbase * 16 + 31 <= t[qs]);
            else la[qs] = (kbase <= t[qs]);
        }
        if (__any((la[0] || la[1]) ? 1 : 0)) {
            f32x4 s[2][4];
#pragma unroll
            for (int sub = 0; sub < 4; ++sub) {
                s[0][sub] = (f32x4){0.f, 0.f, 0.f, 0.f}; s[1][sub] = (f32x4){0.f, 0.f, 0.f, 0.f};
#pragma unroll
                for (int ks = 0; ks < 2; ++ks) {
                    const bf16x8 a = as_bf16x8(*(const u32x4*)(Ks + (16 * sub + lq) * 72 + quad * 8 + 32 * ks));
                    s[0][sub] = mfma16(a, qf[0][ks], s[0][sub]); s[1][sub] = mfma16(a, qf[1][ks], s[1][sub]);
                }
            }
            bool need_mask;
            if (MODE == M_WIN) need_mask = (kbase + 63 > t_min) || (kbase <= t_min + 31 - 512);
            else if (MODE == M_CMP) need_mask = true;
            else need_mask = (kbase + 63 > t_min);
            bf16x8 pb[2][2];
#pragma unroll
            for (int qs = 0; qs < 2; ++qs) {
                if (MODE == M_RET) {
                    const float rowfac = fexp2((float)(t[qs] - kbase - 4 * quad) * log2g);
                    if (need_mask) {
#pragma unroll
                        for (int sub = 0; sub < 4; ++sub)
#pragma unroll
                            for (int j = 0; j < 4; ++j) { const int key = kbase + 16 * sub + 4 * quad + j; s[qs][sub][j] = (key <= t[qs]) ? (s[qs][sub][j] * dku[sub][j]) * rowfac : 0.f; }
                    } else {
#pragma unroll
                        for (int sub = 0; sub < 4; ++sub)
#pragma unroll
                            for (int j = 0; j < 4; ++j) s[qs][sub][j] = (s[qs][sub][j] * dku[sub][j]) * rowfac;
                    }
                } else {
                float mx = -INFINITY, kill = 0.f;
                if (need_mask) {
#pragma unroll
                    for (int sub = 0; sub < 4; ++sub)
#pragma unroll
                        for (int j = 0; j < 4; ++j) {
                            const int key = kbase + 16 * sub + 4 * quad + j;
                            bool valid;
                            if (MODE == M_MOBA || MODE == M_SLC) valid = la[qs] && (key <= t[qs]);
                            else if (MODE == M_WIN) valid = (key <= t[qs]) && (key > t[qs] - 512);
                            else valid = (key * 16 + 31 <= t[qs]);
                            const float sv = valid ? s[qs][sub][j] : -INFINITY;
                            s[qs][sub][j] = sv; mx = fmaxf(mx, sv);
                        }
                } else if (MODE == M_MOBA || MODE == M_SLC) {
#pragma unroll
                    for (int sub = 0; sub < 4; ++sub)
#pragma unroll
                        for (int j = 0; j < 4; ++j) mx = fmaxf(mx, s[qs][sub][j]);
                    mx = la[qs] ? mx : -INFINITY;
                    kill = la[qs] ? 0.f : INFINITY;
                } else {
#pragma unroll
                    for (int sub = 0; sub < 4; ++sub)
#pragma unroll
                        for (int j = 0; j < 4; ++j) mx = fmaxf(mx, s[qs][sub][j]);
                }
                mx = fmaxf(mx, __shfl_xor(mx, 16)); mx = fmaxf(mx, __shfl_xor(mx, 32));
                const float m_new = fmaxf(m[qs], mx * SC);
                const float m_use = (m_new == -INFINITY) ? 0.f : m_new;
                const float alpha = fexp2(m[qs] - m_use);
                const float msub = m_use + kill;
                float rs = 0.f;
#pragma unroll
                for (int sub = 0; sub < 4; ++sub)
#pragma unroll
                    for (int j = 0; j < 4; ++j) { const float e = fexp2(__builtin_fmaf(s[qs][sub][j], SC, -msub)); s[qs][sub][j] = e; rs += e; }
                l[qs] = l[qs] * alpha + rs; m[qs] = m_new;
#pragma unroll
                for (int c = 0; c < DV / 16; ++c) { o[qs][c][0] *= alpha; o[qs][c][1] *= alpha; o[qs][c][2] *= alpha; o[qs][c][3] *= alpha; }
                }
#pragma unroll
                for (int s2 = 0; s2 < 2; ++s2) {
                    u32x4 w; w.x = pk2(s[qs][2 * s2][0], s[qs][2 * s2][1]); w.y = pk2(s[qs][2 * s2][2], s[qs][2 * s2][3]);
                    w.z = pk2(s[qs][2 * s2 + 1][0], s[qs][2 * s2 + 1][1]); w.w = pk2(s[qs][2 * s2 + 1][2], s[qs][2 * s2 + 1][3]);
                    pb[qs][s2] = as_bf16x8(w);
                }
            }
#pragma unroll
            for (int c = 0; c < DV / 16; ++c) {
                if (DV > 64 && (c & 1) == 0) asm volatile("" ::: "memory");
#pragma unroll
                for (int s2 = 0; s2 < 2; ++s2) {
                    const s16x4 t1 = __builtin_amdgcn_ds_read_tr16_b64_v4i16((LAS s16x4*)(Vs + (32 * s2 + 4 * quad + q4) * VST + 16 * c + 4 * pp));
                    const s16x4 t2 = __builtin_amdgcn_ds_read_tr16_b64_v4i16((LAS s16x4*)(Vs + (32 * s2 + 16 + 4 * quad + q4) * VST + 16 * c + 4 * pp));
                    bf16x8 a; a[0] = t1[0]; a[1] = t1[1]; a[2] = t1[2]; a[3] = t1[3]; a[4] = t2[0]; a[5] = t2[1]; a[6] = t2[2]; a[7] = t2[3];
                    o[0][c] = mfma16(a, pb[0][s2], o[0][c]); o[1][c] = mfma16(a, pb[1][s2], o[1][c]);
                }
            }
        }
        __syncthreads();
    }
    if (MODE != M_RET)
#pragma unroll
    for (int qs = 0; qs < 2; ++qs) {
        float lt = l[qs];
        lt += __shfl_xor(lt, 16); lt += __shfl_xor(lt, 32);
        const float inv = (lt > 0.f) ? 1.f / lt : 1.f;
#pragma unroll
        for (int c = 0; c < DV / 16; ++c) { o[qs][c][0] *= inv; o[qs][c][1] *= inv; o[qs][c][2] *= inv; o[qs][c][3] *= inv; }
    }
}

__device__ __forceinline__ void kmean_phase(const Params& p, int tid, int bid, int nblk) {
    const bf16_t* Z = (const bf16_t*)(p.ws + OFF_Z);
    float* km = (float*)(p.ws + OFF_KMEAN);
    for (int it = bid; it < 256; it += nblk) {
        const int b = it >> 4, n = (it >> 1) & 7, half = it & 1;
        const int ch = half * 512 + tid;
        const bf16_t* src = Z + ((size_t)(b * S_ + n * 256)) * EIN + 1024 + ch;
        float s = 0.f;
#pragma unroll 8
        for (int tt = 0; tt < 256; ++tt) s += bf2f(GLD(bf16_t, src + (size_t)tt * EIN));
        const int h = ch >> 6, d = ch & 63;
        GST(float, km + ((size_t)(b * 16 + h) * 8 + n) * 64 + d) = s * (1.f / 256.f);
    }
}

__device__ __forceinline__ void moba_item(const Params& p, unsigned char* smem, int b, int h, int qt, int tid) {
    const int lane = tid & 63, wave = tid >> 6, lq = lane & 15, quad = lane >> 4;
    const bf16_t* Z = (const bf16_t*)(p.ws + OFF_Z) + (size_t)b * S_ * EIN;
    const int q0 = qt * 128, t = q0 + wave * 16 + lq, own = q0 >> 8;
    unsigned rowmask = 1u << own;
    if (own > 0) {
        const float* km = (const float*)(p.ws + OFF_KMEAN) + (size_t)(b * 16 + h) * 8 * 64;
        u32x4 zq[8];
#pragma unroll
        for (int c8 = 0; c8 < 8; ++c8) zq[c8] = GLD(u32x4, Z + (size_t)t * EIN + h * 64 + c8 * 8);
        float g2[2] = {0.f, 0.f};
#pragma unroll
        for (int i = 0; i < 2; ++i) {
            const int n = quad + 4 * i;
            if (n < own) {
                f32x4 kv[16];
#pragma unroll
                for (int d4 = 0; d4 < 16; ++d4) kv[d4] = GLD(f32x4, km + n * 64 + d4 * 4);
                float acc = 0.f;
#pragma unroll
                for (int c8 = 0; c8 < 8; ++c8) {
                    float f[8]; unpack8(zq[c8], f);
                    acc += (f[0] * kv[2 * c8][0] + f[1] * kv[2 * c8][1]) + (f[2] * kv[2 * c8][2] + f[3] * kv[2 * c8][3])
                         + (f[4] * kv[2 * c8 + 1][0] + f[5] * kv[2 * c8 + 1][1]) + (f[6] * kv[2 * c8 + 1][2] + f[7] * kv[2 * c8 + 1][3]);
                }
                g2[i] = acc;
            }
        }
        float gsc[7];
#pragma unroll
        for (int n = 0; n < 7; ++n) gsc[n] = __shfl((n >> 2) ? g2[1] : g2[0], lq + 16 * (n & 3));
#pragma unroll
        for (int n = 0; n < 7; ++n) {
            int cnt = 0;
#pragma unroll
            for (int n2 = 0; n2 < 7; ++n2) { if (n2 != n) { const bool beats = (gsc[n2] > gsc[n]) || (gsc[n2] == gsc[n] && n2 < n); cnt += (n2 < own && beats) ? 1 : 0; } }
            if (n < own && cnt < 3) rowmask |= (1u << n);
        }
    }
    f32x4 o[4];
    attn_pass<M_MOBA, 64>(smem, Z + h * 64, EIN, Z + 1024 + h * 64, EIN, Z + 2048 + h * 64, EIN, q0, rowmask, 0.f, o, tid);
    bf16_t* cat = (bf16_t*)(p.ws + OFF_CAT) + (size_t)(b * S_ + t) * D_ + h * 64;
#pragma unroll
    for (int c = 0; c < 4; ++c) { u32x2 w; w.x = pk2(o[c][0], o[c][1]); w.y = pk2(o[c][2], o[c][3]); GST(u32x2, cat + 16 * c + 4 * quad) = w; }
}


__device__ __forceinline__ void moba_item2(const Params& p, unsigned char* smem, int b, int h, int qt, int tid) {
    const int lane = tid & 63, wave = tid >> 6, lq = lane & 15, quad = lane >> 4;
    const bf16_t* Z = (const bf16_t*)(p.ws + OFF_Z) + (size_t)b * S_ * EIN;
    const int q0 = qt * 256, own = qt;
    int t[2]; t[0] = q0 + wave * 32 + lq; t[1] = t[0] + 16;
    unsigned rowmask[2]; rowmask[0] = 1u << own; rowmask[1] = 1u << own;
    if (own > 0) {
        const float* km = (const float*)(p.ws + OFF_KMEAN) + (size_t)(b * 16 + h) * 8 * 64;
        u32x4 zq[2][8];
#pragma unroll
        for (int qs = 0; qs < 2; ++qs)
#pragma unroll
            for (int c8 = 0; c8 < 8; ++c8) zq[qs][c8] = GLD(u32x4, Z + (size_t)t[qs] * EIN + h * 64 + c8 * 8);
        float g2[2][2] = {{0.f, 0.f}, {0.f, 0.f}};
#pragma unroll
        for (int i = 0; i < 2; ++i) {
            const int n = quad + 4 * i;
            if (n < own) {
                f32x4 kv[16];
#pragma unroll
                for (int d4 = 0; d4 < 16; ++d4) kv[d4] = GLD(f32x4, km + n * 64 + d4 * 4);
#pragma unroll
                for (int qs = 0; qs < 2; ++qs) {
                    float acc = 0.f;
#pragma unroll
                    for (int c8 = 0; c8 < 8; ++c8) {
                        float f[8]; unpack8(zq[qs][c8], f);
                        acc += (f[0] * kv[2 * c8][0] + f[1] * kv[2 * c8][1]) + (f[2] * kv[2 * c8][2] + f[3] * kv[2 * c8][3])
                             + (f[4] * kv[2 * c8 + 1][0] + f[5] * kv[2 * c8 + 1][1]) + (f[6] * kv[2 * c8 + 1][2] + f[7] * kv[2 * c8 + 1][3]);
                    }
                    g2[qs][i] = acc;
                }
            }
        }
#pragma unroll
        for (int qs = 0; qs < 2; ++qs) {
            float gsc[7];
#pragma unroll
            for (int n = 0; n < 7; ++n) gsc[n] = __shfl((n >> 2) ? g2[qs][1] : g2[qs][0], lq + 16 * (n & 3));
#pragma unroll
            for (int n = 0; n < 7; ++n) {
                int cnt = 0;
#pragma unroll
                for (int n2 = 0; n2 < 7; ++n2) { if (n2 != n) { const bool beats = (gsc[n2] > gsc[n]) || (gsc[n2] == gsc[n] && n2 < n); cnt += (n2 < own && beats) ? 1 : 0; } }
                if (n < own && cnt < 3) rowmask[qs] |= (1u << n);
            }
        }
    }
    f32x4 o[2][4];
    attn_pass2<M_MOBA, 64>(smem, Z + h * 64, EIN, Z + 1024 + h * 64, EIN, Z + 2048 + h * 64, EIN, q0, rowmask, 0.f, o, tid);
#pragma unroll
    for (int qs = 0; qs < 2; ++qs) {
        bf16_t* cat = (bf16_t*)(p.ws + OFF_CAT) + (size_t)(b * S_ + t[qs]) * D_ + h * 64;
#pragma unroll
        for (int c = 0; c < 4; ++c) { u32x2 w; w.x = pk2(o[qs][c][0], o[qs][c][1]); w.y = pk2(o[qs][c][2], o[qs][c][3]); GST(u32x2, cat + 16 * c + 4 * quad) = w; }
    }
}

__device__ __forceinline__ void rwkv_item(const Params& p, unsigned char* smem, int b, int h, int tid) {
    const int lane = tid & 63, wave = tid >> 6, lq = lane & 15, quad = lane >> 4;
    constexpr int ZB = 3072;
    const bf16_t* Z = (const bf16_t*)(p.ws + OFF_Z) + (size_t)b * S_ * EIN;
    const float* mu = p.in[4];
    float* R = (float*)smem;
    float* KP = R + 2048; float* V = KP + 2048; float* DEC = V + 2048; float* NKK = DEC + 2048; float* KKA = NKK + 2048;
    float* GG = KKA + 2048; float* Y = GG + 2048; float* AA = Y + 2048; float* BC = AA + 2048;
    bf16_t* TW = (bf16_t*)(BC + 64);
    bf16_t* AL = TW + 32 * 72;
    bf16_t* GL = AL + 32 * 72;
    const int mt = wave >> 2, nt = wave & 3;
    const int chn = h * 64 + 16 * nt + lq;
    bf16x8 bw[2], ba[2], bg[4];
    {
        const float* wup = p.in[6]; const float* aup = p.in[8]; const float* gup = p.in[9];
#pragma unroll
        for (int ks = 0; ks < 2; ++ks) {
            float fw[8], fa[8];
#pragma unroll
            for (int i = 0; i < 8; ++i) { const int k = 32 * ks + quad * 8 + i; fw[i] = wup[(size_t)k * 1024 + chn]; fa[i] = aup[(size_t)k * 1024 + chn]; }
            u32x4 w; w.x = pk2(fw[0], fw[1]); w.y = pk2(fw[2], fw[3]); w.z = pk2(fw[4], fw[5]); w.w = pk2(fw[6], fw[7]); bw[ks] = as_bf16x8(w);
            u32x4 a; a.x = pk2(fa[0], fa[1]); a.y = pk2(fa[2], fa[3]); a.z = pk2(fa[4], fa[5]); a.w = pk2(fa[6], fa[7]); ba[ks] = as_bf16x8(a);
        }
#pragma unroll
        for (int ks = 0; ks < 4; ++ks) {
            float fg[8];
#pragma unroll
            for (int i = 0; i < 8; ++i) { const int k = 32 * ks + quad * 8 + i; fg[i] = gup[(size_t)k * 1024 + chn]; }
            u32x4 g; g.x = pk2(fg[0], fg[1]); g.y = pk2(fg[2], fg[3]); g.z = pk2(fg[4], fg[5]); g.w = pk2(fg[6], fg[7]); bg[ks] = as_bf16x8(g);
        }
    }
    const float w0c = p.in[5][chn], a0c = p.in[7][chn];
    const int cs = tid & 15, ttC = tid >> 4;
    const f32x4 kkc = *(const f32x4*)(p.in[10] + h * 64 + 4 * cs), kac = *(const f32x4*)(p.in[11] + h * 64 + 4 * cs), rkc = *(const f32x4*)(p.in[12] + h * 64 + 4 * cs);
    const f32x4 lng = *(const f32x4*)(p.in[13] + h * 64 + 4 * cs), lnb = *(const f32x4*)(p.in[14] + h * 64 + 4 * cs);
    const int js = tid & 15, rp = tid >> 4;
    f32x2 P[4];
#pragma unroll
    for (int e = 0; e < 4; ++e) P[e] = (f32x2){0.f, 0.f};
    bf16_t* cat = (bf16_t*)(p.ws + OFF_CAT) + (size_t)b * S_ * D_ + 1024 + h * 64;

    int a_off[4];
#pragma unroll
    for (int i = 0; i < 4; ++i) {
        const int idx = tid + 512 * i; const int tt = idx / 56, cv = idx % 56;
        int zc;
        if (cv < 8) zc = ZB + h * 64 + cv * 8;
        else if (cv < 16) zc = ZB + 1024 + h * 64 + (cv - 8) * 8;
        else if (cv < 24) zc = ZB + 2048 + h * 64 + (cv - 16) * 8;
        else zc = ZB + 3072 + (cv - 24) * 8;
        a_off[i] = (idx < 1792) ? (tt * EIN + zc) : zc;
    }
    u32x4 a_cur[4], a_prv[4];
#pragma unroll
    for (int i = 0; i < 4; ++i) {
        const bool act = (i < 3) || (tid < 256);
        a_cur[i] = (u32x4){0u, 0u, 0u, 0u}; a_prv[i] = (u32x4){0u, 0u, 0u, 0u};
        if (act) { a_cur[i] = GLD(u32x4, Z + a_off[i]); if (a_off[i] >= EIN) a_prv[i] = GLD(u32x4, Z + a_off[i] - EIN); }
    }
    for (int t0 = 0; t0 < S_; t0 += 32) {
        __syncthreads();
#pragma unroll
        for (int i = 0; i < 4; ++i) {
            const int idx = tid + 512 * i;
            if ((i < 3) || (tid < 256)) {
            const int tt = idx / 56, cv = idx % 56;
            const int zc = a_off[i] - tt * EIN;
            float cur[8], prv[8];
            unpack8(a_cur[i], cur); unpack8(a_prv[i], prv);
            const f32x4 m0 = GLD(f32x4, mu + (zc - ZB)), m1 = GLD(f32x4, mu + (zc - ZB) + 4);
            float val[8];
#pragma unroll
            for (int e = 0; e < 4; ++e) { val[e] = cur[e] + (prv[e] - cur[e]) * m0[e]; val[4 + e] = cur[4 + e] + (prv[4 + e] - cur[4 + e]) * m1[e]; }
            if (cv < 24) {
                float* dst = (cv < 8 ? R : (cv < 16 ? KP : V)) + tt * 64 + (cv & 7) * 8;
                *(f32x4*)dst = (f32x4){val[0], val[1], val[2], val[3]}; *(f32x4*)(dst + 4) = (f32x4){val[4], val[5], val[6], val[7]};
            } else {
                if (cv < 32) {
#pragma unroll
                    for (int e = 0; e < 8; ++e) { const float ex = fexp(2.f * val[e]); val[e] = 1.f - 2.f * frcp(ex + 1.f); } }
                else if (cv >= 40) {
#pragma unroll
                    for (int e = 0; e < 8; ++e) val[e] = sigmoidf_(val[e]); }
                u32x4 w; w.x = pk2(val[0], val[1]); w.y = pk2(val[2], val[3]); w.z = pk2(val[4], val[5]); w.w = pk2(val[6], val[7]);
                bf16_t* dst = (cv < 32) ? (TW + tt * 72 + (cv - 24) * 8) : ((cv < 40) ? (AL + tt * 72 + (cv - 32) * 8) : (GL + tt * 136 + (cv - 40) * 8));
                *(u32x4*)dst = w;
            }
            }
        }
        __syncthreads();
        if (t0 + 32 < S_) {
#pragma unroll
            for (int i = 0; i < 4; ++i) {
                if ((i < 3) || (tid < 256)) { const size_t o = (size_t)(t0 + 32) * EIN + a_off[i]; a_cur[i] = GLD(u32x4, Z + o); a_prv[i] = GLD(u32x4, Z + o - EIN); }
            }
        }
        {
            f32x4 cw = (f32x4){0.f, 0.f, 0.f, 0.f}, ca = cw, cg_ = cw;
#pragma unroll
            for (int ks = 0; ks < 2; ++ks) {
                const bf16x8 a1 = as_bf16x8(*(const u32x4*)(TW + (16 * mt + lq) * 72 + quad * 8 + 32 * ks));
                const bf16x8 a2 = as_bf16x8(*(const u32x4*)(AL + (16 * mt + lq) * 72 + quad * 8 + 32 * ks));
                cw = mfma16(a1, bw[ks], cw); ca = mfma16(a2, ba[ks], ca);
            }
#pragma unroll
            for (int ks = 0; ks < 4; ++ks) { const bf16x8 a3 = as_bf16x8(*(const u32x4*)(GL + (16 * mt + lq) * 136 + quad * 8 + 32 * ks)); cg_ = mfma16(a3, bg[ks], cg_); }
#pragma unroll
            for (int j = 0; j < 4; ++j) {
                const int tt = 16 * mt + 4 * quad + j, ch = 16 * nt + lq;
                const float wf = cw[j] + w0c;
                const float sp = (wf < -15.f) ? -wf : __logf(1.f + fexp(-wf));
                const float wv = -sp - 0.5f;
                DEC[tt * 64 + ch] = fexp(-fexp(wv));
                AA[tt * 64 + ch] = sigmoidf_(ca[j] + a0c);
                GG[tt * 64 + ch] = cg_[j];
            }
        }
        __syncthreads();
        {
            const f32x4 k4 = *(const f32x4*)(KP + ttC * 64 + 4 * cs), a4 = *(const f32x4*)(AA + ttC * 64 + 4 * cs), r4 = *(const f32x4*)(R + ttC * 64 + 4 * cs);
            f32x4 kkv; float ss = 0.f;
#pragma unroll
            for (int e = 0; e < 4; ++e) { kkv[e] = k4[e] * kkc[e]; ss += kkv[e] * kkv[e]; }
            ss = rowsum16(ss);
            const float inv = fminf(__builtin_amdgcn_rsqf(ss), 1e12f);
            f32x4 nk, ka, kp; float bc = 0.f;
#pragma unroll
            for (int e = 0; e < 4; ++e) { const float kk = kkv[e] * inv; nk[e] = -kk; ka[e] = kk * a4[e]; kp[e] = k4[e] * (1.f + (a4[e] - 1.f) * kac[e]); bc += r4[e] * kp[e] * rkc[e]; }
            bc = rowsum16(bc);
            *(f32x4*)(NKK + ttC * 64 + 4 * cs) = nk; *(f32x4*)(KKA + ttC * 64 + 4 * cs) = ka; *(f32x4*)(KP + ttC * 64 + 4 * cs) = kp;
            if (cs == 0) BC[ttC] = bc;
        }
        __syncthreads();
        {
            f32x4 nk = *(const f32x4*)(NKK + 4 * js), wd = *(const f32x4*)(DEC + 4 * js), ka = *(const f32x4*)(KKA + 4 * js);
            f32x4 kp = *(const f32x4*)(KP + 4 * js), rr = *(const f32x4*)(R + 4 * js);
            f32x2 vv = *(const f32x2*)(V + 2 * rp);
            float yq0 = 0.f, yq1 = 0.f;
#pragma unroll 8
            for (int tt = 0; tt < 32; ++tt) {
                const int tn = (tt < 31) ? tt + 1 : 31;
                const f32x4 nk2 = *(const f32x4*)(NKK + tn * 64 + 4 * js), wd2 = *(const f32x4*)(DEC + tn * 64 + 4 * js), ka2 = *(const f32x4*)(KKA + tn * 64 + 4 * js);
                const f32x4 kp2 = *(const f32x4*)(KP + tn * 64 + 4 * js), rr2 = *(const f32x4*)(R + tn * 64 + 4 * js);
                const f32x2 vv2 = *(const f32x2*)(V + tn * 64 + 2 * rp);
                f32x2 sa = (P[0] * nk[0] + P[1] * nk[1]) + (P[2] * nk[2] + P[3] * nk[3]);
                float sa0 = sa[0], sa1 = sa[1];
                rowsum16x4(sa0, sa1, yq0, yq1);
                if (tt > 0 && js == 0) { f32x2 yy; yy[0] = yq0; yy[1] = yq1; *(f32x2*)(Y + (tt - 1) * 64 + 2 * rp) = yy; }
                f32x2 sav; sav[0] = sa0; sav[1] = sa1;
#pragma unroll
                for (int e = 0; e < 4; ++e) P[e] = P[e] * wd[e] + (sav * ka[e] + vv * kp[e]);
                const f32x2 yv = (P[0] * rr[0] + P[1] * rr[1]) + (P[2] * rr[2] + P[3] * rr[3]);
                yq0 = yv[0]; yq1 = yv[1];
                nk = nk2; wd = wd2; ka = ka2; kp = kp2; rr = rr2; vv = vv2;
            }
            yq0 = rowsum16(yq0); yq1 = rowsum16(yq1);
            if (js == 0) { f32x2 yy; yy[0] = yq0; yy[1] = yq1; *(f32x2*)(Y + 31 * 64 + 2 * rp) = yy; }
        }
        __syncthreads();
        {
            const f32x4 y4 = *(const f32x4*)(Y + ttC * 64 + 4 * cs), v4 = *(const f32x4*)(V + ttC * 64 + 4 * cs), g4 = *(const f32x4*)(GG + ttC * 64 + 4 * cs);
            float sm = (y4[0] + y4[1]) + (y4[2] + y4[3]);
            sm = rowsum16(sm);
            const float mean = sm * (1.f / 64.f);
            float dv[4], sq = 0.f;
#pragma unroll
            for (int e = 0; e < 4; ++e) { dv[e] = y4[e] - mean; sq += dv[e] * dv[e]; }
            sq = rowsum16(sq);
            const float rstd = rsqrtf(sq * (1.f / 64.f) + 6.4e-4f);
            const float bc = BC[ttC];
            float ov[4];
#pragma unroll
            for (int e = 0; e < 4; ++e) ov[e] = (dv[e] * rstd * lng[e] + lnb[e] + bc * v4[e]) * g4[e];
            u32x2 w; w.x = pk2(ov[0], ov[1]); w.y = pk2(ov[2], ov[3]);
            GST(u32x2, cat + (size_t)(t0 + ttC) * D_ + 4 * cs) = w;
        }
    }
}

__device__ __forceinline__ void even_mixer_phase(const Params& p, unsigned char* smem, int tid, int bid, int nblk) {
    for (int rep = 0; rep < REP_RWKV; ++rep)
    for (int it = bid; it < 256; it += nblk) rwkv_item(p, smem, it >> 4, it & 15, tid);
    for (int rep = 0; rep < REP_MOBA; ++rep)
    for (int it = bid; it < 2048; it += nblk) {
        const int qt = 7 - (it >> 8), bh = it & 255;
        moba_item2(p, smem, bh >> 4, bh & 15, qt, tid);
    }
}

__device__ __forceinline__ void gelu_tanh4(f32x4& v) {
#pragma unroll
    for (int j = 0; j < 4; ++j) { const float x = v[j]; const float u = 0.7978845608028654f * (x + 0.044715f * x * x * x); const float ex = fexp(2.f * u); const float th = 1.f - 2.f * frcp(ex + 1.f); v[j] = 0.5f * x * (1.f + th); }
}

__device__ __forceinline__ void odd_prep_phase(const Params& p, unsigned char* smem, int tid, int bid, int nblk) {
    const int lane = tid & 63, wave = tid >> 6, lq = lane & 15, quad = lane >> 4;
    bf16_t* Z = (bf16_t*)(p.ws + OFF_Z);
    {
        const f32x2* rope = (const f32x2*)(p.ws + OFF_ROPE);
        const int half = nblk >> 1, nthreads = (nblk - half) * 512;
        for (int it = (bid >= half) ? (bid - half) * 512 + tid : T_ * 64; it < T_ * 64; it += nthreads) {
            const int row = it >> 6, wh = (it >> 2) & 15, cidx = it & 3;
            const int pos = row & (S_ - 1);
            bf16_t* base = Z + (size_t)row * OLD + wh * 64 + cidx * 8;
            float z1[8], z2[8];
            unpack8(GLD(u32x4, base), z1); unpack8(GLD(u32x4, base + 32), z2);
            float o1[8], o2[8];
#pragma unroll
            for (int e = 0; e < 8; ++e) { const f32x2 cs = GLD(f32x2, rope + pos * 32 + cidx * 8 + e); o1[e] = z1[e] * cs[0] - z2[e] * cs[1]; o2[e] = z1[e] * cs[1] + z2[e] * cs[0]; }
            u32x4 w1; w1.x = pk2(o1[0], o1[1]); w1.y = pk2(o1[2], o1[3]); w1.z = pk2(o1[4], o1[5]); w1.w = pk2(o1[6], o1[7]);
            u32x4 w2; w2.x = pk2(o2[0], o2[1]); w2.y = pk2(o2[2], o2[3]); w2.z = pk2(o2[4], o2[5]); w2.w = pk2(o2[6], o2[7]);
            GST(u32x4, base) = w1; GST(u32x4, base + 32) = w2;
        }
    }
    {
        const int gw = bid * 8 + wave, ngw = nblk * 8;
        bf16_t* hid = (bf16_t*)(smem + wave * (16 * 136 * 2));
        for (int task = gw; task < 1024; task += ngw) {
            const int kv = task >> 9, b = (task >> 5) & 15, g = (task >> 3) & 3, ct = task & 7;
            const bf16_t* Zs = Z + (size_t)b * S_ * OLD + (kv ? 4352 : 4096) + g * 64;
            const bf16_t* w1t = (const bf16_t*)(p.ws + (kv ? OFF_W1T_V : OFF_W1T_K));
            const bf16_t* w2t = (const bf16_t*)(p.ws + (kv ? OFF_W2T_V : OFF_W2T_K));
            const float* bias1 = (const float*)(p.ws + OFF_BIAS1) + kv * 128;
            f32x4 acc[8];
#pragma unroll
            for (int n = 0; n < 8; ++n) acc[n] = (f32x4){0.f, 0.f, 0.f, 0.f};
            const int c = ct * 16 + lq;
            bf16x8 a_c, b_c[8], a_n, b_n[8];
            auto cload = [&](int ks, bf16x8& a, bf16x8 (&bb)[8]) {
                const int l = ks >> 1, d0 = (ks & 1) * 32 + quad * 8;
                int row = 16 * c + l; row = row > 2047 ? 2047 : row;
                a = as_bf16x8(GLD(u32x4, Zs + (size_t)row * OLD + d0));
#pragma unroll
                for (int n = 0; n < 8; ++n) bb[n] = as_bf16x8(GLD(u32x4, w1t + (size_t)(16 * n + lq) * 2048 + ks * 32 + quad * 8));
            };
            cload(0, a_c, b_c);
            for (int ks = 0; ks < 64; ++ks) {
                if (ks + 1 < 64) cload(ks + 1, a_n, b_n);
#pragma unroll
                for (int n = 0; n < 8; ++n) acc[n] = mfma16(a_c, b_c[n], acc[n]);
                a_c = a_n;
#pragma unroll
                for (int n = 0; n < 8; ++n) b_c[n] = b_n[n];
            }
#pragma unroll
            for (int n = 0; n < 8; ++n) {
                const float bv = GLD(float, bias1 + 16 * n + lq);
                f32x4 hv = acc[n]; hv[0] += bv; hv[1] += bv; hv[2] += bv; hv[3] += bv;
                gelu_tanh4(hv);
#pragma unroll
                for (int j = 0; j < 4; ++j) { const unsigned pk = pk2(hv[j], 0.f); hid[(4 * quad + j) * 136 + 16 * n + lq] = (bf16_t)(pk & 0xffffu); }
            }
            lds_wait();
            f32x4 acc2[4];
#pragma unroll
            for (int n = 0; n < 4; ++n) acc2[n] = (f32x4){0.f, 0.f, 0.f, 0.f};
#pragma unroll
            for (int ks = 0; ks < 4; ++ks) {
                const bf16x8 a = as_bf16x8(*(const u32x4*)(hid + lq * 136 + quad * 8 + 32 * ks));
#pragma unroll
                for (int n = 0; n < 4; ++n) { const bf16x8 bb = as_bf16x8(GLD(u32x4, w2t + (size_t)(16 * n + lq) * 128 + ks * 32 + quad * 8)); acc2[n] = mfma16(a, bb, acc2[n]); }
            }
            lds_wait();
            bf16_t* dst = (bf16_t*)(p.ws + (kv ? OFF_VC : OFF_KC)) + (size_t)((b * 4 + g) * 128) * 64;
#pragma unroll
            for (int n = 0; n < 4; ++n)
#pragma unroll
                for (int j = 0; j < 4; ++j) {
                    const int cc = ct * 16 + 4 * quad + j;
                    const float v = (cc < 127) ? acc2[n][j] : 0.f;
                    GST(bf16_t, dst + (size_t)cc * 64 + 16 * n + lq) = (bf16_t)(pk2(v, 0.f) & 0xffffu);
                }
        }
    }
}

__device__ __forceinline__ void select_phase(const Params& p, unsigned char* smem, int tid, int bid, int nblk) {
    const int lane = tid & 63, wave = tid >> 6, lq = lane & 15, quad = lane >> 4;
    const bf16_t* Z = (const bf16_t*)(p.ws + OFF_Z);
    const int gw = bid * 8 + wave, ngw = nblk * 8;
    float* PS = (float*)(smem + wave * 2048);
    constexpr float SC = 0.125f * 1.4426950408889634f;
    for (int task = gw; task < 8192; task += ngw) {
        const int b = task >> 9, g = (task >> 7) & 3, qt = task & 127;
        const int t = qt * 16 + lq;
        const bf16_t* kc = (const bf16_t*)(p.ws + OFF_KC) + (size_t)((b * 4 + g) * 128) * 64;
        const int cmax = (t - 31) >> 4;
        f32x4 psum[8];
#pragma unroll
        for (int sub = 0; sub < 8; ++sub) psum[sub] = (f32x4){0.f, 0.f, 0.f, 0.f};
        bf16x8 kfr[8][2], qfr[4][2];
#pragma unroll
        for (int sub = 0; sub < 8; ++sub)
#pragma unroll
            for (int ks = 0; ks < 2; ++ks) kfr[sub][ks] = as_bf16x8(GLD(u32x4, kc + (size_t)(16 * sub + lq) * 64 + quad * 8 + 32 * ks));
#pragma unroll
        for (int r = 0; r < 4; ++r)
#pragma unroll
            for (int ks = 0; ks < 2; ++ks) qfr[r][ks] = as_bf16x8(GLD(u32x4, Z + (size_t)(b * S_ + t) * OLD + 3072 + (g * 4 + r) * 64 + quad * 8 + 32 * ks));
#pragma unroll
        for (int r = 0; r < 4; ++r) {
            f32x4 s[8]; float mx = -INFINITY;
#pragma unroll
            for (int sub = 0; sub < 8; ++sub) {
                s[sub] = (f32x4){0.f, 0.f, 0.f, 0.f};
#pragma unroll
                for (int ks = 0; ks < 2; ++ks) s[sub] = mfma16(kfr[sub][ks], qfr[r][ks], s[sub]);
#pragma unroll
                for (int j = 0; j < 4; ++j) { const int key = 16 * sub + 4 * quad + j; const float sv = (key <= cmax) ? s[sub][j] * SC : -INFINITY; s[sub][j] = sv; mx = fmaxf(mx, sv); }
            }
            mx = fmaxf(mx, __shfl_xor(mx, 16)); mx = fmaxf(mx, __shfl_xor(mx, 32));
            const float m_use = (mx == -INFINITY) ? 0.f : mx;
            float rs = 0.f;
#pragma unroll
            for (int sub = 0; sub < 8; ++sub)
#pragma unroll
                for (int j = 0; j < 4; ++j) { const float e = fexp2(s[sub][j] - m_use); s[sub][j] = e; rs += e; }
            rs += __shfl_xor(rs, 16); rs += __shfl_xor(rs, 32);
            const float inv = (rs > 0.f) ? 1.f / rs : 0.f;
#pragma unroll
            for (int sub = 0; sub < 8; ++sub)
#pragma unroll
                for (int j = 0; j < 4; ++j) psum[sub][j] += s[sub][j] * inv;
        }
        float pslc[8], tprev[8];
#pragma unroll
        for (int sub = 0; sub < 8; ++sub) tprev[sub] = __shfl(psum[sub][3], (lane + 48) & 63);
#pragma unroll
        for (int sub = 0; sub < 8; ++sub) {
            float extra;
            if (quad >= 1) extra = tprev[sub]; else extra = (sub >= 1) ? tprev[sub >= 1 ? sub - 1 : 0] : 0.f;
            pslc[sub] = ((psum[sub][0] + psum[sub][1]) + (psum[sub][2] + psum[sub][3])) + extra;
            PS[lq * 32 + 4 * sub + quad] = pslc[sub];
        }
        lds_wait();
        float pvv[32];
#pragma unroll
        for (int q = 0; q < 8; ++q) { const f32x4 v = *(const f32x4*)(PS + lq * 32 + 4 * q); pvv[4 * q] = v[0]; pvv[4 * q + 1] = v[1]; pvv[4 * q + 2] = v[2]; pvv[4 * q + 3] = v[3]; }
        lds_wait();
        const int own = t >> 6;
        unsigned bits = 0;
#pragma unroll
        for (int sub = 0; sub < 8; ++sub) {
            const int j = 4 * sub + quad; const float mv = pslc[sub];
            int cnt = 0;
#pragma unroll
            for (int j2 = 1; j2 < 32; ++j2) { const bool beats = (pvv[j2] > mv) || (pvv[j2] == mv && j2 < j); cnt += (j2 < own && j2 != j && beats) ? 1 : 0; }
            const bool sel = (j == 0) || (j == own) || (j >= 1 && j < own && cnt < 14);
            if (sel) bits |= (1u << j);
        }
        bits |= (unsigned)__shfl_xor((int)bits, 16); bits |= (unsigned)__shfl_xor((int)bits, 32);
        if (quad == 0) GST(unsigned, (unsigned*)(p.ws + OFF_SEL) + (size_t)(b * 4 + g) * S_ + t) = bits;
    }
}

__device__ __forceinline__ void nsa_item(const Params& p, unsigned char* smem, int b, int head, int qt, int tid) {
    const int lane = tid & 63, wave = tid >> 6, lq = lane & 15, quad = lane >> 4;
    const int g = head >> 2, q0 = qt * 128, t = q0 + wave * 16 + lq;
    const bf16_t* Z = (const bf16_t*)(p.ws + OFF_Z) + (size_t)b * S_ * OLD;
    const unsigned rowmask = GLD(unsigned, (const unsigned*)(p.ws + OFF_SEL) + (size_t)(b * 4 + g) * S_ + t);
    float gate[3];
#pragma unroll
    for (int i = 0; i < 3; ++i) gate[i] = sigmoidf_(bf2f(GLD(bf16_t, Z + (size_t)t * OLD + 5632 + head * 3 + i)));
    f32x4 o[4], tot[4];
    const bf16_t* kc = (const bf16_t*)(p.ws + OFF_KC) + (size_t)((b * 4 + g) * 128) * 64;
    const bf16_t* vc = (const bf16_t*)(p.ws + OFF_VC) + (size_t)((b * 4 + g) * 128) * 64;
#ifndef NSA_PASSES
#define NSA_PASSES 7
#endif
    if (NSA_PASSES & 1) attn_pass<M_CMP, 64>(smem, Z + 3072 + head * 64, OLD, kc, 64, vc, 64, q0, 0u, 0.f, o, tid);
    else { o[0] = o[1] = o[2] = o[3] = (f32x4){0.f, 0.f, 0.f, 0.f}; }
#pragma unroll
    for (int c = 0; c < 4; ++c) { tot[c][0] = gate[0] * o[c][0]; tot[c][1] = gate[0] * o[c][1]; tot[c][2] = gate[0] * o[c][2]; tot[c][3] = gate[0] * o[c][3]; }
    if (NSA_PASSES & 2) attn_pass<M_SLC, 64>(smem, Z + 3072 + head * 64, OLD, Z + 4608 + g * 64, OLD, Z + 4864 + g * 64, OLD, q0, rowmask, 0.f, o, tid);
#pragma unroll
    for (int c = 0; c < 4; ++c) { tot[c][0] += gate[1] * o[c][0]; tot[c][1] += gate[1] * o[c][1]; tot[c][2] += gate[1] * o[c][2]; tot[c][3] += gate[1] * o[c][3]; }
    if (NSA_PASSES & 4) attn_pass<M_WIN, 64>(smem, Z + 3072 + head * 64, OLD, Z + 5120 + g * 64, OLD, Z + 5376 + g * 64, OLD, q0, 0u, 0.f, o, tid);
#pragma unroll
    for (int c = 0; c < 4; ++c) { tot[c][0] += gate[2] * o[c][0]; tot[c][1] += gate[2] * o[c][1]; tot[c][2] += gate[2] * o[c][2]; tot[c][3] += gate[2] * o[c][3]; }
    bf16_t* cat = (bf16_t*)(p.ws + OFF_CAT) + (size_t)(b * S_ + t) * D_ + 1024 + head * 64;
#pragma unroll
    for (int c = 0; c < 4; ++c) { u32x2 w; w.x = pk2(tot[c][0], tot[c][1]); w.y = pk2(tot[c][2], tot[c][3]); GST(u32x2, cat + 16 * c + 4 * quad) = w; }
}


__device__ __forceinline__ void nsa_item2(const Params& p, unsigned char* smem, int b, int head, int qt, int tid) {
    const int lane = tid & 63, wave = tid >> 6, lq = lane & 15, quad = lane >> 4;
    const int g = head >> 2, q0 = qt * 256;
    int t[2]; t[0] = q0 + wave * 32 + lq; t[1] = t[0] + 16;
    const bf16_t* Z = (const bf16_t*)(p.ws + OFF_Z) + (size_t)b * S_ * OLD;
    unsigned rowmask[2], nomask[2] = {0u, 0u}; float gate[2][3];
#pragma unroll
    for (int qs = 0; qs < 2; ++qs) {
        rowmask[qs] = GLD(unsigned, (const unsigned*)(p.ws + OFF_SEL) + (size_t)(b * 4 + g) * S_ + t[qs]);
#pragma unroll
        for (int i = 0; i < 3; ++i) gate[qs][i] = sigmoidf_(bf2f(GLD(bf16_t, Z + (size_t)t[qs] * OLD + 5632 + head * 3 + i)));
    }
    f32x4 o[2][4];
    f32x4* tl = (f32x4*)(smem + 40960) + tid;
    const bf16_t* kc = (const bf16_t*)(p.ws + OFF_KC) + (size_t)((b * 4 + g) * 128) * 64;
    const bf16_t* vc = (const bf16_t*)(p.ws + OFF_VC) + (size_t)((b * 4 + g) * 128) * 64;
    attn_pass2<M_CMP, 64>(smem, Z + 3072 + head * 64, OLD, kc, 64, vc, 64, q0, nomask, 0.f, o, tid);
#pragma unroll
    for (int qs = 0; qs < 2; ++qs)
#pragma unroll
        for (int c = 0; c < 4; ++c) { f32x4 v; v[0] = gate[qs][0] * o[qs][c][0]; v[1] = gate[qs][0] * o[qs][c][1]; v[2] = gate[qs][0] * o[qs][c][2]; v[3] = gate[qs][0] * o[qs][c][3]; tl[(qs * 4 + c) * 512] = v; }
    attn_pass2<M_SLC, 64>(smem, Z + 3072 + head * 64, OLD, Z + 4608 + g * 64, OLD, Z + 4864 + g * 64, OLD, q0, rowmask, 0.f, o, tid);
#pragma unroll
    for (int qs = 0; qs < 2; ++qs)
#pragma unroll
        for (int c = 0; c < 4; ++c) { f32x4 v = tl[(qs * 4 + c) * 512]; v[0] += gate[qs][1] * o[qs][c][0]; v[1] += gate[qs][1] * o[qs][c][1]; v[2] += gate[qs][1] * o[qs][c][2]; v[3] += gate[qs][1] * o[qs][c][3]; tl[(qs * 4 + c) * 512] = v; }
    attn_pass2<M_WIN, 64>(smem, Z + 3072 + head * 64, OLD, Z + 5120 + g * 64, OLD, Z + 5376 + g * 64, OLD, q0, nomask, 0.f, o, tid);
#pragma unroll
    for (int qs = 0; qs < 2; ++qs) {
        bf16_t* cat = (bf16_t*)(p.ws + OFF_CAT) + (size_t)(b * S_ + t[qs]) * D_ + 1024 + head * 64;
#pragma unroll
        for (int c = 0; c < 4; ++c) {
            const f32x4 v = tl[(qs * 4 + c) * 512];
            const float r0 = v[0] + gate[qs][2] * o[qs][c][0], r1 = v[1] + gate[qs][2] * o[qs][c][1], r2 = v[2] + gate[qs][2] * o[qs][c][2], r3 = v[3] + gate[qs][2] * o[qs][c][3];
            u32x2 w; w.x = pk2(r0, r1); w.y = pk2(r2, r3); GST(u32x2, cat + 16 * c + 4 * quad) = w;
        }
    }
}

__device__ __forceinline__ void ret_item(const Params& p, unsigned char* smem, int b, int h, int qt, int tid) {
    const int lane = tid & 63, wave = tid >> 6, lq = lane & 15, quad = lane >> 4;
    const int q0 = qt * 128, t = q0 + wave * 16 + lq;
    const bf16_t* Z = (const bf16_t*)(p.ws + OFF_Z) + (size_t)b * S_ * OLD;
    const float log2g = log2f(1.f - exp2f(-5.f - (float)h));
    f32x4 o[8];
    attn_pass<M_RET, 128>(smem, Z + h * 64, OLD, Z + 512 + h * 64, OLD, Z + 1024 + h * 128, OLD, q0, 0u, log2g, o, tid);
    float sm = 0.f;
#pragma unroll
    for (int c = 0; c < 8; ++c) sm += (o[c][0] + o[c][1]) + (o[c][2] + o[c][3]);
    sm += __shfl_xor(sm, 16); sm += __shfl_xor(sm, 32);
    const float mean = sm * (1.f / 128.f);
    float sq = 0.f;
#pragma unroll
    for (int c = 0; c < 8; ++c)
#pragma unroll
        for (int j = 0; j < 4; ++j) { o[c][j] -= mean; sq += o[c][j] * o[c][j]; }
    sq += __shfl_xor(sq, 16); sq += __shfl_xor(sq, 32);
    const float rstd = rsqrtf(sq * (1.f / 128.f) + 1e-6f);
    const bf16_t* rg = Z + (size_t)t * OLD + 2048 + h * 128;
    bf16_t* cat = (bf16_t*)(p.ws + OFF_CAT) + (size_t)(b * S_ + t) * D_ + h * 128;
#pragma unroll
    for (int c = 0; c < 8; ++c) {
        const u32x2 gv = GLD(u32x2, rg + 16 * c + 4 * quad);
        const float g0 = __uint_as_float(gv.x << 16), g1 = __uint_as_float(gv.x & 0xffff0000u), g2 = __uint_as_float(gv.y << 16), g3 = __uint_as_float(gv.y & 0xffff0000u);
        const float r0 = g0 * sigmoidf_(g0) * o[c][0] * rstd, r1 = g1 * sigmoidf_(g1) * o[c][1] * rstd, r2 = g2 * sigmoidf_(g2) * o[c][2] * rstd, r3 = g3 * sigmoidf_(g3) * o[c][3] * rstd;
        u32x2 w; w.x = pk2(r0, r1); w.y = pk2(r2, r3);
        GST(u32x2, cat + 16 * c + 4 * quad) = w;
    }
}


__device__ __forceinline__ void ret_item2(const Params& p, unsigned char* smem, int b, int h, int qt, int tid) {
    const int q0 = qt * 256;
    const bf16_t* Z = (const bf16_t*)(p.ws + OFF_Z) + (size_t)b * S_ * OLD;
    const float log2g = log2f(1.f - exp2f(-5.f - (float)h));
    const unsigned nomask[2] = {0u, 0u};
    f32x4 o[2][8];
    attn_pass2<M_RET, 128>(smem, Z + h * 64, OLD, Z + 512 + h * 64, OLD, Z + 1024 + h * 128, OLD, q0, nomask, log2g, o, tid);
    int tid2 = tid; asm volatile("" : "+v"(tid2));
    const int lq2 = tid2 & 15, quad2 = (tid2 >> 4) & 3, wave2 = tid2 >> 6;
    int t2[2]; t2[0] = q0 + wave2 * 32 + lq2; t2[1] = t2[0] + 16;
#pragma unroll
    for (int qs = 0; qs < 2; ++qs) {
        float sm = 0.f;
#pragma unroll
        for (int c = 0; c < 8; ++c) sm += (o[qs][c][0] + o[qs][c][1]) + (o[qs][c][2] + o[qs][c][3]);
        sm += __shfl_xor(sm, 16); sm += __shfl_xor(sm, 32);
        const float mean = sm * (1.f / 128.f);
        float sq = 0.f;
#pragma unroll
        for (int c = 0; c < 8; ++c)
#pragma unroll
            for (int j = 0; j < 4; ++j) { o[qs][c][j] -= mean; sq += o[qs][c][j] * o[qs][c][j]; }
        sq += __shfl_xor(sq, 16); sq += __shfl_xor(sq, 32);
        const float rstd = rsqrtf(sq * (1.f / 128.f) + 1e-6f);
        const bf16_t* rg = Z + (size_t)t2[qs] * OLD + 2048 + h * 128;
        bf16_t* cat = (bf16_t*)(p.ws + OFF_CAT) + (size_t)(b * S_ + t2[qs]) * D_ + h * 128;
#pragma unroll
        for (int c = 0; c < 8; ++c) {
            const u32x2 gv = GLD(u32x2, rg + 16 * c + 4 * quad2);
            const float g0 = __uint_as_float(gv.x << 16), g1 = __uint_as_float(gv.x & 0xffff0000u), g2 = __uint_as_float(gv.y << 16), g3 = __uint_as_float(gv.y & 0xffff0000u);
            const float r0 = g0 * sigmoidf_(g0) * o[qs][c][0] * rstd, r1 = g1 * sigmoidf_(g1) * o[qs][c][1] * rstd, r2 = g2 * sigmoidf_(g2) * o[qs][c][2] * rstd, r3 = g3 * sigmoidf_(g3) * o[qs][c][3] * rstd;
            u32x2 w; w.x = pk2(r0, r1); w.y = pk2(r2, r3);
            GST(u32x2, cat + 16 * c + 4 * quad2) = w;
        }
    }
}

__device__ __forceinline__ void odd_mixer_phase(const Params& p, unsigned char* smem, int tid, int bid, int nblk) {
    for (int it = bid; it < 3072; it += nblk) {
        const int lvl = it / 384, r = it % 384, qt = 7 - lvl;
        int tid_i = tid; asm volatile("" : "+v"(tid_i));
        if (r < 128) ret_item2(p, smem, r >> 3, r & 7, qt, tid_i);
        else { const int bh = r - 128; nsa_item2(p, smem, bh >> 4, bh & 15, qt, tid_i); }
    }
}

#define XB_TMO      128
#define XB_XCNT(j)  (256  + 64 * (j))
#define XB_XSUB(j)  (1280 + 64 * (j))
#define XB_XGEN(j)  (2304 + 64 * (j))
#define XB_TOP      3328
#define XB_TOPGEN   3392
#define XCD_BAR_WORDS 3456
#define XB_SPIN_CAP (1u << 18)

__device__ __forceinline__ unsigned xb_ld(unsigned* p)              { return __hip_atomic_load(p, __ATOMIC_RELAXED, __HIP_MEMORY_SCOPE_AGENT); }
__device__ __forceinline__ unsigned xb_add(unsigned* p, unsigned v) { return __hip_atomic_fetch_add(p, v, __ATOMIC_RELAXED, __HIP_MEMORY_SCOPE_AGENT); }
__device__ __forceinline__ unsigned xb_xcc_id() { return (unsigned)__builtin_amdgcn_s_getreg((3 << 11) | 20) & 0xFu; }
#define XB_SPIN(cond, bar) do { unsigned _sp = 0; while (cond) { __builtin_amdgcn_s_sleep(1); \
    if ((++_sp & 255u) == 0u) { if (xb_ld(&(bar)[XB_TMO])) break; if (_sp > XB_SPIN_CAP) { atomicAdd(&(bar)[XB_TMO], 1u); break; } } } } while (0)

struct XcdBarrier {
    unsigned* bar; unsigned x;
    volatile LAS unsigned* st;
};

__device__ __forceinline__ XcdBarrier xcd_barrier_post(unsigned* bar, volatile LAS unsigned* st) {
    XcdBarrier b; b.bar = bar; b.x = xb_xcc_id(); b.st = st;
    if (threadIdx.x == 0) (void)xb_add(&bar[XB_XCNT(b.x)], 1u);
    return b;
}
__device__ __forceinline__ void xcd_barrier_complete(unsigned* bar, unsigned x, unsigned& nloc, unsigned& nx) {
    const unsigned G = gridDim.x * gridDim.y * gridDim.z;
    unsigned sum, cnt, mine, sp = 0u;
    for (;;) {
        sum = 0u; cnt = 0u; mine = 0u;
#pragma unroll
        for (unsigned j = 0; j < 16; ++j) { const unsigned c = xb_ld(&bar[XB_XCNT(j)]); sum += c; cnt += (c > 0u) ? 1u : 0u; mine = (j == x) ? c : mine; }
        if (sum == G) break;
        __builtin_amdgcn_s_sleep(1);
        if ((++sp & 255u) == 0u) { if (xb_ld(&bar[XB_TMO])) break; if (sp > XB_SPIN_CAP) { atomicAdd(&bar[XB_TMO], 1u); break; } }
    }
    nloc = mine > 0u ? mine : 1u; nx = cnt > 0u ? cnt : 1u;
}

__device__ __forceinline__ void xcd_barrier(const XcdBarrier& b) {
    asm volatile("s_waitcnt vmcnt(0)" ::: "memory");
    __syncthreads();
    if (threadIdx.x == 0) {
        unsigned* bar = b.bar;
        __builtin_amdgcn_s_waitcnt(0);
        unsigned nloc = b.st[0], nx = b.st[1];
        if (nloc == 0u) { xcd_barrier_complete(bar, b.x, nloc, nx); b.st[0] = nloc; b.st[1] = nx; }
        const unsigned old = xb_add(&bar[XB_XSUB(b.x)], 1u);
        const unsigned gen = old / nloc;
        if (old + 1u == (gen + 1u) * nloc) {
            __builtin_amdgcn_fence(__ATOMIC_RELEASE, "agent");
            asm volatile("s_waitcnt vmcnt(0)" ::: "memory");
            const unsigned og = xb_add(&bar[XB_TOP], 1u);
            const unsigned tg = og / nx;
            if (og + 1u == (tg + 1u) * nx) xb_add(&bar[XB_TOPGEN], 1u);
            else XB_SPIN(xb_ld(&bar[XB_TOPGEN]) == tg, bar);
            __builtin_amdgcn_fence(__ATOMIC_ACQUIRE, "agent");
            xb_add(&bar[XB_XGEN(b.x)], 1u);
            asm volatile("s_waitcnt vmcnt(0)" ::: "memory");
        } else {
            XB_SPIN(xb_ld(&bar[XB_XGEN(b.x)]) == gen, bar);
            __builtin_amdgcn_fence(__ATOMIC_ACQUIRE, "agent");
            asm volatile("s_waitcnt vmcnt(0)" ::: "memory");
        }
    }
    __syncthreads();
}

#ifndef ONLYMASK
#define ONLYMASK 0xFFFFFFu
#endif
#define PH_ON(n) ((ONLYMASK >> (n)) & 1u)
__device__ __forceinline__ const Params& opaque_params() {
    const Params* pp = (const Params*)__builtin_amdgcn_kernarg_segment_ptr(); asm volatile("" : "+s"(pp)); return *pp;
}
__device__ __forceinline__ void run_gemm(unsigned char* smem, int ph, int bid, int nblk) {
    const Params& p = opaque_params();
    unsigned char* ws = p.ws;
    pg8::Gemm g; EpiAll E; g.M = T_;
    E.O = (bf16_t*)(ws + OFF_Z); E.ldc = EIN; E.Xin = p.out; E.Xout = p.out; E.mode = 0;
    if (ph == 1) { g.A = (const bf16_t*)(ws + OFF_H); g.Bt = (const bf16_t*)(ws + OFF_WT_EIN); g.N = EIN; g.K = D_; E.mode = 0; E.ldc = EIN; }
    else if (ph == 9) { g.A = (const bf16_t*)(ws + OFF_H); g.Bt = (const bf16_t*)(ws + OFF_WT_OIN); g.N = OLD; g.K = D_; E.mode = 0; E.ldc = OLD; }
    else if (ph == 4) { g.A = (const bf16_t*)(ws + OFF_CAT); g.Bt = (const bf16_t*)(ws + OFF_WT_EOUT); g.N = D_; g.K = D_; E.mode = 1; E.Xin = p.in[0]; }
    else if (ph == 13) { g.A = (const bf16_t*)(ws + OFF_CAT); g.Bt = (const bf16_t*)(ws + OFF_WT_OOUT); g.N = D_; g.K = D_; E.mode = 1; }
    else if (ph == 7) { g.A = (const bf16_t*)(ws + OFF_Z); g.Bt = (const bf16_t*)(ws + OFF_WT2_0); g.N = D_; g.K = FF_; E.mode = 1; }
    else if (ph == 16) { g.A = (const bf16_t*)(ws + OFF_Z); g.Bt = (const bf16_t*)(ws + OFF_WT2_1); g.N = D_; g.K = FF_; E.mode = 1; }
    else if (ph == 6) { g.A = (const bf16_t*)(ws + OFF_H); g.Bt = (const bf16_t*)(ws + OFF_WT13_0); g.N = 2 * FF_; g.K = D_; E.mode = 2; }
    else { g.A = (const bf16_t*)(ws + OFF_H); g.Bt = (const bf16_t*)(ws + OFF_WT13_1); g.N = 2 * FF_; g.K = D_; E.mode = 2; }
    pg8::StaticOrder So; So.init(g.M, g.N, (int)nblk, (int)bid);
    pg8::gemm_phase<EpiAll, pg8::StaticOrder, false>((PG8_LAS unsigned char*)smem, g, So, E, nullptr);
}
__device__ __forceinline__ void run_norm(int ph, int tid, int bid, int nblk) {
    const Params& p = opaque_params();
    const int lane = tid & 63, wave = tid >> 6;
    const int gw = bid * 8 + wave, ngw = nblk * 8;
    bf16_t* H = (bf16_t*)(p.ws + OFF_H);
#ifdef SKEL
    if (ph == 17) rmsnorm_rows(p.in[0], p.in[27], nullptr, p.out, gw, ngw, lane);
    else if (ph == 5) {}
#else
    if (ph == 17) rmsnorm_rows(p.out, p.in[27], nullptr, p.out, gw, ngw, lane);
#endif
    else rmsnorm_rows(p.out, (ph == 8 ? p.in[1] + D_ : p.in[2] + (ph == 14 ? D_ : 0)), H, nullptr, gw, ngw, lane);
}
__global__ void __launch_bounds__(512, 2) mega(Params pk) {
    extern __shared__ __attribute__((aligned(16))) unsigned char smem[];
    cg::grid_group grid = cg::this_grid();
    {
        volatile LAS unsigned* st0 = (volatile LAS unsigned*)(smem + 131072);
        if (threadIdx.x == 0) { st0[0] = 0u; st0[1] = 0u; }
        __syncthreads();
        (void)xcd_barrier_post((unsigned*)(opaque_params().ws + OFF_BAR), st0);
    }
    const int ph_lo = ((const Params*)__builtin_amdgcn_kernarg_segment_ptr())->ph_lo, ph_hi = ((const Params*)__builtin_amdgcn_kernarg_segment_ptr())->ph_hi;
#pragma nounroll
    for (int ph = ph_lo; ph < ph_hi; ++ph) {
        int tid = threadIdx.x; asm volatile("" : "+v"(tid));
        int bid = __builtin_amdgcn_workgroup_id_x(); asm volatile("" : "+s"(bid));
        int nblk = (int)__builtin_amdgcn_grid_size_x() / 512; asm volatile("" : "+s"(nblk));
        if (ph == 0) { for (int rep = 0; rep < REP_P0; ++rep) { phase0(opaque_params(), smem, tid, bid, nblk); __syncthreads(); } }
        else if (ph == 2) { if (PH_ON(2)) kmean_phase(opaque_params(), tid, bid, nblk); }
        else if (ph == 3) { if (PH_ON(3)) even_mixer_phase(opaque_params(), smem, tid, bid, nblk); }
        else if (ph == 10) { if (PH_ON(10)) odd_prep_phase(opaque_params(), smem, tid, bid, nblk); }
        else if (ph == 11) { for (int rep = 0; rep < REP_SEL; ++rep) select_phase(opaque_params(), smem, tid, bid, nblk); }
        else if (ph == 12) { if (PH_ON(12)) odd_mixer_phase(opaque_params(), smem, tid, bid, nblk); }
#ifdef SKEL
        else if (ph == 17) { run_norm(ph, tid, bid, nblk); }
        else if (ph == 5 || ph == 8 || ph == 14) { }
#else
        else if (ph == 5 || ph == 8 || ph == 14 || ph == 17) { const int nrep = (ph == 5) ? REP_NORM : 1; for (int rep = 0; rep < nrep; ++rep) run_norm(ph, tid, bid, nblk); }
#endif
        else { const int nrep = (ph == 1 || ph == 6 || ph == 9 || ph == 15) ? REP_GEMM : 1; for (int rep = 0; rep < nrep; ++rep) { run_gemm(smem, ph, bid, nblk); __syncthreads(); } }
        if (ph + 1 < ph_hi) {
            if (ph == 0) grid.sync();
            else { XcdBarrier xb; xb.bar = (unsigned*)(opaque_params().ws + OFF_BAR); xb.x = xb_xcc_id(); xb.st = (volatile LAS unsigned*)(smem + 131072); xcd_barrier(xb); }
        }
    }
}

extern "C" void kernel_launch(void* const* d_in, const int* in_sizes, int n_in, void* d_out, int out_size, void* d_ws, size_t ws_size, hipStream_t stream) {
    static int grid = 0;
    if (grid == 0) {
        if (n_in != 28 || out_size != T_ * D_ || ws_size < WS_END) { fprintf(stderr, "kernel_launch: unexpected shapes (n_in %d out %d ws %zu need %zu)\n", n_in, out_size, ws_size, (size_t)WS_END); grid = -1; return; }
        int dev = 0, cus = 0, per_cu = 0;
        hipGetDevice(&dev);
        hipDeviceGetAttribute(&cus, hipDeviceAttributeMultiprocessorCount, dev);
        if (hipFuncSetAttribute((const void*)mega, hipFuncAttributeMaxDynamicSharedMemorySize, LDS_BYTES) != hipSuccess) { fprintf(stderr, "kernel_launch: hipFuncSetAttribute failed\n"); grid = -1; return; }
        hipOccupancyMaxActiveBlocksPerMultiprocessor(&per_cu, (const void*)mega, 512, LDS_BYTES);
        if (per_cu < 1) { fprintf(stderr, "kernel_launch: occupancy query says %d blocks per CU\n", per_cu); per_cu = 1; }
        (void)hipGetLastError();
        grid = cus;
    }
    if (grid < 0) return;
    Params p{};
    for (int i = 0; i < 28; ++i) p.in[i] = (const float*)d_in[i];
    p.out = (float*)d_out; p.ws = (unsigned char*)d_ws;
    for (int i = 0; i < 32; ++i) p.inv_freq[i] = pow(10000.0, -(double)i / 32.0);
    p.ph_lo = 0; p.ph_hi = NPHASE;
#ifdef ZEROCAT
    (void)hipMemsetAsync((char*)d_ws + OFF_CAT, 0, (size_t)T_ * D_ * 2, stream);
#endif
    if (hipMemsetAsync((char*)d_ws + OFF_BAR, 0, XCD_BAR_WORDS * sizeof(unsigned), stream) != hipSuccess) { fprintf(stderr, "kernel_launch: memset of barrier words failed\n"); return; }
    void* args[] = {&p};
    hipError_t e = hipLaunchCooperativeKernel((const void*)mega, dim3(grid), dim3(512), args, LDS_BYTES, stream);
    if (e != hipSuccess) fprintf(stderr, "kernel_launch: cooperative launch failed: %s (grid %d)\n", hipGetErrorString(e), grid);
}
```

```cpp
#include <hip/hip_runtime.h>
#include <hip/hip_cooperative_groups.h>
#include <cstdio>
#include <cmath>
namespace cg = cooperative_groups;
namespace pg8 {
#define PG8_LAS __attribute__((address_space(3)))
typedef unsigned short bf16_t;
typedef short bf16x8 __attribute__((ext_vector_type(8)));
typedef float f32x4 __attribute__((ext_vector_type(4)));
typedef unsigned u32x4 __attribute__((ext_vector_type(4)));
constexpr int BM = 256, BK = 64, HALF = 128, HTB = HALF * BK * 2  , STAGE_BYTES = 8 * HTB, NXCD = 8, WGM = 8;

__host__ __device__ __forceinline__ int lds_byte(int r, int c) { const int st = (r >> 4) * 2 + (c >> 5), rr = r & 15, cc = c & 31, ob = rr * 64 + cc * 2; return st * 1024 + (ob ^ (((ob >> 9) & 1) << 5)); }
__host__ __device__ __forceinline__ void stage_rc(int b, int& R, int& C) { const int st = b / 1024, sb = b % 1024, swz = sb ^ (((sb >> 9) & 1) << 5); R = (st >> 1) * 16 + swz / 64; C = (st & 1) * 32 + (swz % 64) / 2; }
__host__ __device__ __forceinline__ int perm32(int rho) { const int n = rho >> 4, i = rho & 15; return 8 * (i >> 2) + 4 * n + (i & 3); }

struct Unit { int pm, pn; };
struct Gemm { const bf16_t* A; const bf16_t* Bt; int M, N, K; };

struct StaticOrder {
    int nM, nN, nwg, G, c;
    __host__ __device__ void init(int M, int N, int G_, int c_) { nM = M / BM; nN = N / BM; nwg = nM * nN; G = G_; c = c_; }
    __host__ __device__ bool next(int i, Unit& u) const {
        const long L = (long)i * G + c; if (L >= nwg) return false;
        int wgid = (int)L; { const int q = nwg / NXCD, r = nwg % NXCD, xcd = wgid % NXCD, off = wgid / NXCD; wgid = (xcd < r ? xcd * (q + 1) : r * (q + 1) + (xcd - r) * q) + off; }
        const int nig = WGM * nN, gid = wgid / nig, fm = gid * WGM, gsz = (nM - fm) < WGM ? (nM - fm) : WGM;
        u.pm = fm + ((wgid % nig) % gsz); u.pn = (wgid % nig) / gsz; return true;
    }
    __device__ __forceinline__ void a_ready(const Unit&) const {}
    __device__ __forceinline__ void done(const Unit&) const {}
};
__device__ __forceinline__ unsigned cvt_pk_bf16(float lo, float hi) { unsigned r; asm volatile("v_cvt_pk_bf16_f32 %0, %1, %2" : "=v"(r) : "v"(lo), "v"(hi)); return r; }
template <class Epi, class Sched, bool STAMP = false>
__device__ __forceinline__ void gemm_phase(PG8_LAS unsigned char* lds, const Gemm g, const Sched& S, const Epi& E, unsigned long long* stamps) {
    int tid = threadIdx.x; asm volatile("" : "+v"(tid)); const int wid = __builtin_amdgcn_readfirstlane(tid >> 6), lane = tid & 63, wr = wid >> 2, wc = wid & 3, fr = lane & 15, fq = lane >> 4;
    const int K = g.K, nt = K / BK;
    int ts_lo = 0, ts_hi = 0, nts = 0; const unsigned long long rt_entry = STAMP ? (unsigned long long)wall_clock64() : 0ull;
#define PG8_STAMP() do { if (STAMP && wid == 0 && nts < 64) { const unsigned long long _c = (unsigned long long)clock64(); \
        ts_lo = (lane == nts) ? (int)(unsigned)_c : ts_lo; ts_hi = (lane == nts) ? (int)(unsigned)(_c >> 32) : ts_hi; ++nts; } } while (0)
    PG8_STAMP();
    unsigned voffA[2], voffB[2];
#pragma unroll
    for (int i = 0; i < 2; ++i) { int R, C; stage_rc(tid * 16 + i * 8192, R, C); const int Rb = Epi::PERM ? ((R & ~31) + perm32(R & 31)) : R;
        voffA[i] = (unsigned)(R * K + C) * 2u; voffB[i] = (unsigned)(Rb * K + C) * 2u; }
    const size_t kstep = (size_t)(BK * 2);
    const size_t hstep = (size_t)HALF * K * 2;
    const size_t tstep = 2 * hstep;
    const unsigned ldsw = (unsigned)wid * 1024u;
    const int aoff = lds_byte(wr * 64 + fr, fq * 8), boff = lds_byte(wc * 32 + fr, fq * 8);
#define PG8_SA(b, h) (((b) * 2 + (h)) * HTB)
#define PG8_SB(b, h) ((4 + (b) * 2 + (h)) * HTB)
#define PG8_STAGE(bufoff, gbase, voff) do { _Pragma("unroll") for (int _i = 0; _i < 2; ++_i) \
        __builtin_amdgcn_global_load_lds((const unsigned*)((const char*)(gbase) + (voff)[_i]), (PG8_LAS unsigned*)(lds + (bufoff) + ldsw + _i * 8192), 16, 0, 0); } while (0)
#define PG8_LDA(dst, b, h) do { _Pragma("unroll") for (int m = 0; m < 4; ++m) _Pragma("unroll") for (int k = 0; k < 2; ++k) dst[m][k] = *(const PG8_LAS bf16x8*)(lds + PG8_SA(b, h) + aoff + m * 2048 + k * 1024); } while (0)
#define PG8_LDB(dst, b, h) do { _Pragma("unroll") for (int n = 0; n < 2; ++n) _Pragma("unroll") for (int k = 0; k < 2; ++k) dst[n][k] = *(const PG8_LAS bf16x8*)(lds + PG8_SB(b, h) + boff + n * 2048 + k * 1024); } while (0)
#define PG8_MMA(ai, bj, At, Bt) do { __builtin_amdgcn_s_setprio(1); _Pragma("unroll") for (int m = 0; m < 4; ++m) _Pragma("unroll") for (int n = 0; n < 2; ++n) _Pragma("unroll") for (int k = 0; k < 2; ++k) \
        acc[ai][bj][m][n] = __builtin_amdgcn_mfma_f32_16x16x32_bf16(Bt[n][k], At[m][k], acc[ai][bj][m][n], 0, 0, 0); __builtin_amdgcn_s_setprio(0); } while (0)
#define PG8_WAIT_V(n) asm volatile("s_waitcnt vmcnt(" #n ")" ::: "memory")
#define PG8_WAIT_L(n) asm volatile("s_waitcnt lgkmcnt(" #n ")" ::: "memory")
#define PG8_BAR __builtin_amdgcn_s_barrier()
#define PG8_SCHED __builtin_amdgcn_sched_barrier(0)
    Unit cur, nxt; int ui = 0;
    if (!S.next(0, cur)) return;
    f32x4 acc[2][2][4][2];
#pragma unroll
    for (int a = 0; a < 2; ++a)
#pragma unroll
        for (int b = 0; b < 2; ++b)
#pragma unroll
            for (int m = 0; m < 4; ++m)
#pragma unroll
                for (int n = 0; n < 2; ++n) acc[a][b][m][n] = (f32x4){0.f, 0.f, 0.f, 0.f};
    bf16x8 At[4][2], B0[2][2], B1[2][2];
    const char* cA = (const char*)g.A + (size_t)cur.pm * tstep; const char* cB = (const char*)g.Bt + (size_t)cur.pn * tstep;
    S.a_ready(cur);
    PG8_STAGE(PG8_SB(0, 0), cB, voffB); PG8_STAGE(PG8_SA(0, 0), cA, voffA); PG8_STAGE(PG8_SB(0, 1), cB + hstep, voffB); PG8_STAGE(PG8_SA(0, 1), cA + hstep, voffA);
    if (wr == 1) PG8_BAR;
    PG8_WAIT_V(4); PG8_BAR;
    PG8_STAGE(PG8_SB(1, 0), cB + kstep, voffB); PG8_STAGE(PG8_SA(1, 0), cA + kstep, voffA); PG8_STAGE(PG8_SB(1, 1), cB + hstep + kstep, voffB);
    PG8_WAIT_V(6); PG8_BAR;
    PG8_STAMP();
    for (;;) {
        const bool has_next = S.next(ui + 1, nxt);
        const char* nA = has_next ? (const char*)g.A + (size_t)nxt.pm * tstep : cA; const char* nB = has_next ? (const char*)g.Bt + (size_t)nxt.pn * tstep : cB;
        for (int t = 0; t < nt; t += 2) {
            const bool last = (t == nt - 2);
            const char* a1 = cA + (size_t)(t + 1) * kstep;
            const char* a2 = last ? nA : cA + (size_t)(t + 2) * kstep; const char* b2 = last ? nB : cB + (size_t)(t + 2) * kstep;
            const char* a3 = a2 + kstep; const char* b3 = b2 + kstep;
            if (last && has_next) S.a_ready(nxt);
            PG8_LDB(B0, 0, 0); PG8_SCHED; PG8_LDA(At, 0, 0); PG8_STAGE(PG8_SA(1, 1), a1 + hstep, voffA);
            PG8_WAIT_L(8); PG8_BAR; PG8_WAIT_L(0); PG8_MMA(0, 0, At, B0); PG8_BAR; PG8_SCHED;
            PG8_LDB(B1, 0, 1); PG8_STAGE(PG8_SB(0, 0), b2, voffB);
            PG8_BAR; PG8_WAIT_L(0); PG8_MMA(0, 1, At, B1); PG8_BAR;
            PG8_LDA(At, 0, 1); PG8_STAGE(PG8_SA(0, 0), a2, voffA);
            PG8_BAR; PG8_WAIT_L(0); PG8_MMA(1, 0, At, B0); PG8_BAR; PG8_SCHED;
            PG8_STAGE(PG8_SB(0, 1), b2 + hstep, voffB);
            PG8_WAIT_V(6); PG8_BAR; PG8_MMA(1, 1, At, B1); PG8_BAR;
            PG8_LDB(B0, 1, 0); PG8_SCHED; PG8_LDA(At, 1, 0); PG8_STAGE(PG8_SA(0, 1), a2 + hstep, voffA);
            PG8_WAIT_L(8); PG8_BAR; PG8_WAIT_L(0); PG8_MMA(0, 0, At, B0); PG8_BAR; PG8_SCHED;
            PG8_LDB(B1, 1, 1); PG8_STAGE(PG8_SB(1, 0), b3, voffB);
            PG8_BAR; PG8_WAIT_L(0); PG8_MMA(0, 1, At, B1); PG8_BAR;
            PG8_LDA(At, 1, 1); PG8_STAGE(PG8_SA(1, 0), a3, voffA);
            PG8_BAR; PG8_WAIT_L(0); PG8_MMA(1, 0, At, B0); PG8_BAR; PG8_SCHED;
            PG8_STAGE(PG8_SB(1, 1), b3 + hstep, voffB);
            PG8_WAIT_V(6); PG8_BAR; PG8_MMA(1, 1, At, B1); PG8_BAR;
        }
        PG8_STAMP();
        if constexpr (!Epi::AFTER_DRAIN) { E(acc, cur, wr, wc, fr, fq); S.done(cur); }
        PG8_STAMP();
        if (!has_next) break;
#pragma unroll
        for (int a = 0; a < 2; ++a)
#pragma unroll
            for (int b = 0; b < 2; ++b)
#pragma unroll
                for (int m = 0; m < 4; ++m)
#pragma unroll
                    for (int n = 0; n < 2; ++n) acc[a][b][m][n] = (f32x4){0.f, 0.f, 0.f, 0.f};
        cur = nxt; cA = nA; cB = nB; ++ui;
    }
    PG8_WAIT_V(0);
    if (wr == 0) PG8_BAR;
    PG8_BAR;
    if constexpr (Epi::AFTER_DRAIN) { E.fused(acc, cur, wr, wc, fr, fq, lds, wid, lane); S.done(cur); }
    PG8_STAMP();
    if (STAMP && wid == 0) { stamps[lane] = lane < nts ? (((unsigned long long)(unsigned)ts_hi << 32) | (unsigned)ts_lo) : 0ull;
        if (lane == 62) stamps[62] = rt_entry; if (lane == 63) stamps[63] = (unsigned long long)wall_clock64(); }
#undef PG8_STAMP
#undef PG8_SA
#undef PG8_SB
#undef PG8_STAGE
#undef PG8_LDA
#undef PG8_LDB
#undef PG8_MMA
#undef PG8_WAIT_V
#undef PG8_WAIT_L
#undef PG8_BAR
#undef PG8_SCHED
}
}
namespace pg8 {
template <class Epi, class Sched, bool ALIGN_EPI = false, bool SP2 = false>
__device__ __forceinline__ void gemm_phase2(PG8_LAS unsigned char* lds, const Gemm g, const Sched& S, const Epi& E) {
    int tid = threadIdx.x; asm volatile("" : "+v"(tid)); const int wid = __builtin_amdgcn_readfirstlane(tid >> 6), lane = tid & 63, wr = wid >> 2, wc = wid & 3, fr = lane & 15, fq = lane >> 4;
    const int K = g.K, nt = K / BK;
    unsigned voffA[2], voffB[2];
#pragma unroll
    for (int i = 0; i < 2; ++i) { int R, C; stage_rc(tid * 16 + i * 8192, R, C); const int Rb = Epi::PERM ? ((R & ~31) + perm32(R & 31)) : R;
        voffA[i] = (unsigned)(R * K + C) * 2u; voffB[i] = (unsigned)(Rb * K + C) * 2u; }
    const size_t kstep = (size_t)(BK * 2);
    const size_t hstep = (size_t)HALF * K * 2;
    const size_t tstep = 2 * hstep;
    const unsigned ldsw = (unsigned)wid * 1024u;
    const int aoff = lds_byte(wr * 64 + fr, fq * 8), boff = lds_byte(wc * 32 + fr, fq * 8);
#define PG8_SA(b, h) (((b) * 2 + (h)) * HTB)
#define PG8_SB(b, h) ((4 + (b) * 2 + (h)) * HTB)
#define PG8_STAGE(bufoff, gbase, voff) do { _Pragma("unroll") for (int _i = 0; _i < 2; ++_i) \
        __builtin_amdgcn_global_load_lds((const unsigned*)((const char*)(gbase) + (voff)[_i]), (PG8_LAS unsigned*)(lds + (bufoff) + ldsw + _i * 8192), 16, 0, 0); } while (0)
#define PG8_LDA(dst, b, h) do { _Pragma("unroll") for (int m = 0; m < 4; ++m) _Pragma("unroll") for (int k = 0; k < 2; ++k) dst[m][k] = *(const PG8_LAS bf16x8*)(lds + PG8_SA(b, h) + aoff + m * 2048 + k * 1024); } while (0)
#define PG8_LDB(dst, b, h) do { _Pragma("unroll") for (int n = 0; n < 2; ++n) _Pragma("unroll") for (int k = 0; k < 2; ++k) dst[n][k] = *(const PG8_LAS bf16x8*)(lds + PG8_SB(b, h) + boff + n * 2048 + k * 1024); } while (0)
#define PG8_MMA(ai, bj, At, Bt) do { __builtin_amdgcn_s_setprio(1); _Pragma("unroll") for (int m = 0; m < 4; ++m) _Pragma("unroll") for (int n = 0; n < 2; ++n) _Pragma("unroll") for (int k = 0; k < 2; ++k) \
        acc[ai][bj][m][n] = __builtin_amdgcn_mfma_f32_16x16x32_bf16(Bt[n][k], At[m][k], acc[ai][bj][m][n], 0, 0, 0); __builtin_amdgcn_s_setprio(0); } while (0)
#define PG8_WAIT_V(n) asm volatile("s_waitcnt vmcnt(" #n ")" ::: "memory")
#define PG8_WAIT_L(n) asm volatile("s_waitcnt lgkmcnt(" #n ")" ::: "memory")
#define PG8_BAR __builtin_amdgcn_s_barrier()
#define PG8_SCHED __builtin_amdgcn_sched_barrier(0)
    Unit cur, nxt; int ui = 0;
    if (!S.next(0, cur)) return;
    f32x4 acc[2][2][4][2];
#pragma unroll
    for (int a = 0; a < 2; ++a)
#pragma unroll
        for (int b = 0; b < 2; ++b)
#pragma unroll
            for (int m = 0; m < 4; ++m)
#pragma unroll
                for (int n = 0; n < 2; ++n) acc[a][b][m][n] = (f32x4){0.f, 0.f, 0.f, 0.f};
    bf16x8 At[4][2], B0[2][2], B1[2][2];
    const char* cA = (const char*)g.A + (size_t)cur.pm * tstep; const char* cB = (const char*)g.Bt + (size_t)cur.pn * tstep;
    S.a_ready(cur);
    if constexpr (SP2) {
        PG8_STAGE(PG8_SB(0, 0), cB, voffB); PG8_STAGE(PG8_SB(0, 1), cB + hstep, voffB); PG8_STAGE(PG8_SA(0, 0), cA, voffA); PG8_STAGE(PG8_SA(0, 1), cA + hstep, voffA);
        if (wr == 1) PG8_BAR;
        PG8_WAIT_V(2); PG8_BAR;
        PG8_STAGE(PG8_SB(1, 0), cB + kstep, voffB); PG8_STAGE(PG8_SA(1, 0), cA + kstep, voffA); PG8_STAGE(PG8_SB(1, 1), cB + hstep + kstep, voffB);
        PG8_WAIT_V(6); PG8_BAR;
    } else {
        PG8_STAGE(PG8_SB(0, 0), cB, voffB); PG8_STAGE(PG8_SA(0, 0), cA, voffA); PG8_STAGE(PG8_SB(0, 1), cB + hstep, voffB); PG8_STAGE(PG8_SA(0, 1), cA + hstep, voffA);
        if (wr == 1) PG8_BAR;
        PG8_WAIT_V(4); PG8_BAR;
        PG8_STAGE(PG8_SB(1, 0), cB + kstep, voffB); PG8_STAGE(PG8_SA(1, 0), cA + kstep, voffA); PG8_STAGE(PG8_SB(1, 1), cB + hstep + kstep, voffB);
        PG8_WAIT_V(6); PG8_BAR;
    }
    for (;;) {
        const bool has_next = S.next(ui + 1, nxt);
        const char* nA = has_next ? (const char*)g.A + (size_t)nxt.pm * tstep : cA; const char* nB = has_next ? (const char*)g.Bt + (size_t)nxt.pn * tstep : cB;
        for (int t = 0; t < nt; t += 2) {
            const bool last = (t == nt - 2);
            const char* a1 = cA + (size_t)(t + 1) * kstep;
            const char* a2 = last ? nA : cA + (size_t)(t + 2) * kstep; const char* b2 = last ? nB : cB + (size_t)(t + 2) * kstep;
            const char* a3 = a2 + kstep; const char* b3 = b2 + kstep;
            if (last && has_next) S.a_ready(nxt);
            if constexpr (SP2) {
            PG8_LDB(B0, 0, 0); PG8_LDB(B1, 0, 1); PG8_SCHED; PG8_LDA(At, 0, 0); PG8_STAGE(PG8_SA(1, 1), a1 + hstep, voffA);
            PG8_WAIT_V(8); PG8_WAIT_L(0); PG8_BAR; PG8_MMA(0, 0, At, B0); PG8_MMA(0, 1, At, B1); PG8_BAR; PG8_SCHED;
            PG8_LDA(At, 0, 1); PG8_STAGE(PG8_SB(0, 0), b2, voffB); PG8_STAGE(PG8_SB(0, 1), b2 + hstep, voffB); PG8_STAGE(PG8_SA(0, 0), a2, voffA);
            PG8_WAIT_V(8); PG8_WAIT_L(0); PG8_BAR; PG8_MMA(1, 0, At, B0); PG8_MMA(1, 1, At, B1); PG8_BAR; PG8_SCHED;
            PG8_LDB(B0, 1, 0); PG8_LDB(B1, 1, 1); PG8_SCHED; PG8_LDA(At, 1, 0); PG8_STAGE(PG8_SA(0, 1), a2 + hstep, voffA);
            PG8_WAIT_V(8); PG8_WAIT_L(0); PG8_BAR; PG8_MMA(0, 0, At, B0); PG8_MMA(0, 1, At, B1); PG8_BAR; PG8_SCHED;
            PG8_LDA(At, 1, 1); PG8_STAGE(PG8_SB(1, 0), b3, voffB); PG8_STAGE(PG8_SB(1, 1), b3 + hstep, voffB); PG8_STAGE(PG8_SA(1, 0), a3, voffA);
            PG8_WAIT_V(8); PG8_WAIT_L(0); PG8_BAR; PG8_MMA(1, 0, At, B0); PG8_MMA(1, 1, At, B1); PG8_BAR; PG8_SCHED;
            } else {
            PG8_LDB(B0, 0, 0); PG8_SCHED; PG8_LDA(At, 0, 0); PG8_STAGE(PG8_SA(1, 1), a1 + hstep, voffA);
            PG8_WAIT_L(8); PG8_BAR; PG8_WAIT_L(0); PG8_MMA(0, 0, At, B0); PG8_BAR; PG8_SCHED;
            PG8_LDB(B1, 0, 1); PG8_STAGE(PG8_SB(0, 0), b2, voffB);
            PG8_BAR; PG8_WAIT_L(0); PG8_MMA(0, 1, At, B1); PG8_BAR;
            PG8_LDA(At, 0, 1); PG8_STAGE(PG8_SA(0, 0), a2, voffA);
            PG8_BAR; PG8_WAIT_L(0); PG8_MMA(1, 0, At, B0); PG8_BAR; PG8_SCHED;
            PG8_STAGE(PG8_SB(0, 1), b2 + hstep, voffB);
            PG8_WAIT_V(6); PG8_BAR; PG8_MMA(1, 1, At, B1); PG8_BAR;
            PG8_LDB(B0, 1, 0); PG8_SCHED; PG8_LDA(At, 1, 0); PG8_STAGE(PG8_SA(0, 1), a2 + hstep, voffA);
            PG8_WAIT_L(8); PG8_BAR; PG8_WAIT_L(0); PG8_MMA(0, 0, At, B0); PG8_BAR; PG8_SCHED;
            PG8_LDB(B1, 1, 1); PG8_STAGE(PG8_SB(1, 0), b3, voffB);
            PG8_BAR; PG8_WAIT_L(0); PG8_MMA(0, 1, At, B1); PG8_BAR;
            PG8_LDA(At, 1, 1); PG8_STAGE(PG8_SA(1, 0), a3, voffA);
            PG8_BAR; PG8_WAIT_L(0); PG8_MMA(1, 0, At, B0); PG8_BAR; PG8_SCHED;
            PG8_STAGE(PG8_SB(1, 1), b3 + hstep, voffB);
            PG8_WAIT_V(6); PG8_BAR; PG8_MMA(1, 1, At, B1); PG8_BAR;
            }
        }
        if constexpr (ALIGN_EPI) { if (wr == 0) PG8_BAR; }
        if constexpr (!Epi::AFTER_DRAIN) { E(acc, cur, wr, wc, fr, fq); S.done(cur); }
        if (!has_next) break;
#pragma unroll
        for (int a = 0; a < 2; ++a)
#pragma unroll
            for (int b = 0; b < 2; ++b)
#pragma unroll
                for (int m = 0; m < 4; ++m)
#pragma unroll
                    for (int n = 0; n < 2; ++n) acc[a][b][m][n] = (f32x4){0.f, 0.f, 0.f, 0.f};
        cur = nxt; cA = nA; cB = nB; ++ui;
        if constexpr (ALIGN_EPI) { if (wr == 1) PG8_BAR; }
    }
    PG8_WAIT_V(0);
    if constexpr (!ALIGN_EPI) { if (wr == 0) PG8_BAR; }
    PG8_BAR;
    if constexpr (Epi::AFTER_DRAIN) { E.fused(acc, cur, wr, wc, fr, fq, lds, wid, lane); S.done(cur); }
#undef PG8_SA
#undef PG8_SB
#undef PG8_STAGE
#undef PG8_LDA
#undef PG8_LDB
#undef PG8_MMA
#undef PG8_WAIT_V
#undef PG8_WAIT_L
#undef PG8_BAR
#undef PG8_SCHED
}
}

typedef unsigned short bf16_t;
typedef short bf16x8 __attribute__((ext_vector_type(8)));
typedef short s16x4 __attribute__((ext_vector_type(4)));
typedef float f32x4 __attribute__((ext_vector_type(4)));
typedef float f32x2 __attribute__((ext_vector_type(2)));
typedef unsigned u32x4 __attribute__((ext_vector_type(4)));
typedef unsigned u32x2 __attribute__((ext_vector_type(2)));
#define LAS __attribute__((address_space(3)))
#define GAS __attribute__((address_space(1)))
#define GLD(T, ptr) (*(const GAS T*)(ptr))
#define GST(T, ptr) (*(GAS T*)(ptr))

constexpr int T_ = 32768, D_ = 2048, S_ = 2048, B_ = 16, FF_ = 5632;
constexpr int EIN = 6400, OIN = 5680, OLD = 5888;
constexpr float EPS_ = 1e-6f;

constexpr size_t AL256(size_t x) { return (x + 255) & ~(size_t)255; }
constexpr size_t OFF_CTRL = 0;
constexpr size_t OFF_WT_EIN = 4096;
constexpr size_t OFF_WT_EOUT = OFF_WT_EIN + (size_t)EIN * D_ * 2;
constexpr size_t OFF_WT_OIN = OFF_WT_EOUT + (size_t)D_ * D_ * 2;
constexpr size_t OFF_WT_OOUT = OFF_WT_OIN + (size_t)OLD * D_ * 2;
constexpr size_t OFF_WT13_0 = OFF_WT_OOUT + (size_t)D_ * D_ * 2;
constexpr size_t OFF_WT13_1 = OFF_WT13_0 + (size_t)2 * FF_ * D_ * 2;
constexpr size_t OFF_WT2_0 = OFF_WT13_1 + (size_t)2 * FF_ * D_ * 2;
constexpr size_t OFF_WT2_1 = OFF_WT2_0 + (size_t)D_ * FF_ * 2;
constexpr size_t OFF_W1T_K = OFF_WT2_1 + (size_t)D_ * FF_ * 2;
constexpr size_t OFF_W1T_V = OFF_W1T_K + (size_t)128 * 2048 * 2;
constexpr size_t OFF_W2T_K = OFF_W1T_V + (size_t)128 * 2048 * 2;
constexpr size_t OFF_W2T_V = OFF_W2T_K + (size_t)64 * 128 * 2;
constexpr size_t OFF_BIAS1 = OFF_W2T_V + (size_t)64 * 128 * 2;
constexpr size_t OFF_ROPE = OFF_BIAS1 + 1024;
constexpr size_t OFF_KMEAN = OFF_ROPE + (size_t)2048 * 32 * 8;
constexpr size_t OFF_KC = OFF_KMEAN + (size_t)16 * 16 * 8 * 64 * 4;
constexpr size_t OFF_VC = OFF_KC + (size_t)16 * 4 * 128 * 64 * 2;
constexpr size_t OFF_SEL = OFF_VC + (size_t)16 * 4 * 128 * 64 * 2;
constexpr size_t OFF_H = OFF_SEL + (size_t)16 * 4 * 2048 * 4;
constexpr size_t OFF_Z = OFF_H + (size_t)T_ * D_ * 2;
constexpr size_t OFF_CAT = OFF_Z + (size_t)T_ * EIN * 2;
constexpr size_t OFF_BAR = OFF_CAT + (size_t)T_ * D_ * 2;
constexpr size_t WS_END = OFF_BAR + 16384;

constexpr int LDS_BYTES = 131072 + 16;
constexpr int NPHASE = 18;
#ifndef REP_P0
#define REP_P0 1
#endif
#ifndef REP_RWKV
#define REP_RWKV 1
#endif
#ifndef REP_MOBA
#define REP_MOBA 1
#endif
#ifndef REP_RET
#define REP_RET 1
#endif
#ifndef REP_NSA
#define REP_NSA 1
#endif
#ifndef REP_GEMM
#define REP_GEMM 1
#endif
#ifndef REP_NORM
#define REP_NORM 1
#endif
#ifndef REP_SEL
#define REP_SEL 1
#endif

struct Params {
    const float* in[28];
    float* out;
    unsigned char* ws;
    double inv_freq[32];
    int ph_lo, ph_hi;
};

__device__ __forceinline__ float bf2f(unsigned short b) { return __uint_as_float(((unsigned)b) << 16); }
typedef __bf16 bf16x2_t __attribute__((ext_vector_type(2)));
__device__ __forceinline__ unsigned pk2(float lo, float hi) { f32x2 v; v[0] = lo; v[1] = hi; const bf16x2_t r = __builtin_convertvector(v, bf16x2_t); return __builtin_bit_cast(unsigned, r); }
__device__ __forceinline__ float wave_sum(float v) {
#pragma unroll
    for (int o = 1; o < 64; o <<= 1) v += __shfl_xor(v, o);
    return v;
}
template <int CTRL> __device__ __forceinline__ float dppf(float x) {
    return __int_as_float(__builtin_amdgcn_update_dpp(0, __float_as_int(x), CTRL, 0xf, 0xf, false));
}
__device__ __forceinline__ float rowsum16(float x) {
    x += dppf<0x128>(x);
    x += dppf<0x124>(x);
    x += dppf<0x4E>(x);
    x += dppf<0xB1>(x);
    return x;
}
__device__ __forceinline__ void rowsum16x4(float& a, float& b, float& c, float& d) {
    asm volatile("" : "+v"(a), "+v"(b), "+v"(c), "+v"(d));
    a += dppf<0x128>(a); b += dppf<0x128>(b); c += dppf<0x128>(c); d += dppf<0x128>(d); asm volatile("" : "+v"(a), "+v"(b), "+v"(c), "+v"(d));
    a += dppf<0x124>(a); b += dppf<0x124>(b); c += dppf<0x124>(c); d += dppf<0x124>(d); asm volatile("" : "+v"(a), "+v"(b), "+v"(c), "+v"(d));
    a += dppf<0x4E>(a); b += dppf<0x4E>(b); c += dppf<0x4E>(c); d += dppf<0x4E>(d); asm volatile("" : "+v"(a), "+v"(b), "+v"(c), "+v"(d));
    a += dppf<0xB1>(a); b += dppf<0xB1>(b); c += dppf<0xB1>(c); d += dppf<0xB1>(d); asm volatile("" : "+v"(a), "+v"(b), "+v"(c), "+v"(d));
}
__device__ __forceinline__ float fexp2(float x) { return __builtin_amdgcn_exp2f(x); }
__device__ __forceinline__ float fexp(float x) { return __builtin_amdgcn_exp2f(x * 1.4426950408889634f); }
__device__ __forceinline__ float frcp(float x) { return __builtin_amdgcn_rcpf(x); }
__device__ __forceinline__ float sigmoidf_(float x) { return frcp(1.f + fexp(-x)); }
__device__ __forceinline__ void lds_wait() { asm volatile("s_waitcnt lgkmcnt(0)" ::: "memory"); }
__device__ __forceinline__ void unpack8(u32x4 v, float (&f)[8]) {
    f[0] = __uint_as_float(v.x << 16); f[1] = __uint_as_float(v.x & 0xffff0000u);
    f[2] = __uint_as_float(v.y << 16); f[3] = __uint_as_float(v.y & 0xffff0000u);
    f[4] = __uint_as_float(v.z << 16); f[5] = __uint_as_float(v.z & 0xffff0000u);
    f[6] = __uint_as_float(v.w << 16); f[7] = __uint_as_float(v.w & 0xffff0000u);
}
__device__ __forceinline__ bf16x8 as_bf16x8(u32x4 v) { return __builtin_bit_cast(bf16x8, v); }
__device__ __forceinline__ f32x4 mfma16(bf16x8 a, bf16x8 b, f32x4 c) { return __builtin_amdgcn_mfma_f32_16x16x32_bf16(a, b, c, 0, 0, 0); }

struct EpiAll {
    static constexpr bool PERM = true, AFTER_DRAIN = false;
    int mode; bf16_t* O; int ldc; const float* Xin; float* Xout;
    __device__ __forceinline__ void operator()(const pg8::f32x4 (&acc)[2][2][4][2], const pg8::Unit& u, int wr, int wc, int fr, int fq) const {
        const int row0 = u.pm * 256 + wr * 64 + fr;
        if (mode == 0) {
            const int col0 = u.pn * 256 + wc * 32 + 8 * fq;
#pragma unroll
            for (int ai = 0; ai < 2; ++ai)
#pragma unroll
                for (int m = 0; m < 4; ++m) {
                    bf16_t* rowp = O + (size_t)(row0 + ai * 128 + m * 16) * ldc + col0;
#pragma unroll
                    for (int bj = 0; bj < 2; ++bj) {
                        const pg8::f32x4 v0 = acc[ai][bj][m][0], v1 = acc[ai][bj][m][1];
                        u32x4 w; w.x = pk2(v0[0], v0[1]); w.y = pk2(v0[2], v0[3]); w.z = pk2(v1[0], v1[1]); w.w = pk2(v1[2], v1[3]);
                        GST(u32x4, rowp + bj * 128) = w;
                    }
                }
        } else if (mode == 1) {
            const int col0 = u.pn * 256 + wc * 32 + 8 * fq;
#pragma unroll
            for (int ai = 0; ai < 2; ++ai)
#pragma unroll
                for (int m = 0; m < 4; ++m) {
                    const size_t off = (size_t)(row0 + ai * 128 + m * 16) * D_ + col0;
#pragma unroll
                    for (int bj = 0; bj < 2; ++bj)
#pragma unroll
                        for (int n = 0; n < 2; ++n) {
                            const size_t idx = off + bj * 128 + n * 4;
                            const f32x4 x = GLD(f32x4, Xin + idx);
                            f32x4 r; r[0] = x[0] + acc[ai][bj][m][n][0]; r[1] = x[1] + acc[ai][bj][m][n][1]; r[2] = x[2] + acc[ai][bj][m][n][2]; r[3] = x[3] + acc[ai][bj][m][n][3];
                            GST(f32x4, Xout + idx) = r;
                        }
                }
        } else {
            const int col0 = u.pn * 128 + wc * 32 + 8 * fq;
#pragma unroll
            for (int ai = 0; ai < 2; ++ai)
#pragma unroll
                for (int m = 0; m < 4; ++m) {
                    bf16_t* rowp = O + (size_t)(row0 + ai * 128 + m * 16) * FF_ + col0;
                    float hv[8];
#pragma unroll
                    for (int n = 0; n < 2; ++n)
#pragma unroll
                        for (int j = 0; j < 4; ++j) { const float g = acc[ai][0][m][n][j], up = acc[ai][1][m][n][j]; hv[n * 4 + j] = g * sigmoidf_(g) * up; }
                    u32x4 w; w.x = pk2(hv[0], hv[1]); w.y = pk2(hv[2], hv[3]); w.z = pk2(hv[4], hv[5]); w.w = pk2(hv[6], hv[7]);
                    GST(u32x4, rowp) = w;
                }
        }
    }
};

template <int MODE>
__device__ __forceinline__ void prep_w(const float* Wa, const float* Wb, int K, int Nsrc, bf16_t* WT, int nOutBlocks, float* scr, int gw, int ngw, int lane, const float* gain) {
    const int nkb = K / 64, nitems = nkb * nOutBlocks;
    const int lr = lane >> 3, lc = (lane & 7) * 4;
    f32x4 cur[8], nxt[8];
    auto locate = [&](int it, const float*& src, int& c0, int& k0, int& ob) {
        ob = it % nOutBlocks; k0 = (it / nOutBlocks) * 64;
        if (MODE == 0) { src = Wa; c0 = ob * 32; }
        else { const int pn = ob >> 3, sb = ob & 7; src = (sb < 4) ? Wa : Wb; c0 = (pn * 4 + (sb & 3)) * 32; }
    };
    auto load = [&](int it, f32x4 (&v)[8]) {
        const float* src; int c0, k0, ob; locate(it, src, c0, k0, ob);
        const int col = c0 + lc;
#pragma unroll
        for (int i = 0; i < 8; ++i) v[i] = (col < Nsrc) ? GLD(f32x4, src + (size_t)(k0 + 8 * i + lr) * Nsrc + col) : (f32x4){0.f, 0.f, 0.f, 0.f};
    };
    int it = gw;
    if (it < nitems) load(it, cur);
    for (; it < nitems; it += ngw) {
        const int itn = it + ngw;
        if (itn < nitems) load(itn, nxt);
        const float* src; int c0, k0, ob; locate(it, src, c0, k0, ob);
#pragma unroll
        for (int i = 0; i < 8; ++i) {
            const int kk = 8 * i + lr; const float gk = gain ? gain[k0 + kk] : 1.f;
            float* d = scr + kk * 33 + lc;
            d[0] = cur[i][0] * gk; d[1] = cur[i][1] * gk; d[2] = cur[i][2] * gk; d[3] = cur[i][3] * gk;
        }
        lds_wait();
        const int c = lane & 7;
#pragma unroll
        for (int j = 0; j < 4; ++j) {
            const int n = (lane >> 3) + 8 * j; const float* sp = scr + (8 * c) * 33 + n;
            u32x4 o; o.x = pk2(sp[0 * 33], sp[1 * 33]); o.y = pk2(sp[2 * 33], sp[3 * 33]); o.z = pk2(sp[4 * 33], sp[5 * 33]); o.w = pk2(sp[6 * 33], sp[7 * 33]);
            GST(u32x4, WT + (size_t)(ob * 32 + n) * K + k0 + 8 * c) = o;
        }
        lds_wait();
#pragma unroll
        for (int i = 0; i < 8; ++i) cur[i] = nxt[i];
    }
}

__device__ __forceinline__ void rmsnorm_rows(const float* X, const float* g, bf16_t* H, float* OutF, int gw, int ngw, int lane) {
    f32x4 gv[8];
#pragma unroll
    for (int j = 0; j < 8; ++j) gv[j] = GLD(f32x4, (const f32x4*)g + lane + 64 * j);
    f32x4 v[8], vn[8];
    int m = gw;
    if (m < T_) {
#pragma unroll
        for (int j = 0; j < 8; ++j) v[j] = GLD(f32x4, (const f32x4*)(X + (size_t)m * D_) + lane + 64 * j);
    }
    for (; m < T_; m += ngw) {
        const int mn = m + ngw;
        if (mn < T_) {
#pragma unroll
            for (int j = 0; j < 8; ++j) vn[j] = GLD(f32x4, (const f32x4*)(X + (size_t)mn * D_) + lane + 64 * j);
        }
        float ss = 0.f;
#pragma unroll
        for (int j = 0; j < 8; ++j) ss += (v[j][0] * v[j][0] + v[j][1] * v[j][1]) + (v[j][2] * v[j][2] + v[j][3] * v[j][3]);
        ss = wave_sum(ss);
        const float rstd = rsqrtf(ss * (1.f / D_) + EPS_);
#pragma unroll
        for (int j = 0; j < 8; ++j) {
            const float y0 = v[j][0] * rstd * gv[j][0], y1 = v[j][1] * rstd * gv[j][1], y2 = v[j][2] * rstd * gv[j][2], y3 = v[j][3] * rstd * gv[j][3];
            if (H) { u32x2 o; o.x = pk2(y0, y1); o.y = pk2(y2, y3); GST(u32x2, H + (size_t)m * D_ + (lane + 64 * j) * 4) = o; }
            if (OutF) { f32x4 o; o[0] = y0; o[1] = y1; o[2] = y2; o[3] = y3; GST(f32x4, (f32x4*)(OutF + (size_t)m * D_) + lane + 64 * j) = o; }
        }
#pragma unroll
        for (int j = 0; j < 8; ++j) v[j] = vn[j];
    }
}

__device__ __forceinline__ void phase0(const Params& p, unsigned char* smem, int tid, int bid, int nblk) {
    const int lane = tid & 63, wave = tid >> 6;
    const int gw = bid * 8 + wave, ngw = nblk * 8;
    float* scr = (float*)(smem + wave * 8448);
    unsigned char* ws = p.ws;
    prep_w<0>(p.in[3], nullptr, D_, EIN, (bf16_t*)(ws + OFF_WT_EIN), EIN / 32, scr, gw, ngw, lane, nullptr);
    prep_w<0>(p.in[15], nullptr, D_, D_, (bf16_t*)(ws + OFF_WT_EOUT), D_ / 32, scr, gw, ngw, lane, nullptr);
    prep_w<0>(p.in[16], nullptr, D_, OIN, (bf16_t*)(ws + OFF_WT_OIN), OLD / 32, scr, gw, ngw, lane, nullptr);
    prep_w<0>(p.in[23], nullptr, D_, D_, (bf16_t*)(ws + OFF_WT_OOUT), D_ / 32, scr, gw, ngw, lane, nullptr);
    prep_w<1>(p.in[24], p.in[25], D_, FF_, (bf16_t*)(ws + OFF_WT13_0), 2 * FF_ / 32, scr, gw, ngw, lane, nullptr);
    prep_w<1>(p.in[24] + (size_t)D_ * FF_, p.in[25] + (size_t)D_ * FF_, D_, FF_, (bf16_t*)(ws + OFF_WT13_1), 2 * FF_ / 32, scr, gw, ngw, lane, nullptr);
    prep_w<0>(p.in[26], nullptr, FF_, D_, (bf16_t*)(ws + OFF_WT2_0), D_ / 32, scr, gw, ngw, lane, nullptr);
    prep_w<0>(p.in[26] + (size_t)FF_ * D_, nullptr, FF_, D_, (bf16_t*)(ws + OFF_WT2_1), D_ / 32, scr, gw, ngw, lane, nullptr);
    prep_w<0>(p.in[18], nullptr, 2048, 128, (bf16_t*)(ws + OFF_W1T_K), 4, scr, gw, ngw, lane, nullptr);
    prep_w<0>(p.in[21], nullptr, 2048, 128, (bf16_t*)(ws + OFF_W1T_V), 4, scr, gw, ngw, lane, nullptr);
    prep_w<0>(p.in[19], nullptr, 128, 64, (bf16_t*)(ws + OFF_W2T_K), 2, scr, gw, ngw, lane, nullptr);
    prep_w<0>(p.in[22], nullptr, 128, 64, (bf16_t*)(ws + OFF_W2T_V), 2, scr, gw, ngw, lane, nullptr);
    if (gw < 256) {
        const int kv = gw >> 7, n = gw & 127;
        const float* pe = p.in[kv ? 20 : 17]; const float* w1 = p.in[kv ? 21 : 18];
        float s = 0.f;
        for (int k = lane; k < 2048; k += 64) s += pe[k] * w1[(size_t)k * 128 + n];
        s = wave_sum(s);
        if (lane == 0) ((float*)(ws + OFF_BIAS1))[gw] = s;
    }
    {
        f32x2* rope = (f32x2*)(ws + OFF_ROPE);
        for (int e = bid * 512 + tid; e < 2048 * 32; e += nblk * 512) {
            const int pos = e >> 5, i = e & 31;
            const double ang = (double)pos * p.inv_freq[i];
            const double kq = rint(ang * 0.63661977236758134308);
            double r = fma(-kq, 1.57079632679489655800e+00, ang);
            r = fma(-kq, 6.12323399573676603587e-17, r);
            const float rf = (float)r;
            const float r2 = rf * rf;
            const float sn = rf * (1.f + r2 * (-1.6666667e-1f + r2 * (8.3333333e-3f + r2 * (-1.9841270e-4f + r2 * 2.7557319e-6f))));
            const float cs = 1.f + r2 * (-0.5f + r2 * (4.1666667e-2f + r2 * (-1.3888889e-3f + r2 * (2.4801587e-5f + r2 * -2.7557319e-7f))));
            const int q = ((int)kq) & 3;
            float c, s;
            if (q == 0) { c = cs; s = sn; } else if (q == 1) { c = -sn; s = cs; } else if (q == 2) { c = -cs; s = -sn; } else { c = sn; s = -cs; }
            f32x2 o; o[0] = c; o[1] = s; rope[e] = o;
        }
    }
    rmsnorm_rows(p.in[0], p.in[1], (bf16_t*)(ws + OFF_H), nullptr, gw, ngw, lane);
}

enum { M_MOBA = 0, M_SLC = 1, M_WIN = 2, M_CMP = 3, M_RET = 4 };
template <int MODE, int DV>
__device__ __forceinline__ void attn_pass(unsigned char* smem, const bf16_t* Qb, int ldq, const bf16_t* Kb, int ldk, const bf16_t* Vb, int ldv,
                                          int q0, unsigned rowmask, float log2g, f32x4 (&o)[DV / 16], int tid) {
    constexpr int VST = DV + 8;
    const int lane = tid & 63, wave = tid >> 6, lq = lane & 15, quad = lane >> 4;
    const int t = q0 + wave * 16 + lq;
    constexpr int KSZ = 64 * 72 * 2, BUFSZ = KSZ + 64 * VST * 2;
    bf16x8 qf[2];
#pragma unroll
    for (int ks = 0; ks < 2; ++ks) qf[ks] = as_bf16x8(GLD(u32x4, Qb + (size_t)t * ldq + quad * 8 + 32 * ks));
    float m = -INFINITY, l = 0.f;
#pragma unroll
    for (int c = 0; c < DV / 16; ++c) o[c] = (f32x4){0.f, 0.f, 0.f, 0.f};
    int kt_lo = 0, kt_hi = (q0 + 127) >> 6;
    if (MODE == M_WIN) { const int lo = q0 - 511; kt_lo = (lo > 0 ? lo : 0) >> 6; }
    if (MODE == M_CMP) { kt_hi = 1; }
    constexpr float SC = 0.125f * 1.4426950408889634f;
    const int q4 = lq >> 2, pp = lq & 3;
    float dk[4][4];
#pragma unroll
    for (int sub = 0; sub < 4; ++sub)
#pragma unroll
        for (int j = 0; j < 4; ++j) dk[sub][j] = (MODE == M_RET) ? 0.125f * fexp2(-(float)(16 * sub + 4 * quad + j) * log2g) : 0.f;
    const int rk_ = tid >> 3, chk_ = tid & 7;
    u32x4 kreg, vreg[DV / 64];
    auto gload = [&](int kt) {
        kreg = GLD(u32x4, Kb + (size_t)(kt * 64 + rk_) * ldk + chk_ * 8);
#pragma unroll
        for (int i = 0; i < DV / 64; ++i) { const int idx = tid + i * 512; const int r = idx / (DV / 8), ch = idx % (DV / 8); vreg[i] = GLD(u32x4, Vb + (size_t)(kt * 64 + r) * ldv + ch * 8); }
    };
    auto lstore = [&](int b) {
        bf16_t* Ks_ = (bf16_t*)(smem + b * BUFSZ); bf16_t* Vs_ = (bf16_t*)(smem + b * BUFSZ + KSZ);
        *(u32x4*)(Ks_ + rk_ * 72 + chk_ * 8) = kreg;
#pragma unroll
        for (int i = 0; i < DV / 64; ++i) { const int idx = tid + i * 512; const int r = idx / (DV / 8), ch = idx % (DV / 8); *(u32x4*)(Vs_ + r * VST + ch * 8) = vreg[i]; }
    };
    gload(kt_lo);
    __syncthreads();
    lstore(0);
    if (kt_lo + 1 <= kt_hi) gload(kt_lo + 1);
    __syncthreads();
    int bsel = 0;
    for (int kt = kt_lo; kt <= kt_hi; ++kt, bsel ^= 1) {
        if (kt + 1 <= kt_hi) lstore(bsel ^ 1);
        if (kt + 2 <= kt_hi) gload(kt + 2);
        const bf16_t* Ks = (const bf16_t*)(smem + bsel * BUFSZ); const bf16_t* Vs = (const bf16_t*)(smem + bsel * BUFSZ + KSZ);
        const int kbase = kt * 64;
        bool lane_any;
        if (MODE == M_MOBA) lane_any = (kbase <= t) && ((rowmask >> (kt >> 2)) & 1u);
        else if (MODE == M_SLC) lane_any = (kbase <= t) && ((rowmask >> kt) & 1u);
        else if (MODE == M_WIN) lane_any = (kbase <= t) && (kbase + 63 > t - 512);
        else if (MODE == M_CMP) lane_any = (kbase * 16 + 31 <= t);
        else lane_any = (kbase <= t);
        if (__any(lane_any ? 1 : 0)) {
        f32x4 s[4];
#pragma unroll
        for (int sub = 0; sub < 4; ++sub) {
            s[sub] = (f32x4){0.f, 0.f, 0.f, 0.f};
#pragma unroll
            for (int ks = 0; ks < 2; ++ks) { const bf16x8 a = as_bf16x8(*(const u32x4*)(Ks + (16 * sub + lq) * 72 + quad * 8 + 32 * ks)); s[sub] = mfma16(a, qf[ks], s[sub]); }
        }
        float pv[4][4];
        const int t_min = q0 + wave * 16;
        bool need_mask;
        if (MODE == M_WIN) need_mask = (kbase + 63 > t_min) || (kbase <= t_min + 15 - 512);
        else if (MODE == M_CMP) need_mask = true;
        else need_mask = (kbase + 63 > t_min);
        if (MODE != M_RET) {
            float mx = -INFINITY;
            if (need_mask) {
#pragma unroll
                for (int sub = 0; sub < 4; ++sub)
#pragma unroll
                    for (int j = 0; j < 4; ++j) {
                        const int key = kbase + 16 * sub + 4 * quad + j;
                        bool valid;
                        if (MODE == M_MOBA || MODE == M_SLC) valid = lane_any && (key <= t);
                        else if (MODE == M_WIN) valid = (key <= t) && (key > t - 512);
                        else valid = (key * 16 + 31 <= t);
                        const float sv = valid ? s[sub][j] : -INFINITY;
                        pv[sub][j] = sv; mx = fmaxf(mx, sv);
                    }
            } else if (MODE == M_MOBA || MODE == M_SLC) {
#pragma unroll
                for (int sub = 0; sub < 4; ++sub)
#pragma unroll
                    for (int j = 0; j < 4; ++j) { const float sv = lane_any ? s[sub][j] : -INFINITY; pv[sub][j] = sv; mx = fmaxf(mx, sv); }
            } else {
#pragma unroll
                for (int sub = 0; sub < 4; ++sub)
#pragma unroll
                    for (int j = 0; j < 4; ++j) { pv[sub][j] = s[sub][j]; mx = fmaxf(mx, s[sub][j]); }
            }
            mx = fmaxf(mx, __shfl_xor(mx, 16)); mx = fmaxf(mx, __shfl_xor(mx, 32));
            const float m_new = fmaxf(m, mx * SC);
            const float m_use = (m_new == -INFINITY) ? 0.f : m_new;
            const float alpha = fexp2(m - m_use);
            float rs = 0.f;
#pragma unroll
            for (int sub = 0; sub < 4; ++sub)
#pragma unroll
                for (int j = 0; j < 4; ++j) { const float e = fexp2(__builtin_fmaf(pv[sub][j], SC, -m_use)); pv[sub][j] = e; rs += e; }
            l = l * alpha + rs; m = m_new;
#pragma unroll
            for (int c = 0; c < DV / 16; ++c) { o[c][0] *= alpha; o[c][1] *= alpha; o[c][2] *= alpha; o[c][3] *= alpha; }
        } else {
            const float rowfac = fexp2((float)(t - kbase) * log2g);
            if (need_mask) {
#pragma unroll
                for (int sub = 0; sub < 4; ++sub)
#pragma unroll
                    for (int j = 0; j < 4; ++j) { const int key = kbase + 16 * sub + 4 * quad + j; pv[sub][j] = (key <= t) ? (s[sub][j] * dk[sub][j]) * rowfac : 0.f; }
            } else {
#pragma unroll
                for (int sub = 0; sub < 4; ++sub)
#pragma unroll
                    for (int j = 0; j < 4; ++j) pv[sub][j] = (s[sub][j] * dk[sub][j]) * rowfac;
            }
        }
        bf16x8 pb[2];
#pragma unroll
        for (int s2 = 0; s2 < 2; ++s2) {
            u32x4 w; w.x = pk2(pv[2 * s2][0], pv[2 * s2][1]); w.y = pk2(pv[2 * s2][2], pv[2 * s2][3]); w.z = pk2(pv[2 * s2 + 1][0], pv[2 * s2 + 1][1]); w.w = pk2(pv[2 * s2 + 1][2], pv[2 * s2 + 1][3]);
            pb[s2] = as_bf16x8(w);
        }
#pragma unroll
        for (int c = 0; c < DV / 16; ++c)
#pragma unroll
            for (int s2 = 0; s2 < 2; ++s2) {
                const s16x4 t1 = __builtin_amdgcn_ds_read_tr16_b64_v4i16((LAS s16x4*)(Vs + (32 * s2 + 4 * quad + q4) * VST + 16 * c + 4 * pp));
                const s16x4 t2 = __builtin_amdgcn_ds_read_tr16_b64_v4i16((LAS s16x4*)(Vs + (32 * s2 + 16 + 4 * quad + q4) * VST + 16 * c + 4 * pp));
                bf16x8 a; a[0] = t1[0]; a[1] = t1[1]; a[2] = t1[2]; a[3] = t1[3]; a[4] = t2[0]; a[5] = t2[1]; a[6] = t2[2]; a[7] = t2[3];
                o[c] = mfma16(a, pb[s2], o[c]);
            }
            }
        __syncthreads();
    }
    if (MODE != M_RET) {
        l += __shfl_xor(l, 16); l += __shfl_xor(l, 32);
        const float inv = (l > 0.f) ? 1.f / l : 1.f;
#pragma unroll
        for (int c = 0; c < DV / 16; ++c) { o[c][0] *= inv; o[c][1] *= inv; o[c][2] *= inv; o[c][3] *= inv; }
    }
}


template <int MODE, int DV>
__device__ __forceinline__ void attn_pass2(unsigned char* smem, const bf16_t* Qb, int ldq, const bf16_t* Kb, int ldk, const bf16_t* Vb, int ldv,
                                           int q0, const unsigned (&rowmask)[2], float log2g, f32x4 (&o)[2][DV / 16], int tid) {
    constexpr int VST = DV + 8;
    const int lane = tid & 63, wave = tid >> 6, lq = lane & 15, quad = lane >> 4;
    const int t_min = q0 + wave * 32;
    int t[2]; t[0] = t_min + lq; t[1] = t_min + 16 + lq;
    constexpr int KSZ = 64 * 72 * 2, BUFSZ = KSZ + 64 * VST * 2;
    bf16x8 qf[2][2];
#pragma unroll
    for (int qs = 0; qs < 2; ++qs)
#pragma unroll
        for (int ks = 0; ks < 2; ++ks) qf[qs][ks] = as_bf16x8(GLD(u32x4, Qb + (size_t)t[qs] * ldq + quad * 8 + 32 * ks));
    float m[2], l[2];
#pragma unroll
    for (int qs = 0; qs < 2; ++qs) { m[qs] = -INFINITY; l[qs] = 0.f;
#pragma unroll
        for (int c = 0; c < DV / 16; ++c) o[qs][c] = (f32x4){0.f, 0.f, 0.f, 0.f}; }
    int kt_lo = 0, kt_hi = (q0 + 255) >> 6;
    if (MODE == M_WIN) { const int lo = q0 - 511; kt_lo = (lo > 0 ? lo : 0) >> 6; }
    if (MODE == M_CMP) { kt_hi = (q0 + 255 >= 64 * 16 + 31) ? 1 : 0; }
    constexpr float SC = 0.125f * 1.4426950408889634f;
    const int q4 = lq >> 2, pp = lq & 3;
    const int rk_ = tid >> 3, chk_ = tid & 7;
    float dku[4][4];
#pragma unroll
    for (int sub = 0; sub < 4; ++sub)
#pragma unroll
        for (int j = 0; j < 4; ++j) dku[sub][j] = (MODE == M_RET) ? __int_as_float(__builtin_amdgcn_readfirstlane(__float_as_int(0.125f * fexp2(-(float)(16 * sub + j) * log2g)))) : 0.f;
    u32x4 kreg, vreg[DV / 64];
    auto gload = [&](int kt) {
        kreg = GLD(u32x4, Kb + (size_t)(kt * 64 + rk_) * ldk + chk_ * 8);
#pragma unroll
        for (int i = 0; i < DV / 64; ++i) { const int idx = tid + i * 512; const int r = idx / (DV / 8), ch = idx % (DV / 8); vreg[i] = GLD(u32x4, Vb + (size_t)(kt * 64 + r) * ldv + ch * 8); }
    };
    auto lstore = [&](int b) {
        bf16_t* Ks_ = (bf16_t*)(smem + b * BUFSZ); bf16_t* Vs_ = (bf16_t*)(smem + b * BUFSZ + KSZ);
        *(u32x4*)(Ks_ + rk_ * 72 + chk_ * 8) = kreg;
#pragma unroll
        for (int i = 0; i < DV / 64; ++i) { const int idx = tid + i * 512; const int r = idx / (DV / 8), ch = idx % (DV / 8); *(u32x4*)(Vs_ + r * VST + ch * 8) = vreg[i]; }
    };
    gload(kt_lo);
    __syncthreads();
    lstore(0);
    if (kt_lo + 1 <= kt_hi) gload(kt_lo + 1);
    __syncthreads();
    int bsel = 0;
    for (int kt = kt_lo; kt <= kt_hi; ++kt, bsel ^= 1) {
        if (kt + 1 <= kt_hi) lstore(bsel ^ 1);
        if (kt + 2 <= kt_hi) gload(kt + 2);
        const bf16_t* Ks = (const bf16_t*)(smem + bsel * BUFSZ); const bf16_t* Vs = (const bf16_t*)(smem + bsel * BUFSZ + KSZ);
        const int kbase = kt * 64;
        bool la[2];
#pragma unroll
        for (int qs = 0; qs < 2; ++qs) {
            if (MODE == M_MOBA) la[qs] = (kbase <= t[qs]) && ((rowmask[qs] >> (kt >> 2)) & 1u);
            else if (MODE == M_SLC) la[qs] = (kbase <= t[qs]) && ((rowmask[qs] >> kt) & 1u);
            else if (MODE == M_WIN) la[qs] = (kbase <= t[qs]) && (kbase + 63 > t[qs] - 512);
            else if (MODE == M_CMP) la[qs] = (kbase * 16 + 31 <= t[qs]);
            else la[qs] = (kbase <= t[qs]);
        }
        if (__any((la[0] || la[1]) ? 1 : 0)) {
            f32x4 s[2][4];
#pragma unroll
            for (int sub = 0; sub < 4; ++sub) {
                s[0][sub] = (f32x4){0.f, 0.f, 0.f, 0.f}; s[1][sub] = (f32x4){0.f, 0.f, 0.f, 0.f};
#pragma unroll
                for (int ks = 0; ks < 2; ++ks) {
                    const bf16x8 a = as_bf16x8(*(const u32x4*)(Ks + (16 * sub + lq) * 72 + quad * 8 + 32 * ks));
                    s[0][sub] = mfma16(a, qf[0][ks], s[0][sub]); s[1][sub] = mfma16(a, qf[1][ks], s[1][sub]);
                }
            }
            bool need_mask;
            if (MODE == M_WIN) need_mask = (kbase + 63 > t_min) || (kbase <= t_min + 31 - 512);
            else if (MODE == M_CMP) need_mask = true;
            else need_mask = (kbase + 63 > t_min);
            bf16x8 pb[2][2];
#pragma unroll
            for (int qs = 0; qs < 2; ++qs) {
                if (MODE == M_RET) {
                    const float rowfac = fexp2((float)(t[qs] - kbase - 4 * quad) * log2g);
                    if (need_mask) {
#pragma unroll
                        for (int sub = 0; sub < 4; ++sub)
#pragma unroll
                            for (int j = 0; j < 4; ++j) { const int key = kbase + 16 * sub + 4 * quad + j; s[qs][sub][j] = (key <= t[qs]) ? (s[qs][sub][j] * dku[sub][j]) * rowfac : 0.f; }
                    } else {
#pragma unroll
                        for (int sub = 0; sub < 4; ++sub)
#pragma unroll
                            for (int j = 0; j < 4; ++j) s[qs][sub][j] = (s[qs][sub][j] * dku[sub][j]) * rowfac;
                    }
                } else {
                float mx = -INFINITY, kill = 0.f;
                if (need_mask) {
#pragma unroll
                    for (int sub = 0; sub < 4; ++sub)
#pragma unroll
                        for (int j = 0; j < 4; ++j) {
                            const int key = kbase + 16 * sub + 4 * quad + j;
                            bool valid;
                            if (MODE == M_MOBA || MODE == M_SLC) valid = la[qs] && (key <= t[qs]);
                            else if (MODE == M_WIN) valid = (key <= t[qs]) && (key > t[qs] - 512);
                            else valid = (key * 16 + 31 <= t[qs]);
                            const float sv = valid ? s[qs][sub][j] : -INFINITY;
                            s[qs][sub][j] = sv; mx = fmaxf(mx, sv);
                        }
                } else if (MODE == M_MOBA || MODE == M_SLC) {
#pragma unroll
                    for (int sub = 0; sub < 4; ++sub)
#pragma unroll
                        for (int j = 0; j < 4; ++j) mx = fmaxf(mx, s[qs][sub][j]);
                    mx = la[qs] ? mx : -INFINITY;
                    kill = la[qs] ? 0.f : INFINITY;
                } else {
#pragma unroll
                    for (int sub = 0; sub < 4; ++sub)
#pragma unroll
                        for (int j = 0; j < 4; ++j) mx = fmaxf(mx, s[qs][sub][j]);
                }
                mx = fmaxf(mx, __shfl_xor(mx, 16)); mx = fmaxf(mx, __shfl_xor(mx, 32));
                const float m_new = fmaxf(m[qs], mx * SC);
                const float m_use = (m_new == -INFINITY) ? 0.f : m_new;
                const float alpha = fexp2(m[qs] - m_use);
                const float msub = m_use + kill;
                float rs = 0.f;
#pragma unroll
                for (int sub = 0; sub < 4; ++sub)
#pragma unroll
                    for (int j = 0; j < 4; ++j) { const float e = fexp2(__builtin_fmaf(s[qs][sub][j], SC, -msub)); s[qs][sub][j] = e; rs += e; }
                l[qs] = l[qs] * alpha + rs; m[qs] = m_new;
#pragma unroll
                for (int c = 0; c < DV / 16; ++c) { o[qs][c][0] *= alpha; o[qs][c][1] *= alpha; o[qs][c][2] *= alpha; o[qs][c][3] *= alpha; }
                }
#pragma unroll
                for (int s2 = 0; s2 < 2; ++s2) {
                    u32x4 w; w.x = pk2(s[qs][2 * s2][0], s[qs][2 * s2][1]); w.y = pk2(s[qs][2 * s2][2], s[qs][2 * s2][3]);
                    w.z = pk2(s[qs][2 * s2 + 1][0], s[qs][2 * s2 + 1][1]); w.w = pk2(s[qs][2 * s2 + 1][2], s[qs][2 * s2 + 1][3]);
                    pb[qs][s2] = as_bf16x8(w);
                }
            }
#pragma unroll
            for (int c = 0; c < DV / 16; ++c) {
                if (DV > 64 && (c & 1) == 0) asm volatile("" ::: "memory");
#pragma unroll
                for (int s2 = 0; s2 < 2; ++s2) {
                    const s16x4 t1 = __builtin_amdgcn_ds_read_tr16_b64_v4i16((LAS s16x4*)(Vs + (32 * s2 + 4 * quad + q4) * VST + 16 * c + 4 * pp));
                    const s16x4 t2 = __builtin_amdgcn_ds_read_tr16_b64_v4i16((LAS s16x4*)(Vs + (32 * s2 + 16 + 4 * quad + q4) * VST + 16 * c + 4 * pp));
                    bf16x8 a; a[0] = t1[0]; a[1] = t1[1]; a[2] = t1[2]; a[3] = t1[3]; a[4] = t2[0]; a[5] = t2[1]; a[6] = t2[2]; a[7] = t2[3];
                    o[0][c] = mfma16(a, pb[0][s2], o[0][c]); o[1][c] = mfma16(a, pb[1][s2], o[1][c]);
                }
            }
        }
        __syncthreads();
    }
    if (MODE != M_RET)
#pragma unroll
    for (int qs = 0; qs < 2; ++qs) {
        float lt = l[qs];
        lt += __shfl_xor(lt, 16); lt += __shfl_xor(lt, 32);
        const float inv = (lt > 0.f) ? 1.f / lt : 1.f;
#pragma unroll
        for (int c = 0; c < DV / 16; ++c) { o[qs][c][0] *= inv; o[qs][c][1] *= inv; o[qs][c][2] *= inv; o[qs][c][3] *= inv; }
    }
}

__device__ __forceinline__ void kmean_phase(const Params& p, int tid, int bid, int nblk) {
    const bf16_t* Z = (const bf16_t*)(p.ws + OFF_Z);
    float* km = (float*)(p.ws + OFF_KMEAN);
    for (int it = bid; it < 256; it += nblk) {
        const int b = it >> 4, n = (it >> 1) & 7, half = it & 1;
        const int ch = half * 512 + tid;
        const bf16_t* src = Z + ((size_t)(b * S_ + n * 256)) * EIN + 1024 + ch;
        float s = 0.f;
#pragma unroll 8
        for (int tt = 0; tt < 256; ++tt) s += bf2f(GLD(bf16_t, src + (size_t)tt * EIN));
        const int h = ch >> 6, d = ch & 63;
        GST(float, km + ((size_t)(b * 16 + h) * 8 + n) * 64 + d) = s * (1.f / 256.f);
    }
}

__device__ __forceinline__ void moba_item(const Params& p, unsigned char* smem, int b, int h, int qt, int tid) {
    const int lane = tid & 63, wave = tid >> 6, lq = lane & 15, quad = lane >> 4;
    const bf16_t* Z = (const bf16_t*)(p.ws + OFF_Z) + (size_t)b * S_ * EIN;
    const int q0 = qt * 128, t = q0 + wave * 16 + lq, own = q0 >> 8;
    unsigned rowmask = 1u << own;
    if (own > 0) {
        const float* km = (const float*)(p.ws + OFF_KMEAN) + (size_t)(b * 16 + h) * 8 * 64;
        u32x4 zq[8];
#pragma unroll
        for (int c8 = 0; c8 < 8; ++c8) zq[c8] = GLD(u32x4, Z + (size_t)t * EIN + h * 64 + c8 * 8);
        float g2[2] = {0.f, 0.f};
#pragma unroll
        for (int i = 0; i < 2; ++i) {
            const int n = quad + 4 * i;
            if (n < own) {
                f32x4 kv[16];
#pragma unroll
                for (int d4 = 0; d4 < 16; ++d4) kv[d4] = GLD(f32x4, km + n * 64 + d4 * 4);
                float acc = 0.f;
#pragma unroll
                for (int c8 = 0; c8 < 8; ++c8) {
                    float f[8]; unpack8(zq[c8], f);
                    acc += (f[0] * kv[2 * c8][0] + f[1] * kv[2 * c8][1]) + (f[2] * kv[2 * c8][2] + f[3] * kv[2 * c8][3])
                         + (f[4] * kv[2 * c8 + 1][0] + f[5] * kv[2 * c8 + 1][1]) + (f[6] * kv[2 * c8 + 1][2] + f[7] * kv[2 * c8 + 1][3]);
                }
                g2[i] = acc;
            }
        }
        float gsc[7];
#pragma unroll
        for (int n = 0; n < 7; ++n) gsc[n] = __shfl((n >> 2) ? g2[1] : g2[0], lq + 16 * (n & 3));
#pragma unroll
        for (int n = 0; n < 7; ++n) {
            int cnt = 0;
#pragma unroll
            for (int n2 = 0; n2 < 7; ++n2) { if (n2 != n) { const bool beats = (gsc[n2] > gsc[n]) || (gsc[n2] == gsc[n] && n2 < n); cnt += (n2 < own && beats) ? 1 : 0; } }
            if (n < own && cnt < 3) rowmask |= (1u << n);
        }
    }
    f32x4 o[4];
    attn_pass<M_MOBA, 64>(smem, Z + h * 64, EIN, Z + 1024 + h * 64, EIN, Z + 2048 + h * 64, EIN, q0, rowmask, 0.f, o, tid);
    bf16_t* cat = (bf16_t*)(p.ws + OFF_CAT) + (size_t)(b * S_ + t) * D_ + h * 64;
#pragma unroll
    for (int c = 0; c < 4; ++c) { u32x2 w; w.x = pk2(o[c][0], o[c][1]); w.y = pk2(o[c][2], o[c][3]); GST(u32x2, cat + 16 * c + 4 * quad) = w; }
}


__device__ __forceinline__ void moba_item2(const Params& p, unsigned char* smem, int b, int h, int qt, int tid) {
    const int lane = tid & 63, wave = tid >> 6, lq = lane & 15, quad = lane >> 4;
    const bf16_t* Z = (const bf16_t*)(p.ws + OFF_Z) + (size_t)b * S_ * EIN;
    const int q0 = qt * 256, own = qt;
    int t[2]; t[0] = q0 + wave * 32 + lq; t[1] = t[0] + 16;
    unsigned rowmask[2]; rowmask[0] = 1u << own; rowmask[1] = 1u << own;
    if (own > 0) {
        const float* km = (const float*)(p.ws + OFF_KMEAN) + (size_t)(b * 16 + h) * 8 * 64;
        u32x4 zq[2][8];
#pragma unroll
        for (int qs = 0; qs < 2; ++qs)
#pragma unroll
            for (int c8 = 0; c8 < 8; ++c8) zq[qs][c8] = GLD(u32x4, Z + (size_t)t[qs] * EIN + h * 64 + c8 * 8);
        float g2[2][2] = {{0.f, 0.f}, {0.f, 0.f}};
#pragma unroll
        for (int i = 0; i < 2; ++i) {
            const int n = quad + 4 * i;
            if (n < own) {
                f32x4 kv[16];
#pragma unroll
                for (int d4 = 0; d4 < 16; ++d4) kv[d4] = GLD(f32x4, km + n * 64 + d4 * 4);
#pragma unroll
                for (int qs = 0; qs < 2; ++qs) {
                    float acc = 0.f;
#pragma unroll
                    for (int c8 = 0; c8 < 8; ++c8) {
                        float f[8]; unpack8(zq[qs][c8], f);
                        acc += (f[0] * kv[2 * c8][0] + f[1] * kv[2 * c8][1]) + (f[2] * kv[2 * c8][2] + f[3] * kv[2 * c8][3])
                             + (f[4] * kv[2 * c8 + 1][0] + f[5] * kv[2 * c8 + 1][1]) + (f[6] * kv[2 * c8 + 1][2] + f[7] * kv[2 * c8 + 1][3]);
                    }
                    g2[qs][i] = acc;
                }
            }
        }
#pragma unroll
        for (int qs = 0; qs < 2; ++qs) {
            float gsc[7];
#pragma unroll
            for (int n = 0; n < 7; ++n) gsc[n] = __shfl((n >> 2) ? g2[qs][1] : g2[qs][0], lq + 16 * (n & 3));
#pragma unroll
            for (int n = 0; n < 7; ++n) {
                int cnt = 0;
#pragma unroll
                for (int n2 = 0; n2 < 7; ++n2) { if (n2 != n) { const bool beats = (gsc[n2] > gsc[n]) || (gsc[n2] == gsc[n] && n2 < n); cnt += (n2 < own && beats) ? 1 : 0; } }
                if (n < own && cnt < 3) rowmask[qs] |= (1u << n);
            }
        }
    }
    f32x4 o[2][4];
    attn_pass2<M_MOBA, 64>(smem, Z + h * 64, EIN, Z + 1024 + h * 64, EIN, Z + 2048 + h * 64, EIN, q0, rowmask, 0.f, o, tid);
#pragma unroll
    for (int qs = 0; qs < 2; ++qs) {
        bf16_t* cat = (bf16_t*)(p.ws + OFF_CAT) + (size_t)(b * S_ + t[qs]) * D_ + h * 64;
#pragma unroll
        for (int c = 0; c < 4; ++c) { u32x2 w; w.x = pk2(o[qs][c][0], o[qs][c][1]); w.y = pk2(o[qs][c][2], o[qs][c][3]); GST(u32x2, cat + 16 * c + 4 * quad) = w; }
    }
}

__device__ __forceinline__ void rwkv_item(const Params& p, unsigned char* smem, int b, int h, int tid) {
    const int lane = tid & 63, wave = tid >> 6, lq = lane & 15, quad = lane >> 4;
    constexpr int ZB = 3072;
    const bf16_t* Z = (const bf16_t*)(p.ws + OFF_Z) + (size_t)b * S_ * EIN;
    const float* mu = p.in[4];
    float* R = (float*)smem;
    float* KP = R + 2048; float* V = KP + 2048; float* DEC = V + 2048; float* NKK = DEC + 2048; float* KKA = NKK + 2048;
    float* GG = KKA + 2048; float* Y = GG + 2048; float* AA = Y + 2048; float* BC = AA + 2048;
    bf16_t* TW = (bf16_t*)(BC + 64);
    bf16_t* AL = TW + 32 * 72;
    bf16_t* GL = AL + 32 * 72;
    const int mt = wave >> 2, nt = wave & 3;
    const int chn = h * 64 + 16 * nt + lq;
    bf16x8 bw[2], ba[2], bg[4];
    {
        const float* wup = p.in[6]; const float* aup = p.in[8]; const float* gup = p.in[9];
#pragma unroll
        for (int ks = 0; ks < 2; ++ks) {
            float fw[8], fa[8];
#pragma unroll
            for (int i = 0; i < 8; ++i) { const int k = 32 * ks + quad * 8 + i; fw[i] = wup[(size_t)k * 1024 + chn]; fa[i] = aup[(size_t)k * 1024 + chn]; }
            u32x4 w; w.x = pk2(fw[0], fw[1]); w.y = pk2(fw[2], fw[3]); w.z = pk2(fw[4], fw[5]); w.w = pk2(fw[6], fw[7]); bw[ks] = as_bf16x8(w);
            u32x4 a; a.x = pk2(fa[0], fa[1]); a.y = pk2(fa[2], fa[3]); a.z = pk2(fa[4], fa[5]); a.w = pk2(fa[6], fa[7]); ba[ks] = as_bf16x8(a);
        }
#pragma unroll
        for (int ks = 0; ks < 4; ++ks) {
            float fg[8];
#pragma unroll
            for (int i = 0; i < 8; ++i) { const int k = 32 * ks + quad * 8 + i; fg[i] = gup[(size_t)k * 1024 + chn]; }
            u32x4 g; g.x = pk2(fg[0], fg[1]); g.y = pk2(fg[2], fg[3]); g.z = pk2(fg[4], fg[5]); g.w = pk2(fg[6], fg[7]); bg[ks] = as_bf16x8(g);
        }
    }
    const float w0c = p.in[5][chn], a0c = p.in[7][chn];
    const int cs = tid & 15, ttC = tid >> 4;
    const f32x4 kkc = *(const f32x4*)(p.in[10] + h * 64 + 4 * cs), kac = *(const f32x4*)(p.in[11] + h * 64 + 4 * cs), rkc = *(const f32x4*)(p.in[12] + h * 64 + 4 * cs);
    const f32x4 lng = *(const f32x4*)(p.in[13] + h * 64 + 4 * cs), lnb = *(const f32x4*)(p.in[14] + h * 64 + 4 * cs);
    const int js = tid & 15, rp = tid >> 4;
    f32x2 P[4];
#pragma unroll
    for (int e = 0; e < 4; ++e) P[e] = (f32x2){0.f, 0.f};
    bf16_t* cat = (bf16_t*)(p.ws + OFF_CAT) + (size_t)b * S_ * D_ + 1024 + h * 64;

    int a_off[4];
#pragma unroll
    for (int i = 0; i < 4; ++i) {
        const int idx = tid + 512 * i; const int tt = idx / 56, cv = idx % 56;
        int zc;
        if (cv < 8) zc = ZB + h * 64 + cv * 8;
        else if (cv < 16) zc = ZB + 1024 + h * 64 + (cv - 8) * 8;
        else if (cv < 24) zc = ZB + 2048 + h * 64 + (cv - 16) * 8;
        else zc = ZB + 3072 + (cv - 24) * 8;
        a_off[i] = (idx < 1792) ? (tt * EIN + zc) : zc;
    }
    u32x4 a_cur[4], a_prv[4];
#pragma unroll
    for (int i = 0; i < 4; ++i) {
        const bool act = (i < 3) || (tid < 256);
        a_cur[i] = (u32x4){0u, 0u, 0u, 0u}; a_prv[i] = (u32x4){0u, 0u, 0u, 0u};
        if (act) { a_cur[i] = GLD(u32x4, Z + a_off[i]); if (a_off[i] >= EIN) a_prv[i] = GLD(u32x4, Z + a_off[i] - EIN); }
    }
    for (int t0 = 0; t0 < S_; t0 += 32) {
        __syncthreads();
#pragma unroll
        for (int i = 0; i < 4; ++i) {
            const int idx = tid + 512 * i;
            if ((i < 3) || (tid < 256)) {
            const int tt = idx / 56, cv = idx % 56;
            const int zc = a_off[i] - tt * EIN;
            float cur[8], prv[8];
            unpack8(a_cur[i], cur); unpack8(a_prv[i], prv);
            const f32x4 m0 = GLD(f32x4, mu + (zc - ZB)), m1 = GLD(f32x4, mu + (zc - ZB) + 4);
            float val[8];
#pragma unroll
            for (int e = 0; e < 4; ++e) { val[e] = cur[e] + (prv[e] - cur[e]) * m0[e]; val[4 + e] = cur[4 + e] + (prv[4 + e] - cur[4 + e]) * m1[e]; }
            if (cv < 24) {
                float* dst = (cv < 8 ? R : (cv < 16 ? KP : V)) + tt * 64 + (cv & 7) * 8;
                *(f32x4*)dst = (f32x4){val[0], val[1], val[2], val[3]}; *(f32x4*)(dst + 4) = (f32x4){val[4], val[5], val[6], val[7]};
            } else {
                if (cv < 32) {
#pragma unroll
                    for (int e = 0; e < 8; ++e) { const float ex = fexp(2.f * val[e]); val[e] = 1.f - 2.f * frcp(ex + 1.f); } }
                else if (cv >= 40) {
#pragma unroll
                    for (int e = 0; e < 8; ++e) val[e] = sigmoidf_(val[e]); }
                u32x4 w; w.x = pk2(val[0], val[1]); w.y = pk2(val[2], val[3]); w.z = pk2(val[4], val[5]); w.w = pk2(val[6], val[7]);
                bf16_t* dst = (cv < 32) ? (TW + tt * 72 + (cv - 24) * 8) : ((cv < 40) ? (AL + tt * 72 + (cv - 32) * 8) : (GL + tt * 136 + (cv - 40) * 8));
                *(u32x4*)dst = w;
            }
            }
        }
        __syncthreads();
        if (t0 + 32 < S_) {
#pragma unroll
            for (int i = 0; i < 4; ++i) {
                if ((i < 3) || (tid < 256)) { const size_t o = (size_t)(t0 + 32) * EIN + a_off[i]; a_cur[i] = GLD(u32x4, Z + o); a_prv[i] = GLD(u32x4, Z + o - EIN); }
            }
        }
        {
            f32x4 cw = (f32x4){0.f, 0.f, 0.f, 0.f}, ca = cw, cg_ = cw;
#pragma unroll
            for (int ks = 0; ks < 2; ++ks) {
                const bf16x8 a1 = as_bf16x8(*(const u32x4*)(TW + (16 * mt + lq) * 72 + quad * 8 + 32 * ks));
                const bf16x8 a2 = as_bf16x8(*(const u32x4*)(AL + (16 * mt + lq) * 72 + quad * 8 + 32 * ks));
                cw = mfma16(a1, bw[ks], cw); ca = mfma16(a2, ba[ks], ca);
            }
#pragma unroll
            for (int ks = 0; ks < 4; ++ks) { const bf16x8 a3 = as_bf16x8(*(const u32x4*)(GL + (16 * mt + lq) * 136 + quad * 8 + 32 * ks)); cg_ = mfma16(a3, bg[ks], cg_); }
#pragma unroll
            for (int j = 0; j < 4; ++j) {
                const int tt = 16 * mt + 4 * quad + j, ch = 16 * nt + lq;
                const float wf = cw[j] + w0c;
                const float sp = (wf < -15.f) ? -wf : __logf(1.f + fexp(-wf));
                const float wv = -sp - 0.5f;
                DEC[tt * 64 + ch] = fexp(-fexp(wv));
                AA[tt * 64 + ch] = sigmoidf_(ca[j] + a0c);
                GG[tt * 64 + ch] = cg_[j];
            }
        }
        __syncthreads();
        {
            const f32x4 k4 = *(const f32x4*)(KP + ttC * 64 + 4 * cs), a4 = *(const f32x4*)(AA + ttC * 64 + 4 * cs), r4 = *(const f32x4*)(R + ttC * 64 + 4 * cs);
            f32x4 kkv; float ss = 0.f;
#pragma unroll
            for (int e = 0; e < 4; ++e) { kkv[e] = k4[e] * kkc[e]; ss += kkv[e] * kkv[e]; }
            ss = rowsum16(ss);
            const float inv = fminf(__builtin_amdgcn_rsqf(ss), 1e12f);
            f32x4 nk, ka, kp; float bc = 0.f;
#pragma unroll
            for (int e = 0; e < 4; ++e) { const float kk = kkv[e] * inv; nk[e] = -kk; ka[e] = kk * a4[e]; kp[e] = k4[e] * (1.f + (a4[e] - 1.f) * kac[e]); bc += r4[e] * kp[e] * rkc[e]; }
            bc = rowsum16(bc);
            *(f32x4*)(NKK + ttC * 64 + 4 * cs) = nk; *(f32x4*)(KKA + ttC * 64 + 4 * cs) = ka; *(f32x4*)(KP + ttC * 64 + 4 * cs) = kp;
            if (cs == 0) BC[ttC] = bc;
        }
        __syncthreads();
        {
            f32x4 nk = *(const f32x4*)(NKK + 4 * js), wd = *(const f32x4*)(DEC + 4 * js), ka = *(const f32x4*)(KKA + 4 * js);
            f32x4 kp = *(const f32x4*)(KP + 4 * js), rr = *(const f32x4*)(R + 4 * js);
            f32x2 vv = *(const f32x2*)(V + 2 * rp);
            float yq0 = 0.f, yq1 = 0.f;
#pragma unroll 8
            for (int tt = 0; tt < 32; ++tt) {
                const int tn = (tt < 31) ? tt + 1 : 31;
                const f32x4 nk2 = *(const f32x4*)(NKK + tn * 64 + 4 * js), wd2 = *(const f32x4*)(DEC + tn * 64 + 4 * js), ka2 = *(const f32x4*)(KKA + tn * 64 + 4 * js);
                const f32x4 kp2 = *(const f32x4*)(KP + tn * 64 + 4 * js), rr2 = *(const f32x4*)(R + tn * 64 + 4 * js);
                const f32x2 vv2 = *(const f32x2*)(V + tn * 64 + 2 * rp);
                f32x2 sa = (P[0] * nk[0] + P[1] * nk[1]) + (P[2] * nk[2] + P[3] * nk[3]);
                float sa0 = sa[0], sa1 = sa[1];
                rowsum16x4(sa0, sa1, yq0, yq1);
                if (tt > 0 && js == 0) { f32x2 yy; yy[0] = yq0; yy[1] = yq1; *(f32x2*)(Y + (tt - 1) * 64 + 2 * rp) = yy; }
                f32x2 sav; sav[0] = sa0; sav[1] = sa1;
#pragma unroll
                for (int e = 0; e < 4; ++e) P[e] = P[e] * wd[e] + (sav * ka[e] + vv * kp[e]);
                const f32x2 yv = (P[0] * rr[0] + P[1] * rr[1]) + (P[2] * rr[2] + P[3] * rr[3]);
                yq0 = yv[0]; yq1 = yv[1];
                nk = nk2; wd = wd2; ka = ka2; kp = kp2; rr = rr2; vv = vv2;
            }
            yq0 = rowsum16(yq0); yq1 = rowsum16(yq1);
            if (js == 0) { f32x2 yy; yy[0] = yq0; yy[1] = yq1; *(f32x2*)(Y + 31 * 64 + 2 * rp) = yy; }
        }
        __syncthreads();
        {
            const f32x4 y4 = *(const f32x4*)(Y + ttC * 64 + 4 * cs), v4 = *(const f32x4*)(V + ttC * 64 + 4 * cs), g4 = *(const f32x4*)(GG + ttC * 64 + 4 * cs);
            float sm = (y4[0] + y4[1]) + (y4[2] + y4[3]);
            sm = rowsum16(sm);
            const float mean = sm * (1.f / 64.f);
            float dv[4], sq = 0.f;
#pragma unroll
            for (int e = 0; e < 4; ++e) { dv[e] = y4[e] - mean; sq += dv[e] * dv[e]; }
            sq = rowsum16(sq);
            const float rstd = rsqrtf(sq * (1.f / 64.f) + 6.4e-4f);
            const float bc = BC[ttC];
            float ov[4];
#pragma unroll
            for (int e = 0; e < 4; ++e) ov[e] = (dv[e] * rstd * lng[e] + lnb[e] + bc * v4[e]) * g4[e];
            u32x2 w; w.x = pk2(ov[0], ov[1]); w.y = pk2(ov[2], ov[3]);
            GST(u32x2, cat + (size_t)(t0 + ttC) * D_ + 4 * cs) = w;
        }
    }
}

__device__ __forceinline__ void even_mixer_phase(const Params& p, unsigned char* smem, int tid, int bid, int nblk) {
    for (int rep = 0; rep < REP_RWKV; ++rep)
    for (int it = bid; it < 256; it += nblk) rwkv_item(p, smem, it >> 4, it & 15, tid);
    for (int rep = 0; rep < REP_MOBA; ++rep)
    for (int it = bid; it < 2048; it += nblk) {
        const int qt = 7 - (it >> 8), bh = it & 255;
        moba_item2(p, smem, bh >> 4, bh & 15, qt, tid);
    }
}

__device__ __forceinline__ void gelu_tanh4(f32x4& v) {
#pragma unroll
    for (int j = 0; j < 4; ++j) { const float x = v[j]; const float u = 0.7978845608028654f * (x + 0.044715f * x * x * x); const float ex = fexp(2.f * u); const float th = 1.f - 2.f * frcp(ex + 1.f); v[j] = 0.5f * x * (1.f + th); }
}

__device__ __forceinline__ void odd_prep_phase(const Params& p, unsigned char* smem, int tid, int bid, int nblk) {
    const int lane = tid & 63, wave = tid >> 6, lq = lane & 15, quad = lane >> 4;
    bf16_t* Z = (bf16_t*)(p.ws + OFF_Z);
    {
        const f32x2* rope = (const f32x2*)(p.ws + OFF_ROPE);
        const int half = nblk >> 1, nthreads = (nblk - half) * 512;
        for (int it = (bid >= half) ? (bid - half) * 512 + tid : T_ * 64; it < T_ * 64; it += nthreads) {
            const int row = it >> 6, wh = (it >> 2) & 15, cidx = it & 3;
            const int pos = row & (S_ - 1);
            bf16_t* base = Z + (size_t)row * OLD + wh * 64 + cidx * 8;
            float z1[8], z2[8];
            unpack8(GLD(u32x4, base), z1); unpack8(GLD(u32x4, base + 32), z2);
            float o1[8], o2[8];
#pragma unroll
            for (int e = 0; e < 8; ++e) { const f32x2 cs = GLD(f32x2, rope + pos * 32 + cidx * 8 + e); o1[e] = z1[e] * cs[0] - z2[e] * cs[1]; o2[e] = z1[e] * cs[1] + z2[e] * cs[0]; }
            u32x4 w1; w1.x = pk2(o1[0], o1[1]); w1.y = pk2(o1[2], o1[3]); w1.z = pk2(o1[4], o1[5]); w1.w = pk2(o1[6], o1[7]);
            u32x4 w2; w2.x = pk2(o2[0], o2[1]); w2.y = pk2(o2[2], o2[3]); w2.z = pk2(o2[4], o2[5]); w2.w = pk2(o2[6], o2[7]);
            GST(u32x4, base) = w1; GST(u32x4, base + 32) = w2;
        }
    }
    {
        const int gw = bid * 8 + wave, ngw = nblk * 8;
        bf16_t* hid = (bf16_t*)(smem + wave * (16 * 136 * 2));
        for (int task = gw; task < 1024; task += ngw) {
            const int kv = task >> 9, b = (task >> 5) & 15, g = (task >> 3) & 3, ct = task & 7;
            const bf16_t* Zs = Z + (size_t)b * S_ * OLD + (kv ? 4352 : 4096) + g * 64;
            const bf16_t* w1t = (const bf16_t*)(p.ws + (kv ? OFF_W1T_V : OFF_W1T_K));
            const bf16_t* w2t = (const bf16_t*)(p.ws + (kv ? OFF_W2T_V : OFF_W2T_K));
            const float* bias1 = (const float*)(p.ws + OFF_BIAS1) + kv * 128;
            f32x4 acc[8];
#pragma unroll
            for (int n = 0; n < 8; ++n) acc[n] = (f32x4){0.f, 0.f, 0.f, 0.f};
            const int c = ct * 16 + lq;
            bf16x8 a_c, b_c[8], a_n, b_n[8];
            auto cload = [&](int ks, bf16x8& a, bf16x8 (&bb)[8]) {
                const int l = ks >> 1, d0 = (ks & 1) * 32 + quad * 8;
                int row = 16 * c + l; row = row > 2047 ? 2047 : row;
                a = as_bf16x8(GLD(u32x4, Zs + (size_t)row * OLD + d0));
#pragma unroll
                for (int n = 0; n < 8; ++n) bb[n] = as_bf16x8(GLD(u32x4, w1t + (size_t)(16 * n + lq) * 2048 + ks * 32 + quad * 8));
            };
            cload(0, a_c, b_c);
            for (int ks = 0; ks < 64; ++ks) {
                if (ks + 1 < 64) cload(ks + 1, a_n, b_n);
#pragma unroll
                for (int n = 0; n < 8; ++n) acc[n] = mfma16(a_c, b_c[n], acc[n]);
                a_c = a_n;
#pragma unroll
                for (int n = 0; n < 8; ++n) b_c[n] = b_n[n];
            }
#pragma unroll
            for (int n = 0; n < 8; ++n) {
                const float bv = GLD(float, bias1 + 16 * n + lq);
                f32x4 hv = acc[n]; hv[0] += bv; hv[1] += bv; hv[2] += bv; hv[3] += bv;
                gelu_tanh4(hv);
#pragma unroll
                for (int j = 0; j < 4; ++j) { const unsigned pk = pk2(hv[j], 0.f); hid[(4 * quad + j) * 136 + 16 * n + lq] = (bf16_t)(pk & 0xffffu); }
            }
            lds_wait();
            f32x4 acc2[4];
#pragma unroll
            for (int n = 0; n < 4; ++n) acc2[n] = (f32x4){0.f, 0.f, 0.f, 0.f};
#pragma unroll
            for (int ks = 0; ks < 4; ++ks) {
                const bf16x8 a = as_bf16x8(*(const u32x4*)(hid + lq * 136 + quad * 8 + 32 * ks));
#pragma unroll
                for (int n = 0; n < 4; ++n) { const bf16x8 bb = as_bf16x8(GLD(u32x4, w2t + (size_t)(16 * n + lq) * 128 + ks * 32 + quad * 8)); acc2[n] = mfma16(a, bb, acc2[n]); }
            }
            lds_wait();
            bf16_t* dst = (bf16_t*)(p.ws + (kv ? OFF_VC : OFF_KC)) + (size_t)((b * 4 + g) * 128) * 64;
#pragma unroll
            for (int n = 0; n < 4; ++n)
#pragma unroll
                for (int j = 0; j < 4; ++j) {
                    const int cc = ct * 16 + 4 * quad + j;
                    const float v = (cc < 127) ? acc2[n][j] : 0.f;
                    GST(bf16_t, dst + (size_t)cc * 64 + 16 * n + lq) = (bf16_t)(pk2(v, 0.f) & 0xffffu);
                }
        }
    }
}

__device__ __forceinline__ void select_phase(const Params& p, unsigned char* smem, int tid, int bid, int nblk) {
    const int lane = tid & 63, wave = tid >> 6, lq = lane & 15, quad = lane >> 4;
    const bf16_t* Z = (const bf16_t*)(p.ws + OFF_Z);
    const int gw = bid * 8 + wave, ngw = nblk * 8;
    float* PS = (float*)(smem + wave * 2048);
    constexpr float SC = 0.125f * 1.4426950408889634f;
    for (int task = gw; task < 8192; task += ngw) {
        const int b = task >> 9, g = (task >> 7) & 3, qt = task & 127;
        const int t = qt * 16 + lq;
        const bf16_t* kc = (const bf16_t*)(p.ws + OFF_KC) + (size_t)((b * 4 + g) * 128) * 64;
        const int cmax = (t - 31) >> 4;
        f32x4 psum[8];
#pragma unroll
        for (int sub = 0; sub < 8; ++sub) psum[sub] = (f32x4){0.f, 0.f, 0.f, 0.f};
        bf16x8 kfr[8][2], qfr[4][2];
#pragma unroll
        for (int sub = 0; sub < 8; ++sub)
#pragma unroll
            for (int ks = 0; ks < 2; ++ks) kfr[sub][ks] = as_bf16x8(GLD(u32x4, kc + (size_t)(16 * sub + lq) * 64 + quad * 8 + 32 * ks));
#pragma unroll
        for (int r = 0; r < 4; ++r)
#pragma unroll
            for (int ks = 0; ks < 2; ++ks) qfr[r][ks] = as_bf16x8(GLD(u32x4, Z + (size_t)(b * S_ + t) * OLD + 3072 + (g * 4 + r) * 64 + quad * 8 + 32 * ks));
#pragma unroll
        for (int r = 0; r < 4; ++r) {
            f32x4 s[8]; float mx = -INFINITY;
#pragma unroll
            for (int sub = 0; sub < 8; ++sub) {
                s[sub] = (f32x4){0.f, 0.f, 0.f, 0.f};
#pragma unroll
                for (int ks = 0; ks < 2; ++ks) s[sub] = mfma16(kfr[sub][ks], qfr[r][ks], s[sub]);
#pragma unroll
                for (int j = 0; j < 4; ++j) { const int key = 16 * sub + 4 * quad + j; const float sv = (key <= cmax) ? s[sub][j] * SC : -INFINITY; s[sub][j] = sv; mx = fmaxf(mx, sv); }
            }
            mx = fmaxf(mx, __shfl_xor(mx, 16)); mx = fmaxf(mx, __shfl_xor(mx, 32));
            const float m_use = (mx == -INFINITY) ? 0.f : mx;
            float rs = 0.f;
#pragma unroll
            for (int sub = 0; sub < 8; ++sub)
#pragma unroll
                for (int j = 0; j < 4; ++j) { const float e = fexp2(s[sub][j] - m_use); s[sub][j] = e; rs += e; }
            rs += __shfl_xor(rs, 16); rs += __shfl_xor(rs, 32);
            const float inv = (rs > 0.f) ? 1.f / rs : 0.f;
#pragma unroll
            for (int sub = 0; sub < 8; ++sub)
#pragma unroll
                for (int j = 0; j < 4; ++j) psum[sub][j] += s[sub][j] * inv;
        }
        float pslc[8], tprev[8];
#pragma unroll
        for (int sub = 0; sub < 8; ++sub) tprev[sub] = __shfl(psum[sub][3], (lane + 48) & 63);
#pragma unroll
        for (int sub = 0; sub < 8; ++sub) {
            float extra;
            if (quad >= 1) extra = tprev[sub]; else extra = (sub >= 1) ? tprev[sub >= 1 ? sub - 1 : 0] : 0.f;
            pslc[sub] = ((psum[sub][0] + psum[sub][1]) + (psum[sub][2] + psum[sub][3])) + extra;
            PS[lq * 32 + 4 * sub + quad] = pslc[sub];
        }
        lds_wait();
        float pvv[32];
#pragma unroll
        for (int q = 0; q < 8; ++q) { const f32x4 v = *(const f32x4*)(PS + lq * 32 + 4 * q); pvv[4 * q] = v[0]; pvv[4 * q + 1] = v[1]; pvv[4 * q + 2] = v[2]; pvv[4 * q + 3] = v[3]; }
        lds_wait();
        const int own = t >> 6;
        unsigned bits = 0;
#pragma unroll
        for (int sub = 0; sub < 8; ++sub) {
            const int j = 4 * sub + quad; const float mv = pslc[sub];
            int cnt = 0;
#pragma unroll
            for (int j2 = 1; j2 < 32; ++j2) { const bool beats = (pvv[j2] > mv) || (pvv[j2] == mv && j2 < j); cnt += (j2 < own && j2 != j && beats) ? 1 : 0; }
            const bool sel = (j == 0) || (j == own) || (j >= 1 && j < own && cnt < 14);
            if (sel) bits |= (1u << j);
        }
        bits |= (unsigned)__shfl_xor((int)bits, 16); bits |= (unsigned)__shfl_xor((int)bits, 32);
        if (quad == 0) GST(unsigned, (unsigned*)(p.ws + OFF_SEL) + (size_t)(b * 4 + g) * S_ + t) = bits;
    }
}

__device__ __forceinline__ void nsa_item(const Params& p, unsigned char* smem, int b, int head, int qt, int tid) {
    const int lane = tid & 63, wave = tid >> 6, lq = lane & 15, quad = lane >> 4;
    const int g = head >> 2, q0 = qt * 128, t = q0 + wave * 16 + lq;
    const bf16_t* Z = (const bf16_t*)(p.ws + OFF_Z) + (size_t)b * S_ * OLD;
    const unsigned rowmask = GLD(unsigned, (const unsigned*)(p.ws + OFF_SEL) + (size_t)(b * 4 + g) * S_ + t);
    float gate[3];
#pragma unroll
    for (int i = 0; i < 3; ++i) gate[i] = sigmoidf_(bf2f(GLD(bf16_t, Z + (size_t)t * OLD + 5632 + head * 3 + i)));
    f32x4 o[4], tot[4];
    const bf16_t* kc = (const bf16_t*)(p.ws + OFF_KC) + (size_t)((b * 4 + g) * 128) * 64;
    const bf16_t* vc = (const bf16_t*)(p.ws + OFF_VC) + (size_t)((b * 4 + g) * 128) * 64;
#ifndef NSA_PASSES
#define NSA_PASSES 7
#endif
    if (NSA_PASSES & 1) attn_pass<M_CMP, 64>(smem, Z + 3072 + head * 64, OLD, kc, 64, vc, 64, q0, 0u, 0.f, o, tid);
    else { o[0] = o[1] = o[2] = o[3] = (f32x4){0.f, 0.f, 0.f, 0.f}; }
#pragma unroll
    for (int c = 0; c < 4; ++c) { tot[c][0] = gate[0] * o[c][0]; tot[c][1] = gate[0] * o[c][1]; tot[c][2] = gate[0] * o[c][2]; tot[c][3] = gate[0] * o[c][3]; }
    if (NSA_PASSES & 2) attn_pass<M_SLC, 64>(smem, Z + 3072 + head * 64, OLD, Z + 4608 + g * 64, OLD, Z + 4864 + g * 64, OLD, q0, rowmask, 0.f, o, tid);
#pragma unroll
    for (int c = 0; c < 4; ++c) { tot[c][0] += gate[1] * o[c][0]; tot[c][1] += gate[1] * o[c][1]; tot[c][2] += gate[1] * o[c][2]; tot[c][3] += gate[1] * o[c][3]; }
    if (NSA_PASSES & 4) attn_pass<M_WIN, 64>(smem, Z + 3072 + head * 64, OLD, Z + 5120 + g * 64, OLD, Z + 5376 + g * 64, OLD, q0, 0u, 0.f, o, tid);
#pragma unroll
    for (int c = 0; c < 4; ++c) { tot[c][0] += gate[2] * o[c][0]; tot[c][1] += gate[2] * o[c][1]; tot[c][2] += gate[2] * o[c][2]; tot[c][3] += gate[2] * o[c][3]; }
    bf16_t* cat = (bf16_t*)(p.ws + OFF_CAT) + (size_t)(b * S_ + t) * D_ + 1024 + head * 64;
#pragma unroll
    for (int c = 0; c < 4; ++c) { u32x2 w; w.x = pk2(tot[c][0], tot[c][1]); w.y = pk2(tot[c][2], tot[c][3]); GST(u32x2, cat + 16 * c + 4 * quad) = w; }
}


__device__ __forceinline__ void nsa_item2(const Params& p, unsigned char* smem, int b, int head, int qt, int tid) {
    const int lane = tid & 63, wave = tid >> 6, lq = lane & 15, quad = lane >> 4;
    const int g = head >> 2, q0 = qt * 256;
    int t[2]; t[0] = q0 + wave * 32 + lq; t[1] = t[0] + 16;
    const bf16_t* Z = (const bf16_t*)(p.ws + OFF_Z) + (size_t)b * S_ * OLD;
    unsigned rowmask[2], nomask[2] = {0u, 0u}; float gate[2][3];
#pragma unroll
    for (int qs = 0; qs < 2; ++qs) {
        rowmask[qs] = GLD(unsigned, (const unsigned*)(p.ws + OFF_SEL) + (size_t)(b * 4 + g) * S_ + t[qs]);
#pragma unroll
        for (int i = 0; i < 3; ++i) gate[qs][i] = sigmoidf_(bf2f(GLD(bf16_t, Z + (size_t)t[qs] * OLD + 5632 + head * 3 + i)));
    }
    f32x4 o[2][4];
    f32x4* tl = (f32x4*)(smem + 40960) + tid;
    const bf16_t* kc = (const bf16_t*)(p.ws + OFF_KC) + (size_t)((b * 4 + g) * 128) * 64;
    const bf16_t* vc = (const bf16_t*)(p.ws + OFF_VC) + (size_t)((b * 4 + g) * 128) * 64;
    attn_pass2<M_CMP, 64>(smem, Z + 3072 + head * 64, OLD, kc, 64, vc, 64, q0, nomask, 0.f, o, tid);
#pragma unroll
    for (int qs = 0; qs < 2; ++qs)
#pragma unroll
        for (int c = 0; c < 4; ++c) { f32x4 v; v[0] = gate[qs][0] * o[qs][c][0]; v[1] = gate[qs][0] * o[qs][c][1]; v[2] = gate[qs][0] * o[qs][c][2]; v[3] = gate[qs][0] * o[qs][c][3]; tl[(qs * 4 + c) * 512] = v; }
    attn_pass2<M_SLC, 64>(smem, Z + 3072 + head * 64, OLD, Z + 4608 + g * 64, OLD, Z + 4864 + g * 64, OLD, q0, rowmask, 0.f, o, tid);
#pragma unroll
    for (int qs = 0; qs < 2; ++qs)
#pragma unroll
        for (int c = 0; c < 4; ++c) { f32x4 v = tl[(qs * 4 + c) * 512]; v[0] += gate[qs][1] * o[qs][c][0]; v[1] += gate[qs][1] * o[qs][c][1]; v[2] += gate[qs][1] * o[qs][c][2]; v[3] += gate[qs][1] * o[qs][c][3]; tl[(qs * 4 + c) * 512] = v; }
    attn_pass2<M_WIN, 64>(smem, Z + 3072 + head * 64, OLD, Z + 5120 + g * 64, OLD, Z + 5376 + g * 64, OLD, q0, nomask, 0.f, o, tid);
#pragma unroll
    for (int qs = 0; qs < 2; ++qs) {
        bf16_t* cat = (bf16_t*)(p.ws + OFF_CAT) + (size_t)(b * S_ + t[qs]) * D_ + 1024 + head * 64;
#pragma unroll
        for (int c = 0; c < 4; ++c) {
            const f32x4 v = tl[(qs * 4 + c) * 512];
            const float r0 = v[0] + gate[qs][2] * o[qs][c][0], r1 = v[1] + gate[qs][2] * o[qs][c][1], r2 = v[2] + gate[qs][2] * o[qs][c][2], r3 = v[3] + gate[qs][2] * o[qs][c][3];
            u32x2 w; w.x = pk2(r0, r1); w.y = pk2(r2, r3); GST(u32x2, cat + 16 * c + 4 * quad) = w;
        }
    }
}

__device__ __forceinline__ void ret_item(const Params& p, unsigned char* smem, int b, int h, int qt, int tid) {
    const int lane = tid & 63, wave = tid >> 6, lq = lane & 15, quad = lane >> 4;
    const int q0 = qt * 128, t = q0 + wave * 16 + lq;
    const bf16_t* Z = (const bf16_t*)(p.ws + OFF_Z) + (size_t)b * S_ * OLD;
    const float log2g = log2f(1.f - exp2f(-5.f - (float)h));
    f32x4 o[8];
    attn_pass<M_RET, 128>(smem, Z + h * 64, OLD, Z + 512 + h * 64, OLD, Z + 1024 + h * 128, OLD, q0, 0u, log2g, o, tid);
    float sm = 0.f;
#pragma unroll
    for (int c = 0; c < 8; ++c) sm += (o[c][0] + o[c][1]) + (o[c][2] + o[c][3]);
    sm += __shfl_xor(sm, 16); sm += __shfl_xor(sm, 32);
    const float mean = sm * (1.f / 128.f);
    float sq = 0.f;
#pragma unroll
    for (int c = 0; c < 8; ++c)
#pragma unroll
        for (int j = 0; j < 4; ++j) { o[c][j] -= mean; sq += o[c][j] * o[c][j]; }
    sq += __shfl_xor(sq, 16); sq += __shfl_xor(sq, 32);
    const float rstd = rsqrtf(sq * (1.f / 128.f) + 1e-6f);
    const bf16_t* rg = Z + (size_t)t * OLD + 2048 + h * 128;
    bf16_t* cat = (bf16_t*)(p.ws + OFF_CAT) + (size_t)(b * S_ + t) * D_ + h * 128;
#pragma unroll
    for (int c = 0; c < 8; ++c) {
        const u32x2 gv = GLD(u32x2, rg + 16 * c + 4 * quad);
        const float g0 = __uint_as_float(gv.x << 16), g1 = __uint_as_float(gv.x & 0xffff0000u), g2 = __uint_as_float(gv.y << 16), g3 = __uint_as_float(gv.y & 0xffff0000u);
        const float r0 = g0 * sigmoidf_(g0) * o[c][0] * rstd, r1 = g1 * sigmoidf_(g1) * o[c][1] * rstd, r2 = g2 * sigmoidf_(g2) * o[c][2] * rstd, r3 = g3 * sigmoidf_(g3) * o[c][3] * rstd;
        u32x2 w; w.x = pk2(r0, r1); w.y = pk2(r2, r3);
        GST(u32x2, cat + 16 * c + 4 * quad) = w;
    }
}


__device__ __forceinline__ void ret_item2(const Params& p, unsigned char* smem, int b, int h, int qt, int tid) {
    const int q0 = qt * 256;
    const bf16_t* Z = (const bf16_t*)(p.ws + OFF_Z) + (size_t)b * S_ * OLD;
    const float log2g = log2f(1.f - exp2f(-5.f - (float)h));
    const unsigned nomask[2] = {0u, 0u};
    f32x4 o[2][8];
    attn_pass2<M_RET, 128>(smem, Z + h * 64, OLD, Z + 512 + h * 64, OLD, Z + 1024 + h * 128, OLD, q0, nomask, log2g, o, tid);
    int tid2 = tid; asm volatile("" : "+v"(tid2));
    const int lq2 = tid2 & 15, quad2 = (tid2 >> 4) & 3, wave2 = tid2 >> 6;
    int t2[2]; t2[0] = q0 + wave2 * 32 + lq2; t2[1] = t2[0] + 16;
#pragma unroll
    for (int qs = 0; qs < 2; ++qs) {
        float sm = 0.f;
#pragma unroll
        for (int c = 0; c < 8; ++c) sm += (o[qs][c][0] + o[qs][c][1]) + (o[qs][c][2] + o[qs][c][3]);
        sm += __shfl_xor(sm, 16); sm += __shfl_xor(sm, 32);
        const float mean = sm * (1.f / 128.f);
        float sq = 0.f;
#pragma unroll
        for (int c = 0; c < 8; ++c)
#pragma unroll
            for (int j = 0; j < 4; ++j) { o[qs][c][j] -= mean; sq += o[qs][c][j] * o[qs][c][j]; }
        sq += __shfl_xor(sq, 16); sq += __shfl_xor(sq, 32);
        const float rstd = rsqrtf(sq * (1.f / 128.f) + 1e-6f);
        const bf16_t* rg = Z + (size_t)t2[qs] * OLD + 2048 + h * 128;
        bf16_t* cat = (bf16_t*)(p.ws + OFF_CAT) + (size_t)(b * S_ + t2[qs]) * D_ + h * 128;
#pragma unroll
        for (int c = 0; c < 8; ++c) {
            const u32x2 gv = GLD(u32x2, rg + 16 * c + 4 * quad2);
            const float g0 = __uint_as_float(gv.x << 16), g1 = __uint_as_float(gv.x & 0xffff0000u), g2 = __uint_as_float(gv.y << 16), g3 = __uint_as_float(gv.y & 0xffff0000u);
            const float r0 = g0 * sigmoidf_(g0) * o[qs][c][0] * rstd, r1 = g1 * sigmoidf_(g1) * o[qs][c][1] * rstd, r2 = g2 * sigmoidf_(g2) * o[qs][c][2] * rstd, r3 = g3 * sigmoidf_(g3) * o[qs][c][3] * rstd;
            u32x2 w; w.x = pk2(r0, r1); w.y = pk2(r2, r3);
            GST(u32x2, cat + 16 * c + 4 * quad2) = w;
        }
    }
}

__device__ __forceinline__ void odd_mixer_phase(const Params& p, unsigned char* smem, int tid, int bid, int nblk) {
    for (int it = bid; it < 3072; it += nblk) {
        const int lvl = it / 384, r = it % 384, qt = 7 - lvl;
        int tid_i = tid; asm volatile("" : "+v"(tid_i));
        if (r < 128) ret_item2(p, smem, r >> 3, r & 7, qt, tid_i);
        else { const int bh = r - 128; nsa_item2(p, smem, bh >> 4, bh & 15, qt, tid_i); }
    }
}

#define XB_TMO      128
#define XB_XCNT(j)  (256  + 64 * (j))
#define XB_XSUB(j)  (1280 + 64 * (j))
#define XB_XGEN(j)  (2304 + 64 * (j))
#define XB_TOP      3328
#define XB_TOPGEN   3392
#define XCD_BAR_WORDS 3456
#define XB_SPIN_CAP (1u << 18)

__device__ __forceinline__ unsigned xb_ld(unsigned* p)              { return __hip_atomic_load(p, __ATOMIC_RELAXED, __HIP_MEMORY_SCOPE_AGENT); }
__device__ __forceinline__ unsigned xb_add(unsigned* p, unsigned v) { return __hip_atomic_fetch_add(p, v, __ATOMIC_RELAXED, __HIP_MEMORY_SCOPE_AGENT); }
__device__ __forceinline__ unsigned xb_xcc_id() { return (unsigned)__builtin_amdgcn_s_getreg((3 << 11) | 20) & 0xFu; }
#define XB_SPIN(cond, bar) do { unsigned _sp = 0; while (cond) { __builtin_amdgcn_s_sleep(1); \
    if ((++_sp & 255u) == 0u) { if (xb_ld(&(bar)[XB_TMO])) break; if (_sp > XB_SPIN_CAP) { atomicAdd(&(bar)[XB_TMO], 1u); break; } } } } while (0)

struct XcdBarrier {
    unsigned* bar; unsigned x;
    volatile LAS unsigned* st;
};

__device__ __forceinline__ XcdBarrier xcd_barrier_post(unsigned* bar, volatile LAS unsigned* st) {
    XcdBarrier b; b.bar = bar; b.x = xb_xcc_id(); b.st = st;
    if (threadIdx.x == 0) (void)xb_add(&bar[XB_XCNT(b.x)], 1u);
    return b;
}
__device__ __forceinline__ void xcd_barrier_complete(unsigned* bar, unsigned x, unsigned& nloc, unsigned& nx) {
    const unsigned G = gridDim.x * gridDim.y * gridDim.z;
    unsigned sum, cnt, mine, sp = 0u;
    for (;;) {
        sum = 0u; cnt = 0u; mine = 0u;
#pragma unroll
        for (unsigned j = 0; j < 16; ++j) { const unsigned c = xb_ld(&bar[XB_XCNT(j)]); sum += c; cnt += (c > 0u) ? 1u : 0u; mine = (j == x) ? c : mine; }
        if (sum == G) break;
        __builtin_amdgcn_s_sleep(1);
        if ((++sp & 255u) == 0u) { if (xb_ld(&bar[XB_TMO])) break; if (sp > XB_SPIN_CAP) { atomicAdd(&bar[XB_TMO], 1u); break; } }
    }
    nloc = mine > 0u ? mine : 1u; nx = cnt > 0u ? cnt : 1u;
}

__device__ __forceinline__ void xcd_barrier(const XcdBarrier& b) {
    asm volatile("s_waitcnt vmcnt(0)" ::: "memory");
    __syncthreads();
    if (threadIdx.x == 0) {
        unsigned* bar = b.bar;
        __builtin_amdgcn_s_waitcnt(0);
        unsigned nloc = b.st[0], nx = b.st[1];
        if (nloc == 0u) { xcd_barrier_complete(bar, b.x, nloc, nx); b.st[0] = nloc; b.st[1] = nx; }
        const unsigned old = xb_add(&bar[XB_XSUB(b.x)], 1u);
        const unsigned gen = old / nloc;
        if (old + 1u == (gen + 1u) * nloc) {
            __builtin_amdgcn_fence(__ATOMIC_RELEASE, "agent");
            asm volatile("s_waitcnt vmcnt(0)" ::: "memory");
            const unsigned og = xb_add(&bar[XB_TOP], 1u);
            const unsigned tg = og / nx;
            if (og + 1u == (tg + 1u) * nx) xb_add(&bar[XB_TOPGEN], 1u);
            else XB_SPIN(xb_ld(&bar[XB_TOPGEN]) == tg, bar);
            __builtin_amdgcn_fence(__ATOMIC_ACQUIRE, "agent");
            xb_add(&bar[XB_XGEN(b.x)], 1u);
            asm volatile("s_waitcnt vmcnt(0)" ::: "memory");
        } else {
            XB_SPIN(xb_ld(&bar[XB_XGEN(b.x)]) == gen, bar);
            __builtin_amdgcn_fence(__ATOMIC_ACQUIRE, "agent");
            asm volatile("s_waitcnt vmcnt(0)" ::: "memory");
        }
    }
    __syncthreads();
}

#ifndef ONLYMASK
#define ONLYMASK 0xFFFFFFu
#endif
#define PH_ON(n) ((ONLYMASK >> (n)) & 1u)
__device__ __forceinline__ const Params& opaque_params() {
    const Params* pp = (const Params*)__builtin_amdgcn_kernarg_segment_ptr(); asm volatile("" : "+s"(pp)); return *pp;
}
__device__ __forceinline__ void run_gemm(unsigned char* smem, int ph, int bid, int nblk) {
    const Params& p = opaque_params();
    unsigned char* ws = p.ws;
    pg8::Gemm g; EpiAll E; g.M = T_;
    E.O = (bf16_t*)(ws + OFF_Z); E.ldc = EIN; E.Xin = p.out; E.Xout = p.out; E.mode = 0;
    if (ph == 1) { g.A = (const bf16_t*)(ws + OFF_H); g.Bt = (const bf16_t*)(ws + OFF_WT_EIN); g.N = EIN; g.K = D_; E.mode = 0; E.ldc = EIN; }
    else if (ph == 9) { g.A = (const bf16_t*)(ws + OFF_H); g.Bt = (const bf16_t*)(ws + OFF_WT_OIN); g.N = OLD; g.K = D_; E.mode = 0; E.ldc = OLD; }
    else if (ph == 4) { g.A = (const bf16_t*)(ws + OFF_CAT); g.Bt = (const bf16_t*)(ws + OFF_WT_EOUT); g.N = D_; g.K = D_; E.mode = 1; E.Xin = p.in[0]; }
    else if (ph == 13) { g.A = (const bf16_t*)(ws + OFF_CAT); g.Bt = (const bf16_t*)(ws + OFF_WT_OOUT); g.N = D_; g.K = D_; E.mode = 1; }
    else if (ph == 7) { g.A = (const bf16_t*)(ws + OFF_Z); g.Bt = (const bf16_t*)(ws + OFF_WT2_0); g.N = D_; g.K = FF_; E.mode = 1; }
    else if (ph == 16) { g.A = (const bf16_t*)(ws + OFF_Z); g.Bt = (const bf16_t*)(ws + OFF_WT2_1); g.N = D_; g.K = FF_; E.mode = 1; }
    else if (ph == 6) { g.A = (const bf16_t*)(ws + OFF_H); g.Bt = (const bf16_t*)(ws + OFF_WT13_0); g.N = 2 * FF_; g.K = D_; E.mode = 2; }
    else { g.A = (const bf16_t*)(ws + OFF_H); g.Bt = (const bf16_t*)(ws + OFF_WT13_1); g.N = 2 * FF_; g.K = D_; E.mode = 2; }
    pg8::StaticOrder So; So.init(g.M, g.N, (int)nblk, (int)bid);
    pg8::gemm_phase2<EpiAll, pg8::StaticOrder, true, true>((PG8_LAS unsigned char*)smem, g, So, E);
}
__device__ __forceinline__ void run_norm(int ph, int tid, int bid, int nblk) {
    const Params& p = opaque_params();
    const int lane = tid & 63, wave = tid >> 6;
    const int gw = bid * 8 + wave, ngw = nblk * 8;
    bf16_t* H = (bf16_t*)(p.ws + OFF_H);
#ifdef SKEL
    if (ph == 17) rmsnorm_rows(p.in[0], p.in[27], nullptr, p.out, gw, ngw, lane);
    else if (ph == 5) {}
#else
    if (ph == 17) rmsnorm_rows(p.out, p.in[27], nullptr, p.out, gw, ngw, lane);
#endif
    else rmsnorm_rows(p.out, (ph == 8 ? p.in[1] + D_ : p.in[2] + (ph == 14 ? D_ : 0)), H, nullptr, gw, ngw, lane);
}
__global__ void __launch_bounds__(512, 2) mega(Params pk) {
    extern __shared__ __attribute__((aligned(16))) unsigned char smem[];
    cg::grid_group grid = cg::this_grid();
    {
        volatile LAS unsigned* st0 = (volatile LAS unsigned*)(smem + 131072);
        if (threadIdx.x == 0) { st0[0] = 0u; st0[1] = 0u; }
        __syncthreads();
        (void)xcd_barrier_post((unsigned*)(opaque_params().ws + OFF_BAR), st0);
    }
    const int ph_lo = ((const Params*)__builtin_amdgcn_kernarg_segment_ptr())->ph_lo, ph_hi = ((const Params*)__builtin_amdgcn_kernarg_segment_ptr())->ph_hi;
#pragma nounroll
    for (int ph = ph_lo; ph < ph_hi; ++ph) {
        int tid = threadIdx.x; asm volatile("" : "+v"(tid));
        int bid = __builtin_amdgcn_workgroup_id_x(); asm volatile("" : "+s"(bid));
        int nblk = (int)__builtin_amdgcn_grid_size_x() / 512; asm volatile("" : "+s"(nblk));
        if (ph == 0) { for (int rep = 0; rep < REP_P0; ++rep) { phase0(opaque_params(), smem, tid, bid, nblk); __syncthreads(); } }
        else if (ph == 2) { if (PH_ON(2)) kmean_phase(opaque_params(), tid, bid, nblk); }
        else if (ph == 3) { if (PH_ON(3)) even_mixer_phase(opaque_params(), smem, tid, bid, nblk); }
        else if (ph == 10) { if (PH_ON(10)) odd_prep_phase(opaque_params(), smem, tid, bid, nblk); }
        else if (ph == 11) { for (int rep = 0; rep < REP_SEL; ++rep) select_phase(opaque_params(), smem, tid, bid, nblk); }
        else if (ph == 12) { if (PH_ON(12)) odd_mixer_phase(opaque_params(), smem, tid, bid, nblk); }
#ifdef SKEL
        else if (ph == 17) { run_norm(ph, tid, bid, nblk); }
        else if (ph == 5 || ph == 8 || ph == 14) { }
#else
        else if (ph == 5 || ph == 8 || ph == 14 || ph == 17) { const int nrep = (ph == 5) ? REP_NORM : 1; for (int rep = 0; rep < nrep; ++rep) run_norm(ph, tid, bid, nblk); }
#endif
        else { const int nrep = (ph == 1 || ph == 6 || ph == 9 || ph == 15) ? REP_GEMM : 1; for (int rep = 0; rep < nrep; ++rep) { run_gemm(smem, ph, bid, nblk); __syncthreads(); } }
        if (ph + 1 < ph_hi) {
            if (ph == 0) grid.sync();
            else { XcdBarrier xb; xb.bar = (unsigned*)(opaque_params().ws + OFF_BAR); xb.x = xb_xcc_id(); xb.st = (volatile LAS unsigned*)(smem + 131072); xcd_barrier(xb); }
        }
    }
}

extern "C" void kernel_launch(void* const* d_in, const int* in_sizes, int n_in, void* d_out, int out_size, void* d_ws, size_t ws_size, hipStream_t stream) {
    static int grid = 0;
    if (grid == 0) {
        if (n_in != 28 || out_size != T_ * D_ || ws_size < WS_END) { fprintf(stderr, "kernel_launch: unexpected shapes (n_in %d out %d ws %zu need %zu)\n", n_in, out_size, ws_size, (size_t)WS_END); grid = -1; return; }
        int dev = 0, cus = 0, per_cu = 0;
        hipGetDevice(&dev);
        hipDeviceGetAttribute(&cus, hipDeviceAttributeMultiprocessorCount, dev);
        if (hipFuncSetAttribute((const void*)mega, hipFuncAttributeMaxDynamicSharedMemorySize, LDS_BYTES) != hipSuccess) { fprintf(stderr, "kernel_launch: hipFuncSetAttribute failed\n"); grid = -1; return; }
        hipOccupancyMaxActiveBlocksPerMultiprocessor(&per_cu, (const void*)mega, 512, LDS_BYTES);
        if (per_cu < 1) { fprintf(stderr, "kernel_launch: occupancy query says %d blocks per CU\n", per_cu); per_cu = 1; }
        (void)hipGetLastError();
        grid = cus;
    }
    if (grid < 0) return;
    Params p{};
    for (int i = 0; i < 28; ++i) p.in[i] = (const float*)d_in[i];
    p.out = (float*)d_out; p.ws = (unsigned char*)d_ws;
    for (int i = 0; i < 32; ++i) p.inv_freq[i] = pow(10000.0, -(double)i / 32.0);
    p.ph_lo = 0; p.ph_hi = NPHASE;
#ifdef ZEROCAT
    (void)hipMemsetAsync((char*)d_ws + OFF_CAT, 0, (size_t)T_ * D_ * 2, stream);
#endif
    if (hipMemsetAsync((char*)d_ws + OFF_BAR, 0, XCD_BAR_WORDS * sizeof(unsigned), stream) != hipSuccess) { fprintf(stderr, "kernel_launch: memset of barrier words failed\n"); return; }
    void* args[] = {&p};
    hipError_t e = hipLaunchCooperativeKernel((const void*)mega, dim3(grid), dim3(512), args, LDS_BYTES, stream);
    if (e != hipSuccess) fprintf(stderr, "kernel_launch: cooperative launch failed: %s (grid %d)\n", hipGetErrorString(e), grid);
}
```
